# Optimizing an MI355X kernel written in HIP

```python
import jax, jax.numpy as jnp
from jax import lax
import numpy as np

D_MODEL = 2048
BATCH = 4
SEQ = 2048
DEPTH = 2
DEC_BATCH = 128
DEC_SEQ = 1
PAST_LEN = 16384
PAGE_SIZE = 128

GROUP_WIDTH = D_MODEL // 4
SSD_WIDTH = GROUP_WIDTH
SSD_HEAD_DIM = 64
SSD_HEADS = SSD_WIDTH // SSD_HEAD_DIM
SSD_GROUPS = 2
SSD_STATE = 64
SSD_CONV = 4
SSD_CHUNK = 128
XBC_WIDTH = SSD_WIDTH + 2 * SSD_GROUPS * SSD_STATE
S5_WIDTH = GROUP_WIDTH
S5_CH = 16
S5_GROUPS = S5_WIDTH // S5_CH
S5_STATE = 64
SC_WIDTH = GROUP_WIDTH
SC_CONV = 3
POOL_WIDTH = GROUP_WIDTH
POOL_WINDOWS = (2, 4, 8, 16)
POOL_GROUP = POOL_WIDTH // len(POOL_WINDOWS)
POOL_HIST = max(POOL_WINDOWS) - 1
N_MEM = 256
XA_HEADS = 4
XA_HEAD_DIM = D_MODEL // XA_HEADS
D_FF = 4 * D_MODEL
EPS = 1e-6
IN_SPLIT_SIZES = (SSD_WIDTH, XBC_WIDTH, SSD_HEADS, S5_WIDTH, SC_WIDTH, SC_WIDTH, SC_WIDTH, POOL_WIDTH)
IN_WIDTH = sum(IN_SPLIT_SIZES)

kernel_name = 'hymba_ssd_s5_conv_pool_step'


def rmsnorm(x, g):
    xf = x.astype(jnp.float32)
    y = xf * lax.rsqrt(jnp.mean(xf * xf, axis=-1, keepdims=True) + EPS)
    return (y * g.astype(jnp.float32)).astype(x.dtype)


def split_cols(x, sizes):
    idx = np.cumsum(np.array(sizes))[:-1].tolist()
    return jnp.split(x, idx, axis=-1)


def causal_dwconv(full, w):
    ch = full.shape[-1]
    return lax.conv_general_dilated(full, w[:, None, :].astype(full.dtype), window_strides=(1,), padding='VALID',
                                    dimension_numbers=('NWC', 'WIO', 'NWC'), feature_group_count=ch)


def ssd_scan(xh, dt, a, bm, cm, h0):
    b, t, nh, hd = xh.shape
    ln = SSD_CHUNK if t % SSD_CHUNK == 0 else t
    nc = t // ln

    def chunks(v):
        return v.reshape((b, nc, ln) + v.shape[2:])

    xc, dtc, bc, cc = chunks(xh), chunks(dt), chunks(bm), chunks(cm)
    acum = jnp.cumsum(dtc * a, axis=2)
    causal = jnp.tril(jnp.ones((ln, ln), dtype=bool))[None, None, :, :, None]
    seg = acum[:, :, :, None, :] - acum[:, :, None, :, :]
    decay = jnp.exp(jnp.where(causal, seg, -jnp.inf))
    xdt = xc * dtc[..., None]
    scores = jnp.einsum('bclhn,bcshn->bclsh', cc, bc) * decay
    y_diag = jnp.einsum('bclsh,bcshp->bclhp', scores, xdt)
    to_end = jnp.exp(acum[:, :, -1:, :] - acum)
    chunk_states = jnp.einsum('bclhn,bclh,bclhp->bchpn', bc, to_end, xdt)
    chunk_decay = jnp.exp(acum[:, :, -1, :])

    def step(hc, inp):
        s_c, d_c = inp
        return hc * d_c[:, :, None, None] + s_c, hc

    h_last, h_prev = lax.scan(step, h0, (jnp.swapaxes(chunk_states, 0, 1), jnp.swapaxes(chunk_decay, 0, 1)))
    h_prev = jnp.swapaxes(h_prev, 0, 1)
    y_off = jnp.einsum('bclhn,bchpn,bclh->bclhp', cc, h_prev, jnp.exp(acum))
    return (y_diag + y_off).reshape(b, t, nh, hd), h_last


def _lin_combine(left, right):
    a_l, b_l = left
    a_r, b_r = right
    return a_r * a_l, a_r * b_l + b_r


def s5_mixer(u, h0_re, h0_im, p):
    f32 = jnp.float32
    b, t, _ = u.shape
    lam = lax.complex(p['s5_lam_re'].astype(f32), p['s5_lam_im'].astype(f32))
    delta = jnp.exp(p['s5_log_dt'].astype(f32))[:, None]
    abar = jnp.exp(lam * delta)
    bbar = ((abar - 1.0) / lam)[..., None] * lax.complex(p['s5_b_re'].astype(f32), p['s5_b_im'].astype(f32))
    cmat = lax.complex(p['s5_c_re'].astype(f32), p['s5_c_im'].astype(f32))
    ug = u.reshape(b, t, S5_GROUPS, S5_CH).astype(jnp.complex64)
    bu = jnp.einsum('gnk,btgk->btgn', bbar, ug)
    a_pow, hs = lax.associative_scan(_lin_combine, (jnp.broadcast_to(abar, bu.shape), bu), axis=1)
    hs = hs + a_pow * lax.complex(h0_re.astype(f32), h0_im.astype(f32))[:, None]
    y = jnp.real(jnp.einsum('gkn,btgn->btgk', cmat, hs)).reshape(b, t, S5_WIDTH) + p['s5_d'].astype(f32) * u
    y = jax.nn.gelu(y)
    y = y * jax.nn.sigmoid(y @ p['s5_w_glu'].astype(f32) + p['s5_b_glu'].astype(f32))
    h_end = hs[:, -1]
    return y, jnp.real(h_end), jnp.imag(h_end)


def pool_mixer(u, prev, start_pos, p):
    f32 = jnp.float32
    b, t, _ = u.shape
    full = jnp.concatenate([prev.astype(f32), u], axis=1)
    csum = jnp.concatenate([jnp.zeros((b, 1, POOL_WIDTH), f32), jnp.cumsum(full, axis=1)], axis=1)
    upto = csum[:, POOL_HIST + 1:]
    pos = start_pos + jnp.arange(t, dtype=jnp.int32)
    parts = []
    for g, w in enumerate(POOL_WINDOWS):
        cs = slice(g * POOL_GROUP, (g + 1) * POOL_GROUP)
        lo = csum[:, POOL_HIST + 1 - w: POOL_HIST + 1 - w + t, cs]
        cnt = jnp.minimum(w, pos + 1).astype(f32)[None, :, None]
        parts.append((upto[..., cs] - lo) / cnt - u[..., cs])
    pooled = jnp.stack(parts, axis=2)
    y = jnp.einsum('btgc,gcd->btgd', pooled, p['pool_w'].astype(f32)).reshape(b, t, POOL_WIDTH)
    return y * p['pool_scale'].astype(f32), full[:, -POOL_HIST:]


def memory_kv(mem, p):
    b, m, _ = mem.shape
    mn = rmsnorm(mem, p['norm_mem_g'])
    k = (mn @ p['w_k']).reshape(b, m, XA_HEADS, XA_HEAD_DIM)
    v = (mn @ p['w_v']).reshape(b, m, XA_HEADS, XA_HEAD_DIM)
    return k, v


def trunk_layer(h, mem_k, mem_v, st, start_pos, p):
    f32 = jnp.float32
    conv_prev, ssd_h0, s5_re0, s5_im0, sc_prev, pool_prev = st
    b, t, _ = h.shape
    xn = rmsnorm(h, p['norm_mix_g'])
    proj = (xn @ p['w_in']).astype(f32)
    z, xbc, dt_raw, u5, gate_b, gate_c, hv, upool = split_cols(proj, IN_SPLIT_SIZES)

    xbc_full = jnp.concatenate([conv_prev.astype(f32), xbc], axis=1)
    xbc_c = jax.nn.silu(causal_dwconv(xbc_full, p['ssd_conv_w'].astype(f32)) + p['ssd_conv_b'].astype(f32))
    xs, bm, cm = split_cols(xbc_c, (SSD_WIDTH, SSD_GROUPS * SSD_STATE, SSD_GROUPS * SSD_STATE))
    xs = xs.reshape(b, t, SSD_HEADS, SSD_HEAD_DIM)
    rep = SSD_HEADS // SSD_GROUPS
    bm = jnp.repeat(bm.reshape(b, t, SSD_GROUPS, SSD_STATE), rep, axis=2)
    cm = jnp.repeat(cm.reshape(b, t, SSD_GROUPS, SSD_STATE), rep, axis=2)
    dt = jax.nn.softplus(dt_raw + p['ssd_dt_bias'].astype(f32))
    a = -jnp.exp(p['ssd_a_log'].astype(f32))
    y_ssd, ssd_new = ssd_scan(xs, dt, a, bm, cm, ssd_h0.astype(f32))
    y_ssd = (y_ssd + p['ssd_d'].astype(f32)[:, None] * xs).reshape(b, t, SSD_WIDTH) * jax.nn.silu(z)

    y_s5, s5_re, s5_im = s5_mixer(u5, s5_re0, s5_im0, p)

    sc_full = jnp.concatenate([sc_prev.astype(f32), gate_c * hv], axis=1)
    y_sc = gate_b * causal_dwconv(sc_full, p['sc_conv_w'].astype(f32))

    y_pool, pool_new = pool_mixer(upool, pool_prev, start_pos, p)

    mix = jnp.concatenate([y_ssd, y_s5, y_sc, y_pool], axis=-1).reshape(b, t, 4, GROUP_WIDTH)
    mix = mix * lax.rsqrt(jnp.mean(mix * mix, axis=-1, keepdims=True) + EPS)
    mix = (mix * p['mix_out_g'].astype(f32).reshape(4, GROUP_WIDTH)).reshape(b, t, D_MODEL)
    h = h + mix.astype(h.dtype) @ p['w_out']

    q = (rmsnorm(h, p['norm_xa_g']) @ p['w_q']).reshape(b, t, XA_HEADS, XA_HEAD_DIM)
    s = jnp.einsum('bthd,bmhd->bhtm', q.astype(f32), mem_k.astype(f32)) * (XA_HEAD_DIM ** -0.5)
    prob = jax.nn.softmax(s, axis=-1)
    o = jnp.einsum('bhtm,bmhd->bthd', prob, mem_v.astype(f32)).reshape(b, t, D_MODEL)
    h = h + o.astype(h.dtype) @ p['w_o']

    xm = rmsnorm(h, p['norm_mlp_g'])
    h = h + jnp.square(jax.nn.relu(xm @ p['w_up'])) @ p['w_down']

    new_st = (xbc_full[:, -(SSD_CONV - 1):], ssd_new, s5_re, s5_im, sc_full[:, -(SC_CONV - 1):], pool_new)
    return h, new_st


def setup_inputs(seed: int = 0) -> dict:
    key = jax.random.key(seed)
    ks = iter(jax.random.split(key, 64))
    f32 = jnp.float32

    def nrm(shape, scale):
        return scale * jax.random.normal(next(ks), shape, f32)

    def gain(shape):
        return 1.0 + 0.02 * jax.random.normal(next(ks), shape, f32)

    def unif(shape, lo, hi):
        return jax.random.uniform(next(ks), shape, f32, minval=lo, maxval=hi)

    dt0 = jnp.exp(unif((DEPTH, SSD_HEADS), np.log(1e-3), np.log(1e-1)))
    lam_im0 = jnp.pi * jnp.arange(S5_STATE, dtype=f32)
    return {
        'x_prompt': nrm((BATCH, SEQ, D_MODEL), 1.0),
        'x_sample': nrm((DEC_BATCH, DEC_SEQ, D_MODEL), 1.0),
        'mem_prompt': nrm((BATCH, N_MEM, D_MODEL), 1.0),
        'state_ssd_conv': nrm((DEPTH, DEC_BATCH, SSD_CONV - 1, XBC_WIDTH), 1.0),
        'state_ssd': nrm((DEPTH, DEC_BATCH, SSD_HEADS, SSD_HEAD_DIM, SSD_STATE), 0.5),
        'state_s5_re': nrm((DEPTH, DEC_BATCH, S5_GROUPS, S5_STATE), 0.3),
        'state_s5_im': nrm((DEPTH, DEC_BATCH, S5_GROUPS, S5_STATE), 0.3),
        'state_sconv': nrm((DEPTH, DEC_BATCH, SC_CONV - 1, SC_WIDTH), 1.0),
        'state_pool': nrm((DEPTH, DEC_BATCH, POOL_HIST, POOL_WIDTH), 1.0),
        'cache_mem_k': nrm((DEPTH, DEC_BATCH, N_MEM, XA_HEADS, XA_HEAD_DIM), 1.0),
        'cache_mem_v': nrm((DEPTH, DEC_BATCH, N_MEM, XA_HEADS, XA_HEAD_DIM), 1.0),
        'norm_mix_g': gain((DEPTH, D_MODEL)),
        'w_in': nrm((DEPTH, D_MODEL, IN_WIDTH), D_MODEL ** -0.5),
        'ssd_conv_w': nrm((DEPTH, SSD_CONV, XBC_WIDTH), SSD_CONV ** -0.5),
        'ssd_conv_b': nrm((DEPTH, XBC_WIDTH), 0.02),
        'ssd_dt_bias': dt0 + jnp.log(-jnp.expm1(-dt0)),
        'ssd_a_log': jnp.log(unif((DEPTH, SSD_HEADS), 1.0, 16.0)),
        'ssd_d': gain((DEPTH, SSD_HEADS)),
        's5_lam_re': -0.5 + nrm((DEPTH, S5_GROUPS, S5_STATE), 0.01),
        's5_lam_im': lam_im0 + nrm((DEPTH, S5_GROUPS, S5_STATE), 0.01),
        's5_log_dt': unif((DEPTH, S5_GROUPS), np.log(1e-3), np.log(1e-1)),
        's5_b_re': nrm((DEPTH, S5_GROUPS, S5_STATE, S5_CH), (2 * S5_CH) ** -0.5),
        's5_b_im': nrm((DEPTH, S5_GROUPS, S5_STATE, S5_CH), (2 * S5_CH) ** -0.5),
        's5_c_re': nrm((DEPTH, S5_GROUPS, S5_CH, S5_STATE), S5_STATE ** -0.5),
        's5_c_im': nrm((DEPTH, S5_GROUPS, S5_CH, S5_STATE), S5_STATE ** -0.5),
        's5_d': nrm((DEPTH, S5_WIDTH), 1.0),
        's5_w_glu': nrm((DEPTH, S5_WIDTH, S5_WIDTH), S5_WIDTH ** -0.5),
        's5_b_glu': nrm((DEPTH, S5_WIDTH), 0.02),
        'sc_conv_w': nrm((DEPTH, SC_CONV, SC_WIDTH), SC_CONV ** -0.5),
        'pool_w': nrm((DEPTH, len(POOL_WINDOWS), POOL_GROUP, POOL_GROUP), POOL_GROUP ** -0.5),
        'pool_scale': 1.0 + nrm((DEPTH, POOL_WIDTH), 0.1),
        'mix_out_g': gain((DEPTH, D_MODEL)),
        'w_out': nrm((DEPTH, D_MODEL, D_MODEL), D_MODEL ** -0.5),
        'norm_xa_g': gain((DEPTH, D_MODEL)),
        'norm_mem_g': gain((DEPTH, D_MODEL)),
        'w_q': nrm((DEPTH, D_MODEL, D_MODEL), D_MODEL ** -0.5),
        'w_k': nrm((DEPTH, D_MODEL, D_MODEL), D_MODEL ** -0.5),
        'w_v': nrm((DEPTH, D_MODEL, D_MODEL), D_MODEL ** -0.5),
        'w_o': nrm((DEPTH, D_MODEL, D_MODEL), D_MODEL ** -0.5),
        'norm_mlp_g': gain((DEPTH, D_MODEL)),
        'w_up': nrm((DEPTH, D_MODEL, D_FF), D_MODEL ** -0.5),
        'w_down': nrm((DEPTH, D_FF, D_MODEL), D_FF ** -0.5),
        'final_norm_g': gain((D_MODEL,)),
    }


def reference(x_prompt, x_sample, mem_prompt, state_ssd_conv, state_ssd, state_s5_re, state_s5_im,
              state_sconv, state_pool, cache_mem_k, cache_mem_v, norm_mix_g, w_in, ssd_conv_w, ssd_conv_b,
              ssd_dt_bias, ssd_a_log, ssd_d, s5_lam_re, s5_lam_im, s5_log_dt, s5_b_re, s5_b_im, s5_c_re,
              s5_c_im, s5_d, s5_w_glu, s5_b_glu, sc_conv_w, pool_w, pool_scale, mix_out_g, w_out, norm_xa_g,
              norm_mem_g, w_q, w_k, w_v, w_o, norm_mlp_g, w_up, w_down, final_norm_g):
    f32 = jnp.float32
    stacked = dict(norm_mix_g=norm_mix_g, w_in=w_in, ssd_conv_w=ssd_conv_w, ssd_conv_b=ssd_conv_b,
                   ssd_dt_bias=ssd_dt_bias, ssd_a_log=ssd_a_log, ssd_d=ssd_d, s5_lam_re=s5_lam_re,
                   s5_lam_im=s5_lam_im, s5_log_dt=s5_log_dt, s5_b_re=s5_b_re, s5_b_im=s5_b_im,
                   s5_c_re=s5_c_re, s5_c_im=s5_c_im, s5_d=s5_d, s5_w_glu=s5_w_glu, s5_b_glu=s5_b_glu,
                   sc_conv_w=sc_conv_w, pool_w=pool_w, pool_scale=pool_scale, mix_out_g=mix_out_g,
                   w_out=w_out, norm_xa_g=norm_xa_g, norm_mem_g=norm_mem_g, w_q=w_q, w_k=w_k, w_v=w_v,
                   w_o=w_o, norm_mlp_g=norm_mlp_g, w_up=w_up, w_down=w_down)
    bp = x_prompt.shape[0]
    st_prompt = (jnp.zeros((bp, SSD_CONV - 1, XBC_WIDTH), f32),
                 jnp.zeros((bp, SSD_HEADS, SSD_HEAD_DIM, SSD_STATE), f32),
                 jnp.zeros((bp, S5_GROUPS, S5_STATE), f32),
                 jnp.zeros((bp, S5_GROUPS, S5_STATE), f32),
                 jnp.zeros((bp, SC_CONV - 1, SC_WIDTH), f32),
                 jnp.zeros((bp, POOL_HIST, POOL_WIDTH), f32))
    hp, hs = x_prompt, x_sample
    p_new, s_new, p_mk, p_mv = [], [], [], []
    for l in range(DEPTH):
        p = {name: arr[l] for name, arr in stacked.items()}
        mk, mv = memory_kv(mem_prompt, p)
        hp, st_p = trunk_layer(hp, mk, mv, st_prompt, 0, p)
        st_s_in = (state_ssd_conv[l], state_ssd[l], state_s5_re[l], state_s5_im[l], state_sconv[l], state_pool[l])
        hs, st_s = trunk_layer(hs, cache_mem_k[l], cache_mem_v[l], st_s_in, PAST_LEN, p)
        p_new.append(st_p)
        s_new.append(st_s)
        p_mk.append(mk)
        p_mv.append(mv)
    y_prompt = rmsnorm(hp, final_norm_g)
    y_sample = rmsnorm(hs, final_norm_g)
    p_ssd_conv, p_ssd, p_s5_re, p_s5_im, p_sconv, p_pool = [jnp.stack(c) for c in zip(*p_new)]
    s_ssd_conv, s_ssd, s_s5_re, s_s5_im, s_sconv, s_pool = [jnp.stack(c) for c in zip(*s_new)]
    p_mem_k = jnp.stack(p_mk)
    p_mem_v = jnp.stack(p_mv)
    return (y_prompt, y_sample, p_ssd_conv, p_ssd, p_s5_re, p_s5_im, p_sconv, p_pool, p_mem_k, p_mem_v,
            s_ssd_conv, s_ssd, s_s5_re, s_s5_im, s_sconv, s_pool)
```

```cpp
#include <hip/hip_runtime.h>
#include <cstdio>
#include <cstdint>
namespace pg8 {
#define PG8_LAS __attribute__((address_space(3)))
typedef unsigned short bf16_t;
typedef short bf16x8 __attribute__((ext_vector_type(8)));
typedef float f32x4 __attribute__((ext_vector_type(4)));
typedef unsigned u32x4 __attribute__((ext_vector_type(4)));
constexpr int BM = 256, BK = 64, HALF = 128, HTB = HALF * BK * 2  , STAGE_BYTES = 8 * HTB, NXCD = 8, WGM = 8;

__host__ __device__ __forceinline__ int lds_byte(int r, int c) { const int st = (r >> 4) * 2 + (c >> 5), rr = r & 15, cc = c & 31, ob = rr * 64 + cc * 2; return st * 1024 + (ob ^ (((ob >> 9) & 1) << 5)); }
__host__ __device__ __forceinline__ void stage_rc(int b, int& R, int& C) { const int st = b / 1024, sb = b % 1024, swz = sb ^ (((sb >> 9) & 1) << 5); R = (st >> 1) * 16 + swz / 64; C = (st & 1) * 32 + (swz % 64) / 2; }
__host__ __device__ __forceinline__ int perm32(int rho) { const int n = rho >> 4, i = rho & 15; return 8 * (i >> 2) + 4 * n + (i & 3); }

struct Unit { int pm, pn; };
struct Gemm { const bf16_t* A; const bf16_t* Bt; int M, N, K; };

struct StaticOrder {
    int nM, nN, nwg, G, c;
    __host__ __device__ void init(int M, int N, int G_, int c_) { nM = M / BM; nN = N / BM; nwg = nM * nN; G = G_; c = c_; }
    __host__ __device__ bool next(int i, Unit& u) const {
        const long L = (long)i * G + c; if (L >= nwg) return false;
        int wgid = (int)L; { const int q = nwg / NXCD, r = nwg % NXCD, xcd = wgid % NXCD, off = wgid / NXCD; wgid = (xcd < r ? xcd * (q + 1) : r * (q + 1) + (xcd - r) * q) + off; }
        const int nig = WGM * nN, gid = wgid / nig, fm = gid * WGM, gsz = (nM - fm) < WGM ? (nM - fm) : WGM;
        u.pm = fm + ((wgid % nig) % gsz); u.pn = (wgid % nig) / gsz; return true;
    }
    __device__ __forceinline__ void a_ready(const Unit&) const {}
    __device__ __forceinline__ void done(const Unit&) const {}
};


__device__ __forceinline__ unsigned cvt_pk_bf16(float lo, float hi) { unsigned r; asm volatile("v_cvt_pk_bf16_f32 %0, %1, %2" : "=v"(r) : "v"(lo), "v"(hi)); return r; }

template <int ACT> struct EpiScaleBf16 {
    static constexpr bool PERM = true, AFTER_DRAIN = false;
    bf16_t* O; int ldc; const float* ssq;
    __device__ __forceinline__ void operator()(const f32x4 (&acc)[2][2][4][2], const Unit& u, int wr, int wc, int fr, int fq) const {
        const int row0 = u.pm * BM + wr * 64 + fr, col0 = u.pn * BM + wc * 32 + 8 * fq;
#pragma unroll
        for (int ai = 0; ai < 2; ++ai)
#pragma unroll
            for (int m = 0; m < 4; ++m) { const int row = row0 + ai * HALF + m * 16; const float rs = __builtin_amdgcn_rsqf(ssq[row] * (1.0f / 2048.0f) + 1e-6f);
                bf16_t* rowp = O + (size_t)row * ldc + col0;
#pragma unroll
                for (int bj = 0; bj < 2; ++bj) { f32x4 v0 = acc[ai][bj][m][0] * rs, v1 = acc[ai][bj][m][1] * rs;
                    if (ACT == 1) {
#pragma unroll
                        for (int e = 0; e < 4; ++e) { const float a0 = v0[e] > 0.f ? v0[e] : 0.f, a1 = v1[e] > 0.f ? v1[e] : 0.f; v0[e] = a0 * a0; v1[e] = a1 * a1; } }
                    u32x4 w; w.x = cvt_pk_bf16(v0[0], v0[1]); w.y = cvt_pk_bf16(v0[2], v0[3]); w.z = cvt_pk_bf16(v1[0], v1[1]); w.w = cvt_pk_bf16(v1[2], v1[3]);
                    *(u32x4*)(rowp + bj * HALF) = w; } }
    }
};
struct EpiRes {
    static constexpr bool PERM = true, AFTER_DRAIN = false;
    float* h; bf16_t* hb; float* ssq_out; int ldc;
    __device__ __forceinline__ void operator()(const f32x4 (&acc)[2][2][4][2], const Unit& u, int wr, int wc, int fr, int fq) const {
        const int row0 = u.pm * BM + wr * 64 + fr, col0 = u.pn * BM + wc * 32 + 8 * fq;
#pragma unroll
        for (int ai = 0; ai < 2; ++ai)
#pragma unroll
            for (int m = 0; m < 4; ++m) { const int row = row0 + ai * HALF + m * 16; float sq = 0.f;
                float* hp = h + (size_t)row * ldc + col0; bf16_t* bp = hb + (size_t)row * ldc + col0;
#pragma unroll
                for (int bj = 0; bj < 2; ++bj) { f32x4 v0 = *(const f32x4*)(hp + bj * HALF) + acc[ai][bj][m][0], v1 = *(const f32x4*)(hp + bj * HALF + 4) + acc[ai][bj][m][1];
                    *(f32x4*)(hp + bj * HALF) = v0; *(f32x4*)(hp + bj * HALF + 4) = v1;
                    sq += (v0[0] * v0[0] + v0[1] * v0[1]) + (v0[2] * v0[2] + v0[3] * v0[3]) + (v1[0] * v1[0] + v1[1] * v1[1]) + (v1[2] * v1[2] + v1[3] * v1[3]);
                    u32x4 w; w.x = cvt_pk_bf16(v0[0], v0[1]); w.y = cvt_pk_bf16(v0[2], v0[3]); w.z = cvt_pk_bf16(v1[0], v1[1]); w.w = cvt_pk_bf16(v1[2], v1[3]);
                    *(u32x4*)(bp + bj * HALF) = w; }
                sq += __shfl_xor(sq, 16); sq += __shfl_xor(sq, 32);
                if (fq == 0) unsafeAtomicAdd(ssq_out + row, sq); }
    }
};
struct EpiKV {
    static constexpr bool PERM = true, AFTER_DRAIN = false;
    float* outk; size_t voff; bf16_t* kb; bf16_t* vt; const float* rstd;
    __device__ __forceinline__ void operator()(const f32x4 (&acc)[2][2][4][2], const Unit& u, int wr, int wc, int fr, int fq) const {
        const int row0 = u.pm * BM + wr * 64 + fr; const int colt = u.pn * BM, which = colt >> 11, l = which >> 1, isv = which & 1;
        const int col0 = (colt & 2047) + wc * 32 + 8 * fq;
#pragma unroll
        for (int ai = 0; ai < 2; ++ai)
#pragma unroll
            for (int m = 0; m < 4; ++m) { const int row = row0 + ai * HALF + m * 16; const float rs = rstd[row];
#pragma unroll
                for (int bj = 0; bj < 2; ++bj) { const f32x4 v0 = acc[ai][bj][m][0] * rs, v1 = acc[ai][bj][m][1] * rs; const int col = col0 + bj * HALF;
                    float* op = outk + (isv ? voff : (size_t)0) + ((size_t)l * 1024 + row) * 2048 + col;
                    *(f32x4*)op = v0; *(f32x4*)(op + 4) = v1;
                    if (!isv) { u32x4 w; w.x = cvt_pk_bf16(v0[0], v0[1]); w.y = cvt_pk_bf16(v0[2], v0[3]); w.z = cvt_pk_bf16(v1[0], v1[1]); w.w = cvt_pk_bf16(v1[2], v1[3]);
                        *(u32x4*)(kb + ((size_t)l * 1024 + row) * 2048 + col) = w; }
                    else { const int b = row >> 8, mm = row & 255; bf16_t* vp = vt + (((size_t)l * 4 + b) * 2048 + col) * 256 + mm;
#pragma unroll
                        for (int e = 0; e < 4; ++e) { vp[(size_t)e * 256] = (bf16_t)(cvt_pk_bf16(v0[e], 0.f) & 0xffffu); vp[(size_t)(e + 4) * 256] = (bf16_t)(cvt_pk_bf16(v1[e], 0.f) & 0xffffu); } } } }
    }
};
template <class Epi, class Sched, bool ALIGN_EPI = false, bool SP2 = false>
__device__ __forceinline__ void gemm_phase(PG8_LAS unsigned char* lds, const Gemm g, const Sched& S, const Epi& E, int tid) {
    asm volatile("" : "+v"(tid));
    const int wid = __builtin_amdgcn_readfirstlane(tid >> 6), lane = tid & 63, wr = wid >> 2, wc = wid & 3, fr = lane & 15, fq = lane >> 4;
    const int K = g.K, nt = K / BK;
    unsigned voffA[2], voffB[2];
#pragma unroll
    for (int i = 0; i < 2; ++i) { int R, C; stage_rc(tid * 16 + i * 8192, R, C); const int Rb = Epi::PERM ? ((R & ~31) + perm32(R & 31)) : R;
        voffA[i] = (unsigned)(R * K + C) * 2u; voffB[i] = (unsigned)(Rb * K + C) * 2u; }
    const size_t kstep = (size_t)(BK * 2);
    const size_t hstep = (size_t)HALF * K * 2;
    const size_t tstep = 2 * hstep;
    const unsigned ldsw = (unsigned)wid * 1024u;
    const int aoff = lds_byte(wr * 64 + fr, fq * 8), boff = lds_byte(wc * 32 + fr, fq * 8);
#define PG8_SA(b, h) (((b) * 2 + (h)) * HTB)
#define PG8_SB(b, h) ((4 + (b) * 2 + (h)) * HTB)
#define PG8_STAGE(bufoff, gbase, voff) do { _Pragma("unroll") for (int _i = 0; _i < 2; ++_i) \
        __builtin_amdgcn_global_load_lds((const unsigned*)((const char*)(gbase) + (voff)[_i]), (PG8_LAS unsigned*)(lds + (bufoff) + ldsw + _i * 8192), 16, 0, 0); } while (0)
#define PG8_LDA(dst, b, h) do { _Pragma("unroll") for (int m = 0; m < 4; ++m) _Pragma("unroll") for (int k = 0; k < 2; ++k) dst[m][k] = *(const PG8_LAS bf16x8*)(lds + PG8_SA(b, h) + aoff + m * 2048 + k * 1024); } while (0)
#define PG8_LDB(dst, b, h) do { _Pragma("unroll") for (int n = 0; n < 2; ++n) _Pragma("unroll") for (int k = 0; k < 2; ++k) dst[n][k] = *(const PG8_LAS bf16x8*)(lds + PG8_SB(b, h) + boff + n * 2048 + k * 1024); } while (0)
#define PG8_MMA(ai, bj, At, Bt) do { __builtin_amdgcn_s_setprio(1); _Pragma("unroll") for (int m = 0; m < 4; ++m) _Pragma("unroll") for (int n = 0; n < 2; ++n) _Pragma("unroll") for (int k = 0; k < 2; ++k) \
        acc[ai][bj][m][n] = __builtin_amdgcn_mfma_f32_16x16x32_bf16(Bt[n][k], At[m][k], acc[ai][bj][m][n], 0, 0, 0); __builtin_amdgcn_s_setprio(0); } while (0)
#define PG8_WAIT_V(n) asm volatile("s_waitcnt vmcnt(" #n ")" ::: "memory")
#define PG8_WAIT_L(n) asm volatile("s_waitcnt lgkmcnt(" #n ")" ::: "memory")
#define PG8_BAR __builtin_amdgcn_s_barrier()
#define PG8_SCHED __builtin_amdgcn_sched_barrier(0)
    Unit cur, nxt; int ui = 0;
    if (!S.next(0, cur)) return;
    f32x4 acc[2][2][4][2];
#pragma unroll
    for (int a = 0; a < 2; ++a)
#pragma unroll
        for (int b = 0; b < 2; ++b)
#pragma unroll
            for (int m = 0; m < 4; ++m)
#pragma unroll
                for (int n = 0; n < 2; ++n) acc[a][b][m][n] = (f32x4){0.f, 0.f, 0.f, 0.f};
    bf16x8 At[4][2], B0[2][2], B1[2][2];
    const char* cA = (const char*)g.A + (size_t)cur.pm * tstep; const char* cB = (const char*)g.Bt + (size_t)cur.pn * tstep;
    S.a_ready(cur);
    if constexpr (SP2) {
        PG8_STAGE(PG8_SB(0, 0), cB, voffB); PG8_STAGE(PG8_SB(0, 1), cB + hstep, voffB); PG8_STAGE(PG8_SA(0, 0), cA, voffA); PG8_STAGE(PG8_SA(0, 1), cA + hstep, voffA);
        if (wr == 1) PG8_BAR;
        PG8_WAIT_V(2); PG8_BAR;
        PG8_STAGE(PG8_SB(1, 0), cB + kstep, voffB); PG8_STAGE(PG8_SA(1, 0), cA + kstep, voffA); PG8_STAGE(PG8_SB(1, 1), cB + hstep + kstep, voffB);
        PG8_WAIT_V(6); PG8_BAR;
    } else {
        PG8_STAGE(PG8_SB(0, 0), cB, voffB); PG8_STAGE(PG8_SA(0, 0), cA, voffA); PG8_STAGE(PG8_SB(0, 1), cB + hstep, voffB); PG8_STAGE(PG8_SA(0, 1), cA + hstep, voffA);
        if (wr == 1) PG8_BAR;
        PG8_WAIT_V(4); PG8_BAR;
        PG8_STAGE(PG8_SB(1, 0), cB + kstep, voffB); PG8_STAGE(PG8_SA(1, 0), cA + kstep, voffA); PG8_STAGE(PG8_SB(1, 1), cB + hstep + kstep, voffB);
        PG8_WAIT_V(6); PG8_BAR;
    }
    for (;;) {
        const bool has_next = S.next(ui + 1, nxt);
        const char* nA = has_next ? (const char*)g.A + (size_t)nxt.pm * tstep : cA; const char* nB = has_next ? (const char*)g.Bt + (size_t)nxt.pn * tstep : cB;
        for (int t = 0; t < nt; t += 2) {
            const bool last = (t == nt - 2);
            const char* a1 = cA + (size_t)(t + 1) * kstep;
            const char* a2 = last ? nA : cA + (size_t)(t + 2) * kstep; const char* b2 = last ? nB : cB + (size_t)(t + 2) * kstep;
            const char* a3 = a2 + kstep; const char* b3 = b2 + kstep;
            if (last && has_next) S.a_ready(nxt);
            if constexpr (SP2) {
            PG8_LDB(B0, 0, 0); PG8_LDB(B1, 0, 1); PG8_SCHED; PG8_LDA(At, 0, 0); PG8_STAGE(PG8_SA(1, 1), a1 + hstep, voffA);
            PG8_WAIT_V(8); PG8_WAIT_L(0); PG8_BAR; PG8_MMA(0, 0, At, B0); PG8_MMA(0, 1, At, B1); PG8_BAR; PG8_SCHED;
            PG8_LDA(At, 0, 1); PG8_STAGE(PG8_SB(0, 0), b2, voffB); PG8_STAGE(PG8_SB(0, 1), b2 + hstep, voffB); PG8_STAGE(PG8_SA(0, 0), a2, voffA);
            PG8_WAIT_V(8); PG8_WAIT_L(0); PG8_BAR; PG8_MMA(1, 0, At, B0); PG8_MMA(1, 1, At, B1); PG8_BAR; PG8_SCHED;
            PG8_LDB(B0, 1, 0); PG8_LDB(B1, 1, 1); PG8_SCHED; PG8_LDA(At, 1, 0); PG8_STAGE(PG8_SA(0, 1), a2 + hstep, voffA);
            PG8_WAIT_V(8); PG8_WAIT_L(0); PG8_BAR; PG8_MMA(0, 0, At, B0); PG8_MMA(0, 1, At, B1); PG8_BAR; PG8_SCHED;
            PG8_LDA(At, 1, 1); PG8_STAGE(PG8_SB(1, 0), b3, voffB); PG8_STAGE(PG8_SB(1, 1), b3 + hstep, voffB); PG8_STAGE(PG8_SA(1, 0), a3, voffA);
            PG8_WAIT_V(8); PG8_WAIT_L(0); PG8_BAR; PG8_MMA(1, 0, At, B0); PG8_MMA(1, 1, At, B1); PG8_BAR; PG8_SCHED;
            } else {
            PG8_LDB(B0, 0, 0); PG8_SCHED; PG8_LDA(At, 0, 0); PG8_STAGE(PG8_SA(1, 1), a1 + hstep, voffA);
            PG8_WAIT_L(8); PG8_BAR; PG8_WAIT_L(0); PG8_MMA(0, 0, At, B0); PG8_BAR; PG8_SCHED;
            PG8_LDB(B1, 0, 1); PG8_STAGE(PG8_SB(0, 0), b2, voffB);
            PG8_BAR; PG8_WAIT_L(0); PG8_MMA(0, 1, At, B1); PG8_BAR;
            PG8_LDA(At, 0, 1); PG8_STAGE(PG8_SA(0, 0), a2, voffA);
            PG8_BAR; PG8_WAIT_L(0); PG8_MMA(1, 0, At, B0); PG8_BAR; PG8_SCHED;
            PG8_STAGE(PG8_SB(0, 1), b2 + hstep, voffB);
            PG8_WAIT_V(6); PG8_BAR; PG8_MMA(1, 1, At, B1); PG8_BAR;
            PG8_LDB(B0, 1, 0); PG8_SCHED; PG8_LDA(At, 1, 0); PG8_STAGE(PG8_SA(0, 1), a2 + hstep, voffA);
            PG8_WAIT_L(8); PG8_BAR; PG8_WAIT_L(0); PG8_MMA(0, 0, At, B0); PG8_BAR; PG8_SCHED;
            PG8_LDB(B1, 1, 1); PG8_STAGE(PG8_SB(1, 0), b3, voffB);
            PG8_BAR; PG8_WAIT_L(0); PG8_MMA(0, 1, At, B1); PG8_BAR;
            PG8_LDA(At, 1, 1); PG8_STAGE(PG8_SA(1, 0), a3, voffA);
            PG8_BAR; PG8_WAIT_L(0); PG8_MMA(1, 0, At, B0); PG8_BAR; PG8_SCHED;
            PG8_STAGE(PG8_SB(1, 1), b3 + hstep, voffB);
            PG8_WAIT_V(6); PG8_BAR; PG8_MMA(1, 1, At, B1); PG8_BAR;
            }
        }
        if constexpr (ALIGN_EPI) { if (wr == 0) PG8_BAR; }
        if constexpr (!Epi::AFTER_DRAIN) { E(acc, cur, wr, wc, fr, fq); S.done(cur); }
        if (!has_next) break;
#pragma unroll
        for (int a = 0; a < 2; ++a)
#pragma unroll
            for (int b = 0; b < 2; ++b)
#pragma unroll
                for (int m = 0; m < 4; ++m)
#pragma unroll
                    for (int n = 0; n < 2; ++n) acc[a][b][m][n] = (f32x4){0.f, 0.f, 0.f, 0.f};
        cur = nxt; cA = nA; cB = nB; ++ui;
        if constexpr (ALIGN_EPI) { if (wr == 1) PG8_BAR; }
    }
    PG8_WAIT_V(0);
    if constexpr (!ALIGN_EPI) { if (wr == 0) PG8_BAR; }
    PG8_BAR;
    if constexpr (Epi::AFTER_DRAIN) { E.fused(acc, cur, wr, wc, fr, fq, lds, wid, lane); S.done(cur); }
#undef PG8_SA
#undef PG8_SB
#undef PG8_STAGE
#undef PG8_LDA
#undef PG8_LDB
#undef PG8_MMA
#undef PG8_WAIT_V
#undef PG8_WAIT_L
#undef PG8_BAR
#undef PG8_SCHED
}
}

constexpr int NWAVES = 8, NTHR = NWAVES * 64;
#ifndef MK_PER_PHASE
#define MK_PER_PHASE 0
#endif

constexpr int D = 2048, NB = 4, T = 2048, MP = NB * T, MS = 128, MR = MP + MS, MPAD = 8448, NL = 2;
constexpr int NIN = 3840, INW = 3848, FF = 8192, NMEM = 256, MROWS = NB * NMEM, NHX = 4, HDX = 512;
constexpr int C_Z = 0, C_XBC = 512, C_BM = 1024, C_CM = 1152, C_U5 = 1280, C_GB = 1792, C_GC = 2304, C_HV = 2816, C_UP = 3328;
constexpr float EPS = 1e-6f;
constexpr int SSD_L = 64, SSD_NC = T / SSD_L;
constexpr int S5_L = 32, S5_NC = T / S5_L;

constexpr size_t O_YP = 0, O_YS = O_YP + (size_t)MP * D, O_PCONV = O_YS + (size_t)MS * D, O_PSSD = O_PCONV + NL * NB * 3 * 768, O_PS5R = O_PSSD + NL * NB * 8 * 4096,
    O_PS5I = O_PS5R + NL * NB * 2048, O_PSC = O_PS5I + NL * NB * 2048, O_PPOOL = O_PSC + NL * NB * 2 * 512, O_PMK = O_PPOOL + NL * NB * 15 * 512, O_PMV = O_PMK + (size_t)NL * MROWS * D,
    O_SCONV = O_PMV + (size_t)NL * MROWS * D, O_SSSD = O_SCONV + NL * MS * 3 * 768, O_SS5R = O_SSSD + (size_t)NL * MS * 8 * 4096, O_SS5I = O_SS5R + NL * MS * 2048, O_SSC = O_SS5I + NL * MS * 2048,
    O_SPOOL = O_SSC + NL * MS * 2 * 512, O_END = O_SPOOL + NL * MS * 15 * 512;
static_assert(O_END == 38066176, "output size");

enum In { I_XP = 0, I_XS, I_MEM, I_ST_CONV, I_ST_SSD, I_ST_S5R, I_ST_S5I, I_ST_SC, I_ST_POOL, I_CK, I_CV, I_G_MIX, I_W_IN, I_CONV_W, I_CONV_B, I_DT_BIAS, I_A_LOG, I_SSD_D,
          I_LAM_RE, I_LAM_IM, I_LOG_DT, I_B_RE, I_B_IM, I_C_RE, I_C_IM, I_S5_D, I_W_GLU, I_B_GLU, I_SC_W, I_POOL_W, I_POOL_SCALE, I_G_MIXOUT, I_W_OUT, I_G_XA, I_G_MEM,
          I_W_Q, I_W_K, I_W_V, I_W_O, I_G_MLP, I_W_UP, I_W_DOWN, I_G_FINAL, N_IN };
static_assert(N_IN == 43, "inputs");

constexpr size_t MiB = 1u << 20;
constexpr size_t WS_CTL = 0, CTL_ZERO_BYTES = 1 * MiB;
constexpr int CW_TMO = 0, CW_BAR = 4096, CW_SSQ = 16384;
static_assert((CW_SSQ + 7 * MPAD) * 4 <= (int)CTL_ZERO_BYTES, "ctl");
constexpr size_t WS_TAB = 1 * MiB, TAB_L = 2 * MiB;
constexpr size_t TB_ABAR = 0, TB_ABARL = 16384, TB_BBAR = 32768, TB_CMT = TB_BBAR + 262144, TB_WDT = TB_CMT + 131072, TB_WGLUT = TB_WDT + 65536, TB_WPT = TB_WGLUT + 524288, TB_END = TB_WPT + 131072;
static_assert(TB_END <= TAB_L, "tables");
constexpr size_t WS_W = 8 * MiB, W_L = 104 * MiB;
constexpr size_t WO_IN = 0, WO_OUT = 15 * MiB, WO_Q = 23 * MiB, WO_O = 31 * MiB, WO_UP = 39 * MiB, WO_DOWN = 71 * MiB;
static_assert(WO_DOWN + 32 * MiB <= W_L && (size_t)NIN * D * 2 == 15 * MiB, "weights");
constexpr size_t WS_WKV = WS_W + 2 * W_L;
constexpr size_t WS_H = 256 * MiB, WS_HB = 322 * MiB, WS_PROJ = 356 * MiB, WS_MIX = 418 * MiB, WS_Q = 452 * MiB, WS_O = 486 * MiB, WS_HID = 520 * MiB,
    WS_MEMB = 652 * MiB, WS_KB = 656 * MiB, WS_VT = 664 * MiB, WS_DTV = 672 * MiB, WS_RSTDM = 673 * MiB, WS_SS = 674 * MiB, WS_CD = 690 * MiB, WS_S5ER = 691 * MiB, WS_S5EI = 693 * MiB, WS_END = 696 * MiB;
static_assert(WS_WKV + 32 * MiB <= WS_H && WS_H + (size_t)MPAD * D * 4 <= WS_HB && WS_HB + (size_t)MPAD * D * 2 <= WS_PROJ && WS_PROJ + (size_t)MPAD * NIN * 2 <= WS_MIX, "ws map 1");
static_assert(WS_HID + (size_t)MPAD * FF * 2 <= WS_MEMB && WS_SS + (size_t)NB * SSD_NC * 8 * 4096 * 4 <= WS_CD && WS_S5ER + (size_t)NB * S5_NC * 2048 * 4 <= WS_S5EI, "ws map 2");

constexpr int RING_OFF = 0, RING_BYTES = 131072;
constexpr int LDSCTL_OFF = RING_BYTES, MISC_OFF = LDSCTL_OFF + 320;
constexpr int LDS_BYTES = 147456;
static_assert(MISC_OFF + 128 <= LDS_BYTES, "LDS map");
#define GAS __attribute__((address_space(1)))
#define LAS __attribute__((address_space(3)))
typedef unsigned short bf16;
typedef unsigned v4u __attribute__((ext_vector_type(4)));
typedef float f32x4 __attribute__((ext_vector_type(4)));
typedef short bf16x8 __attribute__((ext_vector_type(8)));
typedef GAS unsigned gu32;
typedef GAS unsigned long long gu64;
#define RLX_AGENT __ATOMIC_RELAXED, __HIP_MEMORY_SCOPE_AGENT
#define LDS_WAIT() asm volatile("s_waitcnt lgkmcnt(0)" ::: "memory")
#define VM_WAIT() asm volatile("s_waitcnt vmcnt(0)" ::: "memory")
__device__ __forceinline__ unsigned long long rt() { return __builtin_amdgcn_s_memrealtime(); }
__device__ __forceinline__ unsigned f2bf(float f) { unsigned u = __builtin_bit_cast(unsigned, f); return (u + 0x7fffu + ((u >> 16) & 1u)) >> 16; }
__device__ __forceinline__ unsigned pk2(float lo, float hi) { return f2bf(lo) | (f2bf(hi) << 16); }

#define XB_TMO      128
#define XB_XCNT(j)  (256  + 64 * (j))
#define XB_XSUB(j)  (1280 + 64 * (j))
#define XB_XGEN(j)  (2304 + 64 * (j))
#define XB_TOP      3328
#define XB_TOPGEN   3392
#define XCD_BAR_WORDS 3456
#define XB_SPIN_CAP (1u << 18)

__device__ __forceinline__ unsigned xb_ld(unsigned* p)              { return __hip_atomic_load(p, __ATOMIC_RELAXED, __HIP_MEMORY_SCOPE_AGENT); }
__device__ __forceinline__ unsigned xb_add(unsigned* p, unsigned v) { return __hip_atomic_fetch_add(p, v, __ATOMIC_RELAXED, __HIP_MEMORY_SCOPE_AGENT); }
__device__ __forceinline__ unsigned xb_xcc_id() { return (unsigned)__builtin_amdgcn_s_getreg((3 << 11) | 20) & 0xFu; }
#define XB_SPIN(cond, bar) do { unsigned _sp = 0; while (cond) { __builtin_amdgcn_s_sleep(1); \
    if ((++_sp & 255u) == 0u) { if (xb_ld(&(bar)[XB_TMO])) break; if (_sp > XB_SPIN_CAP) { atomicAdd(&(bar)[XB_TMO], 1u); break; } } } } while (0)

struct XcdBarrier {
    unsigned* bar; unsigned x;
    volatile LAS unsigned* st;
};

__device__ __forceinline__ XcdBarrier xcd_barrier_post(unsigned* bar, volatile LAS unsigned* st) {
    XcdBarrier b; b.bar = bar; b.x = xb_xcc_id(); b.st = st;
    if (threadIdx.x == 0) (void)xb_add(&bar[XB_XCNT(b.x)], 1u);
    return b;
}
__device__ __forceinline__ void xcd_barrier_complete(unsigned* bar, unsigned x, unsigned& nloc, unsigned& nx) {
    const unsigned G = gridDim.x * gridDim.y * gridDim.z;
    unsigned sum, cnt, mine, sp = 0u;
    for (;;) {
        sum = 0u; cnt = 0u; mine = 0u;
#pragma unroll
        for (unsigned j = 0; j < 16; ++j) { const unsigned c = xb_ld(&bar[XB_XCNT(j)]); sum += c; cnt += (c > 0u) ? 1u : 0u; mine = (j == x) ? c : mine; }
        if (sum == G) break;
        __builtin_amdgcn_s_sleep(1);
        if ((++sp & 255u) == 0u) { if (xb_ld(&bar[XB_TMO])) break; if (sp > XB_SPIN_CAP) { atomicAdd(&bar[XB_TMO], 1u); break; } }
    }
    nloc = mine > 0u ? mine : 1u; nx = cnt > 0u ? cnt : 1u;
}

__device__ __forceinline__ void xcd_barrier(const XcdBarrier& b) {
    asm volatile("s_waitcnt vmcnt(0)" ::: "memory");
    __syncthreads();
    if (threadIdx.x == 0) {
        unsigned* bar = b.bar;
        __builtin_amdgcn_s_waitcnt(0);
        unsigned nloc = b.st[0], nx = b.st[1];
        if (nloc == 0u) { xcd_barrier_complete(bar, b.x, nloc, nx); b.st[0] = nloc; b.st[1] = nx; }
        const unsigned old = xb_add(&bar[XB_XSUB(b.x)], 1u);
        const unsigned gen = old / nloc;
        if (old + 1u == (gen + 1u) * nloc) {
            __builtin_amdgcn_fence(__ATOMIC_RELEASE, "agent");
            asm volatile("s_waitcnt vmcnt(0)" ::: "memory");
            const unsigned og = xb_add(&bar[XB_TOP], 1u);
            const unsigned tg = og / nx;
            if (og + 1u == (tg + 1u) * nx) xb_add(&bar[XB_TOPGEN], 1u);
            else XB_SPIN(xb_ld(&bar[XB_TOPGEN]) == tg, bar);
            __builtin_amdgcn_fence(__ATOMIC_ACQUIRE, "agent");
            xb_add(&bar[XB_XGEN(b.x)], 1u);
            asm volatile("s_waitcnt vmcnt(0)" ::: "memory");
        } else {
            XB_SPIN(xb_ld(&bar[XB_XGEN(b.x)]) == gen, bar);
            __builtin_amdgcn_fence(__ATOMIC_ACQUIRE, "agent");
            asm volatile("s_waitcnt vmcnt(0)" ::: "memory");
        }
    }
    __syncthreads();
}

struct Args { const float* in[N_IN]; float* out; unsigned char* ws; int ph_lo, ph_hi; };
static_assert(sizeof(Args) == 45 * 8 + 8, "Args has no holes");
typedef float f32x2 __attribute__((ext_vector_type(2)));
typedef unsigned v2u __attribute__((ext_vector_type(2)));
#define WAVE_SYNC() asm volatile("s_waitcnt lgkmcnt(0)" ::: "memory")
#define BLOCK_SYNC() do { asm volatile("s_waitcnt vmcnt(0) lgkmcnt(0)" ::: "memory"); __builtin_amdgcn_s_barrier(); asm volatile("" ::: "memory"); } while (0)
__device__ __forceinline__ float bf_lo(unsigned u) { return __uint_as_float(u << 16); }
__device__ __forceinline__ float bf_hi(unsigned u) { return __uint_as_float(u & 0xffff0000u); }
__device__ __forceinline__ float bf2f(bf16 b) { return __uint_as_float((unsigned)b << 16); }
__device__ __forceinline__ unsigned cvtpk(float lo, float hi) { return pg8::cvt_pk_bf16(lo, hi); }
__device__ __forceinline__ bf16 f2b(float f) { return (bf16)(cvtpk(f, 0.f) & 0xffffu); }
__device__ __forceinline__ float wave_sum(float v) {
#pragma unroll
    for (int o = 1; o < 64; o <<= 1) v += __shfl_xor(v, o);
    return v;
}
__device__ __forceinline__ float sum16(float v) { v += __shfl_xor(v, 1); v += __shfl_xor(v, 2); v += __shfl_xor(v, 4); v += __shfl_xor(v, 8); return v; }
__device__ __forceinline__ float max16(float v) { v = fmaxf(v, __shfl_xor(v, 1)); v = fmaxf(v, __shfl_xor(v, 2)); v = fmaxf(v, __shfl_xor(v, 4)); v = fmaxf(v, __shfl_xor(v, 8)); return v; }
__device__ __forceinline__ float silu_f(float x) { return x / (1.f + __expf(-x)); }
__device__ __forceinline__ float sigmoid_f(float x) { return 1.f / (1.f + __expf(-x)); }
__device__ __forceinline__ float softplus_f(float x) { return x > 20.f ? x : log1pf(expf(x)); }
__device__ __forceinline__ float gelu_tanh_f(float x) { const float u = 0.7978845608f * (x + 0.044715f * x * x * x); const float e = __expf(2.f * u); const float th = 1.f - 2.f / (e + 1.f); return 0.5f * x * (1.f + th); }
__device__ __forceinline__ f32x4 mfma16(bf16x8 a, bf16x8 b, f32x4 c) { return __builtin_amdgcn_mfma_f32_16x16x32_bf16(a, b, c, 0, 0, 0); }
__device__ __forceinline__ bf16x8 ldsfrag(const LAS unsigned char* p) { return *(const LAS bf16x8*)p; }
__device__ __forceinline__ bf16x8 gfrag(const bf16* p) { return *(const bf16x8*)p; }
__device__ __forceinline__ bf16x8 pack8(f32x4 a, f32x4 b) { v4u w; w.x = cvtpk(a[0], a[1]); w.y = cvtpk(a[2], a[3]); w.z = cvtpk(b[0], b[1]); w.w = cvtpk(b[2], b[3]); return __builtin_bit_cast(bf16x8, w); }
__device__ __forceinline__ void unpack8(v4u w, float (&f)[8]) { f[0] = bf_lo(w.x); f[1] = bf_hi(w.x); f[2] = bf_lo(w.y); f[3] = bf_hi(w.y); f[4] = bf_lo(w.z); f[5] = bf_hi(w.z); f[6] = bf_lo(w.w); f[7] = bf_hi(w.w); }
__device__ __forceinline__ void dsincos(double x, double& s, double& c) {
    const double k = rint(x * 0.63661977236758134308); double r = fma(-k, 1.57079632673412561417e+00, x); r = fma(-k, 6.07710050650619224932e-11, r);
    const double r2 = r * r;
    double sp = -7.6471637318198164759e-13; sp = fma(sp, r2, 1.6059043836821614599e-10); sp = fma(sp, r2, -2.5052108385441718775e-08); sp = fma(sp, r2, 2.7557319223985890653e-06); sp = fma(sp, r2, -1.9841269841269841270e-04);
    sp = fma(sp, r2, 8.3333333333333333333e-03); sp = fma(sp, r2, -1.6666666666666666667e-01); const double sr = fma(sp * r2, r, r);
    double cp = 4.7794773323873852974e-14; cp = fma(cp, r2, -1.1470745597729724714e-11); cp = fma(cp, r2, 2.0876756987868098979e-09); cp = fma(cp, r2, -2.7557319223985890653e-07); cp = fma(cp, r2, 2.4801587301587301587e-05);
    cp = fma(cp, r2, -1.3888888888888888889e-03); cp = fma(cp, r2, 4.1666666666666666667e-02); cp = fma(cp, r2, -0.5); const double cr = fma(cp, r2, 1.0);
    const int q = (int)k & 3;
    s = (q == 0) ? sr : (q == 1) ? cr : (q == 2) ? -sr : -cr; c = (q == 0) ? cr : (q == 1) ? -sr : (q == 2) ? -cr : sr;
}

__device__ __forceinline__ void p0_transpose_item(const float* W, int ldw, int scol0, int K, int k0, const float* gain, bf16* WT, int drow0, LAS float* scr, int lane) {
#pragma unroll 8
    for (int i = 0; i < 32; ++i) { const int kk = 2 * i + (lane >> 5); const float g = gain ? gain[k0 + kk] : 1.f; scr[kk * 33 + (lane & 31)] = g * W[(size_t)(k0 + kk) * ldw + scol0 + (lane & 31)]; }
    LDS_WAIT(); asm volatile("" ::: "memory");
    const int c = lane & 7;
#pragma unroll
    for (int j = 0; j < 4; ++j) { const int n = (lane >> 3) + 8 * j; const LAS float* s = scr + (8 * c) * 33 + n;
        v4u o; o.x = cvtpk(s[0 * 33], s[1 * 33]); o.y = cvtpk(s[2 * 33], s[3 * 33]); o.z = cvtpk(s[4 * 33], s[5 * 33]); o.w = cvtpk(s[6 * 33], s[7 * 33]);
        *(GAS v4u*)(WT + (size_t)(drow0 + n) * K + k0 + 8 * c) = o; }
    LDS_WAIT(); asm volatile("" ::: "memory");
}
__device__ __forceinline__ void p0_mat(const float* W, int ldw, int K, int N, const float* gain, bf16* WT, int drow_base, int item, LAS float* scr, int lane) {
    const int nblk = N / 32, kb = item / nblk, nb = item % nblk;
    p0_transpose_item(W, ldw, 32 * nb, K, 64 * kb, gain, WT, drow_base + 32 * nb, scr, lane);
}
__device__ __forceinline__ void p0_prologue(const Args& A, LAS unsigned char* lds, int vcu, int G, int wave, int lane) {
    LAS float* scr = (LAS float*)(lds + RING_OFF + wave * 16384);
    const int gw = vcu * NWAVES + wave, NGW = G * NWAVES;
    unsigned char* ws = A.ws;
    constexpr int I_IN = (D / 64) * (NIN / 32), I_SQ = (D / 64) * (D / 32), I_UP = (D / 64) * (FF / 32), I_DN = (FF / 64) * (D / 32), I_GLU = (512 / 64) * (512 / 32), I_PW = (128 / 64) * (128 / 32);
    constexpr int I_LAYER = I_IN + 5 * I_SQ + I_UP + I_DN + I_GLU + 4 * I_PW;
    for (int it = gw; it < NL * I_LAYER; it += NGW) {
        const int l = it / I_LAYER; int r = it % I_LAYER;
        bf16* wl = (bf16*)(ws + WS_W + (size_t)l * W_L); unsigned char* tb = ws + WS_TAB + (size_t)l * TAB_L;
        if (r < I_IN) { const int nblk = NIN / 32, kb = r / nblk, nb = r % nblk, n0 = 32 * nb;
            p0_transpose_item(A.in[I_W_IN] + (size_t)l * D * INW, INW, n0 + (n0 >= 1280 ? 8 : 0), D, 64 * kb, A.in[I_G_MIX] + l * D, (bf16*)((unsigned char*)wl + WO_IN), n0, scr, lane); continue; } r -= I_IN;
        if (r < I_SQ) { p0_mat(A.in[I_W_OUT] + (size_t)l * D * D, D, D, D, A.in[I_G_MIXOUT] + l * D, (bf16*)((unsigned char*)wl + WO_OUT), 0, r, scr, lane); continue; } r -= I_SQ;
        if (r < I_SQ) { p0_mat(A.in[I_W_Q] + (size_t)l * D * D, D, D, D, A.in[I_G_XA] + l * D, (bf16*)((unsigned char*)wl + WO_Q), 0, r, scr, lane); continue; } r -= I_SQ;
        if (r < I_SQ) { p0_mat(A.in[I_W_O] + (size_t)l * D * D, D, D, D, nullptr, (bf16*)((unsigned char*)wl + WO_O), 0, r, scr, lane); continue; } r -= I_SQ;
        if (r < I_SQ) { p0_mat(A.in[I_W_K] + (size_t)l * D * D, D, D, D, A.in[I_G_MEM] + l * D, (bf16*)(ws + WS_WKV), l * 4096, r, scr, lane); continue; } r -= I_SQ;
        if (r < I_SQ) { p0_mat(A.in[I_W_V] + (size_t)l * D * D, D, D, D, A.in[I_G_MEM] + l * D, (bf16*)(ws + WS_WKV), l * 4096 + 2048, r, scr, lane); continue; } r -= I_SQ;
        if (r < I_UP) { p0_mat(A.in[I_W_UP] + (size_t)l * D * FF, FF, D, FF, A.in[I_G_MLP] + l * D, (bf16*)((unsigned char*)wl + WO_UP), 0, r, scr, lane); continue; } r -= I_UP;
        if (r < I_DN) { p0_mat(A.in[I_W_DOWN] + (size_t)l * FF * D, D, FF, D, nullptr, (bf16*)((unsigned char*)wl + WO_DOWN), 0, r, scr, lane); continue; } r -= I_DN;
        if (r < I_GLU) { p0_mat(A.in[I_W_GLU] + (size_t)l * 512 * 512, 512, 512, 512, nullptr, (bf16*)(tb + TB_WGLUT), 0, r, scr, lane); continue; } r -= I_GLU;
        { const int gI = r / I_PW; p0_mat(A.in[I_POOL_W] + ((size_t)l * 4 + gI) * 128 * 128, 128, 128, 128, nullptr, (bf16*)(tb + TB_WPT) + gI * 128 * 128, 0, r % I_PW, scr, lane); }
    }
    float* H = (float*)(ws + WS_H); bf16* HB = (bf16*)(ws + WS_HB); float* ssq0 = (float*)(ws + WS_CTL) + CW_SSQ;
    for (int m = gw; m < MPAD; m += NGW) {
        f32x4 v[8];
        if (m < MR) { const GAS f32x4* xr = (const GAS f32x4*)(m < MP ? A.in[I_XP] + (size_t)m * D : A.in[I_XS] + (size_t)(m - MP) * D) + lane;
#pragma unroll
            for (int j = 0; j < 8; ++j) v[j] = xr[64 * j]; }
        else {
#pragma unroll
            for (int j = 0; j < 8; ++j) v[j] = (f32x4){0.f, 0.f, 0.f, 0.f}; }
        float s = 0.f;
#pragma unroll
        for (int j = 0; j < 8; ++j) s += (v[j].x * v[j].x + v[j].y * v[j].y) + (v[j].z * v[j].z + v[j].w * v[j].w);
        s = wave_sum(s);
        GAS f32x4* hr = (GAS f32x4*)(H + (size_t)m * D) + lane; GAS v2u* br = (GAS v2u*)(HB + (size_t)m * D) + lane;
#pragma unroll
        for (int j = 0; j < 8; ++j) { hr[64 * j] = v[j]; v2u w; w.x = cvtpk(v[j].x, v[j].y); w.y = cvtpk(v[j].z, v[j].w); br[64 * j] = w; }
        if (lane == 0) ssq0[m] = s;
    }
    bf16* MEMB = (bf16*)(ws + WS_MEMB); float* RSTDM = (float*)(ws + WS_RSTDM);
    for (int m = gw; m < MROWS; m += NGW) {
        const GAS f32x4* xr = (const GAS f32x4*)(A.in[I_MEM] + (size_t)m * D) + lane; f32x4 v[8]; float s = 0.f;
#pragma unroll
        for (int j = 0; j < 8; ++j) { v[j] = xr[64 * j]; s += (v[j].x * v[j].x + v[j].y * v[j].y) + (v[j].z * v[j].z + v[j].w * v[j].w); }
        s = wave_sum(s);
        GAS v2u* br = (GAS v2u*)(MEMB + (size_t)m * D) + lane;
#pragma unroll
        for (int j = 0; j < 8; ++j) { v2u w; w.x = cvtpk(v[j].x, v[j].y); w.y = cvtpk(v[j].z, v[j].w); br[64 * j] = w; }
        if (lane == 0) RSTDM[m] = 1.0f / sqrtf(s * (1.0f / D) + EPS);
    }
    const int gt = gw * 64 + lane, NGT = NGW * 64;
    for (int i = gt; i < NL * 2048; i += NGT) {
        const int l = i >> 11, gn = i & 2047, g = gn >> 6, n = gn & 63; unsigned char* tb = ws + WS_TAB + (size_t)l * TAB_L;
        const double lr = (double)A.in[I_LAM_RE][l * 2048 + gn], li = (double)A.in[I_LAM_IM][l * 2048 + gn], dl = exp((double)A.in[I_LOG_DT][l * 32 + g]);
        double s1, c1, sL, cL; dsincos(li * dl, s1, c1); dsincos(li * dl * (double)S5_L, sL, cL);
        const double m1 = exp(lr * dl), mL = exp(lr * dl * (double)S5_L), ar = m1 * c1, ai = m1 * s1;
        ((f32x2*)(tb + TB_ABAR))[gn] = (f32x2){(float)ar, (float)ai}; ((f32x2*)(tb + TB_ABARL))[gn] = (f32x2){(float)(mL * cL), (float)(mL * sL)};
        const double den = lr * lr + li * li, cr = ((ar - 1.0) * lr + ai * li) / den, ci = (ai * lr - (ar - 1.0) * li) / den;
        const float* bre = A.in[I_B_RE] + ((size_t)l * 2048 + gn) * 16; const float* bim = A.in[I_B_IM] + ((size_t)l * 2048 + gn) * 16;
        f32x2* bb = (f32x2*)(tb + TB_BBAR) + (size_t)g * 16 * 64 + n; bf16* cmt = (bf16*)(tb + TB_CMT) + (size_t)g * 16 * 128;
        for (int k = 0; k < 16; ++k) { const double br = bre[k], bi = bim[k]; bb[k * 64] = (f32x2){(float)(cr * br - ci * bi), (float)(cr * bi + ci * br)};
            cmt[k * 128 + n] = f2b(A.in[I_C_RE][((size_t)l * 32 + g) * 1024 + k * 64 + n]); cmt[k * 128 + 64 + n] = f2b(-A.in[I_C_IM][((size_t)l * 32 + g) * 1024 + k * 64 + n]); }
    }
    for (int i = gt; i < NL * D; i += NGT) {
        const int l = i >> 11, k = i & 2047; const float g = A.in[I_G_MIX][l * D + k]; const float* w = A.in[I_W_IN] + ((size_t)l * D + k) * INW + 1280;
        float* o = (float*)(ws + WS_TAB + (size_t)l * TAB_L + TB_WDT) + k * 8;
#pragma unroll
        for (int j = 0; j < 8; ++j) o[j] = g * w[j];
    }
}

__device__ __forceinline__ void dt_rows(const Args& A, int l, int vcu, int G, int wave, int lane) {
    asm volatile("" : "+v"(lane));
    unsigned char* ws = A.ws; const bf16* HB = (const bf16*)(ws + WS_HB); const float* WDT = (const float*)(ws + WS_TAB + (size_t)l * TAB_L + TB_WDT);
    const float* ssq = (const float*)(ws + WS_CTL) + CW_SSQ + (3 * l) * MPAD; float* DTV = (float*)(ws + WS_DTV);
    const int gw = vcu * NWAVES + wave, NGW = G * NWAVES;
    for (int m = gw; m < MR; m += NGW) {
        float acc[8];
#pragma unroll
        for (int j = 0; j < 8; ++j) acc[j] = 0.f;
#pragma unroll
        for (int i = 0; i < 4; ++i) { const int k0 = 8 * lane + 512 * i; float x[8]; unpack8(*(const GAS v4u*)(HB + (size_t)m * D + k0), x);
#pragma unroll
            for (int e = 0; e < 8; ++e) { const f32x4 w0 = *(const GAS f32x4*)(WDT + (k0 + e) * 8), w1 = *(const GAS f32x4*)(WDT + (k0 + e) * 8 + 4);
                acc[0] += x[e] * w0.x; acc[1] += x[e] * w0.y; acc[2] += x[e] * w0.z; acc[3] += x[e] * w0.w; acc[4] += x[e] * w1.x; acc[5] += x[e] * w1.y; acc[6] += x[e] * w1.z; acc[7] += x[e] * w1.w; } }
#pragma unroll
        for (int j = 0; j < 8; ++j) acc[j] = wave_sum(acc[j]);
        const float rs = 1.0f / sqrtf(ssq[m] * (1.0f / D) + EPS);
        if (lane < 8) { float v = acc[0];
#pragma unroll
            for (int j = 1; j < 8; ++j) v = (lane == j) ? acc[j] : v;
            DTV[(size_t)m * 8 + lane] = softplus_f(v * rs + A.in[I_DT_BIAS][l * 8 + lane]); }
    }
}

__device__ __forceinline__ void lds_add(LAS float* p, float v) { (void)__hip_atomic_fetch_add(p, v, __ATOMIC_RELAXED, __HIP_MEMORY_SCOPE_WORKGROUP); }

__device__ __forceinline__ float wave_scan_incl(float v, int lane) {
#pragma unroll
    for (int o = 1; o < 64; o <<= 1) { const float t = __shfl_up(v, o); if (lane >= o) v += t; }
    return v;
}
template <int NCH> __device__ __forceinline__ void conv8(const bf16* proj, const float* cw, const float* cb, int grow0, int t0, bool seq_first, int cx0, float (&out)[8][NCH]) {
    float raw[11][NCH];
#pragma unroll
    for (int r = 0; r < 11; ++r) { const int tt = t0 - 3 + r;
        if (seq_first && tt < 0) {
#pragma unroll
            for (int e = 0; e < NCH; ++e) raw[r][e] = 0.f; }
        else { const bf16* p = proj + (size_t)(grow0 + tt) * NIN + C_XBC + cx0;
            if constexpr (NCH == 8) { float f[8]; unpack8(*(const GAS v4u*)p, f);
#pragma unroll
                for (int e = 0; e < 8; ++e) raw[r][e] = f[e]; }
            else if constexpr (NCH == 4) { const v2u w = *(const GAS v2u*)p; raw[r][0] = bf_lo(w.x); raw[r][1] = bf_hi(w.x); raw[r][2] = bf_lo(w.y); raw[r][3] = bf_hi(w.y); }
            else if constexpr (NCH == 2) { const unsigned w = *(const GAS unsigned*)p; raw[r][0] = bf_lo(w); raw[r][1] = bf_hi(w); }
            else { raw[r][0] = bf2f(*p); } } }
    float w[4][NCH], bsv[NCH];
#pragma unroll
    for (int e = 0; e < NCH; ++e) { bsv[e] = cb[cx0 + e];
#pragma unroll
        for (int j = 0; j < 4; ++j) w[j][e] = cw[j * 768 + cx0 + e]; }
#pragma unroll
    for (int i = 0; i < 8; ++i)
#pragma unroll
        for (int e = 0; e < NCH; ++e) { const float v = bsv[e] + w[0][e] * raw[i][e] + w[1][e] * raw[i + 1][e] + w[2][e] * raw[i + 2][e] + w[3][e] * raw[i + 3][e]; out[i][e] = silu_f(v); }
}

__device__ __forceinline__ void ma_ssd_unit(const Args& A, LAS unsigned char* lds, int l, int b, int c, int grp, int tid, int lane, int wave) {
    asm volatile("" : "+v"(tid)); lane = tid & 63; wave = __builtin_amdgcn_readfirstlane(tid >> 6);
    unsigned char* ws = A.ws; const bf16* proj = (const bf16*)(ws + WS_PROJ); const float* DTV = (const float*)(ws + WS_DTV);
    LAS float* AC = (LAS float*)(lds); LAS float* DTs = (LAS float*)(lds + 1024); LAS unsigned char* XT = lds + 2048; LAS unsigned char* BT = lds + 2048 + 36864;
    const int grow0 = b * T + c * SSD_L;
    if (wave < 4) { const int h = 4 * grp + wave; const float an = -expf(A.in[I_A_LOG][l * 8 + h]); const float dt = DTV[(size_t)(grow0 + lane) * 8 + h];
        AC[wave * 64 + lane] = wave_scan_incl(dt * an, lane); DTs[wave * 64 + lane] = dt; }
    BLOCK_SYNC();
    { const int t0 = 8 * wave; const float* cw = A.in[I_CONV_W] + l * 4 * 768; const float* cb = A.in[I_CONV_B] + l * 768;
        float xs[8][4]; conv8<4>(proj, cw, cb, grow0, t0, c == 0, 256 * grp + 4 * lane, xs);
        const int hl = lane >> 4, p0 = 4 * (lane & 15); const float alast = AC[hl * 64 + 63];
        float sc[8];
#pragma unroll
        for (int i = 0; i < 8; ++i) sc[i] = DTs[hl * 64 + t0 + i] * __expf(alast - AC[hl * 64 + t0 + i]);
#pragma unroll
        for (int e = 0; e < 4; ++e) { v4u w; w.x = cvtpk(xs[0][e] * sc[0], xs[1][e] * sc[1]); w.y = cvtpk(xs[2][e] * sc[2], xs[3][e] * sc[3]); w.z = cvtpk(xs[4][e] * sc[4], xs[5][e] * sc[5]); w.w = cvtpk(xs[6][e] * sc[6], xs[7][e] * sc[7]);
            *(LAS v4u*)(XT + ((hl * 64 + p0 + e) * 72 + t0) * 2) = w; }
        float bm[8][1]; conv8<1>(proj, cw, cb, grow0, t0, c == 0, 512 + 64 * grp + lane, bm);
        v4u w; w.x = cvtpk(bm[0][0], bm[1][0]); w.y = cvtpk(bm[2][0], bm[3][0]); w.z = cvtpk(bm[4][0], bm[5][0]); w.w = cvtpk(bm[6][0], bm[7][0]);
        *(LAS v4u*)(BT + (lane * 72 + t0) * 2) = w; }
    BLOCK_SYNC();
    { const int hl = wave >> 1, ph = wave & 1, fr = lane & 15, fq = lane >> 4; f32x4 acc[2][4];
#pragma unroll
        for (int i = 0; i < 2; ++i)
#pragma unroll
            for (int j = 0; j < 4; ++j) acc[i][j] = (f32x4){0.f, 0.f, 0.f, 0.f};
#pragma unroll
        for (int ks = 0; ks < 2; ++ks) { bf16x8 fb[4], fx[2];
#pragma unroll
            for (int j = 0; j < 4; ++j) fb[j] = ldsfrag(BT + ((16 * j + fr) * 72 + 32 * ks + 8 * fq) * 2);
#pragma unroll
            for (int i = 0; i < 2; ++i) fx[i] = ldsfrag(XT + ((hl * 64 + 32 * ph + 16 * i + fr) * 72 + 32 * ks + 8 * fq) * 2);
#pragma unroll
            for (int i = 0; i < 2; ++i)
#pragma unroll
                for (int j = 0; j < 4; ++j) acc[i][j] = mfma16(fb[j], fx[i], acc[i][j]); }
        float* SS = (float*)(ws + WS_SS) + ((size_t)(b * SSD_NC + c) * 8 + 4 * grp + hl) * 4096;
#pragma unroll
        for (int i = 0; i < 2; ++i)
#pragma unroll
            for (int j = 0; j < 4; ++j) *(GAS f32x4*)(SS + (32 * ph + 16 * i + fr) * 64 + 16 * j + 4 * fq) = acc[i][j]; }
    if (tid < 4) ((float*)(ws + WS_CD))[(b * SSD_NC + c) * 8 + 4 * grp + tid] = expf(AC[tid * 64 + 63]);
    BLOCK_SYNC();
}

struct S5Coef { float br[16], bi[16], ar, ai; };
__device__ __forceinline__ void s5_load(const Args& A, int l, int g, int grow0, int lane, LAS float* UW, S5Coef& C) {
    const unsigned char* tb = A.ws + WS_TAB + (size_t)l * TAB_L; const bf16* proj = (const bf16*)(A.ws + WS_PROJ);
    { const int t = lane >> 1, hf = lane & 1; float f[8]; unpack8(*(const GAS v4u*)(proj + (size_t)(grow0 + t) * NIN + C_U5 + 16 * g + 8 * hf), f);
        *(LAS f32x4*)(UW + t * 16 + 8 * hf) = (f32x4){f[0], f[1], f[2], f[3]}; *(LAS f32x4*)(UW + t * 16 + 8 * hf + 4) = (f32x4){f[4], f[5], f[6], f[7]}; }
    const f32x2* bb = (const f32x2*)(tb + TB_BBAR) + (size_t)g * 16 * 64 + lane;
#pragma unroll
    for (int k = 0; k < 16; ++k) { const f32x2 v = bb[k * 64]; C.br[k] = v.x; C.bi[k] = v.y; }
    const f32x2 a = ((const f32x2*)(tb + TB_ABAR))[g * 64 + lane]; C.ar = a.x; C.ai = a.y;
    WAVE_SYNC();
}
__device__ __forceinline__ void s5_step(const S5Coef& C, const LAS float* ut, float& hr, float& hi) {
    const f32x4 u0 = *(const LAS f32x4*)ut, u1 = *(const LAS f32x4*)(ut + 4), u2 = *(const LAS f32x4*)(ut + 8), u3 = *(const LAS f32x4*)(ut + 12);
    const float u[16] = {u0.x, u0.y, u0.z, u0.w, u1.x, u1.y, u1.z, u1.w, u2.x, u2.y, u2.z, u2.w, u3.x, u3.y, u3.z, u3.w};
    float r = 0.f, i = 0.f;
#pragma unroll
    for (int k = 0; k < 16; ++k) { r += C.br[k] * u[k]; i += C.bi[k] * u[k]; }
    const float nr = C.ar * hr - C.ai * hi + r, ni = C.ar * hi + C.ai * hr + i; hr = nr; hi = ni;
}
__device__ __forceinline__ void ma_s5_unit(const Args& A, LAS unsigned char* lds, int l, int b, int c, int lane, int wave) {
    asm volatile("" : "+v"(lane));
    LAS float* UW = (LAS float*)(lds + wave * 2048); const int grow0 = b * T + c * S5_L;
    float* ER = (float*)(A.ws + WS_S5ER); float* EI = (float*)(A.ws + WS_S5EI);
    for (int gi = 0; gi < 4; ++gi) { const int g = 4 * wave + gi; S5Coef C; s5_load(A, l, g, grow0, lane, UW, C);
        float hr = 0.f, hi = 0.f;
#pragma unroll 4
        for (int t = 0; t < S5_L; ++t) s5_step(C, UW + t * 16, hr, hi);
        const size_t o = ((size_t)(b * S5_NC + c) * 32 + g) * 64 + lane; ER[o] = hr; EI[o] = hi;
        WAVE_SYNC(); }
}

__device__ __forceinline__ void mb_scan(const Args& A, int l, int vcu, int G, int tid) {
    unsigned char* ws = A.ws; const int gt = vcu * NTHR + tid, NGT = G * NTHR;
    float* SS = (float*)(ws + WS_SS); const float* CD = (const float*)(ws + WS_CD);
    for (int i = gt; i < NB * 8 * 4096; i += NGT) { const int b = i >> 15, h = (i >> 12) & 7, pn = i & 4095; float run = 0.f;
#pragma unroll 8
        for (int c = 0; c < SSD_NC; ++c) { float* p = SS + ((size_t)(b * SSD_NC + c) * 8 + h) * 4096 + pn; const float s = *p, d = CD[(b * SSD_NC + c) * 8 + h]; *p = run; run = run * d + s; }
        A.out[O_PSSD + (size_t)l * NB * 8 * 4096 + i] = run; }
    float* ER = (float*)(ws + WS_S5ER); float* EI = (float*)(ws + WS_S5EI); const f32x2* AL = (const f32x2*)(ws + WS_TAB + (size_t)l * TAB_L + TB_ABARL);
    for (int i = gt; i < NB * 2048; i += NGT) { const int b = i >> 11, gn = i & 2047; const f32x2 a = AL[gn]; float rr = 0.f, ri = 0.f;
#pragma unroll 8
        for (int c = 0; c < S5_NC; ++c) { const size_t o = (size_t)(b * S5_NC + c) * 2048 + gn; const float er = ER[o], ei = EI[o]; ER[o] = rr; EI[o] = ri;
            const float nr = a.x * rr - a.y * ri + er, ni = a.x * ri + a.y * rr + ei; rr = nr; ri = ni; }
        A.out[O_PS5R + (size_t)l * NB * 2048 + i] = rr; A.out[O_PS5I + (size_t)l * NB * 2048 + i] = ri; }
}

__device__ __forceinline__ void mc_s5_unit(const Args& A, LAS unsigned char* lds, int l, int b, int c, int tid, int lane, int wave) {
    asm volatile("" : "+v"(tid)); lane = tid & 63; wave = __builtin_amdgcn_readfirstlane(tid >> 6);
    unsigned char* ws = A.ws; const unsigned char* tb = ws + WS_TAB + (size_t)l * TAB_L;
    LAS float* UW = (LAS float*)(lds + wave * 2048); LAS unsigned char* HS = lds + 16384 + wave * 8704;
    LAS unsigned char* Y = lds + 16384 + 8 * 8704; LAS float* SQ = (LAS float*)(lds + 16384 + 8 * 8704 + 33280);
    const int grow0 = b * T + c * S5_L, fr = lane & 15, fq = lane >> 4;
    const float* ER = (const float*)(ws + WS_S5ER); const float* EI = (const float*)(ws + WS_S5EI);
    if (tid < 32) SQ[tid] = 0.f;
    for (int gi = 0; gi < 4; ++gi) { const int g = 4 * wave + gi; S5Coef C; s5_load(A, l, g, grow0, lane, UW, C);
        const size_t o = ((size_t)(b * S5_NC + c) * 32 + g) * 64 + lane; float hr = ER[o], hi = EI[o];
#pragma unroll 4
        for (int t = 0; t < S5_L; ++t) { s5_step(C, UW + t * 16, hr, hi);
            *(LAS bf16*)(HS + (t * 136 + lane) * 2) = f2b(hr); *(LAS bf16*)(HS + (t * 136 + 64 + lane) * 2) = f2b(hi); }
        WAVE_SYNC();
        const bf16* cmt = (const bf16*)(tb + TB_CMT) + (size_t)g * 16 * 128; const float dsk = A.in[I_S5_D][l * 512 + 16 * g + fr];
        f32x4 acc[2] = {(f32x4){0.f, 0.f, 0.f, 0.f}, (f32x4){0.f, 0.f, 0.f, 0.f}};
#pragma unroll
        for (int ks = 0; ks < 4; ++ks) { const bf16x8 fc = gfrag(cmt + fr * 128 + 32 * ks + 8 * fq);
#pragma unroll
            for (int rt = 0; rt < 2; ++rt) acc[rt] = mfma16(ldsfrag(HS + ((16 * rt + fr) * 136 + 32 * ks + 8 * fq) * 2), fc, acc[rt]); }
#pragma unroll
        for (int rt = 0; rt < 2; ++rt)
#pragma unroll
            for (int e = 0; e < 4; ++e) { const int t = 16 * rt + 4 * fq + e; const float y = acc[rt][e] + dsk * UW[t * 16 + fr]; *(LAS bf16*)(Y + (t * 520 + 16 * g + fr) * 2) = f2b(gelu_tanh_f(y)); }
        WAVE_SYNC(); }
    BLOCK_SYNC();
    const bf16* wg = (const bf16*)(tb + TB_WGLUT); f32x4 acc[2][4];
#pragma unroll
    for (int i = 0; i < 2; ++i)
#pragma unroll
        for (int j = 0; j < 4; ++j) acc[i][j] = (f32x4){0.f, 0.f, 0.f, 0.f};
#pragma unroll 2
    for (int ks = 0; ks < 16; ++ks) { bf16x8 fa[2], fb[4];
#pragma unroll
        for (int i = 0; i < 2; ++i) fa[i] = ldsfrag(Y + ((16 * i + fr) * 520 + 32 * ks + 8 * fq) * 2);
#pragma unroll
        for (int j = 0; j < 4; ++j) fb[j] = gfrag(wg + (size_t)(64 * wave + 16 * j + fr) * 512 + 32 * ks + 8 * fq);
#pragma unroll
        for (int i = 0; i < 2; ++i)
#pragma unroll
            for (int j = 0; j < 4; ++j) acc[i][j] = mfma16(fa[i], fb[j], acc[i][j]); }
#pragma unroll
    for (int i = 0; i < 2; ++i)
#pragma unroll
        for (int e = 0; e < 4; ++e) { const int t = 16 * i + 4 * fq + e; float sq = 0.f;
#pragma unroll
            for (int j = 0; j < 4; ++j) { const int col = 64 * wave + 16 * j + fr; const float yv = bf2f(*(const LAS bf16*)(Y + (t * 520 + col) * 2));
                const float o = yv * sigmoid_f(acc[i][j][e] + A.in[I_B_GLU][l * 512 + col]); acc[i][j][e] = o; sq += o * o; }
            sq = sum16(sq); if (fr == 0) lds_add(SQ + t, sq); }
    BLOCK_SYNC();
    bf16* mix = (bf16*)(ws + WS_MIX);
#pragma unroll
    for (int i = 0; i < 2; ++i)
#pragma unroll
        for (int e = 0; e < 4; ++e) { const int t = 16 * i + 4 * fq + e; const float rs = 1.0f / sqrtf(SQ[t] * (1.0f / 512.0f) + EPS);
#pragma unroll
            for (int j = 0; j < 4; ++j) mix[(size_t)(grow0 + t) * D + 512 + 64 * wave + 16 * j + fr] = f2b(acc[i][j][e] * rs); }
    BLOCK_SYNC();
}


#define RELANE() do { asm volatile("" : "+v"(tid)); lane = tid & 63; fr = lane & 15; fq = lane >> 4; } while (0)
__device__ __forceinline__ void mc_rest_unit(const Args& A, LAS unsigned char* lds, int l, int b, int c, int tid, int lane, int wave) {
    asm volatile("" : "+v"(tid)); lane = tid & 63; wave = __builtin_amdgcn_readfirstlane(tid >> 6);
    unsigned char* ws = A.ws; const bf16* proj = (const bf16*)(ws + WS_PROJ); const float* DTV = (const float*)(ws + WS_DTV); bf16* mix = (bf16*)(ws + WS_MIX);
    LAS float* AC = (LAS float*)lds; LAS float* DTs = (LAS float*)(lds + 2048); LAS float* SQ = (LAS float*)(lds + 4096);
    LAS unsigned char* XT = lds + 4608; LAS unsigned char* BMs = lds + 41472; LAS unsigned char* CMs = lds + 50688; LAS unsigned char* PW = lds + 59904 + wave * 4608;
    LAS unsigned char* PL = lds + 4608;
    const int grow0 = b * T + c * SSD_L; int fr = lane & 15, fq = lane >> 4; const bool first = (c == 0), lastc = (c == SSD_NC - 1);
    const float* cw = A.in[I_CONV_W] + l * 4 * 768; const float* cb = A.in[I_CONV_B] + l * 768;
    { const float an = -expf(A.in[I_A_LOG][l * 8 + wave]); const float dt = DTV[(size_t)(grow0 + lane) * 8 + wave];
        AC[wave * 64 + lane] = wave_scan_incl(dt * an, lane); DTs[wave * 64 + lane] = dt; if (tid < 128) SQ[tid] = 0.f; }
    BLOCK_SYNC();
    f32x4 yv[2][2][4];
#pragma unroll
    for (int half = 0; half < 2; ++half) {
        RELANE();
        { const int t0 = 8 * wave; float xs[8][4]; conv8<4>(proj, cw, cb, grow0, t0, first, 256 * half + 4 * lane, xs);
            const int hl = lane >> 4, p0 = 4 * (lane & 15);
#pragma unroll
            for (int e = 0; e < 4; ++e) { v4u w; w.x = cvtpk(xs[0][e], xs[1][e]); w.y = cvtpk(xs[2][e], xs[3][e]); w.z = cvtpk(xs[4][e], xs[5][e]); w.w = cvtpk(xs[6][e], xs[7][e]);
                *(LAS v4u*)(XT + ((hl * 64 + p0 + e) * 72 + t0) * 2) = w; }
            float bc[8][2]; const int isc = lane >> 5, n0 = 2 * (lane & 31); conv8<2>(proj, cw, cb, grow0, t0, first, 512 + 128 * isc + 64 * half + n0, bc);
            LAS unsigned char* dst = isc ? CMs : BMs;
#pragma unroll
            for (int i = 0; i < 8; ++i) *(LAS unsigned*)(dst + ((t0 + i) * 72 + n0) * 2) = cvtpk(bc[i][0], bc[i][1]); }
        BLOCK_SYNC(); RELANE();
        { const int hl = wave >> 1, th = wave & 1, h = 4 * half + hl;
#pragma unroll
            for (int rt = 0; rt < 2; ++rt) { const bf16x8 fc0 = ldsfrag(CMs + ((32 * th + 16 * rt + fr) * 72 + 8 * fq) * 2), fc1 = ldsfrag(CMs + ((32 * th + 16 * rt + fr) * 72 + 32 + 8 * fq) * 2);
#pragma unroll
                for (int st = 0; st < 4; ++st) { f32x4 g = (f32x4){0.f, 0.f, 0.f, 0.f};
                    g = mfma16(fc0, ldsfrag(BMs + ((16 * st + fr) * 72 + 8 * fq) * 2), g); g = mfma16(fc1, ldsfrag(BMs + ((16 * st + fr) * 72 + 32 + 8 * fq) * 2), g);
                    const int s = 16 * st + fr; const float as = AC[h * 64 + s], ds = DTs[h * 64 + s];
#pragma unroll
                    for (int e = 0; e < 4; ++e) { const int tl = 16 * rt + 4 * fq + e, t = 32 * th + tl; const float pv = (s <= t) ? g[e] * __expf(AC[h * 64 + t] - as) * ds : 0.f;
                        *(LAS bf16*)(PW + (tl * 72 + s) * 2) = f2b(pv); } asm volatile("" ::: "memory"); } }
            WAVE_SYNC(); RELANE();
            const float* HP = (const float*)(ws + WS_SS) + ((size_t)(b * SSD_NC + c) * 8 + h) * 4096; const float dsk = A.in[I_SSD_D][l * 8 + h]; float sqp[2][4];
#pragma unroll
            for (int rt = 0; rt < 2; ++rt) { const bf16x8 fp0 = ldsfrag(PW + ((16 * rt + fr) * 72 + 8 * fq) * 2), fp1 = ldsfrag(PW + ((16 * rt + fr) * 72 + 32 + 8 * fq) * 2);
                const bf16x8 fc0 = ldsfrag(CMs + ((32 * th + 16 * rt + fr) * 72 + 8 * fq) * 2), fc1 = ldsfrag(CMs + ((32 * th + 16 * rt + fr) * 72 + 32 + 8 * fq) * 2);
#pragma unroll
                for (int e = 0; e < 4; ++e) sqp[rt][e] = 0.f;
#pragma unroll
                for (int pt = 0; pt < 4; ++pt) { const int p = 16 * pt + fr; f32x4 y = (f32x4){0.f, 0.f, 0.f, 0.f}, yo = (f32x4){0.f, 0.f, 0.f, 0.f};
                    y = mfma16(fp0, ldsfrag(XT + ((hl * 64 + p) * 72 + 8 * fq) * 2), y); y = mfma16(fp1, ldsfrag(XT + ((hl * 64 + p) * 72 + 32 + 8 * fq) * 2), y);
                    const float* hp = HP + p * 64 + 8 * fq;
                    yo = mfma16(fc0, pack8(*(const GAS f32x4*)hp, *(const GAS f32x4*)(hp + 4)), yo); yo = mfma16(fc1, pack8(*(const GAS f32x4*)(hp + 32), *(const GAS f32x4*)(hp + 36)), yo);
                    const v2u xw = *(const LAS v2u*)(XT + ((hl * 64 + p) * 72 + 32 * th + 16 * rt + 4 * fq) * 2); const float xv[4] = {bf_lo(xw.x), bf_hi(xw.x), bf_lo(xw.y), bf_hi(xw.y)};
#pragma unroll
                    for (int e = 0; e < 4; ++e) { const int t = 32 * th + 16 * rt + 4 * fq + e; const float z = bf2f(proj[(size_t)(grow0 + t) * NIN + C_Z + 64 * h + p]);
                        const float v = (y[e] + __expf(AC[h * 64 + t]) * yo[e] + dsk * xv[e]) * silu_f(z); y[e] = v; sqp[rt][e] += v * v; }
                    yv[half][rt][pt] = y; asm volatile("" ::: "memory"); }
#pragma unroll
                for (int e = 0; e < 4; ++e) { const float s = sum16(sqp[rt][e]); if (fr == 0) lds_add(SQ + 32 * th + 16 * rt + 4 * fq + e, s); } } }
        BLOCK_SYNC();
    }
    RELANE();
    { const int hl = wave >> 1, th = wave & 1;
#pragma unroll
        for (int half = 0; half < 2; ++half)
#pragma unroll
            for (int rt = 0; rt < 2; ++rt)
#pragma unroll
                for (int e = 0; e < 4; ++e) { const int t = 32 * th + 16 * rt + 4 * fq + e; const float rs = 1.0f / sqrtf(SQ[t] * (1.0f / 512.0f) + EPS);
#pragma unroll
                    for (int pt = 0; pt < 4; ++pt) mix[(size_t)(grow0 + t) * D + 64 * (4 * half + hl) + 16 * pt + fr] = f2b(yv[half][rt][pt][e] * rs); } }
    RELANE();
    { const int t0 = 8 * wave, ch = 8 * lane; float v2[8], v1[8], w[3][8];
#pragma unroll
        for (int j = 0; j < 3; ++j)
#pragma unroll
            for (int e = 0; e < 8; ++e) w[j][e] = A.in[I_SC_W][(l * 3 + j) * 512 + ch + e];
#pragma unroll
        for (int e = 0; e < 8; ++e) { v2[e] = 0.f; v1[e] = 0.f; }
#pragma unroll 1
        for (int r = -2; r < 8; ++r) { const int tt = t0 + r; float v0[8];
            if (first && tt < 0) {
#pragma unroll
                for (int e = 0; e < 8; ++e) v0[e] = 0.f; }
            else { float gc[8], hv[8]; const bf16* p = proj + (size_t)(grow0 + tt) * NIN; unpack8(*(const GAS v4u*)(p + C_GC + ch), gc); unpack8(*(const GAS v4u*)(p + C_HV + ch), hv);
#pragma unroll
                for (int e = 0; e < 8; ++e) v0[e] = gc[e] * hv[e]; }
            if (r >= 0) { float gb[8], y[8]; unpack8(*(const GAS v4u*)(proj + (size_t)(grow0 + tt) * NIN + C_GB + ch), gb); float sq = 0.f;
#pragma unroll
                for (int e = 0; e < 8; ++e) { y[e] = gb[e] * (w[0][e] * v2[e] + w[1][e] * v1[e] + w[2][e] * v0[e]); sq += y[e] * y[e]; }
                const float rs = 1.0f / sqrtf(wave_sum(sq) * (1.0f / 512.0f) + EPS);
                v4u o; o.x = cvtpk(y[0] * rs, y[1] * rs); o.y = cvtpk(y[2] * rs, y[3] * rs); o.z = cvtpk(y[4] * rs, y[5] * rs); o.w = cvtpk(y[6] * rs, y[7] * rs);
                *(GAS v4u*)(mix + (size_t)(grow0 + tt) * D + 1024 + ch) = o;
                if (lastc && tt >= 62) { float* o2 = A.out + O_PSC + ((size_t)(l * NB + b) * 2 + (tt - 62)) * 512 + ch; *(GAS f32x4*)o2 = (f32x4){v0[0], v0[1], v0[2], v0[3]}; *(GAS f32x4*)(o2 + 4) = (f32x4){v0[4], v0[5], v0[6], v0[7]}; } }
#pragma unroll
            for (int e = 0; e < 8; ++e) { v2[e] = v1[e]; v1[e] = v0[e]; } }
    }
    BLOCK_SYNC();
#pragma unroll 1
    for (int hh = 0; hh < 2; ++hh) { RELANE(); const int t0 = 8 * wave, ch = 4 * lane + 256 * hh, gI = ch >> 7;
        float u[23][4];
#pragma unroll
        for (int r = 0; r < 23; ++r) { const int tt = t0 - 15 + r;
            if (first && tt < 0) {
#pragma unroll
                for (int e = 0; e < 4; ++e) u[r][e] = 0.f; }
            else { const v2u w = *(const GAS v2u*)(proj + (size_t)(grow0 + tt) * NIN + C_UP + ch); u[r][0] = bf_lo(w.x); u[r][1] = bf_hi(w.x); u[r][2] = bf_lo(w.y); u[r][3] = bf_hi(w.y); } }
        const int win = 2 << gI;
#pragma unroll
        for (int i = 0; i < 8; ++i) { const int r = 15 + i; float pv[4]; const int pos = c * SSD_L + t0 + i; const float inv = 1.0f / (float)(pos + 1 < win ? pos + 1 : win);
#pragma unroll
            for (int e = 0; e < 4; ++e) { const float s2 = u[r][e] + u[r - 1][e], s4 = s2 + u[r - 2][e] + u[r - 3][e], s8 = s4 + (u[r - 4][e] + u[r - 5][e]) + (u[r - 6][e] + u[r - 7][e]);
                const float s16 = s8 + ((u[r - 8][e] + u[r - 9][e]) + (u[r - 10][e] + u[r - 11][e])) + ((u[r - 12][e] + u[r - 13][e]) + (u[r - 14][e] + u[r - 15][e]));
                const float cs = gI == 0 ? s2 : gI == 1 ? s4 : gI == 2 ? s8 : s16; pv[e] = cs * inv - u[r][e]; }
            v2u o; o.x = cvtpk(pv[0], pv[1]); o.y = cvtpk(pv[2], pv[3]); *(LAS v2u*)(PL + ((t0 + i) * 520 + ch) * 2) = o;
            if (lastc && t0 + i >= 49) *(GAS f32x4*)(A.out + O_PPOOL + ((size_t)(l * NB + b) * 15 + (t0 + i - 49)) * 512 + ch) = (f32x4){u[r][0], u[r][1], u[r][2], u[r][3]}; }
    }
    BLOCK_SYNC(); RELANE();
    { const int gI = wave >> 1, dh = wave & 1; const bf16* wp = (const bf16*)(ws + WS_TAB + (size_t)l * TAB_L + TB_WPT) + (size_t)gI * 128 * 128; f32x4 acc[4][4];
#pragma unroll
        for (int i = 0; i < 4; ++i)
#pragma unroll
            for (int j = 0; j < 4; ++j) acc[i][j] = (f32x4){0.f, 0.f, 0.f, 0.f};
#pragma unroll
        for (int ks = 0; ks < 4; ++ks) { bf16x8 fa[4], fb[4];
#pragma unroll
            for (int i = 0; i < 4; ++i) fa[i] = ldsfrag(PL + ((16 * i + fr) * 520 + 128 * gI + 32 * ks + 8 * fq) * 2);
#pragma unroll
            for (int j = 0; j < 4; ++j) fb[j] = gfrag(wp + (size_t)(64 * dh + 16 * j + fr) * 128 + 32 * ks + 8 * fq);
#pragma unroll
            for (int i = 0; i < 4; ++i)
#pragma unroll
                for (int j = 0; j < 4; ++j) acc[i][j] = mfma16(fa[i], fb[j], acc[i][j]); }
        float psc[4];
#pragma unroll
        for (int j = 0; j < 4; ++j) psc[j] = A.in[I_POOL_SCALE][l * 512 + 128 * gI + 64 * dh + 16 * j + fr];
#pragma unroll
        for (int i = 0; i < 4; ++i)
#pragma unroll
            for (int e = 0; e < 4; ++e) { float sq = 0.f;
#pragma unroll
                for (int j = 0; j < 4; ++j) { const float o = acc[i][j][e] * psc[j]; acc[i][j][e] = o; sq += o * o; }
                sq = sum16(sq); if (fr == 0) lds_add(SQ + 64 + 16 * i + 4 * fq + e, sq); }
        BLOCK_SYNC();
#pragma unroll
        for (int i = 0; i < 4; ++i)
#pragma unroll
            for (int e = 0; e < 4; ++e) { const int t = 16 * i + 4 * fq + e; const float rs = 1.0f / sqrtf(SQ[64 + t] * (1.0f / 512.0f) + EPS);
#pragma unroll
                for (int j = 0; j < 4; ++j) mix[(size_t)(grow0 + t) * D + 1536 + 128 * gI + 64 * dh + 16 * j + fr] = f2b(acc[i][j][e] * rs); }
    }
    if (lastc) for (int i = tid; i < 3 * 768; i += NTHR) { const int r = i / 768, ch = i % 768; A.out[O_PCONV + ((size_t)(l * NB + b) * 3 + r) * 768 + ch] = bf2f(proj[(size_t)(grow0 + 61 + r) * NIN + C_XBC + ch]); }
    BLOCK_SYNC();
}

__device__ __forceinline__ void mc_sample_unit(const Args& A, LAS unsigned char* lds, int l, int s, int tid, int lane, int wave) {
    asm volatile("" : "+v"(tid)); lane = tid & 63; wave = __builtin_amdgcn_readfirstlane(tid >> 6);
    unsigned char* ws = A.ws; const bf16* proj = (const bf16*)(ws + WS_PROJ) + (size_t)(MP + s) * NIN; const unsigned char* tb = ws + WS_TAB + (size_t)l * TAB_L; float* out = A.out;
    LAS float* XC = (LAS float*)lds; LAS float* U5 = (LAS float*)(lds + 5120); LAS float* Y5 = (LAS float*)(lds + 7168); LAS float* PLs = (LAS float*)(lds + 9216); LAS float* OUT = (LAS float*)(lds + 11264);
    const int ls = l * MS + s;
    for (int ch = tid; ch < 768; ch += NTHR) { const float* st = A.in[I_ST_CONV] + (size_t)ls * 3 * 768 + ch; const float s0 = st[0], s1 = st[768], s2 = st[1536], nw = bf2f(proj[C_XBC + ch]);
        const float* cw = A.in[I_CONV_W] + l * 4 * 768 + ch; XC[ch] = silu_f(A.in[I_CONV_B][l * 768 + ch] + cw[0] * s0 + cw[768] * s1 + cw[1536] * s2 + cw[2304] * nw);
        float* o = out + O_SCONV + (size_t)ls * 3 * 768 + ch; o[0] = s1; o[768] = s2; o[1536] = nw; }
    U5[tid] = bf2f(proj[C_U5 + tid]);
    BLOCK_SYNC();
    { const int h = wave; const float dt = ((const float*)(ws + WS_DTV))[(size_t)(MP + s) * 8 + h], dec = expf(-dt * expf(A.in[I_A_LOG][l * 8 + h])), dsk = A.in[I_SSD_D][l * 8 + h];
        const int n4 = 4 * (lane & 15); const f32x4 Bv = *(const LAS f32x4*)(XC + 512 + 64 * (h >> 2) + n4), Cv = *(const LAS f32x4*)(XC + 640 + 64 * (h >> 2) + n4);
#pragma unroll 4
        for (int it = 0; it < 16; ++it) { const int p = it * 4 + (lane >> 4); const size_t o = (((size_t)ls * 8 + h) * 64 + p) * 64 + n4; const float x = XC[64 * h + p];
            const f32x4 h0 = *(const GAS f32x4*)(A.in[I_ST_SSD] + o); const f32x4 hn = h0 * dec + Bv * (dt * x);
            *(GAS f32x4*)(out + O_SSSD + o) = hn;
            float y = (hn.x * Cv.x + hn.y * Cv.y) + (hn.z * Cv.z + hn.w * Cv.w); y = sum16(y);
            if ((lane & 15) == 0) OUT[64 * h + p] = (y + dsk * x) * silu_f(bf2f(proj[C_Z + 64 * h + p])); } }
    for (int gi = 0; gi < 4; ++gi) { const int g = 4 * wave + gi; const f32x2* bb = (const f32x2*)(tb + TB_BBAR) + (size_t)g * 16 * 64 + lane; float br = 0.f, bi = 0.f;
#pragma unroll
        for (int k = 0; k < 16; ++k) { const f32x2 v = bb[k * 64]; const float u = U5[16 * g + k]; br += v.x * u; bi += v.y * u; }
        const f32x2 a = ((const f32x2*)(tb + TB_ABAR))[g * 64 + lane]; const size_t o = ((size_t)ls * 32 + g) * 64 + lane; const float h0r = A.in[I_ST_S5R][o], h0i = A.in[I_ST_S5I][o];
        const float hr = a.x * h0r - a.y * h0i + br, hi = a.x * h0i + a.y * h0r + bi; out[O_SS5R + o] = hr; out[O_SS5I + o] = hi;
        const float* cre = A.in[I_C_RE] + ((size_t)l * 32 + g) * 1024 + lane; const float* cim = A.in[I_C_IM] + ((size_t)l * 32 + g) * 1024 + lane; float mine = 0.f;
#pragma unroll
        for (int k = 0; k < 16; ++k) { const float v = wave_sum(cre[k * 64] * hr - cim[k * 64] * hi); mine = (lane == k) ? v : mine; }
        if (lane < 16) Y5[16 * g + lane] = gelu_tanh_f(mine + A.in[I_S5_D][l * 512 + 16 * g + lane] * U5[16 * g + lane]); }
    { const int c = tid; const float* st = A.in[I_ST_SC] + (size_t)ls * 2 * 512 + c; const float s0 = st[0], s1 = st[512], v = bf2f(proj[C_GC + c]) * bf2f(proj[C_HV + c]); const float* w = A.in[I_SC_W] + l * 3 * 512 + c;
        OUT[1024 + c] = bf2f(proj[C_GB + c]) * (w[0] * s0 + w[512] * s1 + w[1024] * v); float* o = out + O_SSC + (size_t)ls * 2 * 512 + c; o[0] = s1; o[512] = v; }
    { const int c = tid, gI = c >> 7, win = 2 << gI; const float* st = A.in[I_ST_POOL] + (size_t)ls * 15 * 512 + c; const float u = bf2f(proj[C_UP + c]); float* o = out + O_SPOOL + (size_t)ls * 15 * 512 + c; float sum = u;
#pragma unroll
        for (int r = 0; r < 15; ++r) { const float hv = st[r * 512]; if (15 - r < win) sum += hv; if (r > 0) o[(r - 1) * 512] = hv; }
        o[14 * 512] = u; PLs[c] = sum / (float)win - u; }
    BLOCK_SYNC();
    { const int j = tid; const float* wg = A.in[I_W_GLU] + (size_t)l * 512 * 512 + j; float z = A.in[I_B_GLU][l * 512 + j];
#pragma unroll 8
        for (int i = 0; i < 512; ++i) z += Y5[i] * wg[(size_t)i * 512];
        OUT[512 + j] = Y5[j] * sigmoid_f(z);
        const int gI = tid >> 7, d = tid & 127; const float* wp = A.in[I_POOL_W] + ((size_t)l * 4 + gI) * 128 * 128 + d; float acc = 0.f;
#pragma unroll 8
        for (int c = 0; c < 128; ++c) acc += PLs[128 * gI + c] * wp[c * 128];
        OUT[1536 + tid] = acc * A.in[I_POOL_SCALE][l * 512 + tid]; }
    BLOCK_SYNC();
    if (wave < 4) { float v[8]; float sq = 0.f;
#pragma unroll
        for (int e = 0; e < 8; ++e) { v[e] = OUT[512 * wave + 8 * lane + e]; sq += v[e] * v[e]; }
        const float rs = 1.0f / sqrtf(wave_sum(sq) * (1.0f / 512.0f) + EPS);
        v4u o; o.x = cvtpk(v[0] * rs, v[1] * rs); o.y = cvtpk(v[2] * rs, v[3] * rs); o.z = cvtpk(v[4] * rs, v[5] * rs); o.w = cvtpk(v[6] * rs, v[7] * rs);
        *(GAS v4u*)((bf16*)(ws + WS_MIX) + (size_t)(MP + s) * D + 512 * wave + 8 * lane) = o; }
    BLOCK_SYNC();
}

__device__ __forceinline__ void att_prompt_unit(const Args& A, LAS unsigned char* lds, int l, int b, int hd, int qb, int tid, int lane, int wave) {
    asm volatile("" : "+v"(tid)); lane = tid & 63; wave = __builtin_amdgcn_readfirstlane(tid >> 6);
    unsigned char* ws = A.ws; const int fr = lane & 15, fq = lane >> 4, grow0 = b * T + qb * 128;
    const bf16* Q = (const bf16*)(ws + WS_Q) + (size_t)grow0 * D + hd * HDX; const bf16* K = (const bf16*)(ws + WS_KB) + ((size_t)l * MROWS + b * NMEM) * D + hd * HDX;
    const bf16* V = (const bf16*)(ws + WS_VT) + (((size_t)l * NB + b) * D + hd * HDX) * NMEM; bf16* O = (bf16*)(ws + WS_O) + (size_t)grow0 * D + hd * HDX;
    LAS unsigned char* PS = lds; LAS unsigned char* KS = lds + 67584; LAS unsigned char* QS = lds + 104448; LAS unsigned char* VS = lds + 67584;
    f32x4 acc[16];
#pragma unroll
    for (int i = 0; i < 16; ++i) acc[i] = (f32x4){0.f, 0.f, 0.f, 0.f};
#pragma unroll 1
    for (int ds = 0; ds < 8; ++ds) {
#pragma unroll
        for (int i = 0; i < 4; ++i) { const int id = tid + NTHR * i, key = id >> 3, part = id & 7; *(LAS v4u*)(KS + (key * 72 + 8 * part) * 2) = *(const GAS v4u*)(K + (size_t)key * D + 64 * ds + 8 * part); }
#pragma unroll
        for (int i = 0; i < 2; ++i) { const int id = tid + NTHR * i, r = id >> 3, part = id & 7; *(LAS v4u*)(QS + (r * 72 + 8 * part) * 2) = *(const GAS v4u*)(Q + (size_t)r * D + 64 * ds + 8 * part); }
        BLOCK_SYNC();
#pragma unroll
        for (int ks = 0; ks < 2; ++ks) { const bf16x8 fa = ldsfrag(QS + ((16 * wave + fr) * 72 + 32 * ks + 8 * fq) * 2);
#pragma unroll
            for (int kt = 0; kt < 16; ++kt) acc[kt] = mfma16(fa, ldsfrag(KS + ((16 * kt + fr) * 72 + 32 * ks + 8 * fq) * 2), acc[kt]); }
        BLOCK_SYNC();
    }
    float inv[4]; const float scale = 0.044194173824159216f;
#pragma unroll
    for (int e = 0; e < 4; ++e) { float m = acc[0][e];
#pragma unroll
        for (int kt = 1; kt < 16; ++kt) m = fmaxf(m, acc[kt][e]);
        m = max16(m); float sum = 0.f;
#pragma unroll
        for (int kt = 0; kt < 16; ++kt) { const float p = __expf((acc[kt][e] - m) * scale); sum += p; *(LAS bf16*)(PS + ((16 * wave + 4 * fq + e) * 264 + 16 * kt + fr) * 2) = f2b(p); }
        inv[e] = 1.0f / sum16(sum); }
#pragma unroll 1
    for (int ds = 0; ds < 8; ++ds) {
#pragma unroll
        for (int i = 0; i < 4; ++i) { const int id = tid + NTHR * i, dr = id >> 5, part = id & 31; *(LAS v4u*)(VS + (dr * 264 + 8 * part) * 2) = *(const GAS v4u*)(V + (size_t)(64 * ds + dr) * NMEM + 8 * part); }
        BLOCK_SYNC();
        f32x4 o[4] = {(f32x4){0.f, 0.f, 0.f, 0.f}, (f32x4){0.f, 0.f, 0.f, 0.f}, (f32x4){0.f, 0.f, 0.f, 0.f}, (f32x4){0.f, 0.f, 0.f, 0.f}};
#pragma unroll
        for (int ks = 0; ks < 8; ++ks) { const bf16x8 fa = ldsfrag(PS + ((16 * wave + fr) * 264 + 32 * ks + 8 * fq) * 2);
#pragma unroll
            for (int dt = 0; dt < 4; ++dt) o[dt] = mfma16(fa, ldsfrag(VS + ((16 * dt + fr) * 264 + 32 * ks + 8 * fq) * 2), o[dt]); }
#pragma unroll
        for (int dt = 0; dt < 4; ++dt)
#pragma unroll
            for (int e = 0; e < 4; ++e) O[(size_t)(16 * wave + 4 * fq + e) * D + 64 * ds + 16 * dt + fr] = f2b(o[dt][e] * inv[e]);
        BLOCK_SYNC();
    }
}
__device__ __forceinline__ void att_sample_unit(const Args& A, LAS unsigned char* lds, int l, int s, int hp, int tid, int lane, int wave) {
    asm volatile("" : "+v"(tid)); lane = tid & 63; wave = __builtin_amdgcn_readfirstlane(tid >> 6);
    unsigned char* ws = A.ws; const bf16* Q = (const bf16*)(ws + WS_Q) + (size_t)(MP + s) * D + hp * 1024;
    const float* K = A.in[I_CK] + (((size_t)l * MS + s) * NMEM) * D + hp * 1024; const float* V = A.in[I_CV] + (((size_t)l * MS + s) * NMEM) * D + hp * 1024;
    LAS float* SC = (LAS float*)lds; LAS float* RED = (LAS float*)(lds + 2048);
    f32x4 q[4];
#pragma unroll
    for (int j = 0; j < 4; ++j) { const v2u w = *(const GAS v2u*)(Q + 4 * lane + 256 * j); q[j] = (f32x4){bf_lo(w.x), bf_hi(w.x), bf_lo(w.y), bf_hi(w.y)}; }
#pragma unroll 4
    for (int kk = 0; kk < 32; ++kk) { const int key = 32 * wave + kk; const GAS f32x4* kr = (const GAS f32x4*)(K + (size_t)key * D) + lane; float p0, p1;
        { const f32x4 a = kr[0], b2 = kr[64], c = kr[128], d = kr[192];
            p0 = (a.x * q[0].x + a.y * q[0].y) + (a.z * q[0].z + a.w * q[0].w) + (b2.x * q[1].x + b2.y * q[1].y) + (b2.z * q[1].z + b2.w * q[1].w);
            p1 = (c.x * q[2].x + c.y * q[2].y) + (c.z * q[2].z + c.w * q[2].w) + (d.x * q[3].x + d.y * q[3].y) + (d.z * q[3].z + d.w * q[3].w); }
        p0 = wave_sum(p0); p1 = wave_sum(p1);
        if (lane == 0) { SC[key] = p0; SC[256 + key] = p1; } }
    BLOCK_SYNC();
    if (wave < 2) { const float scale = 0.044194173824159216f; float v[4]; float m = -3.0e38f;
#pragma unroll
        for (int e = 0; e < 4; ++e) { v[e] = SC[256 * wave + lane + 64 * e]; m = fmaxf(m, v[e]); }
#pragma unroll
        for (int o = 1; o < 64; o <<= 1) m = fmaxf(m, __shfl_xor(m, o));
        float sum = 0.f;
#pragma unroll
        for (int e = 0; e < 4; ++e) { v[e] = __expf((v[e] - m) * scale); sum += v[e]; }
        const float inv = 1.0f / wave_sum(sum);
#pragma unroll
        for (int e = 0; e < 4; ++e) SC[256 * wave + lane + 64 * e] = v[e] * inv; }
    BLOCK_SYNC();
    f32x4 o[4] = {(f32x4){0.f, 0.f, 0.f, 0.f}, (f32x4){0.f, 0.f, 0.f, 0.f}, (f32x4){0.f, 0.f, 0.f, 0.f}, (f32x4){0.f, 0.f, 0.f, 0.f}};
#pragma unroll 4
    for (int kk = 0; kk < 32; ++kk) { const int key = 32 * wave + kk; const GAS f32x4* vr = (const GAS f32x4*)(V + (size_t)key * D) + lane; const float p0 = SC[key], p1 = SC[256 + key];
        o[0] += vr[0] * p0; o[1] += vr[64] * p0; o[2] += vr[128] * p1; o[3] += vr[192] * p1; }
#pragma unroll
    for (int j = 0; j < 4; ++j) *(LAS f32x4*)(RED + wave * 1024 + 4 * lane + 256 * j) = o[j];
    BLOCK_SYNC();
    { float a0 = 0.f, a1 = 0.f;
#pragma unroll
        for (int w = 0; w < 8; ++w) { const f32x2 v = *(const LAS f32x2*)(RED + w * 1024 + 2 * tid); a0 += v.x; a1 += v.y; }
        *(GAS unsigned*)((bf16*)(ws + WS_O) + (size_t)(MP + s) * D + hp * 1024 + 2 * tid) = cvtpk(a0, a1); }
    BLOCK_SYNC();
}

__device__ __forceinline__ void final_norm(const Args& A, int vcu, int G, int wave, int lane) {
    unsigned char* ws = A.ws; const float* H = (const float*)(ws + WS_H); const float* ssq = (const float*)(ws + WS_CTL) + CW_SSQ + 6 * MPAD; const int gw = vcu * NWAVES + wave, NGW = G * NWAVES;
    for (int m = gw; m < MR; m += NGW) { const float rs = 1.0f / sqrtf(ssq[m] * (1.0f / D) + EPS); const GAS f32x4* hr = (const GAS f32x4*)(H + (size_t)m * D) + lane; const GAS f32x4* gr = (const GAS f32x4*)A.in[I_G_FINAL] + lane;
        GAS f32x4* o = (GAS f32x4*)(A.out + (m < MP ? O_YP + (size_t)m * D : O_YS + (size_t)(m - MP) * D)) + lane;
#pragma unroll
        for (int j = 0; j < 8; ++j) o[64 * j] = hr[64 * j] * gr[64 * j] * rs; }
}

constexpr int PH_PER_LAYER = 10, PH_FINAL = 2 + NL * PH_PER_LAYER, NPHASE = PH_FINAL + 1;
__global__ void __launch_bounds__(NTHR, 2) mk_fwd(Args args) {
    extern __shared__ __attribute__((aligned(16))) unsigned char lds_raw[];
    LAS unsigned char* lds = (LAS unsigned char*)lds_raw;
    volatile LAS unsigned* MISC = (volatile LAS unsigned*)(lds + MISC_OFF);
    int tid = threadIdx.x, lane = tid & 63, wave = __builtin_amdgcn_readfirstlane(tid >> 6);
#define RETID() do { asm volatile("" : "+v"(tid)); lane = tid & 63; wave = __builtin_amdgcn_readfirstlane(tid >> 6); } while (0)
    const int G = gridDim.x; const int bx = blockIdx.x; const int vcu = (G % 8 == 0) ? (bx % 8) * (G / 8) + bx / 8 : bx;
    unsigned char* ws = args.ws;
    for (int u = tid; u < (LDS_BYTES - LDSCTL_OFF) / 4; u += NTHR) ((LAS unsigned*)(lds + LDSCTL_OFF))[u] = 0u;
    __syncthreads();
    XcdBarrier bar; bar.bar = (unsigned*)(ws + WS_CTL) + CW_BAR; bar.x = 0; bar.st = nullptr;
    if (!MK_PER_PHASE) bar = xcd_barrier_post((unsigned*)(ws + WS_CTL) + CW_BAR, MISC + 8);
    const int lo = args.ph_lo, hi = args.ph_hi;
#ifdef ONLY_PH
#define IN(k) (((k) < 2 || (k) >= PH_FINAL) ? ((k) == ONLY_PH) : (((k) - 2) % PH_PER_LAYER + 2 == ONLY_PH) && lo <= (k) && (k) < hi)
#else
#define IN(k) (lo <= (k) && (k) < hi)
#endif
#define GRID_BAR() do { if (!MK_PER_PHASE) xcd_barrier(bar); } while (0)
#define SSQ(s) ((float*)(ws + WS_CTL) + CW_SSQ + (s) * MPAD)
    if (IN(0)) { RETID(); p0_prologue(args, lds, vcu, G, wave, lane); GRID_BAR(); }
    if (IN(1)) { RETID();
        pg8::Gemm g{(const bf16*)(ws + WS_MEMB), (const bf16*)(ws + WS_WKV), MROWS, 4 * D, D}; pg8::StaticOrder S; S.init(MROWS, 4 * D, G, bx);
        pg8::EpiKV E{args.out + O_PMK, (size_t)(O_PMV - O_PMK), (bf16*)(ws + WS_KB), (bf16*)(ws + WS_VT), (const float*)(ws + WS_RSTDM)};
        pg8::gemm_phase<pg8::EpiKV, pg8::StaticOrder, true, true>(lds + RING_OFF, g, S, E, tid); GRID_BAR(); }
#pragma unroll 1
    for (int l = 0; l < NL; ++l) {
        const int pb = 2 + l * PH_PER_LAYER; const bf16* wl = (const bf16*)(ws + WS_W + (size_t)l * W_L);
        if (IN(pb + 0)) { RETID();
#ifndef NO_DT
            dt_rows(args, l, vcu, G, wave, lane);
#endif
            pg8::Gemm g{(const bf16*)(ws + WS_HB), (const bf16*)((const unsigned char*)wl + WO_IN), MPAD, NIN, D}; pg8::StaticOrder S; S.init(MPAD, NIN, G, bx);
            pg8::EpiScaleBf16<0> E{(bf16*)(ws + WS_PROJ), NIN, SSQ(3 * l)};
            pg8::gemm_phase<pg8::EpiScaleBf16<0>, pg8::StaticOrder, true, true>(lds + RING_OFF, g, S, E, tid); GRID_BAR(); }
        if (IN(pb + 1)) { RETID();
#pragma unroll 1
            for (int u = vcu; u < 512; u += G) { if (u < 256) ma_s5_unit(args, lds, l, u >> 6, u & 63, lane, wave); else { const int v = u - 256; ma_ssd_unit(args, lds, l, v >> 6, (v >> 1) & 31, v & 1, tid, lane, wave); } }
            GRID_BAR(); }
        if (IN(pb + 2)) { RETID(); mb_scan(args, l, vcu, G, tid); GRID_BAR(); }
        if (IN(pb + 3)) { RETID();
#pragma unroll 1
            for (int u = vcu; u < 512; u += G) {
#ifndef NO_MC_S5
                if (u < 256) mc_s5_unit(args, lds, l, u >> 6, u & 63, tid, lane, wave); else
#endif
#ifndef NO_MC_REST
                if (u >= 256 && u < 384) { const int v = u - 256; mc_rest_unit(args, lds, l, v >> 5, v & 31, tid, lane, wave); } else
#endif
#ifndef NO_MC_SAMPLE
                if (u >= 384) mc_sample_unit(args, lds, l, u - 384, tid, lane, wave);
#endif
                { } }
            GRID_BAR(); }
        if (IN(pb + 4)) { RETID();
            pg8::Gemm g{(const bf16*)(ws + WS_MIX), (const bf16*)((const unsigned char*)wl + WO_OUT), MPAD, D, D}; pg8::StaticOrder S; S.init(MPAD, D, G, bx);
            pg8::EpiRes E{(float*)(ws + WS_H), (bf16*)(ws + WS_HB), SSQ(3 * l + 1), D};
            pg8::gemm_phase<pg8::EpiRes, pg8::StaticOrder, true, true>(lds + RING_OFF, g, S, E, tid); GRID_BAR(); }
        if (IN(pb + 5)) { RETID();
            pg8::Gemm g{(const bf16*)(ws + WS_HB), (const bf16*)((const unsigned char*)wl + WO_Q), MPAD, D, D}; pg8::StaticOrder S; S.init(MPAD, D, G, bx);
            pg8::EpiScaleBf16<0> E{(bf16*)(ws + WS_Q), D, SSQ(3 * l + 1)};
            pg8::gemm_phase<pg8::EpiScaleBf16<0>, pg8::StaticOrder, true, true>(lds + RING_OFF, g, S, E, tid); GRID_BAR(); }
        if (IN(pb + 6)) { RETID();
#pragma unroll 1
            for (int u = vcu; u < 512; u += G) { if (u < 256) att_prompt_unit(args, lds, l, u >> 6, (u >> 4) & 3, u & 15, tid, lane, wave); else { const int v = u - 256; att_sample_unit(args, lds, l, v >> 1, v & 1, tid, lane, wave); } }
            GRID_BAR(); }
        if (IN(pb + 7)) { RETID();
            pg8::Gemm g{(const bf16*)(ws + WS_O), (const bf16*)((const unsigned char*)wl + WO_O), MPAD, D, D}; pg8::StaticOrder S; S.init(MPAD, D, G, bx);
            pg8::EpiRes E{(float*)(ws + WS_H), (bf16*)(ws + WS_HB), SSQ(3 * l + 2), D};
            pg8::gemm_phase<pg8::EpiRes, pg8::StaticOrder, true, true>(lds + RING_OFF, g, S, E, tid); GRID_BAR(); }
        if (IN(pb + 8)) { RETID();
            pg8::Gemm g{(const bf16*)(ws + WS_HB), (const bf16*)((const unsigned char*)wl + WO_UP), MPAD, FF, D}; pg8::StaticOrder S; S.init(MPAD, FF, G, bx);
            pg8::EpiScaleBf16<1> E{(bf16*)(ws + WS_HID), FF, SSQ(3 * l + 2)};
            pg8::gemm_phase<pg8::EpiScaleBf16<1>, pg8::StaticOrder, true, true>(lds + RING_OFF, g, S, E, tid); GRID_BAR(); }
        if (IN(pb + 9)) { RETID();
            pg8::Gemm g{(const bf16*)(ws + WS_HID), (const bf16*)((const unsigned char*)wl + WO_DOWN), MPAD, D, FF}; pg8::StaticOrder S; S.init(MPAD, D, G, bx);
            pg8::EpiRes E{(float*)(ws + WS_H), (bf16*)(ws + WS_HB), SSQ(3 * l + 3), D};
            pg8::gemm_phase<pg8::EpiRes, pg8::StaticOrder, true, true>(lds + RING_OFF, g, S, E, tid); GRID_BAR(); }
    }
    if (IN(PH_FINAL)) final_norm(args, vcu, G, wave, lane);
#undef IN
#undef GRID_BAR
#undef SSQ
}

extern "C" void kernel_launch(void* const* d_in, const int* in_sizes, int n_in, void* d_out, int out_size, void* d_ws, size_t ws_size, hipStream_t stream) {
    static int grid = 0;
    if (grid == 0) {
        if (n_in != N_IN || in_sizes[0] != MP * D || (size_t)out_size != O_END || ws_size < WS_END) { fprintf(stderr, "kernel_launch: unexpected problem (n_in %d, in0 %d, out %d, ws %zu); nothing launched\n", n_in, n_in > 0 ? in_sizes[0] : -1, out_size, ws_size); grid = -1; return; }
        int dev = 0, cus = 0, per_cu = 0;
        if (hipGetDevice(&dev) != hipSuccess || hipDeviceGetAttribute(&cus, hipDeviceAttributeMultiprocessorCount, dev) != hipSuccess) { fprintf(stderr, "kernel_launch: device query failed\n"); grid = -1; return; }
        if (hipFuncSetAttribute((const void*)mk_fwd, hipFuncAttributeMaxDynamicSharedMemorySize, LDS_BYTES) != hipSuccess) { fprintf(stderr, "kernel_launch: hipFuncSetAttribute failed\n"); grid = -1; return; }
        if (hipOccupancyMaxActiveBlocksPerMultiprocessor(&per_cu, (const void*)mk_fwd, NTHR, LDS_BYTES) != hipSuccess || per_cu < 1) fprintf(stderr, "kernel_launch: note: occupancy query reports %d workgroups per CU\n", per_cu);
        (void)hipGetLastError();
        grid = cus;
    }
    if (grid < 0) return;
    if (hipMemsetAsync((char*)d_ws + WS_CTL, 0, CTL_ZERO_BYTES, stream) != hipSuccess) { fprintf(stderr, "kernel_launch: hipMemsetAsync failed\n"); return; }
    Args a{};
    for (int i = 0; i < N_IN; ++i) a.in[i] = (const float*)d_in[i];
    a.out = (float*)d_out; a.ws = (unsigned char*)d_ws;
#if MK_PER_PHASE
    for (int p = 0; p < NPHASE; ++p) { a.ph_lo = p; a.ph_hi = p + 1; hipLaunchKernelGGL(mk_fwd, dim3(grid), dim3(NTHR), LDS_BYTES, stream, a); }
#else
    a.ph_lo = 0; a.ph_hi = NPHASE; hipLaunchKernelGGL(mk_fwd, dim3(grid), dim3(NTHR), LDS_BYTES, stream, a);
#endif
    const hipError_t le = hipPeekAtLastError();
    if (le != hipSuccess) fprintf(stderr, "kernel_launch: launch failed: %s\n", hipGetErrorName(le));
}
```

```cpp
#include <hip/hip_runtime.h>
#include <cstdio>
#include <cstdint>
namespace pg8 {
#define PG8_LAS __attribute__((address_space(3)))
typedef unsigned short bf16_t;
typedef short bf16x8 __attribute__((ext_vector_type(8)));
typedef float f32x4 __attribute__((ext_vector_type(4)));
typedef unsigned u32x4 __attribute__((ext_vector_type(4)));
constexpr int BM = 256, BK = 64, HALF = 128, HTB = HALF * BK * 2  , STAGE_BYTES = 8 * HTB, NXCD = 8, WGM = 8;

__host__ __device__ __forceinline__ int lds_byte(int r, int c) { const int st = (r >> 4) * 2 + (c >> 5), rr = r & 15, cc = c & 31, ob = rr * 64 + cc * 2; return st * 1024 + (ob ^ (((ob >> 9) & 1) << 5)); }
__host__ __device__ __forceinline__ void stage_rc(int b, int& R, int& C) { const int st = b / 1024, sb = b % 1024, swz = sb ^ (((sb >> 9) & 1) << 5); R = (st >> 1) * 16 + swz / 64; C = (st & 1) * 32 + (swz % 64) / 2; }
__host__ __device__ __forceinline__ int perm32(int rho) { const int n = rho >> 4, i = rho & 15; return 8 * (i >> 2) + 4 * n + (i & 3); }

struct Unit { int pm, pn, z; };
struct Gemm { const bf16_t* A; const bf16_t* Bt; int M, N, K; int lda = 0, ldb = 0; };

struct StaticOrder {
    int nM, nN, nwg, G, c;
    __host__ __device__ void init(int M, int N, int G_, int c_) { nM = M / BM; nN = N / BM; nwg = nM * nN; G = G_; c = c_; }
    __host__ __device__ bool next(int i, Unit& u) const {
        const long L = (long)i * G + c; if (L >= nwg) return false;
        int wgid = (int)L; { const int q = nwg / NXCD, r = nwg % NXCD, xcd = wgid % NXCD, off = wgid / NXCD; wgid = (xcd < r ? xcd * (q + 1) : r * (q + 1) + (xcd - r) * q) + off; }
        const int nig = WGM * nN, gid = wgid / nig, fm = gid * WGM, gsz = (nM - fm) < WGM ? (nM - fm) : WGM;
        u.pm = fm + ((wgid % nig) % gsz); u.pn = (wgid % nig) / gsz; u.z = 0; return true;
    }
    __device__ __forceinline__ void a_ready(const Unit&) const {}
    __device__ __forceinline__ void done(const Unit&) const {}
    __device__ __forceinline__ const char* abase(const Gemm& g, const Unit& u) const { return (const char*)g.A + (size_t)u.pm * 256 * (size_t)(g.lda ? g.lda : g.K) * 2; }
    __device__ __forceinline__ const char* bbase(const Gemm& g, const Unit& u) const { return (const char*)g.Bt + (size_t)u.pn * 256 * (size_t)(g.ldb ? g.ldb : g.K) * 2; }
};


struct PreOrder {
    int G, c; const bf16_t* a0; const bf16_t* b0; const bf16_t* a1; const bf16_t* b1;
    __device__ __forceinline__ bool next(int i, Unit& u) const { const long L = (long)i * G + c; if (L >= 256) return false; const int mode = (int)(L >> 7), head = (int)((L & 127) >> 5), x = (int)((L & 31) >> 3), y = (int)(L & 7);
        u.z = mode * 4 + head; u.pm = mode ? y : x; u.pn = mode ? x : y; return true; }
    __device__ __forceinline__ void a_ready(const Unit&) const {}
    __device__ __forceinline__ void done(const Unit&) const {}
    __device__ __forceinline__ const char* abase(const Gemm&, const Unit& u) const { return (const char*)((u.z >> 2) ? a1 : a0) + ((size_t)u.pm * 256 * 2048 + (size_t)(u.z & 3) * 512) * 2; }
    __device__ __forceinline__ const char* bbase(const Gemm&, const Unit& u) const { return (const char*)((u.z >> 2) ? b1 : b0) + ((size_t)u.pn * 256 * 2048 + (size_t)(u.z & 3) * 512) * 2; }
};
typedef float cvt_f32x2 __attribute__((ext_vector_type(2)));
typedef __bf16 cvt_bf16x2 __attribute__((ext_vector_type(2)));
__device__ __forceinline__ unsigned cvt_pk_bf16(float lo, float hi) { const cvt_f32x2 v = {lo, hi}; return __builtin_bit_cast(unsigned, __builtin_convertvector(v, cvt_bf16x2)); }

__device__ __forceinline__ void ssq_add(unsigned long long* p, float v) { (void)__hip_atomic_fetch_add(p, (unsigned long long)__float2ull_rn(v * 16777216.0f), __ATOMIC_RELAXED, __HIP_MEMORY_SCOPE_AGENT); }
__device__ __forceinline__ float ssq_rstd(unsigned long long v) { return __builtin_amdgcn_rsqf((float)v * (1.0f / (16777216.0f * 2048.0f)) + 1e-6f); }
template <int ACT> struct EpiScaleBf16 {
    static constexpr bool PERM = true, AFTER_DRAIN = false;
    bf16_t* O; int ldc; const unsigned long long* ssq;
    __device__ __forceinline__ void operator()(const f32x4 (&acc)[2][2][4][2], const Unit& u, int wr, int wc, int fr, int fq) const {
        const int row0 = u.pm * BM + wr * 64 + fr, col0 = u.pn * BM + wc * 32 + 8 * fq;
        unsigned long long sv[2][4];
#pragma unroll
        for (int ai = 0; ai < 2; ++ai)
#pragma unroll
            for (int m = 0; m < 4; ++m) sv[ai][m] = ssq[row0 + ai * HALF + m * 16];
#pragma unroll
        for (int ai = 0; ai < 2; ++ai)
#pragma unroll
            for (int m = 0; m < 4; ++m) asm volatile("" : "+v"(sv[ai][m]));
#pragma unroll
        for (int ai = 0; ai < 2; ++ai)
#pragma unroll
            for (int m = 0; m < 4; ++m) { const int row = row0 + ai * HALF + m * 16; const float rs = ssq_rstd(sv[ai][m]);
                bf16_t* rowp = O + (size_t)row * ldc + col0;
#pragma unroll
                for (int bj = 0; bj < 2; ++bj) { f32x4 v0 = acc[ai][bj][m][0] * rs, v1 = acc[ai][bj][m][1] * rs;
                    if (ACT == 1) {
#pragma unroll
                        for (int e = 0; e < 4; ++e) { const float a0 = v0[e] > 0.f ? v0[e] : 0.f, a1 = v1[e] > 0.f ? v1[e] : 0.f; v0[e] = a0 * a0; v1[e] = a1 * a1; } }
                    u32x4 w; w.x = cvt_pk_bf16(v0[0], v0[1]); w.y = cvt_pk_bf16(v0[2], v0[3]); w.z = cvt_pk_bf16(v1[0], v1[1]); w.w = cvt_pk_bf16(v1[2], v1[3]);
                    *(u32x4*)(rowp + bj * HALF) = w; } }
    }
};
struct EpiRes {
    static constexpr bool PERM = true, AFTER_DRAIN = false;
    const float* hin; float* h; bf16_t* hb; unsigned long long* ssq_out; int ldc;
    __device__ __forceinline__ void operator()(const f32x4 (&acc)[2][2][4][2], const Unit& u, int wr, int wc, int fr, int fq) const {
        const int row0 = u.pm * BM + wr * 64 + fr, col0 = u.pn * BM + wc * 32 + 8 * fq;
#pragma unroll
        for (int ai = 0; ai < 2; ++ai) {
            f32x4 hv[4][2][2];
#pragma unroll
            for (int m = 0; m < 4; ++m) { const float* hp = hin + (size_t)(row0 + ai * HALF + m * 16) * ldc + col0;
#pragma unroll
                for (int bj = 0; bj < 2; ++bj) { hv[m][bj][0] = *(const f32x4*)(hp + bj * HALF); hv[m][bj][1] = *(const f32x4*)(hp + bj * HALF + 4); } }
#pragma unroll
            for (int m = 0; m < 4; ++m)
#pragma unroll
                for (int bj = 0; bj < 2; ++bj) { asm volatile("" : "+v"(hv[m][bj][0])); asm volatile("" : "+v"(hv[m][bj][1])); }
#pragma unroll
            for (int m = 0; m < 4; ++m) { const int row = row0 + ai * HALF + m * 16; float sq = 0.f;
                float* hp = h + (size_t)row * ldc + col0; bf16_t* bp = hb + (size_t)row * ldc + col0;
#pragma unroll
                for (int bj = 0; bj < 2; ++bj) { f32x4 v0 = hv[m][bj][0] + acc[ai][bj][m][0], v1 = hv[m][bj][1] + acc[ai][bj][m][1];
                    *(f32x4*)(hp + bj * HALF) = v0; *(f32x4*)(hp + bj * HALF + 4) = v1;
                    sq += (v0[0] * v0[0] + v0[1] * v0[1]) + (v0[2] * v0[2] + v0[3] * v0[3]) + (v1[0] * v1[0] + v1[1] * v1[1]) + (v1[2] * v1[2] + v1[3] * v1[3]);
                    u32x4 w; w.x = cvt_pk_bf16(v0[0], v0[1]); w.y = cvt_pk_bf16(v0[2], v0[3]); w.z = cvt_pk_bf16(v1[0], v1[1]); w.w = cvt_pk_bf16(v1[2], v1[3]);
                    *(u32x4*)(bp + bj * HALF) = w; }
                sq += __shfl_xor(sq, 16); sq += __shfl_xor(sq, 32);
                if (fq == 0) ssq_add(ssq_out + row, sq); } }
    }
};
struct EpiResB {
    static constexpr bool PERM = true, AFTER_DRAIN = false;
    bf16_t* hb; unsigned long long* ssq_out; int ldc; const float* xin;
    __device__ __forceinline__ void operator()(const f32x4 (&acc)[2][2][4][2], const Unit& u, int wr, int wc, int fr, int fq) const {
        const int row0 = u.pm * BM + wr * 64 + fr, col0 = u.pn * BM + wc * 32 + 8 * fq;
        if (xin) {
#pragma unroll
            for (int ai = 0; ai < 2; ++ai) {
                f32x4 xv[4][2][2];
#pragma unroll
                for (int m = 0; m < 4; ++m) { const float* hp = xin + (size_t)(row0 + ai * HALF + m * 16) * ldc + col0;
#pragma unroll
                    for (int bj = 0; bj < 2; ++bj) { xv[m][bj][0] = *(const f32x4*)(hp + bj * HALF); xv[m][bj][1] = *(const f32x4*)(hp + bj * HALF + 4); } }
#pragma unroll
                for (int m = 0; m < 4; ++m)
#pragma unroll
                    for (int bj = 0; bj < 2; ++bj) { asm volatile("" : "+v"(xv[m][bj][0])); asm volatile("" : "+v"(xv[m][bj][1])); }
#pragma unroll
                for (int m = 0; m < 4; ++m) { const int row = row0 + ai * HALF + m * 16; float sq = 0.f; bf16_t* bp = hb + (size_t)row * ldc + col0;
#pragma unroll
                    for (int bj = 0; bj < 2; ++bj) { const f32x4 v0 = xv[m][bj][0] + acc[ai][bj][m][0], v1 = xv[m][bj][1] + acc[ai][bj][m][1];
                        sq += (v0[0] * v0[0] + v0[1] * v0[1]) + (v0[2] * v0[2] + v0[3] * v0[3]) + (v1[0] * v1[0] + v1[1] * v1[1]) + (v1[2] * v1[2] + v1[3] * v1[3]);
                        u32x4 w; w.x = cvt_pk_bf16(v0[0], v0[1]); w.y = cvt_pk_bf16(v0[2], v0[3]); w.z = cvt_pk_bf16(v1[0], v1[1]); w.w = cvt_pk_bf16(v1[2], v1[3]);
                        *(u32x4*)(bp + bj * HALF) = w; }
                    sq += __shfl_xor(sq, 16); sq += __shfl_xor(sq, 32);
                    if (fq == 0) ssq_add(ssq_out + row, sq); } }
            return; }
        u32x4 hv[2][4][2];
#pragma unroll
        for (int ai = 0; ai < 2; ++ai)
#pragma unroll
            for (int m = 0; m < 4; ++m) { const bf16_t* bp = hb + (size_t)(row0 + ai * HALF + m * 16) * ldc + col0;
#pragma unroll
                for (int bj = 0; bj < 2; ++bj) hv[ai][m][bj] = *(const u32x4*)(bp + bj * HALF); }
#pragma unroll
        for (int ai = 0; ai < 2; ++ai)
#pragma unroll
            for (int m = 0; m < 4; ++m) { asm volatile("" : "+v"(hv[ai][m][0])); asm volatile("" : "+v"(hv[ai][m][1])); }
#pragma unroll
        for (int ai = 0; ai < 2; ++ai)
#pragma unroll
            for (int m = 0; m < 4; ++m) { const int row = row0 + ai * HALF + m * 16; float sq = 0.f; bf16_t* bp = hb + (size_t)row * ldc + col0;
#pragma unroll
                for (int bj = 0; bj < 2; ++bj) { const u32x4 w0 = hv[ai][m][bj];
                    const f32x4 v0 = (f32x4){__uint_as_float(w0.x << 16), __uint_as_float(w0.x & 0xffff0000u), __uint_as_float(w0.y << 16), __uint_as_float(w0.y & 0xffff0000u)} + acc[ai][bj][m][0];
                    const f32x4 v1 = (f32x4){__uint_as_float(w0.z << 16), __uint_as_float(w0.z & 0xffff0000u), __uint_as_float(w0.w << 16), __uint_as_float(w0.w & 0xffff0000u)} + acc[ai][bj][m][1];
                    sq += (v0[0] * v0[0] + v0[1] * v0[1]) + (v0[2] * v0[2] + v0[3] * v0[3]) + (v1[0] * v1[0] + v1[1] * v1[1]) + (v1[2] * v1[2] + v1[3] * v1[3]);
                    u32x4 w; w.x = cvt_pk_bf16(v0[0], v0[1]); w.y = cvt_pk_bf16(v0[2], v0[3]); w.z = cvt_pk_bf16(v1[0], v1[1]); w.w = cvt_pk_bf16(v1[2], v1[3]);
                    *(u32x4*)(bp + bj * HALF) = w; }
                sq += __shfl_xor(sq, 16); sq += __shfl_xor(sq, 32);
                if (fq == 0) ssq_add(ssq_out + row, sq); }
    }
};
struct EpiResFinal {
    static constexpr bool PERM = true, AFTER_DRAIN = true;
    const bf16_t* hin; float* y; const float* gfin; unsigned long long* ssq_out; unsigned* cnt; int ldc;
    __device__ __forceinline__ void operator()(const f32x4 (&)[2][2][4][2], const Unit&, int, int, int, int) const {}
    __device__ __forceinline__ void fused(f32x4 (&acc)[2][2][4][2], const Unit& u, int wr, int wc, int fr, int fq, PG8_LAS unsigned char*, int wid, int lane) const {
        const int row0 = u.pm * BM + wr * 64 + fr, col0 = u.pn * BM + wc * 32 + 8 * fq;
#pragma unroll
        for (int ai = 0; ai < 2; ++ai) {
            u32x4 hv[4][2];
#pragma unroll
            for (int m = 0; m < 4; ++m) { const bf16_t* hp = hin + (size_t)(row0 + ai * HALF + m * 16) * ldc + col0;
#pragma unroll
                for (int bj = 0; bj < 2; ++bj) hv[m][bj] = *(const u32x4*)(hp + bj * HALF); }
#pragma unroll
            for (int m = 0; m < 4; ++m) { asm volatile("" : "+v"(hv[m][0])); asm volatile("" : "+v"(hv[m][1])); }
#pragma unroll
            for (int m = 0; m < 4; ++m) { const int row = row0 + ai * HALF + m * 16; float sq = 0.f;
#pragma unroll
                for (int bj = 0; bj < 2; ++bj) { const u32x4 w0 = hv[m][bj];
                    const f32x4 v0 = (f32x4){__uint_as_float(w0.x << 16), __uint_as_float(w0.x & 0xffff0000u), __uint_as_float(w0.y << 16), __uint_as_float(w0.y & 0xffff0000u)} + acc[ai][bj][m][0];
                    const f32x4 v1 = (f32x4){__uint_as_float(w0.z << 16), __uint_as_float(w0.z & 0xffff0000u), __uint_as_float(w0.w << 16), __uint_as_float(w0.w & 0xffff0000u)} + acc[ai][bj][m][1];
                    acc[ai][bj][m][0] = v0; acc[ai][bj][m][1] = v1;
                    sq += (v0[0] * v0[0] + v0[1] * v0[1]) + (v0[2] * v0[2] + v0[3] * v0[3]) + (v1[0] * v1[0] + v1[1] * v1[1]) + (v1[2] * v1[2] + v1[3] * v1[3]); }
                sq += __shfl_xor(sq, 16); sq += __shfl_xor(sq, 32);
                if (fq == 0) ssq_add(ssq_out + row, sq); } }
        asm volatile("s_waitcnt vmcnt(0)" ::: "memory");
        __builtin_amdgcn_s_barrier(); asm volatile("" ::: "memory");
        if (wid == 0 && lane == 0) { unsigned* c = cnt + u.pm * 64;
            (void)__hip_atomic_fetch_add(c, 1u, __ATOMIC_RELAXED, __HIP_MEMORY_SCOPE_AGENT);
            unsigned sp = 0; while (__hip_atomic_load(c, __ATOMIC_RELAXED, __HIP_MEMORY_SCOPE_AGENT) < 8u) { __builtin_amdgcn_s_sleep(1); if (++sp > (1u << 22)) break; } }
        __builtin_amdgcn_s_barrier(); asm volatile("" ::: "memory");
        unsigned long long sv[2][4];
#pragma unroll
        for (int ai = 0; ai < 2; ++ai)
#pragma unroll
            for (int m = 0; m < 4; ++m) sv[ai][m] = __hip_atomic_load(ssq_out + row0 + ai * HALF + m * 16, __ATOMIC_RELAXED, __HIP_MEMORY_SCOPE_AGENT);
        f32x4 gv[2][2];
#pragma unroll
        for (int bj = 0; bj < 2; ++bj) { gv[bj][0] = *(const f32x4*)(gfin + col0 + bj * HALF); gv[bj][1] = *(const f32x4*)(gfin + col0 + bj * HALF + 4); }
#pragma unroll
        for (int ai = 0; ai < 2; ++ai)
#pragma unroll
            for (int m = 0; m < 4; ++m) asm volatile("" : "+v"(sv[ai][m]));
#pragma unroll
        for (int ai = 0; ai < 2; ++ai)
#pragma unroll
            for (int m = 0; m < 4; ++m) { const float rs = ssq_rstd(sv[ai][m]); float* yp = y + (size_t)(row0 + ai * HALF + m * 16) * ldc + col0;
#pragma unroll
                for (int bj = 0; bj < 2; ++bj) { *(f32x4*)(yp + bj * HALF) = acc[ai][bj][m][0] * gv[bj][0] * rs; *(f32x4*)(yp + bj * HALF + 4) = acc[ai][bj][m][1] * gv[bj][1] * rs; } }
    }
};
struct EpiResFinalF {
    static constexpr bool PERM = true, AFTER_DRAIN = true;
    const float* hin; float* y; const float* gfin; unsigned long long* ssq_out; unsigned* cnt; int ldc;
    __device__ __forceinline__ void operator()(const f32x4 (&)[2][2][4][2], const Unit&, int, int, int, int) const {}
    __device__ __forceinline__ void fused(f32x4 (&acc)[2][2][4][2], const Unit& u, int wr, int wc, int fr, int fq, PG8_LAS unsigned char*, int wid, int lane) const {
        const int row0 = u.pm * BM + wr * 64 + fr, col0 = u.pn * BM + wc * 32 + 8 * fq;
#pragma unroll
        for (int ai = 0; ai < 2; ++ai) {
            f32x4 hv[4][2][2];
#pragma unroll
            for (int m = 0; m < 4; ++m) { const float* hp = hin + (size_t)(row0 + ai * HALF + m * 16) * ldc + col0;
#pragma unroll
                for (int bj = 0; bj < 2; ++bj) { hv[m][bj][0] = __builtin_nontemporal_load((const f32x4*)(hp + bj * HALF)); hv[m][bj][1] = __builtin_nontemporal_load((const f32x4*)(hp + bj * HALF + 4)); } }
#pragma unroll
            for (int m = 0; m < 4; ++m)
#pragma unroll
                for (int bj = 0; bj < 2; ++bj) { asm volatile("" : "+v"(hv[m][bj][0])); asm volatile("" : "+v"(hv[m][bj][1])); }
#pragma unroll
            for (int m = 0; m < 4; ++m) { const int row = row0 + ai * HALF + m * 16; float sq = 0.f;
#pragma unroll
                for (int bj = 0; bj < 2; ++bj) { const f32x4 v0 = hv[m][bj][0] + acc[ai][bj][m][0], v1 = hv[m][bj][1] + acc[ai][bj][m][1]; acc[ai][bj][m][0] = v0; acc[ai][bj][m][1] = v1;
                    sq += (v0[0] * v0[0] + v0[1] * v0[1]) + (v0[2] * v0[2] + v0[3] * v0[3]) + (v1[0] * v1[0] + v1[1] * v1[1]) + (v1[2] * v1[2] + v1[3] * v1[3]); }
                sq += __shfl_xor(sq, 16); sq += __shfl_xor(sq, 32);
                if (fq == 0) ssq_add(ssq_out + row, sq); } }
        asm volatile("s_waitcnt vmcnt(0)" ::: "memory");
        __builtin_amdgcn_s_barrier(); asm volatile("" ::: "memory");
        if (wid == 0 && lane == 0) { unsigned* c = cnt + u.pm * 64;
            (void)__hip_atomic_fetch_add(c, 1u, __ATOMIC_RELAXED, __HIP_MEMORY_SCOPE_AGENT);
            unsigned sp = 0; while (__hip_atomic_load(c, __ATOMIC_RELAXED, __HIP_MEMORY_SCOPE_AGENT) < 8u) { __builtin_amdgcn_s_sleep(1); if (++sp > (1u << 22)) break; } }
        __builtin_amdgcn_s_barrier(); asm volatile("" ::: "memory");
        unsigned long long sv[2][4];
#pragma unroll
        for (int ai = 0; ai < 2; ++ai)
#pragma unroll
            for (int m = 0; m < 4; ++m) sv[ai][m] = __hip_atomic_load(ssq_out + row0 + ai * HALF + m * 16, __ATOMIC_RELAXED, __HIP_MEMORY_SCOPE_AGENT);
        f32x4 gv[2][2];
#pragma unroll
        for (int bj = 0; bj < 2; ++bj) { gv[bj][0] = *(const f32x4*)(gfin + col0 + bj * HALF); gv[bj][1] = *(const f32x4*)(gfin + col0 + bj * HALF + 4); }
#pragma unroll
        for (int ai = 0; ai < 2; ++ai)
#pragma unroll
            for (int m = 0; m < 4; ++m) asm volatile("" : "+v"(sv[ai][m]));
#pragma unroll
        for (int ai = 0; ai < 2; ++ai)
#pragma unroll
            for (int m = 0; m < 4; ++m) { const float rs = ssq_rstd(sv[ai][m]); float* yp = y + (size_t)(row0 + ai * HALF + m * 16) * ldc + col0;
#pragma unroll
                for (int bj = 0; bj < 2; ++bj) { *(f32x4*)(yp + bj * HALF) = acc[ai][bj][m][0] * gv[bj][0] * rs; *(f32x4*)(yp + bj * HALF + 4) = acc[ai][bj][m][1] * gv[bj][1] * rs; } }
    }
};
struct BatchBOrder : StaticOrder {
    int pmb; size_t bbs;
    __device__ __forceinline__ const char* bbase(const Gemm& g, const Unit& u) const { return (const char*)g.Bt + ((size_t)(u.pm / pmb) * bbs + (size_t)u.pn * 256 * (size_t)(g.ldb ? g.ldb : g.K)) * 2; }
};
struct EpiSoftmax {
    static constexpr bool PERM = true, AFTER_DRAIN = true;
    bf16_t* P; int ldc; const unsigned long long* ssq; float scale;
    __device__ __forceinline__ void operator()(const f32x4 (&)[2][2][4][2], const Unit&, int, int, int, int) const {}
    __device__ __forceinline__ void fused(f32x4 (&acc)[2][2][4][2], const Unit& u, int wr, int wc, int fr, int fq, PG8_LAS unsigned char* lds, int wid, int lane) const {
        PG8_LAS float* RM = (PG8_LAS float*)lds; PG8_LAS float* RS = (PG8_LAS float*)(lds + 4096);
        const int r0 = wr * 64 + fr, row0 = u.pm * BM + r0, col0 = u.pn * BM + wc * 32 + 8 * fq;
        unsigned long long sv[2][4];
#pragma unroll
        for (int ai = 0; ai < 2; ++ai)
#pragma unroll
            for (int m = 0; m < 4; ++m) sv[ai][m] = ssq[row0 + ai * HALF + m * 16];
#pragma unroll
        for (int ai = 0; ai < 2; ++ai)
#pragma unroll
            for (int m = 0; m < 4; ++m) asm volatile("" : "+v"(sv[ai][m]));
#pragma unroll
        for (int ai = 0; ai < 2; ++ai)
#pragma unroll
            for (int m = 0; m < 4; ++m) { const float sc = ssq_rstd(sv[ai][m]) * scale; float mx = -3.0e38f;
#pragma unroll
                for (int bj = 0; bj < 2; ++bj)
#pragma unroll
                    for (int n = 0; n < 2; ++n) { f32x4 v = acc[ai][bj][m][n] * sc; acc[ai][bj][m][n] = v; mx = fmaxf(fmaxf(mx, fmaxf(v[0], v[1])), fmaxf(v[2], v[3])); }
                mx = fmaxf(mx, __shfl_xor(mx, 16)); mx = fmaxf(mx, __shfl_xor(mx, 32));
                if (fq == 0) RM[(r0 + ai * HALF + m * 16) * 4 + wc] = mx; }
        asm volatile("s_waitcnt lgkmcnt(0)" ::: "memory"); __builtin_amdgcn_s_barrier(); asm volatile("" ::: "memory");
#pragma unroll
        for (int ai = 0; ai < 2; ++ai)
#pragma unroll
            for (int m = 0; m < 4; ++m) { const f32x4 q = *(const PG8_LAS f32x4*)(RM + (r0 + ai * HALF + m * 16) * 4); const float mx = fmaxf(fmaxf(q[0], q[1]), fmaxf(q[2], q[3])); float sm = 0.f;
#pragma unroll
                for (int bj = 0; bj < 2; ++bj)
#pragma unroll
                    for (int n = 0; n < 2; ++n) { f32x4 v = acc[ai][bj][m][n];
#pragma unroll
                        for (int e = 0; e < 4; ++e) { v[e] = __expf(v[e] - mx); sm += v[e]; }
                        acc[ai][bj][m][n] = v; }
                sm += __shfl_xor(sm, 16); sm += __shfl_xor(sm, 32);
                if (fq == 0) RS[(r0 + ai * HALF + m * 16) * 4 + wc] = sm; }
        asm volatile("s_waitcnt lgkmcnt(0)" ::: "memory"); __builtin_amdgcn_s_barrier(); asm volatile("" ::: "memory");
#pragma unroll
        for (int ai = 0; ai < 2; ++ai)
#pragma unroll
            for (int m = 0; m < 4; ++m) { const f32x4 q = *(const PG8_LAS f32x4*)(RS + (r0 + ai * HALF + m * 16) * 4); const float inv = __builtin_amdgcn_rcpf((q[0] + q[1]) + (q[2] + q[3]));
                bf16_t* rowp = P + (size_t)(row0 + ai * HALF + m * 16) * ldc + col0;
#pragma unroll
                for (int bj = 0; bj < 2; ++bj) { const f32x4 v0 = acc[ai][bj][m][0] * inv, v1 = acc[ai][bj][m][1] * inv;
                    u32x4 w; w.x = cvt_pk_bf16(v0[0], v0[1]); w.y = cvt_pk_bf16(v0[2], v0[3]); w.z = cvt_pk_bf16(v1[0], v1[1]); w.w = cvt_pk_bf16(v1[2], v1[3]);
                    *(u32x4*)(rowp + bj * HALF) = w; } }
    }
};
struct EpiPre {
    static constexpr bool PERM = true, AFTER_DRAIN = false;
    bf16_t* wqk; bf16_t* vwt;
    __device__ __forceinline__ void operator()(const f32x4 (&acc)[2][2][4][2], const Unit& u, int wr, int wc, int fr, int fq) const {
        const int mode = u.z >> 2, head = u.z & 3, r0 = wr * 64 + fr, c0 = wc * 32 + 8 * fq;
#pragma unroll
        for (int ai = 0; ai < 2; ++ai)
#pragma unroll
            for (int m = 0; m < 4; ++m) { const int r = r0 + ai * HALF + m * 16;
#pragma unroll
                for (int bj = 0; bj < 2; ++bj) { const int c = c0 + bj * HALF; const f32x4 v0 = acc[ai][bj][m][0], v1 = acc[ai][bj][m][1];
                    u32x4 w; w.x = cvt_pk_bf16(v0[0], v0[1]); w.y = cvt_pk_bf16(v0[2], v0[3]); w.z = cvt_pk_bf16(v1[0], v1[1]); w.w = cvt_pk_bf16(v1[2], v1[3]);
                    const size_t off = mode == 0 ? (((size_t)u.pm * 1024 + head * 256 + r) * 2048 + u.pn * 256 + c) : (((size_t)u.pn * 2048 + u.pm * 256 + r) * 1024 + head * 256 + c);
                    *(u32x4*)((mode == 0 ? wqk : vwt) + off) = w; } }
    }
};
struct EpiKV {
    static constexpr bool PERM = true, AFTER_DRAIN = false;
    float* outk; size_t voff; bf16_t* kb; bf16_t* vt; bf16_t* vb; const float* rstd;
    __device__ __forceinline__ void operator()(const f32x4 (&acc)[2][2][4][2], const Unit& u, int wr, int wc, int fr, int fq) const {
        const int row0 = u.pm * BM + wr * 64 + fr; const int colt = u.pn * BM, which = colt >> 11, l = which >> 1, isv = which & 1;
        const int col0 = (colt & 2047) + wc * 32 + 8 * fq;
        float sv[2][4];
#pragma unroll
        for (int ai = 0; ai < 2; ++ai)
#pragma unroll
            for (int m = 0; m < 4; ++m) sv[ai][m] = rstd[row0 + ai * HALF + m * 16];
#pragma unroll
        for (int ai = 0; ai < 2; ++ai)
#pragma unroll
            for (int m = 0; m < 4; ++m) asm volatile("" : "+v"(sv[ai][m]));
#pragma unroll
        for (int ai = 0; ai < 2; ++ai)
#pragma unroll
            for (int m = 0; m < 4; ++m) { const int row = row0 + ai * HALF + m * 16; const float rs = sv[ai][m];
#pragma unroll
                for (int bj = 0; bj < 2; ++bj) { const f32x4 v0 = acc[ai][bj][m][0] * rs, v1 = acc[ai][bj][m][1] * rs; const int col = col0 + bj * HALF;
                    float* op = outk + (isv ? voff : (size_t)0) + ((size_t)l * 1024 + row) * 2048 + col;
                    *(f32x4*)op = v0; *(f32x4*)(op + 4) = v1;
                    if (!isv) { u32x4 w; w.x = cvt_pk_bf16(v0[0], v0[1]); w.y = cvt_pk_bf16(v0[2], v0[3]); w.z = cvt_pk_bf16(v1[0], v1[1]); w.w = cvt_pk_bf16(v1[2], v1[3]);
                        *(u32x4*)(kb + ((size_t)l * 1024 + row) * 2048 + col) = w; }
                    else { { u32x4 w; w.x = cvt_pk_bf16(v0[0], v0[1]); w.y = cvt_pk_bf16(v0[2], v0[3]); w.z = cvt_pk_bf16(v1[0], v1[1]); w.w = cvt_pk_bf16(v1[2], v1[3]); *(u32x4*)(vb + ((size_t)l * 1024 + row) * 2048 + col) = w; }
                    } } }
    }
};
template <class Epi, class Sched, bool ALIGN_EPI = false, bool SP2 = false>
__device__ __forceinline__ void gemm_phase(PG8_LAS unsigned char* lds, const Gemm g, const Sched& S, const Epi& E, int tid) {
    asm volatile("" : "+v"(tid));
    const int wid = __builtin_amdgcn_readfirstlane(tid >> 6), lane = tid & 63, wr = wid >> 2, wc = wid & 3, fr = lane & 15, fq = lane >> 4;
    const int K = g.K, nt = K / BK, lda = g.lda ? g.lda : K, ldb = g.ldb ? g.ldb : K;
    unsigned voffA[2], voffB[2];
#pragma unroll
    for (int i = 0; i < 2; ++i) { int R, C; stage_rc(tid * 16 + i * 8192, R, C); const int Rb = Epi::PERM ? ((R & ~31) + perm32(R & 31)) : R;
        voffA[i] = (unsigned)(R * lda + C) * 2u; voffB[i] = (unsigned)(Rb * ldb + C) * 2u; }
    const size_t kstep = (size_t)(BK * 2);
    const size_t hstepA = (size_t)HALF * lda * 2, hstepB = (size_t)HALF * ldb * 2;
    const unsigned ldsw = (unsigned)wid * 1024u;
    const int aoff = lds_byte(wr * 64 + fr, fq * 8), boff = lds_byte(wc * 32 + fr, fq * 8);
#define PG8_SA(b, h) (((b) * 2 + (h)) * HTB)
#define PG8_SB(b, h) ((4 + (b) * 2 + (h)) * HTB)
#define PG8_STAGE(bufoff, gbase, voff) do { _Pragma("unroll") for (int _i = 0; _i < 2; ++_i) \
        __builtin_amdgcn_global_load_lds((const unsigned*)((const char*)(gbase) + (voff)[_i]), (PG8_LAS unsigned*)(lds + (bufoff) + ldsw + _i * 8192), 16, 0, 0); } while (0)
#define PG8_LDA(dst, b, h) do { _Pragma("unroll") for (int m = 0; m < 4; ++m) _Pragma("unroll") for (int k = 0; k < 2; ++k) dst[m][k] = *(const PG8_LAS bf16x8*)(lds + PG8_SA(b, h) + aoff + m * 2048 + k * 1024); } while (0)
#define PG8_LDB(dst, b, h) do { _Pragma("unroll") for (int n = 0; n < 2; ++n) _Pragma("unroll") for (int k = 0; k < 2; ++k) dst[n][k] = *(const PG8_LAS bf16x8*)(lds + PG8_SB(b, h) + boff + n * 2048 + k * 1024); } while (0)
#define PG8_MMA(ai, bj, At, Bt) do { __builtin_amdgcn_s_setprio(1); _Pragma("unroll") for (int m = 0; m < 4; ++m) _Pragma("unroll") for (int n = 0; n < 2; ++n) _Pragma("unroll") for (int k = 0; k < 2; ++k) \
        acc[ai][bj][m][n] = __builtin_amdgcn_mfma_f32_16x16x32_bf16(Bt[n][k], At[m][k], acc[ai][bj][m][n], 0, 0, 0); __builtin_amdgcn_s_setprio(0); } while (0)
#define PG8_WAIT_V(n) asm volatile("s_waitcnt vmcnt(" #n ")" ::: "memory")
#define PG8_WAIT_L(n) asm volatile("s_waitcnt lgkmcnt(" #n ")" ::: "memory")
#define PG8_BAR __builtin_amdgcn_s_barrier()
#define PG8_SCHED __builtin_amdgcn_sched_barrier(0)
    Unit cur, nxt; int ui = 0;
    if (!S.next(0, cur)) return;
    f32x4 acc[2][2][4][2];
#pragma unroll
    for (int a = 0; a < 2; ++a)
#pragma unroll
        for (int b = 0; b < 2; ++b)
#pragma unroll
            for (int m = 0; m < 4; ++m)
#pragma unroll
                for (int n = 0; n < 2; ++n) acc[a][b][m][n] = (f32x4){0.f, 0.f, 0.f, 0.f};
    bf16x8 At[4][2], B0[2][2], B1[2][2];
    const char* cA = S.abase(g, cur); const char* cB = S.bbase(g, cur);
    S.a_ready(cur);
    if constexpr (SP2) {
        PG8_STAGE(PG8_SB(0, 0), cB, voffB); PG8_STAGE(PG8_SB(0, 1), cB + hstepB, voffB); PG8_STAGE(PG8_SA(0, 0), cA, voffA); PG8_STAGE(PG8_SA(0, 1), cA + hstepA, voffA);
        if (wr == 1) PG8_BAR;
        PG8_WAIT_V(2); PG8_BAR;
        PG8_STAGE(PG8_SB(1, 0), cB + kstep, voffB); PG8_STAGE(PG8_SA(1, 0), cA + kstep, voffA); PG8_STAGE(PG8_SB(1, 1), cB + hstepB + kstep, voffB);
        PG8_WAIT_V(6); PG8_BAR;
    } else {
        PG8_STAGE(PG8_SB(0, 0), cB, voffB); PG8_STAGE(PG8_SA(0, 0), cA, voffA); PG8_STAGE(PG8_SB(0, 1), cB + hstepB, voffB); PG8_STAGE(PG8_SA(0, 1), cA + hstepA, voffA);
        if (wr == 1) PG8_BAR;
        PG8_WAIT_V(4); PG8_BAR;
        PG8_STAGE(PG8_SB(1, 0), cB + kstep, voffB); PG8_STAGE(PG8_SA(1, 0), cA + kstep, voffA); PG8_STAGE(PG8_SB(1, 1), cB + hstepB + kstep, voffB);
        PG8_WAIT_V(6); PG8_BAR;
    }
    for (;;) {
        const bool has_next = S.next(ui + 1, nxt);
        const char* nA = has_next ? S.abase(g, nxt) : cA; const char* nB = has_next ? S.bbase(g, nxt) : cB;
        for (int t = 0; t < nt; t += 2) {
            const bool last = (t == nt - 2);
            const char* a1 = cA + (size_t)(t + 1) * kstep;
            const char* a2 = last ? nA : cA + (size_t)(t + 2) * kstep; const char* b2 = last ? nB : cB + (size_t)(t + 2) * kstep;
            const char* a3 = a2 + kstep; const char* b3 = b2 + kstep;
            if (last && has_next) S.a_ready(nxt);
            if constexpr (SP2) {
            PG8_LDB(B0, 0, 0); PG8_LDB(B1, 0, 1); PG8_SCHED; PG8_LDA(At, 0, 0); PG8_STAGE(PG8_SA(1, 1), a1 + hstepA, voffA);
            PG8_WAIT_V(8); PG8_WAIT_L(0); PG8_BAR; PG8_MMA(0, 0, At, B0); PG8_MMA(0, 1, At, B1); PG8_BAR; PG8_SCHED;
            PG8_LDA(At, 0, 1); PG8_STAGE(PG8_SB(0, 0), b2, voffB); PG8_STAGE(PG8_SB(0, 1), b2 + hstepB, voffB); PG8_STAGE(PG8_SA(0, 0), a2, voffA);
            PG8_WAIT_V(8); PG8_WAIT_L(0); PG8_BAR; PG8_MMA(1, 0, At, B0); PG8_MMA(1, 1, At, B1); PG8_BAR; PG8_SCHED;
            PG8_LDB(B0, 1, 0); PG8_LDB(B1, 1, 1); PG8_SCHED; PG8_LDA(At, 1, 0); PG8_STAGE(PG8_SA(0, 1), a2 + hstepA, voffA);
            PG8_WAIT_V(8); PG8_WAIT_L(0); PG8_BAR; PG8_MMA(0, 0, At, B0); PG8_MMA(0, 1, At, B1); PG8_BAR; PG8_SCHED;
            PG8_LDA(At, 1, 1); PG8_STAGE(PG8_SB(1, 0), b3, voffB); PG8_STAGE(PG8_SB(1, 1), b3 + hstepB, voffB); PG8_STAGE(PG8_SA(1, 0), a3, voffA);
            PG8_WAIT_V(8); PG8_WAIT_L(0); PG8_BAR; PG8_MMA(1, 0, At, B0); PG8_MMA(1, 1, At, B1); PG8_BAR; PG8_SCHED;
            } else {
            PG8_LDB(B0, 0, 0); PG8_SCHED; PG8_LDA(At, 0, 0); PG8_STAGE(PG8_SA(1, 1), a1 + hstepA, voffA);
            PG8_WAIT_L(8); PG8_BAR; PG8_WAIT_L(0); PG8_MMA(0, 0, At, B0); PG8_BAR; PG8_SCHED;
            PG8_LDB(B1, 0, 1); PG8_STAGE(PG8_SB(0, 0), b2, voffB);
            PG8_BAR; PG8_WAIT_L(0); PG8_MMA(0, 1, At, B1); PG8_BAR;
            PG8_LDA(At, 0, 1); PG8_STAGE(PG8_SA(0, 0), a2, voffA);
            PG8_BAR; PG8_WAIT_L(0); PG8_MMA(1, 0, At, B0); PG8_BAR; PG8_SCHED;
            PG8_STAGE(PG8_SB(0, 1), b2 + hstepB, voffB);
            PG8_WAIT_V(6); PG8_BAR; PG8_MMA(1, 1, At, B1); PG8_BAR;
            PG8_LDB(B0, 1, 0); PG8_SCHED; PG8_LDA(At, 1, 0); PG8_STAGE(PG8_SA(0, 1), a2 + hstepA, voffA);
            PG8_WAIT_L(8); PG8_BAR; PG8_WAIT_L(0); PG8_MMA(0, 0, At, B0); PG8_BAR; PG8_SCHED;
            PG8_LDB(B1, 1, 1); PG8_STAGE(PG8_SB(1, 0), b3, voffB);
            PG8_BAR; PG8_WAIT_L(0); PG8_MMA(0, 1, At, B1); PG8_BAR;
            PG8_LDA(At, 1, 1); PG8_STAGE(PG8_SA(1, 0), a3, voffA);
            PG8_BAR; PG8_WAIT_L(0); PG8_MMA(1, 0, At, B0); PG8_BAR; PG8_SCHED;
            PG8_STAGE(PG8_SB(1, 1), b3 + hstepB, voffB);
            PG8_WAIT_V(6); PG8_BAR; PG8_MMA(1, 1, At, B1); PG8_BAR;
            }
        }
        if constexpr (ALIGN_EPI) { if (wr == 0) PG8_BAR; }
        if constexpr (!Epi::AFTER_DRAIN) { E(acc, cur, wr, wc, fr, fq); S.done(cur); }
        if (!has_next) break;
#pragma unroll
        for (int a = 0; a < 2; ++a)
#pragma unroll
            for (int b = 0; b < 2; ++b)
#pragma unroll
                for (int m = 0; m < 4; ++m)
#pragma unroll
                    for (int n = 0; n < 2; ++n) acc[a][b][m][n] = (f32x4){0.f, 0.f, 0.f, 0.f};
        cur = nxt; cA = nA; cB = nB; ++ui;
        if constexpr (ALIGN_EPI) { if (wr == 1) PG8_BAR; }
    }
    PG8_WAIT_V(0);
    if constexpr (!ALIGN_EPI) { if (wr == 0) PG8_BAR; }
    PG8_BAR;
    if constexpr (Epi::AFTER_DRAIN) { E.fused(acc, cur, wr, wc, fr, fq, lds, wid, lane); S.done(cur); }
#undef PG8_SA
#undef PG8_SB
#undef PG8_STAGE
#undef PG8_LDA
#undef PG8_LDB
#undef PG8_MMA
#undef PG8_WAIT_V
#undef PG8_WAIT_L
#undef PG8_BAR
#undef PG8_SCHED
}
}

constexpr int NWAVES = 8, NTHR = NWAVES * 64;
#ifndef MK_PER_PHASE
#define MK_PER_PHASE 0
#endif

constexpr int D = 2048, NB = 4, T = 2048, MP = NB * T, MS = 128, MR = MP + MS, MPAD = 8448, NL = 2;
constexpr int NIN = 3840, INW = 3848, FF = 8192, NMEM = 256, MROWS = NB * NMEM, NHX = 4, HDX = 512;
constexpr int C_Z = 0, C_XBC = 512, C_BM = 1024, C_CM = 1152, C_U5 = 1280, C_GB = 1792, C_GC = 2304, C_HV = 2816, C_UP = 3328;
constexpr float EPS = 1e-6f;
constexpr int SSD_L = 64, SSD_NC = T / SSD_L;
constexpr int S5_L = 32, S5_NC = T / S5_L;

constexpr size_t O_YP = 0, O_YS = O_YP + (size_t)MP * D, O_PCONV = O_YS + (size_t)MS * D, O_PSSD = O_PCONV + NL * NB * 3 * 768, O_PS5R = O_PSSD + NL * NB * 8 * 4096,
    O_PS5I = O_PS5R + NL * NB * 2048, O_PSC = O_PS5I + NL * NB * 2048, O_PPOOL = O_PSC + NL * NB * 2 * 512, O_PMK = O_PPOOL + NL * NB * 15 * 512, O_PMV = O_PMK + (size_t)NL * MROWS * D,
    O_SCONV = O_PMV + (size_t)NL * MROWS * D, O_SSSD = O_SCONV + NL * MS * 3 * 768, O_SS5R = O_SSSD + (size_t)NL * MS * 8 * 4096, O_SS5I = O_SS5R + NL * MS * 2048, O_SSC = O_SS5I + NL * MS * 2048,
    O_SPOOL = O_SSC + NL * MS * 2 * 512, O_END = O_SPOOL + NL * MS * 15 * 512;
static_assert(O_END == 38066176, "output size");

enum In { I_XP = 0, I_XS, I_MEM, I_ST_CONV, I_ST_SSD, I_ST_S5R, I_ST_S5I, I_ST_SC, I_ST_POOL, I_CK, I_CV, I_G_MIX, I_W_IN, I_CONV_W, I_CONV_B, I_DT_BIAS, I_A_LOG, I_SSD_D,
          I_LAM_RE, I_LAM_IM, I_LOG_DT, I_B_RE, I_B_IM, I_C_RE, I_C_IM, I_S5_D, I_W_GLU, I_B_GLU, I_SC_W, I_POOL_W, I_POOL_SCALE, I_G_MIXOUT, I_W_OUT, I_G_XA, I_G_MEM,
          I_W_Q, I_W_K, I_W_V, I_W_O, I_G_MLP, I_W_UP, I_W_DOWN, I_G_FINAL, N_IN };
static_assert(N_IN == 43, "inputs");

constexpr size_t MiB = 1u << 20;
constexpr size_t WS_CTL = 0, CTL_ZERO_BYTES = 1 * MiB;
constexpr int CW_TMO = 0, CW_BAR = 4096, CW_FCNT = 8192, CW_SSQ = 16384;
static_assert(CW_BAR + 3456 <= CW_FCNT && CW_FCNT + 32 * 64 <= CW_SSQ, "ctl words");
static_assert(CW_SSQ * 4 + 7 * MPAD * 8 <= (int)CTL_ZERO_BYTES, "ctl");
constexpr size_t WS_TAB = 1 * MiB, TAB_L = 2 * MiB;
constexpr size_t TB_ABAR = 0, TB_ABARL = 16384, TB_BBAR = 32768, TB_CMT = TB_BBAR + 262144, TB_WDT = TB_CMT + 131072, TB_WGLUT = TB_WDT + 65536, TB_WPT = TB_WGLUT + 524288, TB_BBT = TB_WPT + 131072, TB_END = TB_BBT + 131072;
static_assert(TB_END <= TAB_L, "tables");
constexpr size_t WS_W = 8 * MiB, W_L = 104 * MiB;
constexpr size_t WO_IN = 0, WO_OUT = 15 * MiB, WO_Q = 23 * MiB, WO_O = 31 * MiB, WO_UP = 39 * MiB, WO_DOWN = 71 * MiB;
static_assert(WO_DOWN + 32 * MiB <= W_L && (size_t)NIN * D * 2 == 15 * MiB, "weights");
constexpr size_t WS_WKV = WS_W + 2 * W_L;
constexpr size_t WS_H = 256 * MiB, WS_HB = 322 * MiB, WS_PROJ = 356 * MiB, WS_MIX = 418 * MiB, WS_Q = 452 * MiB, WS_O = 486 * MiB, WS_HID = 520 * MiB,
    WS_MEMB = 652 * MiB, WS_KB = 656 * MiB, WS_VT = 664 * MiB, WS_DTV = 672 * MiB, WS_RSTDM = 673 * MiB, WS_SS = 674 * MiB, WS_CD = 690 * MiB, WS_S5ER = 691 * MiB, WS_S5EI = 693 * MiB, WS_SA = 700 * MiB, WS_WQKD = 704 * MiB, WS_VB = 720 * MiB, WS_WQK = 728 * MiB, WS_VWT = 760 * MiB, WS_PATT = 792 * MiB, WS_END = 808 * MiB;
constexpr size_t SA_HB = 0, SA_MIX = 512 * 1024, SA_O = 1024 * 1024, SA_HID = 2048 * 1024;
static_assert(WS_WKV + 32 * MiB <= WS_H && WS_H + (size_t)MPAD * D * 4 <= WS_HB && WS_HB + (size_t)MPAD * D * 2 <= WS_PROJ && WS_PROJ + (size_t)MPAD * NIN * 2 <= WS_MIX, "ws map 1");
static_assert(WS_HID + (size_t)MPAD * FF * 2 <= WS_MEMB && WS_SS + (size_t)NB * SSD_NC * 8 * 4096 * 4 <= WS_CD && WS_S5ER + (size_t)NB * S5_NC * 2048 * 4 <= WS_S5EI, "ws map 2");

constexpr int RING_OFF = 0, RING_BYTES = 131072;
constexpr int LDSCTL_OFF = 136192, MISC_OFF = LDSCTL_OFF + 320;
constexpr int LDS_BYTES = 147456;
static_assert(MISC_OFF + 128 <= LDS_BYTES, "LDS map");
#define GAS __attribute__((address_space(1)))
#define LAS __attribute__((address_space(3)))
typedef unsigned short bf16;
typedef unsigned v4u __attribute__((ext_vector_type(4)));
typedef float f32x4 __attribute__((ext_vector_type(4)));
typedef short bf16x8 __attribute__((ext_vector_type(8)));
typedef GAS unsigned gu32;
typedef GAS unsigned long long gu64;
#define RLX_AGENT __ATOMIC_RELAXED, __HIP_MEMORY_SCOPE_AGENT
#define LDS_WAIT() asm volatile("s_waitcnt lgkmcnt(0)" ::: "memory")
#define VM_WAIT() asm volatile("s_waitcnt vmcnt(0)" ::: "memory")
__device__ __forceinline__ unsigned long long rt() { return __builtin_amdgcn_s_memrealtime(); }
__device__ __forceinline__ unsigned f2bf(float f) { unsigned u = __builtin_bit_cast(unsigned, f); return (u + 0x7fffu + ((u >> 16) & 1u)) >> 16; }
__device__ __forceinline__ unsigned pk2(float lo, float hi) { return f2bf(lo) | (f2bf(hi) << 16); }

#define XB_TMO      128
#define XB_XCNT(j)  (256  + 64 * (j))
#define XB_XSUB(j)  (1280 + 64 * (j))
#define XB_XGEN(j)  (2304 + 64 * (j))
#define XB_TOP      3328
#define XB_TOPGEN   3392
#define XCD_BAR_WORDS 3456
#define XB_SPIN_CAP (1u << 18)

__device__ __forceinline__ unsigned xb_ld(unsigned* p)              { return __hip_atomic_load(p, __ATOMIC_RELAXED, __HIP_MEMORY_SCOPE_AGENT); }
__device__ __forceinline__ unsigned xb_add(unsigned* p, unsigned v) { return __hip_atomic_fetch_add(p, v, __ATOMIC_RELAXED, __HIP_MEMORY_SCOPE_AGENT); }
__device__ __forceinline__ unsigned xb_xcc_id() { return (unsigned)__builtin_amdgcn_s_getreg((3 << 11) | 20) & 0xFu; }
#define XB_SPIN(cond, bar) do { unsigned _sp = 0; while (cond) { __builtin_amdgcn_s_sleep(1); \
    if ((++_sp & 255u) == 0u) { if (xb_ld(&(bar)[XB_TMO])) break; if (_sp > XB_SPIN_CAP) { atomicAdd(&(bar)[XB_TMO], 1u); break; } } } } while (0)

struct XcdBarrier {
    unsigned* bar; unsigned x;
    volatile LAS unsigned* st;
};

__device__ __forceinline__ XcdBarrier xcd_barrier_post(unsigned* bar, volatile LAS unsigned* st) {
    XcdBarrier b; b.bar = bar; b.x = xb_xcc_id(); b.st = st;
    if (threadIdx.x == 0) (void)xb_add(&bar[XB_XCNT(b.x)], 1u);
    return b;
}
__device__ __forceinline__ void xcd_barrier_complete(unsigned* bar, unsigned x, unsigned& nloc, unsigned& nx) {
    const unsigned G = gridDim.x * gridDim.y * gridDim.z;
    unsigned sum, cnt, mine, sp = 0u;
    for (;;) {
        sum = 0u; cnt = 0u; mine = 0u;
#pragma unroll
        for (unsigned j = 0; j < 16; ++j) { const unsigned c = xb_ld(&bar[XB_XCNT(j)]); sum += c; cnt += (c > 0u) ? 1u : 0u; mine = (j == x) ? c : mine; }
        if (sum == G) break;
        __builtin_amdgcn_s_sleep(1);
        if ((++sp & 255u) == 0u) { if (xb_ld(&bar[XB_TMO])) break; if (sp > XB_SPIN_CAP) { atomicAdd(&bar[XB_TMO], 1u); break; } }
    }
    nloc = mine > 0u ? mine : 1u; nx = cnt > 0u ? cnt : 1u;
}

__device__ __forceinline__ void xcd_barrier(const XcdBarrier& b) {
    asm volatile("s_waitcnt vmcnt(0)" ::: "memory");
    __syncthreads();
    if (threadIdx.x == 0) {
        unsigned* bar = b.bar;
        __builtin_amdgcn_s_waitcnt(0);
        unsigned nloc = b.st[0], nx = b.st[1];
        if (nloc == 0u) { xcd_barrier_complete(bar, b.x, nloc, nx); b.st[0] = nloc; b.st[1] = nx; }
        const unsigned old = xb_add(&bar[XB_XSUB(b.x)], 1u);
        const unsigned gen = old / nloc;
        if (old + 1u == (gen + 1u) * nloc) {
            __builtin_amdgcn_fence(__ATOMIC_RELEASE, "agent");
            asm volatile("s_waitcnt vmcnt(0)" ::: "memory");
            const unsigned og = xb_add(&bar[XB_TOP], 1u);
            const unsigned tg = og / nx;
            if (og + 1u == (tg + 1u) * nx) xb_add(&bar[XB_TOPGEN], 1u);
            else XB_SPIN(xb_ld(&bar[XB_TOPGEN]) == tg, bar);
            __builtin_amdgcn_fence(__ATOMIC_ACQUIRE, "agent");
            xb_add(&bar[XB_XGEN(b.x)], 1u);
            asm volatile("s_waitcnt vmcnt(0)" ::: "memory");
        } else {
            XB_SPIN(xb_ld(&bar[XB_XGEN(b.x)]) == gen, bar);
            __builtin_amdgcn_fence(__ATOMIC_ACQUIRE, "agent");
            asm volatile("s_waitcnt vmcnt(0)" ::: "memory");
        }
    }
    __syncthreads();
}

struct Args { const float* in[N_IN]; float* out; unsigned char* ws; int ph_lo, ph_hi; };
static_assert(sizeof(Args) == 45 * 8 + 8, "Args has no holes");
typedef float f32x2 __attribute__((ext_vector_type(2)));
typedef unsigned v2u __attribute__((ext_vector_type(2)));
#define PIN(x) asm volatile("" : "+v"(x))
#define WAVE_SYNC() asm volatile("s_waitcnt lgkmcnt(0)" ::: "memory")
#define BLOCK_SYNC() do { asm volatile("s_waitcnt vmcnt(0) lgkmcnt(0)" ::: "memory"); __builtin_amdgcn_s_barrier(); asm volatile("" ::: "memory"); } while (0)
__device__ __forceinline__ float bf_lo(unsigned u) { return __uint_as_float(u << 16); }
__device__ __forceinline__ float bf_hi(unsigned u) { return __uint_as_float(u & 0xffff0000u); }
__device__ __forceinline__ float bf2f(bf16 b) { return __uint_as_float((unsigned)b << 16); }
__device__ __forceinline__ unsigned cvtpk(float lo, float hi) { return pg8::cvt_pk_bf16(lo, hi); }
__device__ __forceinline__ bf16 f2b(float f) { return (bf16)(cvtpk(f, 0.f) & 0xffffu); }
template <int CTRL> __device__ __forceinline__ float dppf(float v) { return __builtin_bit_cast(float, __builtin_amdgcn_update_dpp(0, __builtin_bit_cast(int, v), CTRL, 0xf, 0xf, false)); }
__device__ __forceinline__ float sum16(float v) { v += dppf<0xB1>(v); v += dppf<0x4E>(v); v += dppf<0x141>(v); v += dppf<0x140>(v); return v; }
__device__ __forceinline__ float max16(float v) { v = fmaxf(v, dppf<0xB1>(v)); v = fmaxf(v, dppf<0x4E>(v)); v = fmaxf(v, dppf<0x141>(v)); v = fmaxf(v, dppf<0x140>(v)); return v; }
__device__ __forceinline__ float wave_sum(float v) { v = sum16(v);
    const float r0 = __builtin_bit_cast(float, __builtin_amdgcn_readlane(__builtin_bit_cast(int, v), 0)), r1 = __builtin_bit_cast(float, __builtin_amdgcn_readlane(__builtin_bit_cast(int, v), 16)),
                r2 = __builtin_bit_cast(float, __builtin_amdgcn_readlane(__builtin_bit_cast(int, v), 32)), r3 = __builtin_bit_cast(float, __builtin_amdgcn_readlane(__builtin_bit_cast(int, v), 48));
    return (r0 + r1) + (r2 + r3); }
__device__ __forceinline__ float wave_max(float v) { v = max16(v);
    const float r0 = __builtin_bit_cast(float, __builtin_amdgcn_readlane(__builtin_bit_cast(int, v), 0)), r1 = __builtin_bit_cast(float, __builtin_amdgcn_readlane(__builtin_bit_cast(int, v), 16)),
                r2 = __builtin_bit_cast(float, __builtin_amdgcn_readlane(__builtin_bit_cast(int, v), 32)), r3 = __builtin_bit_cast(float, __builtin_amdgcn_readlane(__builtin_bit_cast(int, v), 48));
    return fmaxf(fmaxf(r0, r1), fmaxf(r2, r3)); }
__device__ __forceinline__ float silu_f(float x) { return x * __builtin_amdgcn_rcpf(1.f + __expf(-x)); }
__device__ __forceinline__ float sigmoid_f(float x) { return __builtin_amdgcn_rcpf(1.f + __expf(-x)); }
__device__ __forceinline__ float softplus_f(float x) { return x > 20.f ? x : log1pf(expf(x)); }
__device__ __forceinline__ float gelu_tanh_f(float x) { const float u = 0.7978845608f * (x + 0.044715f * x * x * x); const float e = __expf(2.f * u); const float th = 1.f - 2.f * __builtin_amdgcn_rcpf(e + 1.f); return 0.5f * x * (1.f + th); }
__device__ __forceinline__ f32x4 mfma16(bf16x8 a, bf16x8 b, f32x4 c) { return __builtin_amdgcn_mfma_f32_16x16x32_bf16(a, b, c, 0, 0, 0); }
__device__ __forceinline__ bf16x8 ldsfrag(const LAS unsigned char* p) { return *(const LAS bf16x8*)p; }
__device__ __forceinline__ bf16x8 gfrag(const bf16* p) { return *(const bf16x8*)p; }
__device__ __forceinline__ bf16x8 pack8(f32x4 a, f32x4 b) { v4u w; w.x = cvtpk(a[0], a[1]); w.y = cvtpk(a[2], a[3]); w.z = cvtpk(b[0], b[1]); w.w = cvtpk(b[2], b[3]); return __builtin_bit_cast(bf16x8, w); }
__device__ __forceinline__ void unpack8(v4u w, float (&f)[8]) { f[0] = bf_lo(w.x); f[1] = bf_hi(w.x); f[2] = bf_lo(w.y); f[3] = bf_hi(w.y); f[4] = bf_lo(w.z); f[5] = bf_hi(w.z); f[6] = bf_lo(w.w); f[7] = bf_hi(w.w); }
__device__ __forceinline__ size_t sfrag(int r, int k, int K) { return ((size_t)((r >> 4) * (K >> 5) + (k >> 5)) << 9) + (size_t)(((((k >> 3) & 3) * 16 + (r & 15)) << 3) + (k & 7)); }
__device__ __forceinline__ void dsincos(double x, double& s, double& c) {
    const double k = rint(x * 0.63661977236758134308); double r = fma(-k, 1.57079632673412561417e+00, x); r = fma(-k, 6.07710050650619224932e-11, r);
    const double r2 = r * r;
    double sp = -7.6471637318198164759e-13; sp = fma(sp, r2, 1.6059043836821614599e-10); sp = fma(sp, r2, -2.5052108385441718775e-08); sp = fma(sp, r2, 2.7557319223985890653e-06); sp = fma(sp, r2, -1.9841269841269841270e-04);
    sp = fma(sp, r2, 8.3333333333333333333e-03); sp = fma(sp, r2, -1.6666666666666666667e-01); const double sr = fma(sp * r2, r, r);
    double cp = 4.7794773323873852974e-14; cp = fma(cp, r2, -1.1470745597729724714e-11); cp = fma(cp, r2, 2.0876756987868098979e-09); cp = fma(cp, r2, -2.7557319223985890653e-07); cp = fma(cp, r2, 2.4801587301587301587e-05);
    cp = fma(cp, r2, -1.3888888888888888889e-03); cp = fma(cp, r2, 4.1666666666666666667e-02); cp = fma(cp, r2, -0.5); const double cr = fma(cp, r2, 1.0);
    const int q = (int)k & 3;
    s = (q == 0) ? sr : (q == 1) ? cr : (q == 2) ? -sr : -cr; c = (q == 0) ? cr : (q == 1) ? -sr : (q == 2) ? -cr : sr;
}

__device__ __forceinline__ void p0_transpose_item(const float* W, int ldw, int scol0, int K, int k0, const float* gain, bf16* WT, int drow0, LAS unsigned char* scr, int lane, bool frag = false) {
    const int kq = lane >> 4, n4 = lane & 15;
    f32x4 t[8][2]; float g[8][2];
#pragma unroll
    for (int s = 0; s < 8; ++s)
#pragma unroll
        for (int h = 0; h < 2; ++h) { const int k = k0 + 8 * s + 2 * kq + h; t[s][h] = __builtin_nontemporal_load((const GAS f32x4*)(W + (size_t)k * ldw + scol0 + 4 * n4)); g[s][h] = gain ? gain[k] : 1.f; }
#pragma unroll
    for (int s = 0; s < 8; ++s) { PIN(t[s][0]); PIN(t[s][1]); }
#pragma unroll
    for (int s = 0; s < 8; ++s)
#pragma unroll
        for (int e = 0; e < 4; ++e) *(LAS unsigned*)(scr + ((4 * n4 + e) * 68 + 8 * s + 2 * kq) * 2) = cvtpk(t[s][0][e] * g[s][0], t[s][1][e] * g[s][1]);
    LDS_WAIT(); asm volatile("" ::: "memory");
    const int c = lane & 7;
#pragma unroll
    for (int j = 0; j < 8; ++j) { const int n = (lane >> 3) + 8 * j; const v2u a = *(const LAS v2u*)(scr + (n * 68 + 8 * c) * 2), b = *(const LAS v2u*)(scr + (n * 68 + 8 * c + 4) * 2);
        *(GAS v4u*)(WT + (frag ? sfrag(drow0 + n, k0 + 8 * c, K) : (size_t)(drow0 + n) * K + k0 + 8 * c)) = (v4u){a.x, a.y, b.x, b.y}; }
    LDS_WAIT(); asm volatile("" ::: "memory");
}
__device__ __forceinline__ void p0_mat(const float* W, int ldw, int K, int N, const float* gain, bf16* WT, int drow_base, int item, LAS unsigned char* scr, int lane, bool frag = false) {
    const int nblk = N / 64, kb = item / nblk, nb = item % nblk;
    p0_transpose_item(W, ldw, 64 * nb, K, 64 * kb, gain, WT, drow_base + 64 * nb, scr, lane, frag);
}
constexpr int P0W_IN = (D / 64) * (NIN / 64), P0W_SQ = (D / 64) * (D / 64), P0W_UP = (D / 64) * (FF / 64), P0W_DN = (FF / 64) * (D / 64), P0W_GLU = (512 / 64) * (512 / 64), P0W_PW = (128 / 64) * (128 / 64);
constexpr int P0W_LAYER = P0W_IN + 5 * P0W_SQ + P0W_UP + P0W_DN + P0W_GLU + 4 * P0W_PW, P0W_DEF_LO = P0W_LAYER + P0W_IN + 5 * P0W_SQ, P0W_DEF_N = P0W_UP + P0W_DN;
__device__ __forceinline__ void p0_weights(const Args& A, LAS unsigned char* lds, int gw, int NGW, int first, int count, int skip_at, int skip_n, int wave, int lane) {
    asm volatile("" : "+v"(lane));
    LAS unsigned char* scr = lds + RING_OFF + wave * 16384;
    unsigned char* ws = A.ws;
    constexpr int I_IN = P0W_IN, I_SQ = P0W_SQ, I_UP = P0W_UP, I_DN = P0W_DN, I_GLU = P0W_GLU, I_PW = P0W_PW, I_LAYER = P0W_LAYER;
#pragma unroll 1
    for (int i = gw; i < count; i += NGW) { int it = first + i; if (it >= skip_at) it += skip_n;
        const int l = it / I_LAYER; int r = it % I_LAYER;
        bf16* wl = (bf16*)(ws + WS_W + (size_t)l * W_L); unsigned char* tb = ws + WS_TAB + (size_t)l * TAB_L;
        const float* W; const float* gain = nullptr; bf16* WT; int ldw, K, N, drow = 0; bool frag = false;
        if (r < I_IN) { const int nblk = NIN / 64, kb = r / nblk, nb = r % nblk, n0 = 64 * nb;
            p0_transpose_item(A.in[I_W_IN] + (size_t)l * D * INW, INW, n0 + (n0 >= 1280 ? 8 : 0), D, 64 * kb, A.in[I_G_MIX] + l * D, (bf16*)((unsigned char*)wl + WO_IN), n0, scr, lane); continue; } r -= I_IN;
        if (r < I_SQ) { W = A.in[I_W_OUT] + (size_t)l * D * D; gain = A.in[I_G_MIXOUT] + l * D; WT = (bf16*)((unsigned char*)wl + WO_OUT); ldw = D; K = D; N = D; }
        else if (r < 2 * I_SQ) { r -= I_SQ; W = A.in[I_W_Q] + (size_t)l * D * D; gain = A.in[I_G_XA] + l * D; WT = (bf16*)((unsigned char*)wl + WO_Q); ldw = D; K = D; N = D; }
        else if (r < 3 * I_SQ) { r -= 2 * I_SQ; W = A.in[I_W_O] + (size_t)l * D * D; WT = (bf16*)((unsigned char*)wl + WO_O); ldw = D; K = D; N = D; }
        else if (r < 4 * I_SQ) { r -= 3 * I_SQ; W = A.in[I_W_K] + (size_t)l * D * D; gain = A.in[I_G_MEM] + l * D; WT = (bf16*)(ws + WS_WKV); drow = l * 4096; ldw = D; K = D; N = D; }
        else if (r < 5 * I_SQ) { r -= 4 * I_SQ; W = A.in[I_W_V] + (size_t)l * D * D; gain = A.in[I_G_MEM] + l * D; WT = (bf16*)(ws + WS_WKV); drow = l * 4096 + 2048; ldw = D; K = D; N = D; }
        else if (r < 5 * I_SQ + I_UP) { r -= 5 * I_SQ; W = A.in[I_W_UP] + (size_t)l * D * FF; gain = A.in[I_G_MLP] + l * D; WT = (bf16*)((unsigned char*)wl + WO_UP); ldw = FF; K = D; N = FF; }
        else if (r < 5 * I_SQ + I_UP + I_DN) { r -= 5 * I_SQ + I_UP; W = A.in[I_W_DOWN] + (size_t)l * FF * D; WT = (bf16*)((unsigned char*)wl + WO_DOWN); ldw = D; K = FF; N = D; }
        else if (r < 5 * I_SQ + I_UP + I_DN + I_GLU) { r -= 5 * I_SQ + I_UP + I_DN; W = A.in[I_W_GLU] + (size_t)l * 512 * 512; WT = (bf16*)(tb + TB_WGLUT); ldw = 512; K = 512; N = 512; frag = true; }
        else { r -= 5 * I_SQ + I_UP + I_DN + I_GLU; const int gI = r / I_PW; r = r % I_PW; W = A.in[I_POOL_W] + ((size_t)l * 4 + gI) * 128 * 128; WT = (bf16*)(tb + TB_WPT) + gI * 128 * 128; ldw = 128; K = 128; N = 128; frag = true; }
        p0_mat(W, ldw, K, N, gain, WT, drow, r, scr, lane, frag);
    }
}
__device__ __forceinline__ void p0_prologue(const Args& A, LAS unsigned char* lds, int vcu, int G, int wave, int lane) {
    asm volatile("" : "+v"(lane));
    const int gw = vcu * NWAVES + wave, NGW = G * NWAVES;
    unsigned char* ws = A.ws;
    { const int nskip = G == 256 ? P0W_DEF_N : 0; p0_weights(A, lds, gw, NGW, 0, NL * P0W_LAYER - nskip, P0W_DEF_LO, nskip, wave, lane); }
    bf16* HB = (bf16*)(ws + WS_HB); unsigned long long* ssq0 = (unsigned long long*)((unsigned*)(ws + WS_CTL) + CW_SSQ);
#pragma unroll 1
    for (int m = gw; m < MR; m += NGW) {
        f32x4 v[8]; const GAS f32x4* xr = (const GAS f32x4*)(m < MP ? A.in[I_XP] + (size_t)m * D : A.in[I_XS] + (size_t)(m - MP) * D) + lane;
#pragma unroll
        for (int j = 0; j < 8; ++j) v[j] = __builtin_nontemporal_load(xr + 64 * j);
#pragma unroll
        for (int j = 0; j < 8; ++j) PIN(v[j]);
        float s = 0.f;
#pragma unroll
        for (int j = 0; j < 8; ++j) s += (v[j].x * v[j].x + v[j].y * v[j].y) + (v[j].z * v[j].z + v[j].w * v[j].w);
        s = wave_sum(s);
        GAS v2u* br = (GAS v2u*)(HB + (size_t)m * D) + lane;
#pragma unroll
        for (int j = 0; j < 8; ++j) { v2u w; w.x = cvtpk(v[j].x, v[j].y); w.y = cvtpk(v[j].z, v[j].w); br[64 * j] = w;
            if (m >= MP) *(GAS v2u*)((bf16*)(ws + WS_SA + SA_HB) + sfrag(m - MP, 4 * lane + 256 * j, D)) = w; }
        if (lane == 0) ssq0[m] = (unsigned long long)__float2ull_rn(s * 16777216.0f);
    }
    bf16* MEMB = (bf16*)(ws + WS_MEMB); float* RSTDM = (float*)(ws + WS_RSTDM);
#pragma unroll 1
    for (int m = gw; m < MROWS; m += NGW) {
        const GAS f32x4* xr = (const GAS f32x4*)(A.in[I_MEM] + (size_t)m * D) + lane; f32x4 v[8]; float s = 0.f;
#pragma unroll
        for (int j = 0; j < 8; ++j) v[j] = xr[64 * j];
#pragma unroll
        for (int j = 0; j < 8; ++j) PIN(v[j]);
#pragma unroll
        for (int j = 0; j < 8; ++j) s += (v[j].x * v[j].x + v[j].y * v[j].y) + (v[j].z * v[j].z + v[j].w * v[j].w);
        s = wave_sum(s);
        GAS v2u* br = (GAS v2u*)(MEMB + (size_t)m * D) + lane;
#pragma unroll
        for (int j = 0; j < 8; ++j) { v2u w; w.x = cvtpk(v[j].x, v[j].y); w.y = cvtpk(v[j].z, v[j].w); br[64 * j] = w; }
        if (lane == 0) RSTDM[m] = 1.0f / sqrtf(s * (1.0f / D) + EPS);
    }
    { bf16* WQKD = (bf16*)(ws + WS_WQKD);
#pragma unroll 1
        for (int m = gw; m < NL * D; m += NGW) { const int l = m >> 11, k = m & 2047; const float gk = A.in[I_G_XA][l * D + k];
            const GAS f32x4* xr = (const GAS f32x4*)(A.in[I_W_Q] + ((size_t)l * D + k) * D) + lane; f32x4 v[8];
#pragma unroll
            for (int j = 0; j < 8; ++j) v[j] = __builtin_nontemporal_load(xr + 64 * j);
#pragma unroll
            for (int j = 0; j < 8; ++j) PIN(v[j]);
            GAS v2u* br = (GAS v2u*)(WQKD + (size_t)m * D) + lane;
#pragma unroll
            for (int j = 0; j < 8; ++j) { v2u w; w.x = cvtpk(v[j].x * gk, v[j].y * gk); w.y = cvtpk(v[j].z * gk, v[j].w * gk); br[64 * j] = w; } } }
    const int gt = gw * 64 + lane, NGT = NGW * 64;
    for (int i2 = gt; i2 < NL * 2048 * 16 * 2; i2 += NGT) { if (i2 & 1) continue; const int i = i2 >> 5, k = (i2 >> 1) & 15;
        const int l = i >> 11, gn = i & 2047, g = gn >> 6, n = gn & 63; unsigned char* tb = ws + WS_TAB + (size_t)l * TAB_L;
        const double lr = (double)A.in[I_LAM_RE][l * 2048 + gn], li = (double)A.in[I_LAM_IM][l * 2048 + gn], dl = exp((double)A.in[I_LOG_DT][l * 32 + g]);
        const float bref = A.in[I_B_RE][((size_t)l * 2048 + gn) * 16 + k], bimf = A.in[I_B_IM][((size_t)l * 2048 + gn) * 16 + k];
        const float cref = A.in[I_C_RE][((size_t)l * 32 + g) * 1024 + k * 64 + n], cimf = A.in[I_C_IM][((size_t)l * 32 + g) * 1024 + k * 64 + n];
        double s1, c1, sL, cL; dsincos(li * dl, s1, c1); dsincos(li * dl * (double)S5_L, sL, cL);
        const double m1 = exp(lr * dl), mL = exp(lr * dl * (double)S5_L), ar = m1 * c1, ai = m1 * s1;
        if (k == 0) { ((f32x2*)(tb + TB_ABAR))[gn] = (f32x2){(float)ar, (float)ai}; ((f32x2*)(tb + TB_ABARL))[gn] = (f32x2){(float)(mL * cL), (float)(mL * sL)}; }
        const double den = lr * lr + li * li, cr = ((ar - 1.0) * lr + ai * li) / den, ci = (ai * lr - (ar - 1.0) * li) / den;
        f32x2* bb = (f32x2*)(tb + TB_BBAR) + (size_t)g * 16 * 64 + n; bf16* cmt = (bf16*)(tb + TB_CMT) + (size_t)g * 16 * 128;
        bf16* bbt = (bf16*)(tb + TB_BBT) + (size_t)g * 128 * 16;
        { const double br = bref, bi = bimf; bb[k * 64] = (f32x2){(float)(cr * br - ci * bi), (float)(cr * bi + ci * br)};
            bbt[n * 16 + k] = f2b((float)(cr * br - ci * bi)); bbt[(64 + n) * 16 + k] = f2b((float)(cr * bi + ci * br));
            cmt[k * 128 + n] = f2b(cref); cmt[k * 128 + 64 + n] = f2b(-cimf); }
    }
    for (int i2 = gt; i2 < NL * D * 32; i2 += NGT) { if (i2 & 31) continue; const int i = i2 >> 5;
        const int l = i >> 11, k = i & 2047; const float g = A.in[I_G_MIX][l * D + k]; const float* w = A.in[I_W_IN] + ((size_t)l * D + k) * INW + 1280;
        float* o = (float*)(ws + WS_TAB + (size_t)l * TAB_L + TB_WDT) + k * 8;
#pragma unroll
        for (int j = 0; j < 8; ++j) o[j] = g * w[j];
    }
}

__device__ __forceinline__ void dt_rows(const Args& A, LAS unsigned char* lds, int l, int vcu, int G, int tid) {
    asm volatile("" : "+v"(tid)); const int lane = tid & 63, wave = __builtin_amdgcn_readfirstlane(tid >> 6);
    unsigned char* ws = A.ws; const bf16* HB = (const bf16*)(ws + WS_HB); const float* WDT = (const float*)(ws + WS_TAB + (size_t)l * TAB_L + TB_WDT);
    const unsigned long long* ssq = (const unsigned long long*)((const unsigned*)(ws + WS_CTL) + CW_SSQ) + (3 * l) * MPAD; float* DTV = (float*)(ws + WS_DTV);
    { v4u t[8];
#pragma unroll
        for (int j = 0; j < 8; ++j) t[j] = *(const GAS v4u*)((const unsigned char*)WDT + (tid + NTHR * j) * 16);
#pragma unroll
        for (int j = 0; j < 8; ++j) PIN(t[j]);
#pragma unroll
        for (int j = 0; j < 8; ++j) { const int p = tid + NTHR * j, k = p >> 1; *(LAS v4u*)(lds + (k >> 3) * 272 + (k & 7) * 32 + (p & 1) * 16) = t[j]; } }
    BLOCK_SYNC();
    const int gw = vcu * NWAVES + wave, NGW = G * NWAVES; const float bias = A.in[I_DT_BIAS][l * 8 + (lane & 7)];
#pragma unroll 1
    for (int m0 = gw; m0 < MR; m0 += 2 * NGW) { const int m1 = m0 + NGW; const bool has1 = m1 < MR; const int m1c = has1 ? m1 : m0;
        v4u x0[4], x1[4];
#pragma unroll
        for (int i = 0; i < 4; ++i) { x0[i] = *(const GAS v4u*)(HB + (size_t)m0 * D + 8 * lane + 512 * i); x1[i] = *(const GAS v4u*)(HB + (size_t)m1c * D + 8 * lane + 512 * i); }
#pragma unroll
        for (int i = 0; i < 4; ++i) { PIN(x0[i]); PIN(x1[i]); }
        float a0[8], a1[8];
#pragma unroll
        for (int j = 0; j < 8; ++j) { a0[j] = 0.f; a1[j] = 0.f; }
#pragma unroll
        for (int i = 0; i < 4; ++i) { float f0[8], f1[8]; unpack8(x0[i], f0); unpack8(x1[i], f1);
#pragma unroll
            for (int e = 0; e < 8; ++e) { const LAS float* wp = (const LAS float*)(lds + (lane + 64 * i) * 272 + e * 32); const f32x4 w0 = *(const LAS f32x4*)wp, w1 = *(const LAS f32x4*)(wp + 4);
                a0[0] += f0[e] * w0.x; a0[1] += f0[e] * w0.y; a0[2] += f0[e] * w0.z; a0[3] += f0[e] * w0.w; a0[4] += f0[e] * w1.x; a0[5] += f0[e] * w1.y; a0[6] += f0[e] * w1.z; a0[7] += f0[e] * w1.w;
                a1[0] += f1[e] * w0.x; a1[1] += f1[e] * w0.y; a1[2] += f1[e] * w0.z; a1[3] += f1[e] * w0.w; a1[4] += f1[e] * w1.x; a1[5] += f1[e] * w1.y; a1[6] += f1[e] * w1.z; a1[7] += f1[e] * w1.w; } }
        float v0 = 0.f, v1 = 0.f;
#pragma unroll
        for (int j = 0; j < 8; ++j) { const float s0 = wave_sum(a0[j]), s1 = wave_sum(a1[j]); if ((lane & 7) == j) { v0 = s0; v1 = s1; } }
        if (lane < 8) { DTV[(size_t)m0 * 8 + lane] = softplus_f(v0 * pg8::ssq_rstd(ssq[m0]) + bias);
            if (has1) DTV[(size_t)m1 * 8 + lane] = softplus_f(v1 * pg8::ssq_rstd(ssq[m1]) + bias); }
    }
    BLOCK_SYNC();
}

__device__ __forceinline__ void lds_add(LAS float* p, float v) { (void)__hip_atomic_fetch_add(p, v, __ATOMIC_RELAXED, __HIP_MEMORY_SCOPE_WORKGROUP); }

__device__ __forceinline__ float wave_scan_incl(float v, int lane) {
#pragma unroll
    for (int o = 1; o < 64; o <<= 1) { const float t = __shfl_up(v, o); if (lane >= o) v += t; }
    return v;
}
template <int NCH> __device__ __forceinline__ void conv8(const bf16* proj, const float* cw, const float* cb, int grow0, int t0, bool seq_first, int cx0, float (&out)[8][NCH]) {
    float raw[11][NCH]; float w[4][NCH], bsv[NCH];
    unsigned rw[11][(NCH + 1) / 2];
#pragma unroll
    for (int r = 0; r < 11; ++r) { const int tt = t0 - 3 + r; const bf16* p = proj + (size_t)(grow0 + ((seq_first && tt < 0) ? 0 : tt)) * NIN + C_XBC + cx0;
        if constexpr (NCH == 4) { const v2u v = *(const GAS v2u*)p; rw[r][0] = v.x; rw[r][1] = v.y; }
        else if constexpr (NCH == 2) { rw[r][0] = *(const GAS unsigned*)p; }
        else { rw[r][0] = (unsigned)*p; } }
#pragma unroll
    for (int e = 0; e < NCH; ++e) { bsv[e] = cb[cx0 + e];
#pragma unroll
        for (int j = 0; j < 4; ++j) w[j][e] = cw[j * 768 + cx0 + e]; }
#pragma unroll
    for (int r = 0; r < 11; ++r)
#pragma unroll
        for (int q = 0; q < (NCH + 1) / 2; ++q) PIN(rw[r][q]);
#pragma unroll
    for (int r = 0; r < 11; ++r) { const bool z = seq_first && (t0 - 3 + r) < 0;
        if constexpr (NCH == 1) raw[r][0] = z ? 0.f : __uint_as_float(rw[r][0] << 16);
        else {
#pragma unroll
            for (int q = 0; q < NCH / 2; ++q) { raw[r][2 * q] = z ? 0.f : bf_lo(rw[r][q]); raw[r][2 * q + 1] = z ? 0.f : bf_hi(rw[r][q]); } } }
#pragma unroll
    for (int i = 0; i < 8; ++i)
#pragma unroll
        for (int e = 0; e < NCH; ++e) { const float v = bsv[e] + w[0][e] * raw[i][e] + w[1][e] * raw[i + 1][e] + w[2][e] * raw[i + 2][e] + w[3][e] * raw[i + 3][e]; out[i][e] = silu_f(v); }
}

__device__ __forceinline__ void ma_ssd_unit(const Args& A, LAS unsigned char* lds, int l, int b, int c, int grp, int tid, int lane, int wave) {
    asm volatile("" : "+v"(tid)); lane = tid & 63; wave = __builtin_amdgcn_readfirstlane(tid >> 6);
    unsigned char* ws = A.ws; const bf16* proj = (const bf16*)(ws + WS_PROJ); const float* DTV = (const float*)(ws + WS_DTV);
    LAS float* AC = (LAS float*)(lds); LAS float* DTs = (LAS float*)(lds + 1024); LAS unsigned char* XT = lds + 2048; LAS unsigned char* BT = lds + 2048 + 36864;
    const int grow0 = b * T + c * SSD_L;
    if (wave < 4) { const int h = 4 * grp + wave; const float an = -expf(A.in[I_A_LOG][l * 8 + h]); const float dt = DTV[(size_t)(grow0 + lane) * 8 + h];
        AC[wave * 64 + lane] = wave_scan_incl(dt * an, lane); DTs[wave * 64 + lane] = dt; }
    BLOCK_SYNC();
    { const int t0 = 8 * wave; const float* cw = A.in[I_CONV_W] + l * 4 * 768; const float* cb = A.in[I_CONV_B] + l * 768;
        float xs[8][4]; conv8<4>(proj, cw, cb, grow0, t0, c == 0, 256 * grp + 4 * lane, xs);
        const int hl = lane >> 4, p0 = 4 * (lane & 15); const float alast = AC[hl * 64 + 63];
        float sc[8];
#pragma unroll
        for (int i = 0; i < 8; ++i) sc[i] = DTs[hl * 64 + t0 + i] * __expf(alast - AC[hl * 64 + t0 + i]);
#pragma unroll
        for (int e = 0; e < 4; ++e) { v4u w; w.x = cvtpk(xs[0][e] * sc[0], xs[1][e] * sc[1]); w.y = cvtpk(xs[2][e] * sc[2], xs[3][e] * sc[3]); w.z = cvtpk(xs[4][e] * sc[4], xs[5][e] * sc[5]); w.w = cvtpk(xs[6][e] * sc[6], xs[7][e] * sc[7]);
            *(LAS v4u*)(XT + ((hl * 64 + p0 + e) * 72 + t0) * 2) = w; }
        float bm[8][1]; conv8<1>(proj, cw, cb, grow0, t0, c == 0, 512 + 64 * grp + lane, bm);
        v4u w; w.x = cvtpk(bm[0][0], bm[1][0]); w.y = cvtpk(bm[2][0], bm[3][0]); w.z = cvtpk(bm[4][0], bm[5][0]); w.w = cvtpk(bm[6][0], bm[7][0]);
        *(LAS v4u*)(BT + (lane * 72 + t0) * 2) = w; }
    BLOCK_SYNC();
    { const int hl = wave >> 1, ph = wave & 1, fr = lane & 15, fq = lane >> 4; f32x4 acc[2][4];
#pragma unroll
        for (int i = 0; i < 2; ++i)
#pragma unroll
            for (int j = 0; j < 4; ++j) acc[i][j] = (f32x4){0.f, 0.f, 0.f, 0.f};
#pragma unroll
        for (int ks = 0; ks < 2; ++ks) { bf16x8 fb[4], fx[2];
#pragma unroll
            for (int j = 0; j < 4; ++j) fb[j] = ldsfrag(BT + ((16 * j + fr) * 72 + 32 * ks + 8 * fq) * 2);
#pragma unroll
            for (int i = 0; i < 2; ++i) fx[i] = ldsfrag(XT + ((hl * 64 + 32 * ph + 16 * i + fr) * 72 + 32 * ks + 8 * fq) * 2);
#pragma unroll
            for (int i = 0; i < 2; ++i)
#pragma unroll
                for (int j = 0; j < 4; ++j) acc[i][j] = mfma16(fb[j], fx[i], acc[i][j]); }
        float* SS = (float*)(ws + WS_SS) + ((size_t)(b * SSD_NC + c) * 8 + 4 * grp + hl) * 4096;
#pragma unroll
        for (int i = 0; i < 2; ++i)
#pragma unroll
            for (int j = 0; j < 4; ++j) *(GAS f32x4*)(SS + (32 * ph + 16 * i + fr) * 64 + 16 * j + 4 * fq) = acc[i][j]; }
    if (tid < 4) ((float*)(ws + WS_CD))[(b * SSD_NC + c) * 8 + 4 * grp + tid] = expf(AC[tid * 64 + 63]);
    BLOCK_SYNC();
}

__device__ __forceinline__ void s5_bu(const Args& A, int l, int g, int grow0, int lane, LAS unsigned char* HS, float& ar, float& ai) {
    const unsigned char* tb = A.ws + WS_TAB + (size_t)l * TAB_L; const bf16* proj = (const bf16*)(A.ws + WS_PROJ); const int fr = lane & 15, fq = lane >> 4;
    const bf16* up = proj + (size_t)(grow0 + fr) * NIN + C_U5 + 16 * g + 8 * (fq & 1); const bf16* bp = (const bf16*)(tb + TB_BBT) + ((size_t)g * 128 + fr) * 16 + 8 * (fq & 1);
    v4u fu[2], fb[8];
#pragma unroll
    for (int rt = 0; rt < 2; ++rt) fu[rt] = *(const GAS v4u*)(up + (size_t)rt * 16 * NIN);
#pragma unroll
    for (int ct = 0; ct < 8; ++ct) fb[ct] = *(const GAS v4u*)(bp + ct * 256);
    f32x2 a = ((const f32x2*)(tb + TB_ABAR))[g * 64 + lane];
    PIN(fu[0]); PIN(fu[1]); PIN(a);
#pragma unroll
    for (int ct = 0; ct < 8; ++ct) PIN(fb[ct]);
    const v4u z = (v4u){0u, 0u, 0u, 0u}; const bool hi2 = fq >= 2;
#pragma unroll
    for (int rt = 0; rt < 2; ++rt) fu[rt] = hi2 ? z : fu[rt];
#pragma unroll
    for (int ct = 0; ct < 8; ++ct) fb[ct] = hi2 ? z : fb[ct];
#pragma unroll
    for (int rt = 0; rt < 2; ++rt)
#pragma unroll
        for (int ct = 0; ct < 8; ++ct) { const f32x4 d = mfma16(__builtin_bit_cast(bf16x8, fu[rt]), __builtin_bit_cast(bf16x8, fb[ct]), (f32x4){0.f, 0.f, 0.f, 0.f});
#pragma unroll
            for (int e = 0; e < 4; ++e) *(LAS bf16*)(HS + ((16 * rt + 4 * fq + e) * 136 + 16 * ct + fr) * 2) = f2b(d[e]); }
    ar = a.x; ai = a.y;
    WAVE_SYNC();
}
template <bool WRITEBACK> __device__ __forceinline__ void s5_scan(LAS unsigned char* HS, int lane, float ar, float ai, float& hr, float& hi) {
#pragma unroll 1
    for (int t0 = 0; t0 < S5_L; t0 += 8) { unsigned short br[8], bi[8];
#pragma unroll
        for (int i = 0; i < 8; ++i) { br[i] = *(const LAS bf16*)(HS + ((t0 + i) * 136 + lane) * 2); bi[i] = *(const LAS bf16*)(HS + ((t0 + i) * 136 + 64 + lane) * 2); }
#pragma unroll
        for (int i = 0; i < 8; ++i) { const float nr = ar * hr - ai * hi + bf2f(br[i]), ni = ar * hi + ai * hr + bf2f(bi[i]); hr = nr; hi = ni;
            if (WRITEBACK) { *(LAS bf16*)(HS + ((t0 + i) * 136 + lane) * 2) = f2b(hr); *(LAS bf16*)(HS + ((t0 + i) * 136 + 64 + lane) * 2) = f2b(hi); } } }
}
__device__ __forceinline__ void ma_s5_unit(const Args& A, LAS unsigned char* lds, int l, int b, int c, int lane, int wave) {
    asm volatile("" : "+v"(lane));
    LAS unsigned char* HS = lds + wave * 8704; const int grow0 = b * T + c * S5_L;
    float* ER = (float*)(A.ws + WS_S5ER); float* EI = (float*)(A.ws + WS_S5EI);
#pragma unroll 1
    for (int gi = 0; gi < 4; ++gi) { const int g = 4 * wave + gi; float ar, ai; s5_bu(A, l, g, grow0, lane, HS, ar, ai);
        float hr = 0.f, hi = 0.f; s5_scan<false>(HS, lane, ar, ai, hr, hi);
        const size_t o = ((size_t)(b * S5_NC + c) * 32 + g) * 64 + lane; ER[o] = hr; EI[o] = hi;
        WAVE_SYNC(); }
    BLOCK_SYNC();
}

__device__ __forceinline__ void mb_scan(const Args& A, int l, int vcu, int G, int tid, int dm = 0) {
    asm volatile("" : "+v"(tid));
    unsigned char* ws = A.ws; const int gt = vcu * NTHR + tid, NGT = G * NTHR;
    float* SS = (float*)(ws + (dm ? WS_END + 200 * MiB : WS_SS)); const float* CD = (const float*)(ws + WS_CD); float* outp = dm ? (float*)(ws + WS_END + 240 * MiB) : A.out;
#pragma unroll 1
    for (int i = gt; i < NB * 8 * 4096; i += NGT) { const int b = i >> 15, h = (i >> 12) & 7, pn = i & 4095; float run = 0.f; float s[SSD_NC], d[SSD_NC];
        float* p = SS + ((size_t)(b * SSD_NC) * 8 + h) * 4096 + pn; const float* dp = CD + (b * SSD_NC) * 8 + h;
#pragma unroll
        for (int c = 0; c < SSD_NC; ++c) { s[c] = p[(size_t)c * 8 * 4096]; d[c] = dp[c * 8]; }
#pragma unroll
        for (int c = 0; c < SSD_NC; ++c) { PIN(s[c]); PIN(d[c]); }
#pragma unroll
        for (int c = 0; c < SSD_NC; ++c) { p[(size_t)c * 8 * 4096] = run; run = run * d[c] + s[c]; }
        outp[O_PSSD + (size_t)l * NB * 8 * 4096 + i] = run; }
    float* ER = (float*)(ws + (dm ? WS_END + 220 * MiB : WS_S5ER)); float* EI = (float*)(ws + (dm ? WS_END + 224 * MiB : WS_S5EI)); const f32x2* AL = (const f32x2*)(ws + WS_TAB + (size_t)l * TAB_L + TB_ABARL);
#pragma unroll 1
    for (int i = gt; i < NB * 2048; i += NGT) { const int b = i >> 11, gn = i & 2047; const f32x2 a = AL[gn]; float rr = 0.f, ri = 0.f;
#pragma unroll 1
        for (int c0 = 0; c0 < S5_NC; c0 += 32) { float er[32], ei[32]; const size_t o = (size_t)(b * S5_NC + c0) * 2048 + gn;
#pragma unroll
            for (int c = 0; c < 32; ++c) { er[c] = ER[o + (size_t)c * 2048]; ei[c] = EI[o + (size_t)c * 2048]; }
#pragma unroll
            for (int c = 0; c < 32; ++c) { PIN(er[c]); PIN(ei[c]); }
#pragma unroll
            for (int c = 0; c < 32; ++c) { ER[o + (size_t)c * 2048] = rr; EI[o + (size_t)c * 2048] = ri; const float nr = a.x * rr - a.y * ri + er[c], ni = a.x * ri + a.y * rr + ei[c]; rr = nr; ri = ni; } }
        outp[O_PS5R + (size_t)l * NB * 2048 + i] = rr; outp[O_PS5I + (size_t)l * NB * 2048 + i] = ri; }
}

__device__ __forceinline__ void mc_s5_unit(const Args& A, LAS unsigned char* lds, int l, int b, int c, int tid, int lane, int wave) {
    asm volatile("" : "+v"(tid)); lane = tid & 63; wave = __builtin_amdgcn_readfirstlane(tid >> 6);
    unsigned char* ws = A.ws; const unsigned char* tb = ws + WS_TAB + (size_t)l * TAB_L;
    LAS unsigned char* HS = lds + 16384 + wave * 8704;
    LAS unsigned char* Y = lds + 16384 + 8 * 8704; LAS float* SQ = (LAS float*)(lds + 16384 + 8 * 8704 + 33280);
    const int grow0 = b * T + c * S5_L, fr = lane & 15, fq = lane >> 4;
    const float* ER = (const float*)(ws + WS_S5ER); const float* EI = (const float*)(ws + WS_S5EI);
#pragma unroll 1
    for (int gi = 0; gi < 4; ++gi) { const int g = 4 * wave + gi;
        const size_t o = ((size_t)(b * S5_NC + c) * 32 + g) * 64 + lane; float hr = ER[o], hi = EI[o];
        const bf16* cmt = (const bf16*)(tb + TB_CMT) + (size_t)g * 16 * 128; float dsk = A.in[I_S5_D][l * 512 + 16 * g + fr]; bf16x8 fc[4]; unsigned uk[2][4];
        const bf16* proj = (const bf16*)(ws + WS_PROJ);
#pragma unroll
        for (int ks = 0; ks < 4; ++ks) fc[ks] = gfrag(cmt + fr * 128 + 32 * ks + 8 * fq);
#pragma unroll
        for (int rt = 0; rt < 2; ++rt)
#pragma unroll
            for (int e = 0; e < 4; ++e) uk[rt][e] = (unsigned)proj[(size_t)(grow0 + 16 * rt + 4 * fq + e) * NIN + C_U5 + 16 * g + fr];
        float ar, ai; s5_bu(A, l, g, grow0, lane, HS, ar, ai);
        PIN(hr); PIN(hi); PIN(dsk);
#pragma unroll
        for (int ks = 0; ks < 4; ++ks) PIN(fc[ks]);
#pragma unroll
        for (int rt = 0; rt < 2; ++rt)
#pragma unroll
            for (int e = 0; e < 4; ++e) PIN(uk[rt][e]);
        s5_scan<true>(HS, lane, ar, ai, hr, hi);
        WAVE_SYNC();
        f32x4 acc[2] = {(f32x4){0.f, 0.f, 0.f, 0.f}, (f32x4){0.f, 0.f, 0.f, 0.f}};
#pragma unroll
        for (int ks = 0; ks < 4; ++ks)
#pragma unroll
            for (int rt = 0; rt < 2; ++rt) acc[rt] = mfma16(ldsfrag(HS + ((16 * rt + fr) * 136 + 32 * ks + 8 * fq) * 2), fc[ks], acc[rt]);
#pragma unroll
        for (int rt = 0; rt < 2; ++rt)
#pragma unroll
            for (int e = 0; e < 4; ++e) { const int t = 16 * rt + 4 * fq + e; const float y = acc[rt][e] + dsk * __uint_as_float(uk[rt][e] << 16); *(LAS bf16*)(Y + (t * 520 + 16 * g + fr) * 2) = f2b(gelu_tanh_f(y)); }
        WAVE_SYNC(); }
    BLOCK_SYNC();
    const bf16* wg = (const bf16*)(tb + TB_WGLUT); f32x4 acc[2][4];
#pragma unroll
    for (int i = 0; i < 2; ++i)
#pragma unroll
        for (int j = 0; j < 4; ++j) acc[i][j] = (f32x4){0.f, 0.f, 0.f, 0.f};
    float bgl[4];
#pragma unroll
    for (int j = 0; j < 4; ++j) bgl[j] = A.in[I_B_GLU][l * 512 + 64 * wave + 16 * j + fr];
#pragma unroll 1
    for (int k4 = 0; k4 < 16; k4 += 4) { bf16x8 fb[4][4];
#pragma unroll
        for (int q = 0; q < 4; ++q)
#pragma unroll
            for (int j = 0; j < 4; ++j) fb[q][j] = gfrag(wg + sfrag(64 * wave + 16 * j, 32 * (k4 + q), 512) + 8 * lane);
#pragma unroll
        for (int q = 0; q < 4; ++q)
#pragma unroll
            for (int j = 0; j < 4; ++j) PIN(fb[q][j]);
#pragma unroll
        for (int q = 0; q < 4; ++q) { bf16x8 fa[2];
#pragma unroll
            for (int i = 0; i < 2; ++i) fa[i] = ldsfrag(Y + ((16 * i + fr) * 520 + 32 * (k4 + q) + 8 * fq) * 2);
#pragma unroll
            for (int i = 0; i < 2; ++i)
#pragma unroll
                for (int j = 0; j < 4; ++j) acc[i][j] = mfma16(fa[i], fb[q][j], acc[i][j]); } }
#pragma unroll
    for (int i = 0; i < 2; ++i)
#pragma unroll
        for (int e = 0; e < 4; ++e) { const int t = 16 * i + 4 * fq + e; float sq = 0.f;
#pragma unroll
            for (int j = 0; j < 4; ++j) { const int col = 64 * wave + 16 * j + fr; const float yv = bf2f(*(const LAS bf16*)(Y + (t * 520 + col) * 2));
                const float o = yv * sigmoid_f(acc[i][j][e] + bgl[j]); acc[i][j][e] = o; sq += o * o; }
            sq = sum16(sq); if (fr == 0) SQ[wave * 32 + t] = sq; }
    BLOCK_SYNC();
    bf16* mix = (bf16*)(ws + WS_MIX);
#pragma unroll
    for (int i = 0; i < 2; ++i)
#pragma unroll
        for (int e = 0; e < 4; ++e) { const int t = 16 * i + 4 * fq + e; float sq = 0.f;
#pragma unroll
            for (int w = 0; w < 8; ++w) sq += SQ[w * 32 + t];
            const float rs = __builtin_amdgcn_rsqf(sq * (1.0f / 512.0f) + EPS);
#pragma unroll
            for (int j = 0; j < 4; ++j) mix[(size_t)(grow0 + t) * D + 512 + 64 * wave + 16 * j + fr] = f2b(acc[i][j][e] * rs); }
    BLOCK_SYNC();
}


#define RELANE() do { asm volatile("" : "+v"(tid)); lane = tid & 63; fr = lane & 15; fq = lane >> 4; } while (0)
__device__ __forceinline__ void mc_rest_unit(const Args& A, LAS unsigned char* lds, int l, int b, int c, int tid, int lane, int wave) {
    asm volatile("" : "+v"(tid)); lane = tid & 63; wave = __builtin_amdgcn_readfirstlane(tid >> 6);
    unsigned char* ws = A.ws; const bf16* proj = (const bf16*)(ws + WS_PROJ); const float* DTV = (const float*)(ws + WS_DTV); bf16* mix = (bf16*)(ws + WS_MIX);
    LAS float* AC = (LAS float*)lds; LAS float* DTs = (LAS float*)(lds + 2048); LAS float* SQ = (LAS float*)(lds + 96768); LAS float* SQ2 = (LAS float*)(lds + 98816);
    LAS unsigned char* XT = lds + 4608; LAS unsigned char* BMs = lds + 41472; LAS unsigned char* CMs = lds + 50688; LAS unsigned char* PW = lds + 59904 + wave * 4608;
    LAS unsigned char* PL = lds + 4608;
    const int grow0 = b * T + c * SSD_L; int fr = lane & 15, fq = lane >> 4; const bool first = (c == 0), lastc = (c == SSD_NC - 1);
    const float* cw = A.in[I_CONV_W] + l * 4 * 768; const float* cb = A.in[I_CONV_B] + l * 768;
    { const float an = -expf(A.in[I_A_LOG][l * 8 + wave]); const float dt = DTV[(size_t)(grow0 + lane) * 8 + wave];
        AC[wave * 64 + lane] = wave_scan_incl(dt * an, lane); DTs[wave * 64 + lane] = dt; }
    BLOCK_SYNC();
    f32x4 yv[2][2][4];
#pragma unroll
    for (int half = 0; half < 2; ++half) {
        RELANE();
        { const int t0 = 8 * wave; float xs[8][4]; conv8<4>(proj, cw, cb, grow0, t0, first, 256 * half + 4 * lane, xs);
            const int hl = lane >> 4, p0 = 4 * (lane & 15);
#pragma unroll
            for (int e = 0; e < 4; ++e) { v4u w; w.x = cvtpk(xs[0][e], xs[1][e]); w.y = cvtpk(xs[2][e], xs[3][e]); w.z = cvtpk(xs[4][e], xs[5][e]); w.w = cvtpk(xs[6][e], xs[7][e]);
                *(LAS v4u*)(XT + ((hl * 64 + p0 + e) * 72 + t0) * 2) = w; }
            float bc[8][2]; const int isc = lane >> 5, n0 = 2 * (lane & 31); conv8<2>(proj, cw, cb, grow0, t0, first, 512 + 128 * isc + 64 * half + n0, bc);
            LAS unsigned char* dst = isc ? CMs : BMs;
#pragma unroll
            for (int i = 0; i < 8; ++i) *(LAS unsigned*)(dst + ((t0 + i) * 72 + n0) * 2) = cvtpk(bc[i][0], bc[i][1]); }
        BLOCK_SYNC(); RELANE();
        { const int hl = wave >> 1, th = wave & 1, h = 4 * half + hl;
#pragma unroll
            for (int rt = 0; rt < 2; ++rt) { const bf16x8 fc0 = ldsfrag(CMs + ((32 * th + 16 * rt + fr) * 72 + 8 * fq) * 2), fc1 = ldsfrag(CMs + ((32 * th + 16 * rt + fr) * 72 + 32 + 8 * fq) * 2);
#pragma unroll
                for (int st = 0; st < 4; ++st) { f32x4 g = (f32x4){0.f, 0.f, 0.f, 0.f};
                    g = mfma16(fc0, ldsfrag(BMs + ((16 * st + fr) * 72 + 8 * fq) * 2), g); g = mfma16(fc1, ldsfrag(BMs + ((16 * st + fr) * 72 + 32 + 8 * fq) * 2), g);
                    const int s = 16 * st + fr; const float as = AC[h * 64 + s], ds = DTs[h * 64 + s];
#pragma unroll
                    for (int e = 0; e < 4; ++e) { const int tl = 16 * rt + 4 * fq + e, t = 32 * th + tl; const float pv = (s <= t) ? g[e] * __expf(AC[h * 64 + t] - as) * ds : 0.f;
                        *(LAS bf16*)(PW + (tl * 72 + s) * 2) = f2b(pv); } asm volatile("" ::: "memory"); } }
            WAVE_SYNC(); RELANE();
            const float* HP = (const float*)(ws + WS_SS) + ((size_t)(b * SSD_NC + c) * 8 + h) * 4096; float dsk = A.in[I_SSD_D][l * 8 + h]; float sqp[2][4];
            bf16x8 hpf[4][2];
            { f32x4 hq[4][4];
#pragma unroll
                for (int pt = 0; pt < 4; ++pt) { const float* hp = HP + (16 * pt + fr) * 64 + 8 * fq; hq[pt][0] = *(const GAS f32x4*)hp; hq[pt][1] = *(const GAS f32x4*)(hp + 4); hq[pt][2] = *(const GAS f32x4*)(hp + 32); hq[pt][3] = *(const GAS f32x4*)(hp + 36); }
#pragma unroll
                for (int pt = 0; pt < 4; ++pt)
#pragma unroll
                    for (int q = 0; q < 4; ++q) PIN(hq[pt][q]);
#pragma unroll
                for (int pt = 0; pt < 4; ++pt) { hpf[pt][0] = pack8(hq[pt][0], hq[pt][1]); hpf[pt][1] = pack8(hq[pt][2], hq[pt][3]); } }
            PIN(dsk);
#pragma unroll
            for (int rt = 0; rt < 2; ++rt) { const bf16x8 fp0 = ldsfrag(PW + ((16 * rt + fr) * 72 + 8 * fq) * 2), fp1 = ldsfrag(PW + ((16 * rt + fr) * 72 + 32 + 8 * fq) * 2);
                const bf16x8 fc0 = ldsfrag(CMs + ((32 * th + 16 * rt + fr) * 72 + 8 * fq) * 2), fc1 = ldsfrag(CMs + ((32 * th + 16 * rt + fr) * 72 + 32 + 8 * fq) * 2);
                unsigned zr[4][4];
#pragma unroll
                for (int pt = 0; pt < 4; ++pt)
#pragma unroll
                    for (int e = 0; e < 4; ++e) zr[pt][e] = (unsigned)proj[(size_t)(grow0 + 32 * th + 16 * rt + 4 * fq + e) * NIN + C_Z + 64 * h + 16 * pt + fr];
#pragma unroll
                for (int pt = 0; pt < 4; ++pt)
#pragma unroll
                    for (int e = 0; e < 4; ++e) PIN(zr[pt][e]);
#pragma unroll
                for (int e = 0; e < 4; ++e) sqp[rt][e] = 0.f;
#pragma unroll
                for (int pt = 0; pt < 4; ++pt) { const int p = 16 * pt + fr; f32x4 y = (f32x4){0.f, 0.f, 0.f, 0.f}, yo = (f32x4){0.f, 0.f, 0.f, 0.f};
                    y = mfma16(fp0, ldsfrag(XT + ((hl * 64 + p) * 72 + 8 * fq) * 2), y); y = mfma16(fp1, ldsfrag(XT + ((hl * 64 + p) * 72 + 32 + 8 * fq) * 2), y);
                    yo = mfma16(fc0, hpf[pt][0], yo); yo = mfma16(fc1, hpf[pt][1], yo);
                    const v2u xw = *(const LAS v2u*)(XT + ((hl * 64 + p) * 72 + 32 * th + 16 * rt + 4 * fq) * 2); const float xv[4] = {bf_lo(xw.x), bf_hi(xw.x), bf_lo(xw.y), bf_hi(xw.y)};
#pragma unroll
                    for (int e = 0; e < 4; ++e) { const int t = 32 * th + 16 * rt + 4 * fq + e; const float z = __uint_as_float(zr[pt][e] << 16);
                        const float v = (y[e] + __expf(AC[h * 64 + t]) * yo[e] + dsk * xv[e]) * silu_f(z); y[e] = v; sqp[rt][e] += v * v; }
                    yv[half][rt][pt] = y; }
#pragma unroll
                for (int e = 0; e < 4; ++e) { const float s = sum16(sqp[rt][e]); if (fr == 0) SQ[(half * 4 + hl) * 64 + 32 * th + 16 * rt + 4 * fq + e] = s; } } }
        BLOCK_SYNC();
    }
    RELANE();
    { const int hl = wave >> 1, th = wave & 1;
#pragma unroll
        for (int half = 0; half < 2; ++half)
#pragma unroll
            for (int rt = 0; rt < 2; ++rt)
#pragma unroll
                for (int e = 0; e < 4; ++e) { const int t = 32 * th + 16 * rt + 4 * fq + e; float sq = 0.f;
#pragma unroll
                    for (int w = 0; w < 8; ++w) sq += SQ[w * 64 + t];
                    const float rs = __builtin_amdgcn_rsqf(sq * (1.0f / 512.0f) + EPS);
#pragma unroll
                    for (int pt = 0; pt < 4; ++pt) mix[(size_t)(grow0 + t) * D + 64 * (4 * half + hl) + 16 * pt + fr] = f2b(yv[half][rt][pt][e] * rs); } }
    RELANE();
    { const int t0 = 8 * wave, ch = 8 * lane; v4u gcr[10], hvr[10], gbr[8]; float w[3][8];
#pragma unroll
        for (int r = 0; r < 10; ++r) { const int tt = t0 - 2 + r; const bf16* p = proj + (size_t)(grow0 + ((first && tt < 0) ? 0 : tt)) * NIN; gcr[r] = *(const GAS v4u*)(p + C_GC + ch); hvr[r] = *(const GAS v4u*)(p + C_HV + ch); }
#pragma unroll
        for (int i = 0; i < 8; ++i) gbr[i] = *(const GAS v4u*)(proj + (size_t)(grow0 + t0 + i) * NIN + C_GB + ch);
#pragma unroll
        for (int j = 0; j < 3; ++j)
#pragma unroll
            for (int e = 0; e < 8; ++e) w[j][e] = A.in[I_SC_W][(l * 3 + j) * 512 + ch + e];
#pragma unroll
        for (int r = 0; r < 10; ++r) { PIN(gcr[r]); PIN(hvr[r]); }
#pragma unroll
        for (int i = 0; i < 8; ++i) PIN(gbr[i]);
        float v2[8], v1[8];
#pragma unroll
        for (int r = 0; r < 10; ++r) { float gc[8], hv[8], v0[8]; unpack8(gcr[r], gc); unpack8(hvr[r], hv); const bool z = first && (t0 - 2 + r) < 0;
#pragma unroll
            for (int e = 0; e < 8; ++e) v0[e] = z ? 0.f : gc[e] * hv[e];
            if (r >= 2) { const int tt = t0 + r - 2; float gb[8], y[8]; unpack8(gbr[r - 2], gb); float sq = 0.f;
#pragma unroll
                for (int e = 0; e < 8; ++e) { y[e] = gb[e] * (w[0][e] * v2[e] + w[1][e] * v1[e] + w[2][e] * v0[e]); sq += y[e] * y[e]; }
                const float rs = __builtin_amdgcn_rsqf(wave_sum(sq) * (1.0f / 512.0f) + EPS);
                v4u o; o.x = cvtpk(y[0] * rs, y[1] * rs); o.y = cvtpk(y[2] * rs, y[3] * rs); o.z = cvtpk(y[4] * rs, y[5] * rs); o.w = cvtpk(y[6] * rs, y[7] * rs);
                *(GAS v4u*)(mix + (size_t)(grow0 + tt) * D + 1024 + ch) = o;
                if (lastc && tt >= 62) { float* o2 = A.out + O_PSC + ((size_t)(l * NB + b) * 2 + (tt - 62)) * 512 + ch; *(GAS f32x4*)o2 = (f32x4){v0[0], v0[1], v0[2], v0[3]}; *(GAS f32x4*)(o2 + 4) = (f32x4){v0[4], v0[5], v0[6], v0[7]}; } }
#pragma unroll
            for (int e = 0; e < 8; ++e) { v2[e] = v1[e]; v1[e] = v0[e]; } }
    }
    BLOCK_SYNC();
#pragma unroll 1
    for (int hh = 0; hh < 2; ++hh) { RELANE(); const int t0 = 8 * wave, ch = 4 * lane + 256 * hh, gI = ch >> 7;
        float u[23][4]; v2u ur[23];
#pragma unroll
        for (int r = 0; r < 23; ++r) { const int tt = t0 - 15 + r; ur[r] = *(const GAS v2u*)(proj + (size_t)(grow0 + ((first && tt < 0) ? 0 : tt)) * NIN + C_UP + ch); }
#pragma unroll
        for (int r = 0; r < 23; ++r) PIN(ur[r]);
#pragma unroll
        for (int r = 0; r < 23; ++r) { const bool z = first && (t0 - 15 + r) < 0; u[r][0] = z ? 0.f : bf_lo(ur[r].x); u[r][1] = z ? 0.f : bf_hi(ur[r].x); u[r][2] = z ? 0.f : bf_lo(ur[r].y); u[r][3] = z ? 0.f : bf_hi(ur[r].y); }
        const int win = 2 << gI;
#pragma unroll
        for (int i = 0; i < 8; ++i) { const int r = 15 + i; float pv[4]; const int pos = c * SSD_L + t0 + i; const float inv = 1.0f / (float)(pos + 1 < win ? pos + 1 : win);
#pragma unroll
            for (int e = 0; e < 4; ++e) { const float s2 = u[r][e] + u[r - 1][e], s4 = s2 + u[r - 2][e] + u[r - 3][e], s8 = s4 + (u[r - 4][e] + u[r - 5][e]) + (u[r - 6][e] + u[r - 7][e]);
                const float s16 = s8 + ((u[r - 8][e] + u[r - 9][e]) + (u[r - 10][e] + u[r - 11][e])) + ((u[r - 12][e] + u[r - 13][e]) + (u[r - 14][e] + u[r - 15][e]));
                const float cs = gI == 0 ? s2 : gI == 1 ? s4 : gI == 2 ? s8 : s16; pv[e] = cs * inv - u[r][e]; }
            v2u o; o.x = cvtpk(pv[0], pv[1]); o.y = cvtpk(pv[2], pv[3]); *(LAS v2u*)(PL + ((t0 + i) * 520 + ch) * 2) = o;
            if (lastc && t0 + i >= 49) *(GAS f32x4*)(A.out + O_PPOOL + ((size_t)(l * NB + b) * 15 + (t0 + i - 49)) * 512 + ch) = (f32x4){u[r][0], u[r][1], u[r][2], u[r][3]}; }
    }
    BLOCK_SYNC(); RELANE();
    { const int gI = wave >> 1, dh = wave & 1; const bf16* wp = (const bf16*)(ws + WS_TAB + (size_t)l * TAB_L + TB_WPT) + (size_t)gI * 128 * 128; f32x4 acc[4][4];
#pragma unroll
        for (int i = 0; i < 4; ++i)
#pragma unroll
            for (int j = 0; j < 4; ++j) acc[i][j] = (f32x4){0.f, 0.f, 0.f, 0.f};
        bf16x8 fbw[4][4]; float psc[4];
#pragma unroll
        for (int ks = 0; ks < 4; ++ks)
#pragma unroll
            for (int j = 0; j < 4; ++j) fbw[ks][j] = gfrag(wp + sfrag(64 * dh + 16 * j, 32 * ks, 128) + 8 * lane);
#pragma unroll
        for (int j = 0; j < 4; ++j) psc[j] = A.in[I_POOL_SCALE][l * 512 + 128 * gI + 64 * dh + 16 * j + fr];
#pragma unroll
        for (int ks = 0; ks < 4; ++ks)
#pragma unroll
            for (int j = 0; j < 4; ++j) PIN(fbw[ks][j]);
#pragma unroll
        for (int ks = 0; ks < 4; ++ks) { bf16x8 fa[4];
#pragma unroll
            for (int i = 0; i < 4; ++i) fa[i] = ldsfrag(PL + ((16 * i + fr) * 520 + 128 * gI + 32 * ks + 8 * fq) * 2);
#pragma unroll
            for (int i = 0; i < 4; ++i)
#pragma unroll
                for (int j = 0; j < 4; ++j) acc[i][j] = mfma16(fa[i], fbw[ks][j], acc[i][j]); }
#pragma unroll
        for (int i = 0; i < 4; ++i)
#pragma unroll
            for (int e = 0; e < 4; ++e) { float sq = 0.f;
#pragma unroll
                for (int j = 0; j < 4; ++j) { const float o = acc[i][j][e] * psc[j]; acc[i][j][e] = o; sq += o * o; }
                sq = sum16(sq); if (fr == 0) SQ2[wave * 64 + 16 * i + 4 * fq + e] = sq; }
        BLOCK_SYNC();
#pragma unroll
        for (int i = 0; i < 4; ++i)
#pragma unroll
            for (int e = 0; e < 4; ++e) { const int t = 16 * i + 4 * fq + e; float sq = 0.f;
#pragma unroll
                for (int w = 0; w < 8; ++w) sq += SQ2[w * 64 + t];
                const float rs = __builtin_amdgcn_rsqf(sq * (1.0f / 512.0f) + EPS);
#pragma unroll
                for (int j = 0; j < 4; ++j) mix[(size_t)(grow0 + t) * D + 1536 + 128 * gI + 64 * dh + 16 * j + fr] = f2b(acc[i][j][e] * rs); }
    }
    if (lastc) for (int i = tid; i < 3 * 768; i += NTHR) { const int r = i / 768, ch = i % 768; A.out[O_PCONV + ((size_t)(l * NB + b) * 3 + r) * 768 + ch] = bf2f(proj[(size_t)(grow0 + 61 + r) * NIN + C_XBC + ch]); }
    BLOCK_SYNC();
}

__device__ __forceinline__ void mc_sample_unit(const Args& A, LAS unsigned char* lds, int l, int s, int tid, int lane, int wave) {
    asm volatile("" : "+v"(tid)); lane = tid & 63; wave = __builtin_amdgcn_readfirstlane(tid >> 6);
    unsigned char* ws = A.ws; const bf16* proj = (const bf16*)(ws + WS_PROJ) + (size_t)(MP + s) * NIN; const unsigned char* tb = ws + WS_TAB + (size_t)l * TAB_L; float* out = A.out;
    LAS float* XC = (LAS float*)lds; LAS float* U5 = (LAS float*)(lds + 5120); LAS float* Y5 = (LAS float*)(lds + 7168); LAS float* PLs = (LAS float*)(lds + 9216); LAS float* OUT = (LAS float*)(lds + 11264); LAS float* ZP = (LAS float*)(lds + 19456);
    const int ls = l * MS + s;
    { const int c1 = tid < 256 ? tid + 512 : tid; const float* st0 = A.in[I_ST_CONV] + (size_t)ls * 3 * 768; const float* cw = A.in[I_CONV_W] + l * 4 * 768;
        float a[2][3], nwv[2], wv[2][4], bsv[2]; const int chs[2] = {tid, c1};
#pragma unroll
        for (int q = 0; q < 2; ++q) { const int ch = chs[q]; a[q][0] = st0[ch]; a[q][1] = st0[768 + ch]; a[q][2] = st0[1536 + ch]; nwv[q] = bf2f(proj[C_XBC + ch]); bsv[q] = A.in[I_CONV_B][l * 768 + ch];
#pragma unroll
            for (int j = 0; j < 4; ++j) wv[q][j] = cw[j * 768 + ch]; }
        float u5v = bf2f(proj[C_U5 + tid]);
#pragma unroll
        for (int q = 0; q < 2; ++q) { PIN(a[q][0]); PIN(a[q][1]); PIN(a[q][2]); PIN(nwv[q]); PIN(bsv[q]); PIN(wv[q][0]); PIN(wv[q][1]); PIN(wv[q][2]); PIN(wv[q][3]); }
        PIN(u5v);
#pragma unroll
        for (int q = 0; q < 2; ++q) if (q == 0 || tid < 256) { const int ch = chs[q]; XC[ch] = silu_f(bsv[q] + wv[q][0] * a[q][0] + wv[q][1] * a[q][1] + wv[q][2] * a[q][2] + wv[q][3] * nwv[q]);
            float* o = out + O_SCONV + (size_t)ls * 3 * 768 + ch; o[0] = a[q][1]; o[768] = a[q][2]; o[1536] = nwv[q]; }
        U5[tid] = u5v; }
    BLOCK_SYNC();
    { const int h = wave; const float dt = ((const float*)(ws + WS_DTV))[(size_t)(MP + s) * 8 + h], dec = expf(-dt * expf(A.in[I_A_LOG][l * 8 + h])), dsk = A.in[I_SSD_D][l * 8 + h];
        const int n4 = 4 * (lane & 15); const f32x4 Bv = *(const LAS f32x4*)(XC + 512 + 64 * (h >> 2) + n4), Cv = *(const LAS f32x4*)(XC + 640 + 64 * (h >> 2) + n4);
        const size_t o0 = (((size_t)ls * 8 + h) * 64 + (lane >> 4)) * 64 + n4; f32x4 h0[16]; unsigned zr[16];
#pragma unroll
        for (int it = 0; it < 16; ++it) { h0[it] = __builtin_nontemporal_load((const GAS f32x4*)(A.in[I_ST_SSD] + o0 + (size_t)it * 256)); zr[it] = (unsigned)proj[C_Z + 64 * h + it * 4 + (lane >> 4)]; }
#pragma unroll
        for (int it = 0; it < 16; ++it) { PIN(h0[it]); PIN(zr[it]); }
#pragma unroll
        for (int it = 0; it < 16; ++it) { const int p = it * 4 + (lane >> 4); const float x = XC[64 * h + p]; const f32x4 hn = h0[it] * dec + Bv * (dt * x);
            __builtin_nontemporal_store(hn, (GAS f32x4*)(out + O_SSSD + o0 + (size_t)it * 256));
            float y = (hn.x * Cv.x + hn.y * Cv.y) + (hn.z * Cv.z + hn.w * Cv.w); y = sum16(y);
            if ((lane & 15) == 0) OUT[64 * h + p] = (y + dsk * x) * silu_f(__uint_as_float(zr[it] << 16)); } }
#pragma unroll 1
    for (int gi = 0; gi < 4; ++gi) { const int g = 4 * wave + gi; const f32x2* bb = (const f32x2*)(tb + TB_BBAR) + (size_t)g * 16 * 64 + lane; f32x2 bv[16]; float cr[16], ci[16];
        const float* cre = A.in[I_C_RE] + ((size_t)l * 32 + g) * 1024 + lane; const float* cim = A.in[I_C_IM] + ((size_t)l * 32 + g) * 1024 + lane;
#pragma unroll
        for (int k = 0; k < 16; ++k) { bv[k] = bb[k * 64]; cr[k] = cre[k * 64]; ci[k] = cim[k * 64]; }
        f32x2 a = ((const f32x2*)(tb + TB_ABAR))[g * 64 + lane]; const size_t o = ((size_t)ls * 32 + g) * 64 + lane; float h0r = A.in[I_ST_S5R][o], h0i = A.in[I_ST_S5I][o]; float dv = A.in[I_S5_D][l * 512 + 16 * g + (lane & 15)];
        PIN(a); PIN(h0r); PIN(h0i); PIN(dv);
#pragma unroll
        for (int k = 0; k < 16; ++k) { PIN(bv[k]); PIN(cr[k]); PIN(ci[k]); }
        float br = 0.f, bi = 0.f;
#pragma unroll
        for (int k = 0; k < 16; ++k) { const float u = U5[16 * g + k]; br += bv[k].x * u; bi += bv[k].y * u; }
        const float hr = a.x * h0r - a.y * h0i + br, hi = a.x * h0i + a.y * h0r + bi; out[O_SS5R + o] = hr; out[O_SS5I + o] = hi;
        float mine = 0.f;
#pragma unroll
        for (int k = 0; k < 16; ++k) { const float v = wave_sum(cr[k] * hr - ci[k] * hi); mine = (lane == k) ? v : mine; }
        if (lane < 16) Y5[16 * g + lane] = gelu_tanh_f(mine + dv * U5[16 * g + lane]); }
    { const int c = tid, gI = c >> 7, win = 2 << gI; const float* st = A.in[I_ST_SC] + (size_t)ls * 2 * 512 + c; const float* w = A.in[I_SC_W] + l * 3 * 512 + c; const float* sp = A.in[I_ST_POOL] + (size_t)ls * 15 * 512 + c;
        float s0 = st[0], s1 = st[512], gc = bf2f(proj[C_GC + c]), hvv = bf2f(proj[C_HV + c]), gb = bf2f(proj[C_GB + c]), w0 = w[0], w1 = w[512], w2 = w[1024], u = bf2f(proj[C_UP + c]); float hh[15];
#pragma unroll
        for (int r = 0; r < 15; ++r) hh[r] = sp[r * 512];
        PIN(s0); PIN(s1); PIN(gc); PIN(hvv); PIN(gb); PIN(w0); PIN(w1); PIN(w2); PIN(u);
#pragma unroll
        for (int r = 0; r < 15; ++r) PIN(hh[r]);
        const float v = gc * hvv; OUT[1024 + c] = gb * (w0 * s0 + w1 * s1 + w2 * v); float* o = out + O_SSC + (size_t)ls * 2 * 512 + c; o[0] = s1; o[512] = v;
        float* op = out + O_SPOOL + (size_t)ls * 15 * 512 + c; float sum = u;
#pragma unroll
        for (int r = 0; r < 15; ++r) { if (15 - r < win) sum += hh[r]; if (r > 0) op[(r - 1) * 512] = hh[r]; }
        op[14 * 512] = u; PLs[c] = sum / (float)win - u; }
    BLOCK_SYNC();
    { const int ig = tid >> 7, j4 = tid & 127; const float* wg = A.in[I_W_GLU] + (size_t)l * 512 * 512 + (size_t)(128 * ig) * 512 + 4 * j4; f32x4 z = (f32x4){0.f, 0.f, 0.f, 0.f};
#pragma unroll 1
        for (int i0 = 0; i0 < 128; i0 += 32) { f32x4 wv[32];
#pragma unroll
            for (int i = 0; i < 32; ++i) wv[i] = *(const GAS f32x4*)(wg + (size_t)(i0 + i) * 512);
#pragma unroll
            for (int i = 0; i < 32; ++i) PIN(wv[i]);
#pragma unroll
            for (int i = 0; i < 32; ++i) z += wv[i] * Y5[128 * ig + i0 + i]; }
        *(LAS f32x4*)(ZP + ig * 512 + 4 * j4) = z;
        const int gI = tid >> 7, d = tid & 127; const float* wp = A.in[I_POOL_W] + ((size_t)l * 4 + gI) * 128 * 128 + d; float acc = 0.f;
#pragma unroll 1
        for (int c0 = 0; c0 < 128; c0 += 32) { float wv[32];
#pragma unroll
            for (int c = 0; c < 32; ++c) wv[c] = wp[(c0 + c) * 128];
#pragma unroll
            for (int c = 0; c < 32; ++c) PIN(wv[c]);
#pragma unroll
            for (int c = 0; c < 32; ++c) acc += PLs[128 * gI + c0 + c] * wv[c]; }
        OUT[1536 + tid] = acc * A.in[I_POOL_SCALE][l * 512 + tid]; }
    BLOCK_SYNC();
    { const int j = tid; const float z = A.in[I_B_GLU][l * 512 + j] + (ZP[j] + ZP[512 + j]) + (ZP[1024 + j] + ZP[1536 + j]); OUT[512 + j] = Y5[j] * sigmoid_f(z); }
    BLOCK_SYNC();
    if (wave < 4) { float v[8]; float sq = 0.f;
#pragma unroll
        for (int e = 0; e < 8; ++e) { v[e] = OUT[512 * wave + 8 * lane + e]; sq += v[e] * v[e]; }
        const float rs = __builtin_amdgcn_rsqf(wave_sum(sq) * (1.0f / 512.0f) + EPS);
        v4u o; o.x = cvtpk(v[0] * rs, v[1] * rs); o.y = cvtpk(v[2] * rs, v[3] * rs); o.z = cvtpk(v[4] * rs, v[5] * rs); o.w = cvtpk(v[6] * rs, v[7] * rs);
        *(GAS v4u*)((bf16*)(ws + WS_SA + SA_MIX) + sfrag(s, 512 * wave + 8 * lane, D)) = o; }
    BLOCK_SYNC();
}

__device__ __forceinline__ void att_prompt_unit(const Args& A, LAS unsigned char* lds, int l, int b, int hd, int qb, int tid, int lane, int wave) {
    asm volatile("" : "+v"(tid)); lane = tid & 63; wave = __builtin_amdgcn_readfirstlane(tid >> 6);
    unsigned char* ws = A.ws; const int fr = lane & 15, fq = lane >> 4, grow0 = b * T + qb * 128;
    const bf16* Q = (const bf16*)(ws + WS_Q) + (size_t)grow0 * D + hd * HDX; const bf16* K = (const bf16*)(ws + WS_KB) + ((size_t)l * MROWS + b * NMEM) * D + hd * HDX;
    const bf16* V = (const bf16*)(ws + WS_VT) + (((size_t)l * NB + b) * D + hd * HDX) * NMEM; bf16* O = (bf16*)(ws + WS_O) + (size_t)grow0 * D + hd * HDX;
    LAS unsigned char* PS = lds; LAS unsigned char* KS = lds + 67584; LAS unsigned char* QS = lds + 104448; LAS unsigned char* VS = lds + 67584;
    f32x4 acc[16];
#pragma unroll
    for (int i = 0; i < 16; ++i) acc[i] = (f32x4){0.f, 0.f, 0.f, 0.f};
#pragma unroll 1
    for (int ds = 0; ds < 8; ++ds) {
        { v4u tk[4], tq[2];
#pragma unroll
            for (int i = 0; i < 4; ++i) { const int id = tid + NTHR * i, key = id >> 3, part = id & 7; tk[i] = *(const GAS v4u*)(K + (size_t)key * D + 64 * ds + 8 * part); }
#pragma unroll
            for (int i = 0; i < 2; ++i) { const int id = tid + NTHR * i, r = id >> 3, part = id & 7; tq[i] = *(const GAS v4u*)(Q + (size_t)r * D + 64 * ds + 8 * part); }
#pragma unroll
            for (int i = 0; i < 4; ++i) PIN(tk[i]);
            PIN(tq[0]); PIN(tq[1]);
#pragma unroll
            for (int i = 0; i < 4; ++i) { const int id = tid + NTHR * i, key = id >> 3, part = id & 7; *(LAS v4u*)(KS + (key * 72 + 8 * part) * 2) = tk[i]; }
#pragma unroll
            for (int i = 0; i < 2; ++i) { const int id = tid + NTHR * i, r = id >> 3, part = id & 7; *(LAS v4u*)(QS + (r * 72 + 8 * part) * 2) = tq[i]; } }
        BLOCK_SYNC();
#pragma unroll
        for (int ks = 0; ks < 2; ++ks) { const bf16x8 fa = ldsfrag(QS + ((16 * wave + fr) * 72 + 32 * ks + 8 * fq) * 2);
#pragma unroll
            for (int kt = 0; kt < 16; ++kt) acc[kt] = mfma16(fa, ldsfrag(KS + ((16 * kt + fr) * 72 + 32 * ks + 8 * fq) * 2), acc[kt]); }
        BLOCK_SYNC();
    }
    float inv[4]; const float scale = 0.044194173824159216f;
#pragma unroll
    for (int e = 0; e < 4; ++e) { float m = acc[0][e];
#pragma unroll
        for (int kt = 1; kt < 16; ++kt) m = fmaxf(m, acc[kt][e]);
        m = max16(m); float sum = 0.f;
#pragma unroll
        for (int kt = 0; kt < 16; ++kt) { const float p = __expf((acc[kt][e] - m) * scale); sum += p; *(LAS bf16*)(PS + ((16 * wave + 4 * fq + e) * 264 + 16 * kt + fr) * 2) = f2b(p); }
        inv[e] = __builtin_amdgcn_rcpf(sum16(sum)); }
#pragma unroll 1
    for (int ds = 0; ds < 8; ++ds) {
        { v4u tv[4];
#pragma unroll
            for (int i = 0; i < 4; ++i) { const int id = tid + NTHR * i, dr = id >> 5, part = id & 31; tv[i] = *(const GAS v4u*)(V + (size_t)(64 * ds + dr) * NMEM + 8 * part); }
#pragma unroll
            for (int i = 0; i < 4; ++i) PIN(tv[i]);
#pragma unroll
            for (int i = 0; i < 4; ++i) { const int id = tid + NTHR * i, dr = id >> 5, part = id & 31; *(LAS v4u*)(VS + (dr * 264 + 8 * part) * 2) = tv[i]; } }
        BLOCK_SYNC();
        f32x4 o[4] = {(f32x4){0.f, 0.f, 0.f, 0.f}, (f32x4){0.f, 0.f, 0.f, 0.f}, (f32x4){0.f, 0.f, 0.f, 0.f}, (f32x4){0.f, 0.f, 0.f, 0.f}};
#pragma unroll
        for (int ks = 0; ks < 8; ++ks) { const bf16x8 fa = ldsfrag(PS + ((16 * wave + fr) * 264 + 32 * ks + 8 * fq) * 2);
#pragma unroll
            for (int dt = 0; dt < 4; ++dt) o[dt] = mfma16(fa, ldsfrag(VS + ((16 * dt + fr) * 264 + 32 * ks + 8 * fq) * 2), o[dt]); }
#pragma unroll
        for (int dt = 0; dt < 4; ++dt)
#pragma unroll
            for (int e = 0; e < 4; ++e) O[(size_t)(16 * wave + 4 * fq + e) * D + 64 * ds + 16 * dt + fr] = f2b(o[dt][e] * inv[e]);
        BLOCK_SYNC();
    }
}
__device__ __forceinline__ void att_sample_unit(const Args& A, LAS unsigned char* lds, int l, int s, int hp, int tid, int lane, int wave) {
    asm volatile("" : "+v"(tid)); lane = tid & 63; wave = __builtin_amdgcn_readfirstlane(tid >> 6);
    unsigned char* ws = A.ws; const bf16* Q = (const bf16*)(ws + WS_Q) + (size_t)(MP + s) * D + hp * 1024;
    const float* K = A.in[I_CK] + (((size_t)l * MS + s) * NMEM) * D + hp * 1024; const float* V = A.in[I_CV] + (((size_t)l * MS + s) * NMEM) * D + hp * 1024;
    LAS float* SC = (LAS float*)lds; LAS float* RED = (LAS float*)(lds + 2048);
    f32x4 q[4];
#pragma unroll
    for (int j = 0; j < 4; ++j) { const v2u w = *(const GAS v2u*)(Q + 4 * lane + 256 * j); q[j] = (f32x4){bf_lo(w.x), bf_hi(w.x), bf_lo(w.y), bf_hi(w.y)}; }
#pragma unroll 1
    for (int kk = 0; kk < 32; kk += 8) { f32x4 kv[8][4];
        const char* kp = (const char*)(K + (size_t)(32 * wave + kk) * D) + (size_t)lane * 16; asm volatile("" : "+v"(kp));
#pragma unroll
        for (int i = 0; i < 8; ++i)
#pragma unroll
            for (int j = 0; j < 4; ++j) kv[i][j] = __builtin_nontemporal_load((const GAS f32x4*)(kp + (size_t)i * (D * 4) + j * 1024));
#pragma unroll
        for (int i = 0; i < 8; ++i)
#pragma unroll
            for (int j = 0; j < 4; ++j) PIN(kv[i][j]);
#pragma unroll
        for (int i = 0; i < 8; ++i) { const f32x4 a = kv[i][0], b2 = kv[i][1], c = kv[i][2], d = kv[i][3];
            float p0 = (a.x * q[0].x + a.y * q[0].y) + (a.z * q[0].z + a.w * q[0].w) + (b2.x * q[1].x + b2.y * q[1].y) + (b2.z * q[1].z + b2.w * q[1].w);
            float p1 = (c.x * q[2].x + c.y * q[2].y) + (c.z * q[2].z + c.w * q[2].w) + (d.x * q[3].x + d.y * q[3].y) + (d.z * q[3].z + d.w * q[3].w);
            p0 = wave_sum(p0); p1 = wave_sum(p1);
            if (lane == 0) { SC[32 * wave + kk + i] = p0; SC[256 + 32 * wave + kk + i] = p1; } } }
    BLOCK_SYNC();
    if (wave < 2) { const float scale = 0.044194173824159216f; float v[4]; float m = -3.0e38f;
#pragma unroll
        for (int e = 0; e < 4; ++e) { v[e] = SC[256 * wave + lane + 64 * e]; m = fmaxf(m, v[e]); }
        m = wave_max(m);
        float sum = 0.f;
#pragma unroll
        for (int e = 0; e < 4; ++e) { v[e] = __expf((v[e] - m) * scale); sum += v[e]; }
        const float inv = __builtin_amdgcn_rcpf(wave_sum(sum));
#pragma unroll
        for (int e = 0; e < 4; ++e) SC[256 * wave + lane + 64 * e] = v[e] * inv; }
    BLOCK_SYNC();
    f32x4 o[4] = {(f32x4){0.f, 0.f, 0.f, 0.f}, (f32x4){0.f, 0.f, 0.f, 0.f}, (f32x4){0.f, 0.f, 0.f, 0.f}, (f32x4){0.f, 0.f, 0.f, 0.f}};
#pragma unroll 1
    for (int kk = 0; kk < 32; kk += 8) { f32x4 vv[8][4];
        const char* vp = (const char*)(V + (size_t)(32 * wave + kk) * D) + (size_t)lane * 16; asm volatile("" : "+v"(vp));
#pragma unroll
        for (int i = 0; i < 8; ++i)
#pragma unroll
            for (int j = 0; j < 4; ++j) vv[i][j] = __builtin_nontemporal_load((const GAS f32x4*)(vp + (size_t)i * (D * 4) + j * 1024));
#pragma unroll
        for (int i = 0; i < 8; ++i)
#pragma unroll
            for (int j = 0; j < 4; ++j) PIN(vv[i][j]);
#pragma unroll
        for (int i = 0; i < 8; ++i) { const float p0 = SC[32 * wave + kk + i], p1 = SC[256 + 32 * wave + kk + i]; o[0] += vv[i][0] * p0; o[1] += vv[i][1] * p0; o[2] += vv[i][2] * p1; o[3] += vv[i][3] * p1; } }
#pragma unroll
    for (int j = 0; j < 4; ++j) *(LAS f32x4*)(RED + wave * 1024 + 4 * lane + 256 * j) = o[j];
    BLOCK_SYNC();
    { float a0 = 0.f, a1 = 0.f;
#pragma unroll
        for (int w = 0; w < 8; ++w) { const f32x2 v = *(const LAS f32x2*)(RED + w * 1024 + 2 * tid); a0 += v.x; a1 += v.y; }
        *(GAS unsigned*)((bf16*)(ws + WS_SA + SA_O) + sfrag(s, hp * 1024 + 2 * tid, D)) = cvtpk(a0, a1); }
    BLOCK_SYNC();
}

struct SEpiScale {
    bf16* O; int ldc; const unsigned long long* ssq; int act, frag;
    __device__ __forceinline__ void operator()(const f32x4& acc, int r, int c) const { const float rs = pg8::ssq_rstd(ssq[MP + r]); f32x4 v = acc * rs;
        if (act) {
#pragma unroll
            for (int e = 0; e < 4; ++e) { const float a = v[e] > 0.f ? v[e] : 0.f; v[e] = a * a; } }
        v2u w; w.x = cvtpk(v[0], v[1]); w.y = cvtpk(v[2], v[3]); *(GAS v2u*)(O + (frag ? sfrag(r, c, ldc) : (size_t)(MP + r) * ldc + c)) = w; }
};
struct SEpiRes {
    const float* hin; float* h; bf16* hb; bf16* hbf; unsigned long long* ssq_out;
    __device__ __forceinline__ void operator()(const f32x4& acc, int r, int c) const { float* hp = h + (size_t)(MP + r) * D + c; const f32x4 v = *(const GAS f32x4*)(hin + (size_t)r * D + c) + acc; *(GAS f32x4*)hp = v;
        v2u w; w.x = cvtpk(v[0], v[1]); w.y = cvtpk(v[2], v[3]); *(GAS v2u*)(hb + (size_t)(MP + r) * D + c) = w; *(GAS v2u*)(hbf + sfrag(r, c, D)) = w;
        float sq = (v[0] * v[0] + v[1] * v[1]) + (v[2] * v[2] + v[3] * v[3]); sq += __shfl_xor(sq, 16); sq += __shfl_xor(sq, 32);
        if ((threadIdx.x & 48) == 0) pg8::ssq_add(ssq_out + MP + r, sq); }
};
constexpr int SG_RED_OFF = 32 * 4112;
static_assert(SG_RED_OFF + 4096 <= LDSCTL_OFF, "sample_gemm LDS");
template <int ROWS, class Epi> __device__ __forceinline__ void sample_gemm(LAS unsigned char* lds, const bf16* Af, const bf16* Bt, int N, int K, const Epi& E, int nwg_main, int kq, int bx, int G, int tid) {
    asm volatile("" : "+v"(tid)); const int lane = tid & 63, wave = __builtin_amdgcn_readfirstlane(tid >> 6), fr = lane & 15, fq = lane >> 4;
    constexpr int RG = 128 / ROWS;
    const int first = nwg_main % G, ns = first ? G - first : G, nunits = (N / 32) * RG;
    int u0, st, cnt;
    if (first == 0) { u0 = bx; st = G; cnt = u0 < nunits ? (nunits - u0 + st - 1) / st : 0; }
    else if (bx >= first) { u0 = bx - first; st = ns; cnt = u0 < nunits ? (nunits - u0 + st - 1) / st : 0; cnt = cnt < kq ? cnt : kq; }
    else { u0 = ns * kq + bx; st = first; cnt = u0 < nunits ? (nunits - u0 + st - 1) / st : 0; }
    if (cnt == 0) return;
    const int rtl = ROWS == 128 ? wave : ((wave & 3) >> 1), ctw = ROWS == 128 ? 0 : (wave & 1), kh = ROWS == 128 ? 0 : (wave >> 2);
#pragma unroll 1
    for (int j = 0; j < cnt; ++j) { const int u = u0 + j * st, cg = u / RG, rg = u % RG, c0 = 32 * cg, R = rg * (ROWS / 16) + rtl;
        f32x4 acc0 = (f32x4){0.f, 0.f, 0.f, 0.f}, acc1 = (f32x4){0.f, 0.f, 0.f, 0.f};
#pragma unroll 1
        for (int kc = 0; kc < K; kc += 2048) {
            const char* apu = (const char*)(Af + ((size_t)(R * (K >> 5) + ((kc + kh * 1024) >> 5)) << 9)) + (size_t)lane * 16; asm volatile("" : "+v"(apu));
            const char* bsrc = (const char*)(Bt + (size_t)(c0 + 4 * wave) * K + kc) + (size_t)lane * 16; asm volatile("" : "+v"(bsrc));
            LAS unsigned char* bdst = lds + wave * (4 * 4112);
            BLOCK_SYNC();
#pragma unroll
            for (int r = 0; r < 4; ++r) { const char* rowp = bsrc + (size_t)r * K * 2; asm volatile("" : "+v"(rowp));
#pragma unroll
                for (int seg = 0; seg < 4; ++seg) __builtin_amdgcn_global_load_lds((const unsigned*)(rowp + seg * 1024), (LAS unsigned*)(bdst + r * 4112 + seg * 1024), 16, 0, 0); }
            bf16x8 a[32];
#pragma unroll
            for (int i = 0; i < 32; ++i) a[i] = *(const bf16x8*)(apu + (size_t)i * 1024);
#pragma unroll
            for (int i = 0; i < 32; ++i) PIN(a[i]);
            BLOCK_SYNC();
            if constexpr (ROWS == 32) {
                const LAS unsigned char* bp = lds + (16 * ctw + fr) * 4112 + kh * 2048 + 16 * fq;
#pragma unroll
                for (int i = 0; i < 32; i += 2) { acc0 = mfma16(ldsfrag(bp + 64 * i), a[i], acc0); acc1 = mfma16(ldsfrag(bp + 64 * (i + 1)), a[i + 1], acc1); }
            } else {
                const LAS unsigned char* bp = lds + fr * 4112 + 16 * fq;
#pragma unroll
                for (int i = 0; i < 32; ++i) { acc0 = mfma16(ldsfrag(bp + 64 * i), a[i], acc0); acc1 = mfma16(ldsfrag(bp + 16 * 4112 + 64 * i), a[i], acc1); }
                const char* apu2 = apu + 32 * 1024; asm volatile("" : "+v"(apu2), "+v"(acc0), "+v"(acc1));
#pragma unroll
                for (int i = 0; i < 32; ++i) a[i] = *(const bf16x8*)(apu2 + (size_t)i * 1024);
#pragma unroll
                for (int i = 0; i < 32; ++i) PIN(a[i]);
#pragma unroll
                for (int i = 0; i < 32; ++i) { acc0 = mfma16(ldsfrag(bp + 64 * (32 + i)), a[i], acc0); acc1 = mfma16(ldsfrag(bp + 16 * 4112 + 64 * (32 + i)), a[i], acc1); }
            } }
        if constexpr (ROWS == 32) {
            f32x4 acc = acc0 + acc1; LAS f32x4* red = (LAS f32x4*)(lds + SG_RED_OFF) + (wave & 3) * 64 + lane;
            if (kh == 1) *red = acc;
            BLOCK_SYNC();
            if (kh == 0) { acc += *red; E(acc, 32 * rg + 16 * rtl + fr, c0 + 16 * ctw + 4 * fq); }
        } else { E(acc0, 16 * wave + fr, c0 + 4 * fq); E(acc1, 16 * wave + fr, c0 + 16 + 4 * fq); } }
    BLOCK_SYNC();
}

__device__ __forceinline__ void final_norm(const Args& A, int vcu, int G, int wave, int lane, int mb = 0) {
    asm volatile("" : "+v"(lane));
    unsigned char* ws = A.ws; const float* H = (const float*)(ws + WS_H); const unsigned long long* ssq = (const unsigned long long*)((const unsigned*)(ws + WS_CTL) + CW_SSQ) + 6 * MPAD; const int gw = vcu * NWAVES + wave, NGW = G * NWAVES;
    f32x4 g[8];
#pragma unroll
    for (int j = 0; j < 8; ++j) g[j] = ((const GAS f32x4*)A.in[I_G_FINAL])[lane + 64 * j];
#pragma unroll 1
    for (int m0 = mb + gw; m0 < MR; m0 += 2 * NGW) { const int m1 = m0 + NGW; const bool has1 = m1 < MR; const int m1c = has1 ? m1 : m0;
        const GAS f32x4* h0 = (const GAS f32x4*)(H + (size_t)m0 * D) + lane; const GAS f32x4* h1 = (const GAS f32x4*)(H + (size_t)m1c * D) + lane; f32x4 v0[8], v1[8];
        const GAS v2u* b0 = (const GAS v2u*)((const bf16*)(ws + WS_HB) + (size_t)m0 * D) + lane; const GAS v2u* b1 = (const GAS v2u*)((const bf16*)(ws + WS_HB) + (size_t)m1c * D) + lane;
        if (m0 < 0) {
#pragma unroll
            for (int j = 0; j < 8; ++j) { const v2u w = b0[64 * j]; v0[j] = (f32x4){bf_lo(w.x), bf_hi(w.x), bf_lo(w.y), bf_hi(w.y)}; } }
        else {
#pragma unroll
            for (int j = 0; j < 8; ++j) v0[j] = __builtin_nontemporal_load(h0 + 64 * j); }
        if (m1c < 0) {
#pragma unroll
            for (int j = 0; j < 8; ++j) { const v2u w = b1[64 * j]; v1[j] = (f32x4){bf_lo(w.x), bf_hi(w.x), bf_lo(w.y), bf_hi(w.y)}; } }
        else {
#pragma unroll
            for (int j = 0; j < 8; ++j) v1[j] = __builtin_nontemporal_load(h1 + 64 * j); }
        const float rs0 = pg8::ssq_rstd(ssq[m0]), rs1 = pg8::ssq_rstd(ssq[m1c]);
#pragma unroll
        for (int j = 0; j < 8; ++j) { PIN(v0[j]); PIN(v1[j]); }
        GAS f32x4* o0 = (GAS f32x4*)(A.out + (m0 < MP ? O_YP + (size_t)m0 * D : O_YS + (size_t)(m0 - MP) * D)) + lane;
#pragma unroll
        for (int j = 0; j < 8; ++j) __builtin_nontemporal_store(v0[j] * g[j] * rs0, o0 + 64 * j);
        if (has1) { GAS f32x4* o1 = (GAS f32x4*)(A.out + (m1 < MP ? O_YP + (size_t)m1 * D : O_YS + (size_t)(m1 - MP) * D)) + lane;
#pragma unroll
            for (int j = 0; j < 8; ++j) __builtin_nontemporal_store(v1[j] * g[j] * rs1, o1 + 64 * j); } }
}

#ifndef PROBE_P0
#define PROBE_P0 1
#endif
#ifndef PROBE_MA
#define PROBE_MA 1
#endif
#ifndef PROBE_MC
#define PROBE_MC 1
#endif
#ifndef PROBE_ATT
#define PROBE_ATT 1
#endif
#ifndef PROBE_BAR
#define PROBE_BAR 1
#endif
#ifndef PROBE_KV
#define PROBE_KV 1
#endif
#ifndef PROBE_RES_O
#define PROBE_RES_O 0
#endif
#ifndef PROBE_RES_DOWN
#define PROBE_RES_DOWN 0
#endif
#ifndef PROBE_THIN
#define PROBE_THIN 0
#endif
#ifndef PROBE_SG_IN
#define PROBE_SG_IN 1
#endif
#ifndef PROBE_SG_Q
#define PROBE_SG_Q 1
#endif
#ifndef PROBE_SG_UP
#define PROBE_SG_UP 1
#endif
#ifndef PROBE_UP
#define PROBE_UP 1
#endif
#ifndef PROBE_Q
#define PROBE_Q 1
#endif
constexpr int PH_PER_LAYER = 10, PH_L0 = 3, PH_FINAL = PH_L0 + NL * PH_PER_LAYER, NPHASE = PH_FINAL + 1;
__global__ void __launch_bounds__(NTHR, 2) mk_fwd(Args args) {
    extern __shared__ __attribute__((aligned(16))) unsigned char lds_raw[];
    LAS unsigned char* lds = (LAS unsigned char*)lds_raw;
    volatile LAS unsigned* MISC = (volatile LAS unsigned*)(lds + MISC_OFF);
    int tid = threadIdx.x, lane = tid & 63, wave = __builtin_amdgcn_readfirstlane(tid >> 6);
#define RETID() do { asm volatile("" : "+v"(tid)); lane = tid & 63; wave = __builtin_amdgcn_readfirstlane(tid >> 6); asm volatile("" : "+s"(ws)); } while (0)
    const int G = gridDim.x; const int bx = blockIdx.x; const int vcu = (G % 8 == 0) ? (bx % 8) * (G / 8) + bx / 8 : bx;
    unsigned char* ws = args.ws;
    for (int u = tid; u < (LDS_BYTES - LDSCTL_OFF) / 4; u += NTHR) ((LAS unsigned*)(lds + LDSCTL_OFF))[u] = 0u;
    __syncthreads();
    XcdBarrier bar; bar.bar = (unsigned*)(ws + WS_CTL) + CW_BAR; bar.x = 0; bar.st = nullptr;
    if (!MK_PER_PHASE) bar = xcd_barrier_post((unsigned*)(ws + WS_CTL) + CW_BAR, MISC + 8);
    const int lo = args.ph_lo, hi = args.ph_hi;
#ifdef ONLY_PH
#define IN(k) (((k) < PH_L0 || (k) >= PH_FINAL) ? ((k) == ONLY_PH) : (((k) - PH_L0) % PH_PER_LAYER + PH_L0 == ONLY_PH) && lo <= (k) && (k) < hi)
#else
#define IN(k) (lo <= (k) && (k) < hi)
#endif
#define GRID_BAR() do { if (!MK_PER_PHASE) { for (int rep_ = 0; rep_ < PROBE_BAR; ++rep_) xcd_barrier(bar); } } while (0)
#define SSQ(s) ((unsigned long long*)((unsigned*)(ws + WS_CTL) + CW_SSQ) + (s) * MPAD)
    if (IN(0)) { RETID(); for (int rep = 0; rep < PROBE_P0; ++rep) { p0_prologue(args, lds, vcu, G, wave, lane); __syncthreads(); } GRID_BAR(); }
    if (IN(1)) { RETID();
        pg8::Gemm g{(const bf16*)(ws + WS_MEMB), (const bf16*)(ws + WS_WKV), MROWS, 4 * D, D}; pg8::StaticOrder S; S.init(MROWS, 4 * D, G, bx);
        pg8::EpiKV E{args.out + O_PMK, (size_t)(O_PMV - O_PMK), (bf16*)(ws + WS_KB), (bf16*)(ws + WS_VT), (bf16*)(ws + WS_VB), (const float*)(ws + WS_RSTDM)};
        for (int rep = 0; rep < PROBE_KV; ++rep) pg8::gemm_phase<pg8::EpiKV, pg8::StaticOrder, true, true>(lds + RING_OFF, g, S, E, tid);
        if (G == 256 && bx >= 128) p0_weights(args, lds, (bx - 128) * NWAVES + wave, 128 * NWAVES, P0W_DEF_LO, P0W_DEF_N, 1 << 30, 0, wave, lane);
        GRID_BAR(); }
#define SETUP_LAYER(LL, GG, CC) do { const int ll_ = (LL); pg8::Gemm g{nullptr, nullptr, 1024, 2048, 512, 2048, 2048}; \
        pg8::PreOrder S{(GG), (CC), (const bf16*)(ws + WS_KB) + (size_t)ll_ * 1024 * 2048, (const bf16*)(ws + WS_WQKD) + (size_t)ll_ * 2048 * 2048, (const bf16*)(ws + WS_W + (size_t)ll_ * W_L + WO_O), (const bf16*)(ws + WS_VB) + (size_t)ll_ * 1024 * 2048}; \
        pg8::EpiPre E{(bf16*)(ws + WS_WQK) + (size_t)ll_ * 4 * 1024 * 2048, (bf16*)(ws + WS_VWT) + (size_t)ll_ * 4 * 2048 * 1024}; \
        pg8::gemm_phase<pg8::EpiPre, pg8::PreOrder, true, true>(lds + RING_OFF, g, S, E, tid); } while (0)
    if (IN(2)) { RETID();
        SETUP_LAYER(0, G, bx);
        SETUP_LAYER(1, G, bx);
        GRID_BAR(); }
#pragma unroll 1
    for (int l = 0; l < NL; ++l) {
        const int pb = PH_L0 + l * PH_PER_LAYER; const bf16* wl = (const bf16*)(ws + WS_W + (size_t)l * W_L);
#define GEMM_MAIN(EPI, Aptr, Woff, NN, KK, ...) do { pg8::Gemm g{(const bf16*)(Aptr), (const bf16*)((const unsigned char*)wl + (Woff)), MP, (NN), (KK)}; pg8::StaticOrder S; S.init(MP, (NN), G, bx); \
            EPI E{__VA_ARGS__}; pg8::gemm_phase<EPI, pg8::StaticOrder, true, true>(lds + RING_OFF, g, S, E, tid); } while (0)
        if (IN(pb + 0)) { RETID();
#ifndef NO_DT
            dt_rows(args, lds, l, vcu, G, tid); for (int rep = 0; rep < PROBE_THIN; ++rep) dt_rows(args, lds, l, vcu, G, tid);
#endif
            GEMM_MAIN(pg8::EpiScaleBf16<0>, ws + WS_HB, WO_IN, NIN, D, (bf16*)(ws + WS_PROJ), NIN, SSQ(3 * l));
            for (int rep = 0; rep < PROBE_SG_IN; ++rep)
            sample_gemm<128>(lds, (const bf16*)(ws + WS_SA + SA_HB), (const bf16*)((const unsigned char*)wl + WO_IN), NIN, D, SEpiScale{(bf16*)(ws + WS_PROJ), NIN, SSQ(3 * l), 0, 0}, (MP / 256) * (NIN / 256), 4, bx, G, tid);
            GRID_BAR(); }
        if (IN(pb + 1)) { RETID();
            for (int rep = 0; rep < PROBE_MA; ++rep)
#pragma unroll 1
            for (int u = vcu; u < 512; u += G) { if (u < 256) ma_s5_unit(args, lds, l, u >> 6, u & 63, lane, wave); else { const int v = u - 256; ma_ssd_unit(args, lds, l, v >> 6, (v >> 1) & 31, v & 1, tid, lane, wave); } }
            GRID_BAR(); }
        if (IN(pb + 2)) { RETID(); mb_scan(args, l, vcu, G, tid); for (int rep = 0; rep < PROBE_THIN; ++rep) mb_scan(args, l, vcu, G, tid, 1); GRID_BAR(); }
        if (IN(pb + 3)) { RETID();
            for (int rep = 0; rep < PROBE_MC; ++rep)
#pragma unroll 1
            for (int u = vcu; u < 512; u += G) {
#ifndef NO_MC_S5
                if (u < 256) mc_s5_unit(args, lds, l, u >> 6, u & 63, tid, lane, wave); else
#endif
#ifndef NO_MC_REST
                if (u >= 256 && u < 384) { const int v = u - 256; mc_rest_unit(args, lds, l, v >> 5, v & 31, tid, lane, wave); } else
#endif
#ifndef NO_MC_SAMPLE
                if (u >= 384) mc_sample_unit(args, lds, l, u - 384, tid, lane, wave);
#endif
                { } }
            GRID_BAR(); }
        if (IN(pb + 4)) { RETID();
            GEMM_MAIN(pg8::EpiRes, ws + WS_MIX, WO_OUT, D, D, (l == 0 ? args.in[I_XP] : (const float*)(ws + WS_H)), (float*)(ws + WS_H), (bf16*)(ws + WS_HB), SSQ(3 * l + 1), D);
            sample_gemm<32>(lds, (const bf16*)(ws + WS_SA + SA_MIX), (const bf16*)((const unsigned char*)wl + WO_OUT), D, D, SEpiRes{(l == 0 ? args.in[I_XS] : (const float*)(ws + WS_H) + (size_t)MP * D), (float*)(ws + WS_H), (bf16*)(ws + WS_HB), (bf16*)(ws + WS_SA + SA_HB), SSQ(3 * l + 1)}, (MP / 256) * (D / 256), 1, bx, G, tid);
            if (G == 256) {
                GRID_BAR();
                sample_gemm<32>(lds, (const bf16*)(ws + WS_SA + SA_HB), (const bf16*)((const unsigned char*)wl + WO_Q), D, D, SEpiScale{(bf16*)(ws + WS_Q), D, SSQ(3 * l + 1), 0, 0}, 0, 1, bx, G, tid); }
            GRID_BAR(); }
        if (IN(pb + 5)) { RETID();
            { pg8::Gemm g{(const bf16*)(ws + WS_HB), (const bf16*)(ws + WS_WQK) + (size_t)l * 4 * 1024 * 2048, MP, 1024, D}; pg8::BatchBOrder S; S.init(MP, 1024, G, bx); S.pmb = 8; S.bbs = (size_t)1024 * 2048;
                pg8::EpiSoftmax E{(bf16*)(ws + WS_PATT), 1024, SSQ(3 * l + 1), 0.044194173824159216f};
                pg8::gemm_phase<pg8::EpiSoftmax, pg8::BatchBOrder, false, true>(lds + RING_OFF, g, S, E, tid); }
            if (G == 256) { if (bx >= 128) att_sample_unit(args, lds, l, bx - 128, 0, tid, lane, wave); }
            else
            sample_gemm<32>(lds, (const bf16*)(ws + WS_SA + SA_HB), (const bf16*)((const unsigned char*)wl + WO_Q), D, D, SEpiScale{(bf16*)(ws + WS_Q), D, SSQ(3 * l + 1), 0, 0}, 128, 2, bx, G, tid);
            GRID_BAR(); }
        if (IN(pb + 6)) { RETID();
            if (bx < 128 || G != 256) { pg8::Gemm g{(const bf16*)(ws + WS_PATT), (const bf16*)(ws + WS_VWT) + (size_t)l * 4 * 2048 * 1024, MP, D, 1024}; pg8::BatchBOrder S; S.init(MP, D, G == 256 ? 128 : G, bx); S.pmb = 8; S.bbs = (size_t)2048 * 1024;
                pg8::EpiRes E{(const float*)(ws + WS_H), (float*)(ws + WS_H), (bf16*)(ws + WS_HB), SSQ(3 * l + 2), D};
                pg8::gemm_phase<pg8::EpiRes, pg8::BatchBOrder, true, true>(lds + RING_OFF, g, S, E, tid); }
            if (bx >= 128 || G != 256) {
#pragma unroll 1
                for (int i = (G == 256) ? 1 : 0; i < 2; ++i) for (int c = (G == 256 ? bx - 128 : bx); c < 128; c += (G == 256 ? 128 : G)) { const int u = c * 2 + i; att_sample_unit(args, lds, l, u >> 1, u & 1, tid, lane, wave); }
                }
            GRID_BAR(); }
        if (IN(pb + 7)) { RETID();
            sample_gemm<32>(lds, (const bf16*)(ws + WS_SA + SA_O), (const bf16*)((const unsigned char*)wl + WO_O), D, D, SEpiRes{(const float*)(ws + WS_H) + (size_t)MP * D, (float*)(ws + WS_H), (bf16*)(ws + WS_HB), (bf16*)(ws + WS_SA + SA_HB), SSQ(3 * l + 2)}, 0, 1, bx, G, tid);
            GRID_BAR(); }
        if (IN(pb + 8)) { RETID();
            for (int rep = 0; rep < PROBE_UP; ++rep)
            GEMM_MAIN(pg8::EpiScaleBf16<1>, ws + WS_HB, WO_UP, FF, D, (bf16*)(ws + WS_HID), FF, SSQ(3 * l + 2));
            for (int rep = 0; rep < PROBE_SG_UP; ++rep)
            sample_gemm<128>(lds, (const bf16*)(ws + WS_SA + SA_HB), (const bf16*)((const unsigned char*)wl + WO_UP), FF, D, SEpiScale{(bf16*)(ws + WS_SA + SA_HID), FF, SSQ(3 * l + 2), 1, 1}, (MP / 256) * (FF / 256), 1, bx, G, tid);
            GRID_BAR(); }
        if (IN(pb + 9)) { RETID();
            if (l == NL - 1 && G == 256) { pg8::Gemm g{(const bf16*)(ws + WS_HID), (const bf16*)((const unsigned char*)wl + WO_DOWN), MP, D, FF}; pg8::StaticOrder S; S.init(MP, D, G, bx);
                pg8::EpiResFinalF E{(const float*)(ws + WS_H), args.out + O_YP, args.in[I_G_FINAL], SSQ(3 * l + 3), (unsigned*)(ws + WS_CTL) + CW_FCNT, D};
                pg8::gemm_phase<pg8::EpiResFinalF, pg8::StaticOrder, false, true>(lds + RING_OFF, g, S, E, tid); }
            else
            GEMM_MAIN(pg8::EpiRes, ws + WS_HID, WO_DOWN, D, FF, (const float*)(ws + WS_H), (float*)(ws + WS_H), (bf16*)(ws + WS_HB), SSQ(3 * l + 3), D);
            sample_gemm<32>(lds, (const bf16*)(ws + WS_SA + SA_HID), (const bf16*)((const unsigned char*)wl + WO_DOWN), D, FF, SEpiRes{(const float*)(ws + WS_H) + (size_t)MP * D, (float*)(ws + WS_H), (bf16*)(ws + WS_HB), (bf16*)(ws + WS_SA + SA_HB), SSQ(3 * l + 3)}, (MP / 256) * (D / 256), 1, bx, G, tid);
            GRID_BAR(); }
#undef GEMM_MAIN
    }
    if (IN(PH_FINAL)) { final_norm(args, vcu, G, wave, lane, G == 256 ? MP : 0); }
#undef IN
#undef GRID_BAR
#undef SSQ
}

extern "C" void kernel_launch(void* const* d_in, const int* in_sizes, int n_in, void* d_out, int out_size, void* d_ws, size_t ws_size, hipStream_t stream) {
    static int grid = 0;
    if (grid == 0) {
        if (n_in != N_IN || in_sizes[0] != MP * D || (size_t)out_size != O_END || ws_size < WS_END) { fprintf(stderr, "kernel_launch: unexpected problem (n_in %d, in0 %d, out %d, ws %zu); nothing launched\n", n_in, n_in > 0 ? in_sizes[0] : -1, out_size, ws_size); grid = -1; return; }
        int dev = 0, cus = 0, per_cu = 0;
        if (hipGetDevice(&dev) != hipSuccess || hipDeviceGetAttribute(&cus, hipDeviceAttributeMultiprocessorCount, dev) != hipSuccess) { fprintf(stderr, "kernel_launch: device query failed\n"); grid = -1; return; }
        if (hipFuncSetAttribute((const void*)mk_fwd, hipFuncAttributeMaxDynamicSharedMemorySize, LDS_BYTES) != hipSuccess) { fprintf(stderr, "kernel_launch: hipFuncSetAttribute failed\n"); grid = -1; return; }
        if (hipOccupancyMaxActiveBlocksPerMultiprocessor(&per_cu, (const void*)mk_fwd, NTHR, LDS_BYTES) != hipSuccess || per_cu < 1) fprintf(stderr, "kernel_launch: note: occupancy query reports %d workgroups per CU\n", per_cu);
        (void)hipGetLastError();
        grid = cus;
    }
    if (grid < 0) return;
    if (hipMemsetAsync((char*)d_ws + WS_CTL, 0, CTL_ZERO_BYTES, stream) != hipSuccess) { fprintf(stderr, "kernel_launch: hipMemsetAsync failed\n"); return; }
    Args a{};
    for (int i = 0; i < N_IN; ++i) a.in[i] = (const float*)d_in[i];
    a.out = (float*)d_out; a.ws = (unsigned char*)d_ws;
#if MK_PER_PHASE
    for (int p = 0; p < NPHASE; ++p) { a.ph_lo = p; a.ph_hi = p + 1; hipLaunchKernelGGL(mk_fwd, dim3(grid), dim3(NTHR), LDS_BYTES, stream, a); }
#else
    a.ph_lo = 0; a.ph_hi = NPHASE; hipLaunchKernelGGL(mk_fwd, dim3(grid), dim3(NTHR), LDS_BYTES, stream, a);
#endif
    const hipError_t le = hipPeekAtLastError();
    if (le != hipSuccess) fprintf(stderr, "kernel_launch: launch failed: %s\n", hipGetErrorName(le));
}
```

```cpp
#include <hip/hip_runtime.h>
#include <cstdio>
#include <cstdint>
namespace pg8 {
#define PG8_LAS __attribute__((address_space(3)))
typedef unsigned short bf16_t;
typedef short bf16x8 __attribute__((ext_vector_type(8)));
typedef float f32x4 __attribute__((ext_vector_type(4)));
typedef unsigned u32x4 __attribute__((ext_vector_type(4)));
constexpr int BM = 256, BK = 64, HALF = 128, HTB = HALF * BK * 2  , STAGE_BYTES = 8 * HTB, NXCD = 8, WGM = 8;

__host__ __device__ __forceinline__ int lds_byte(int r, int c) { const int st = (r >> 4) * 2 + (c >> 5), rr = r & 15, cc = c & 31, ob = rr * 64 + cc * 2; return st * 1024 + (ob ^ (((ob >> 9) & 1) << 5)); }
__host__ __device__ __forceinline__ void stage_rc(int b, int& R, int& C) { const int st = b / 1024, sb = b % 1024, swz = sb ^ (((sb >> 9) & 1) << 5); R = (st >> 1) * 16 + swz / 64; C = (st & 1) * 32 + (swz % 64) / 2; }
__host__ __device__ __forceinline__ int perm32(int rho) { const int n = rho >> 4, i = rho & 15; return 8 * (i >> 2) + 4 * n + (i & 3); }

struct Unit { int pm, pn, z; };
struct Gemm { const bf16_t* A; const bf16_t* Bt; int M, N, K; int lda = 0, ldb = 0; };

struct StaticOrder {
    int nM, nN, nwg, G, c;
    __host__ __device__ void init(int M, int N, int G_, int c_) { nM = M / BM; nN = N / BM; nwg = nM * nN; G = G_; c = c_; }
    __host__ __device__ bool next(int i, Unit& u) const {
        const long L = (long)i * G + c; if (L >= nwg) return false;
        int wgid = (int)L; { const int q = nwg / NXCD, r = nwg % NXCD, xcd = wgid % NXCD, off = wgid / NXCD; wgid = (xcd < r ? xcd * (q + 1) : r * (q + 1) + (xcd - r) * q) + off; }
        const int nig = WGM * nN, gid = wgid / nig, fm = gid * WGM, gsz = (nM - fm) < WGM ? (nM - fm) : WGM;
        u.pm = fm + ((wgid % nig) % gsz); u.pn = (wgid % nig) / gsz; u.z = 0; return true;
    }
    __device__ __forceinline__ void a_ready(const Unit&) const {}
    __device__ __forceinline__ void done(const Unit&) const {}
    __device__ __forceinline__ const char* abase(const Gemm& g, const Unit& u) const { return (const char*)g.A + (size_t)u.pm * 256 * (size_t)(g.lda ? g.lda : g.K) * 2; }
    __device__ __forceinline__ const char* bbase(const Gemm& g, const Unit& u) const { return (const char*)g.Bt + (size_t)u.pn * 256 * (size_t)(g.ldb ? g.ldb : g.K) * 2; }
};


struct PreOrder {
    int G, c; const bf16_t* a0; const bf16_t* b0; const bf16_t* a1; const bf16_t* b1;
    __device__ __forceinline__ bool next(int i, Unit& u) const { const long L = (long)i * G + c; if (L >= 256) return false; const int mode = (int)(L >> 7), head = (int)((L & 127) >> 5), x = (int)((L & 31) >> 3), y = (int)(L & 7);
        u.z = mode * 4 + head; u.pm = mode ? y : x; u.pn = mode ? x : y; return true; }
    __device__ __forceinline__ void a_ready(const Unit&) const {}
    __device__ __forceinline__ void done(const Unit&) const {}
    __device__ __forceinline__ const char* abase(const Gemm&, const Unit& u) const { return (const char*)((u.z >> 2) ? a1 : a0) + ((size_t)u.pm * 256 * 2048 + (size_t)(u.z & 3) * 512) * 2; }
    __device__ __forceinline__ const char* bbase(const Gemm&, const Unit& u) const { return (const char*)((u.z >> 2) ? b1 : b0) + ((size_t)u.pn * 256 * 2048 + (size_t)(u.z & 3) * 512) * 2; }
};
typedef float cvt_f32x2 __attribute__((ext_vector_type(2)));
typedef __bf16 cvt_bf16x2 __attribute__((ext_vector_type(2)));
__device__ __forceinline__ unsigned cvt_pk_bf16(float lo, float hi) { const cvt_f32x2 v = {lo, hi}; return __builtin_bit_cast(unsigned, __builtin_convertvector(v, cvt_bf16x2)); }

__device__ __forceinline__ void ssq_add(unsigned long long* p, float v) { (void)__hip_atomic_fetch_add(p, (unsigned long long)__float2ull_rn(v * 16777216.0f), __ATOMIC_RELAXED, __HIP_MEMORY_SCOPE_AGENT); }
__device__ __forceinline__ float ssq_rstd(unsigned long long v) { return __builtin_amdgcn_rsqf((float)v * (1.0f / (16777216.0f * 2048.0f)) + 1e-6f); }
template <int ACT> struct EpiScaleBf16 {
    static constexpr bool PERM = true, AFTER_DRAIN = false;
    bf16_t* O; int ldc; const unsigned long long* ssq;
    __device__ __forceinline__ void operator()(const f32x4 (&acc)[2][2][4][2], const Unit& u, int wr, int wc, int fr, int fq) const {
        const int row0 = u.pm * BM + wr * 64 + fr, col0 = u.pn * BM + wc * 32 + 8 * fq;
        unsigned long long sv[2][4];
#pragma unroll
        for (int ai = 0; ai < 2; ++ai)
#pragma unroll
            for (int m = 0; m < 4; ++m) sv[ai][m] = ssq[row0 + ai * HALF + m * 16];
#pragma unroll
        for (int ai = 0; ai < 2; ++ai)
#pragma unroll
            for (int m = 0; m < 4; ++m) asm volatile("" : "+v"(sv[ai][m]));
#pragma unroll
        for (int ai = 0; ai < 2; ++ai)
#pragma unroll
            for (int m = 0; m < 4; ++m) { const int row = row0 + ai * HALF + m * 16; const float rs = ssq_rstd(sv[ai][m]);
                bf16_t* rowp = O + (size_t)row * ldc + col0;
#pragma unroll
                for (int bj = 0; bj < 2; ++bj) { f32x4 v0 = acc[ai][bj][m][0] * rs, v1 = acc[ai][bj][m][1] * rs;
                    if (ACT == 1) {
#pragma unroll
                        for (int e = 0; e < 4; ++e) { const float a0 = v0[e] > 0.f ? v0[e] : 0.f, a1 = v1[e] > 0.f ? v1[e] : 0.f; v0[e] = a0 * a0; v1[e] = a1 * a1; } }
                    u32x4 w; w.x = cvt_pk_bf16(v0[0], v0[1]); w.y = cvt_pk_bf16(v0[2], v0[3]); w.z = cvt_pk_bf16(v1[0], v1[1]); w.w = cvt_pk_bf16(v1[2], v1[3]);
                    *(u32x4*)(rowp + bj * HALF) = w; } }
    }
};
struct EpiRes {
    static constexpr bool PERM = true, AFTER_DRAIN = false;
    const float* hin; float* h; bf16_t* hb; unsigned long long* ssq_out; int ldc;
    __device__ __forceinline__ void operator()(const f32x4 (&acc)[2][2][4][2], const Unit& u, int wr, int wc, int fr, int fq) const {
        const int row0 = u.pm * BM + wr * 64 + fr, col0 = u.pn * BM + wc * 32 + 8 * fq;
#pragma unroll
        for (int ai = 0; ai < 2; ++ai) {
            f32x4 hv[4][2][2];
#pragma unroll
            for (int m = 0; m < 4; ++m) { const float* hp = hin + (size_t)(row0 + ai * HALF + m * 16) * ldc + col0;
#pragma unroll
                for (int bj = 0; bj < 2; ++bj) { hv[m][bj][0] = *(const f32x4*)(hp + bj * HALF); hv[m][bj][1] = *(const f32x4*)(hp + bj * HALF + 4); } }
#pragma unroll
            for (int m = 0; m < 4; ++m)
#pragma unroll
                for (int bj = 0; bj < 2; ++bj) { asm volatile("" : "+v"(hv[m][bj][0])); asm volatile("" : "+v"(hv[m][bj][1])); }
#pragma unroll
            for (int m = 0; m < 4; ++m) { const int row = row0 + ai * HALF + m * 16; float sq = 0.f;
                float* hp = h + (size_t)row * ldc + col0; bf16_t* bp = hb + (size_t)row * ldc + col0;
#pragma unroll
                for (int bj = 0; bj < 2; ++bj) { f32x4 v0 = hv[m][bj][0] + acc[ai][bj][m][0], v1 = hv[m][bj][1] + acc[ai][bj][m][1];
                    *(f32x4*)(hp + bj * HALF) = v0; *(f32x4*)(hp + bj * HALF + 4) = v1;
                    sq += (v0[0] * v0[0] + v0[1] * v0[1]) + (v0[2] * v0[2] + v0[3] * v0[3]) + (v1[0] * v1[0] + v1[1] * v1[1]) + (v1[2] * v1[2] + v1[3] * v1[3]);
                    u32x4 w; w.x = cvt_pk_bf16(v0[0], v0[1]); w.y = cvt_pk_bf16(v0[2], v0[3]); w.z = cvt_pk_bf16(v1[0], v1[1]); w.w = cvt_pk_bf16(v1[2], v1[3]);
                    *(u32x4*)(bp + bj * HALF) = w; }
                sq += __shfl_xor(sq, 16); sq += __shfl_xor(sq, 32);
                if (fq == 0) ssq_add(ssq_out + row, sq); } }
    }
};
struct EpiResB {
    static constexpr bool PERM = true, AFTER_DRAIN = false;
    bf16_t* hb; unsigned long long* ssq_out; int ldc; const float* xin;
    __device__ __forceinline__ void operator()(const f32x4 (&acc)[2][2][4][2], const Unit& u, int wr, int wc, int fr, int fq) const {
        const int row0 = u.pm * BM + wr * 64 + fr, col0 = u.pn * BM + wc * 32 + 8 * fq;
        if (xin) {
#pragma unroll
            for (int ai = 0; ai < 2; ++ai) {
                f32x4 xv[4][2][2];
#pragma unroll
                for (int m = 0; m < 4; ++m) { const float* hp = xin + (size_t)(row0 + ai * HALF + m * 16) * ldc + col0;
#pragma unroll
                    for (int bj = 0; bj < 2; ++bj) { xv[m][bj][0] = *(const f32x4*)(hp + bj * HALF); xv[m][bj][1] = *(const f32x4*)(hp + bj * HALF + 4); } }
#pragma unroll
                for (int m = 0; m < 4; ++m)
#pragma unroll
                    for (int bj = 0; bj < 2; ++bj) { asm volatile("" : "+v"(xv[m][bj][0])); asm volatile("" : "+v"(xv[m][bj][1])); }
#pragma unroll
                for (int m = 0; m < 4; ++m) { const int row = row0 + ai * HALF + m * 16; float sq = 0.f; bf16_t* bp = hb + (size_t)row * ldc + col0;
#pragma unroll
                    for (int bj = 0; bj < 2; ++bj) { const f32x4 v0 = xv[m][bj][0] + acc[ai][bj][m][0], v1 = xv[m][bj][1] + acc[ai][bj][m][1];
                        sq += (v0[0] * v0[0] + v0[1] * v0[1]) + (v0[2] * v0[2] + v0[3] * v0[3]) + (v1[0] * v1[0] + v1[1] * v1[1]) + (v1[2] * v1[2] + v1[3] * v1[3]);
                        u32x4 w; w.x = cvt_pk_bf16(v0[0], v0[1]); w.y = cvt_pk_bf16(v0[2], v0[3]); w.z = cvt_pk_bf16(v1[0], v1[1]); w.w = cvt_pk_bf16(v1[2], v1[3]);
                        *(u32x4*)(bp + bj * HALF) = w; }
                    sq += __shfl_xor(sq, 16); sq += __shfl_xor(sq, 32);
                    if (fq == 0) ssq_add(ssq_out + row, sq); } }
            return; }
        u32x4 hv[2][4][2];
#pragma unroll
        for (int ai = 0; ai < 2; ++ai)
#pragma unroll
            for (int m = 0; m < 4; ++m) { const bf16_t* bp = hb + (size_t)(row0 + ai * HALF + m * 16) * ldc + col0;
#pragma unroll
                for (int bj = 0; bj < 2; ++bj) hv[ai][m][bj] = *(const u32x4*)(bp + bj * HALF); }
#pragma unroll
        for (int ai = 0; ai < 2; ++ai)
#pragma unroll
            for (int m = 0; m < 4; ++m) { asm volatile("" : "+v"(hv[ai][m][0])); asm volatile("" : "+v"(hv[ai][m][1])); }
#pragma unroll
        for (int ai = 0; ai < 2; ++ai)
#pragma unroll
            for (int m = 0; m < 4; ++m) { const int row = row0 + ai * HALF + m * 16; float sq = 0.f; bf16_t* bp = hb + (size_t)row * ldc + col0;
#pragma unroll
                for (int bj = 0; bj < 2; ++bj) { const u32x4 w0 = hv[ai][m][bj];
                    const f32x4 v0 = (f32x4){__uint_as_float(w0.x << 16), __uint_as_float(w0.x & 0xffff0000u), __uint_as_float(w0.y << 16), __uint_as_float(w0.y & 0xffff0000u)} + acc[ai][bj][m][0];
                    const f32x4 v1 = (f32x4){__uint_as_float(w0.z << 16), __uint_as_float(w0.z & 0xffff0000u), __uint_as_float(w0.w << 16), __uint_as_float(w0.w & 0xffff0000u)} + acc[ai][bj][m][1];
                    sq += (v0[0] * v0[0] + v0[1] * v0[1]) + (v0[2] * v0[2] + v0[3] * v0[3]) + (v1[0] * v1[0] + v1[1] * v1[1]) + (v1[2] * v1[2] + v1[3] * v1[3]);
                    u32x4 w; w.x = cvt_pk_bf16(v0[0], v0[1]); w.y = cvt_pk_bf16(v0[2], v0[3]); w.z = cvt_pk_bf16(v1[0], v1[1]); w.w = cvt_pk_bf16(v1[2], v1[3]);
                    *(u32x4*)(bp + bj * HALF) = w; }
                sq += __shfl_xor(sq, 16); sq += __shfl_xor(sq, 32);
                if (fq == 0) ssq_add(ssq_out + row, sq); }
    }
};
struct EpiResFinal {
    static constexpr bool PERM = true, AFTER_DRAIN = true;
    const bf16_t* hin; float* y; const float* gfin; unsigned long long* ssq_out; unsigned* cnt; int ldc;
    __device__ __forceinline__ void operator()(const f32x4 (&)[2][2][4][2], const Unit&, int, int, int, int) const {}
    __device__ __forceinline__ void fused(f32x4 (&acc)[2][2][4][2], const Unit& u, int wr, int wc, int fr, int fq, PG8_LAS unsigned char*, int wid, int lane) const {
        const int row0 = u.pm * BM + wr * 64 + fr, col0 = u.pn * BM + wc * 32 + 8 * fq;
#pragma unroll
        for (int ai = 0; ai < 2; ++ai) {
            u32x4 hv[4][2];
#pragma unroll
            for (int m = 0; m < 4; ++m) { const bf16_t* hp = hin + (size_t)(row0 + ai * HALF + m * 16) * ldc + col0;
#pragma unroll
                for (int bj = 0; bj < 2; ++bj) hv[m][bj] = *(const u32x4*)(hp + bj * HALF); }
#pragma unroll
            for (int m = 0; m < 4; ++m) { asm volatile("" : "+v"(hv[m][0])); asm volatile("" : "+v"(hv[m][1])); }
#pragma unroll
            for (int m = 0; m < 4; ++m) { const int row = row0 + ai * HALF + m * 16; float sq = 0.f;
#pragma unroll
                for (int bj = 0; bj < 2; ++bj) { const u32x4 w0 = hv[m][bj];
                    const f32x4 v0 = (f32x4){__uint_as_float(w0.x << 16), __uint_as_float(w0.x & 0xffff0000u), __uint_as_float(w0.y << 16), __uint_as_float(w0.y & 0xffff0000u)} + acc[ai][bj][m][0];
                    const f32x4 v1 = (f32x4){__uint_as_float(w0.z << 16), __uint_as_float(w0.z & 0xffff0000u), __uint_as_float(w0.w << 16), __uint_as_float(w0.w & 0xffff0000u)} + acc[ai][bj][m][1];
                    acc[ai][bj][m][0] = v0; acc[ai][bj][m][1] = v1;
                    sq += (v0[0] * v0[0] + v0[1] * v0[1]) + (v0[2] * v0[2] + v0[3] * v0[3]) + (v1[0] * v1[0] + v1[1] * v1[1]) + (v1[2] * v1[2] + v1[3] * v1[3]); }
                sq += __shfl_xor(sq, 16); sq += __shfl_xor(sq, 32);
                if (fq == 0) ssq_add(ssq_out + row, sq); } }
        asm volatile("s_waitcnt vmcnt(0)" ::: "memory");
        __builtin_amdgcn_s_barrier(); asm volatile("" ::: "memory");
        if (wid == 0 && lane == 0) { unsigned* c = cnt + u.pm * 64;
            (void)__hip_atomic_fetch_add(c, 1u, __ATOMIC_RELAXED, __HIP_MEMORY_SCOPE_AGENT);
            unsigned sp = 0; while (__hip_atomic_load(c, __ATOMIC_RELAXED, __HIP_MEMORY_SCOPE_AGENT) < 8u) { __builtin_amdgcn_s_sleep(1); if (++sp > (1u << 22)) break; } }
        __builtin_amdgcn_s_barrier(); asm volatile("" ::: "memory");
        unsigned long long sv[2][4];
#pragma unroll
        for (int ai = 0; ai < 2; ++ai)
#pragma unroll
            for (int m = 0; m < 4; ++m) sv[ai][m] = __hip_atomic_load(ssq_out + row0 + ai * HALF + m * 16, __ATOMIC_RELAXED, __HIP_MEMORY_SCOPE_AGENT);
        f32x4 gv[2][2];
#pragma unroll
        for (int bj = 0; bj < 2; ++bj) { gv[bj][0] = *(const f32x4*)(gfin + col0 + bj * HALF); gv[bj][1] = *(const f32x4*)(gfin + col0 + bj * HALF + 4); }
#pragma unroll
        for (int ai = 0; ai < 2; ++ai)
#pragma unroll
            for (int m = 0; m < 4; ++m) asm volatile("" : "+v"(sv[ai][m]));
#pragma unroll
        for (int ai = 0; ai < 2; ++ai)
#pragma unroll
            for (int m = 0; m < 4; ++m) { const float rs = ssq_rstd(sv[ai][m]); float* yp = y + (size_t)(row0 + ai * HALF + m * 16) * ldc + col0;
#pragma unroll
                for (int bj = 0; bj < 2; ++bj) { *(f32x4*)(yp + bj * HALF) = acc[ai][bj][m][0] * gv[bj][0] * rs; *(f32x4*)(yp + bj * HALF + 4) = acc[ai][bj][m][1] * gv[bj][1] * rs; } }
    }
};
struct BatchBOrder : StaticOrder {
    int pmb; size_t bbs;
    __device__ __forceinline__ const char* bbase(const Gemm& g, const Unit& u) const { return (const char*)g.Bt + ((size_t)(u.pm / pmb) * bbs + (size_t)u.pn * 256 * (size_t)(g.ldb ? g.ldb : g.K)) * 2; }
};
struct EpiSoftmax {
    static constexpr bool PERM = true, AFTER_DRAIN = true;
    bf16_t* P; int ldc; const unsigned long long* ssq; float scale;
    __device__ __forceinline__ void operator()(const f32x4 (&)[2][2][4][2], const Unit&, int, int, int, int) const {}
    __device__ __forceinline__ void fused(f32x4 (&acc)[2][2][4][2], const Unit& u, int wr, int wc, int fr, int fq, PG8_LAS unsigned char* lds, int wid, int lane) const {
        PG8_LAS float* RM = (PG8_LAS float*)lds; PG8_LAS float* RS = (PG8_LAS float*)(lds + 4096);
        const int r0 = wr * 64 + fr, row0 = u.pm * BM + r0, col0 = u.pn * BM + wc * 32 + 8 * fq;
        unsigned long long sv[2][4];
#pragma unroll
        for (int ai = 0; ai < 2; ++ai)
#pragma unroll
            for (int m = 0; m < 4; ++m) sv[ai][m] = ssq[row0 + ai * HALF + m * 16];
#pragma unroll
        for (int ai = 0; ai < 2; ++ai)
#pragma unroll
            for (int m = 0; m < 4; ++m) asm volatile("" : "+v"(sv[ai][m]));
#pragma unroll
        for (int ai = 0; ai < 2; ++ai)
#pragma unroll
            for (int m = 0; m < 4; ++m) { const float sc = ssq_rstd(sv[ai][m]) * scale; float mx = -3.0e38f;
#pragma unroll
                for (int bj = 0; bj < 2; ++bj)
#pragma unroll
                    for (int n = 0; n < 2; ++n) { f32x4 v = acc[ai][bj][m][n] * sc; acc[ai][bj][m][n] = v; mx = fmaxf(fmaxf(mx, fmaxf(v[0], v[1])), fmaxf(v[2], v[3])); }
                mx = fmaxf(mx, __shfl_xor(mx, 16)); mx = fmaxf(mx, __shfl_xor(mx, 32));
                if (fq == 0) RM[(r0 + ai * HALF + m * 16) * 4 + wc] = mx; }
        asm volatile("s_waitcnt lgkmcnt(0)" ::: "memory"); __builtin_amdgcn_s_barrier(); asm volatile("" ::: "memory");
#pragma unroll
        for (int ai = 0; ai < 2; ++ai)
#pragma unroll
            for (int m = 0; m < 4; ++m) { const f32x4 q = *(const PG8_LAS f32x4*)(RM + (r0 + ai * HALF + m * 16) * 4); const float mx = fmaxf(fmaxf(q[0], q[1]), fmaxf(q[2], q[3])); float sm = 0.f;
#pragma unroll
                for (int bj = 0; bj < 2; ++bj)
#pragma unroll
                    for (int n = 0; n < 2; ++n) { f32x4 v = acc[ai][bj][m][n];
#pragma unroll
                        for (int e = 0; e < 4; ++e) { v[e] = __expf(v[e] - mx); sm += v[e]; }
                        acc[ai][bj][m][n] = v; }
                sm += __shfl_xor(sm, 16); sm += __shfl_xor(sm, 32);
                if (fq == 0) RS[(r0 + ai * HALF + m * 16) * 4 + wc] = sm; }
        asm volatile("s_waitcnt lgkmcnt(0)" ::: "memory"); __builtin_amdgcn_s_barrier(); asm volatile("" ::: "memory");
#pragma unroll
        for (int ai = 0; ai < 2; ++ai)
#pragma unroll
            for (int m = 0; m < 4; ++m) { const f32x4 q = *(const PG8_LAS f32x4*)(RS + (r0 + ai * HALF + m * 16) * 4); const float inv = __builtin_amdgcn_rcpf((q[0] + q[1]) + (q[2] + q[3]));
                bf16_t* rowp = P + (size_t)(row0 + ai * HALF + m * 16) * ldc + col0;
#pragma unroll
                for (int bj = 0; bj < 2; ++bj) { const f32x4 v0 = acc[ai][bj][m][0] * inv, v1 = acc[ai][bj][m][1] * inv;
                    u32x4 w; w.x = cvt_pk_bf16(v0[0], v0[1]); w.y = cvt_pk_bf16(v0[2], v0[3]); w.z = cvt_pk_bf16(v1[0], v1[1]); w.w = cvt_pk_bf16(v1[2], v1[3]);
                    *(u32x4*)(rowp + bj * HALF) = w; } }
    }
};
struct EpiPre {
    static constexpr bool PERM = true, AFTER_DRAIN = false;
    bf16_t* wqk; bf16_t* vwt;
    __device__ __forceinline__ void operator()(const f32x4 (&acc)[2][2][4][2], const Unit& u, int wr, int wc, int fr, int fq) const {
        const int mode = u.z >> 2, head = u.z & 3, r0 = wr * 64 + fr, c0 = wc * 32 + 8 * fq;
#pragma unroll
        for (int ai = 0; ai < 2; ++ai)
#pragma unroll
            for (int m = 0; m < 4; ++m) { const int r = r0 + ai * HALF + m * 16;
#pragma unroll
                for (int bj = 0; bj < 2; ++bj) { const int c = c0 + bj * HALF; const f32x4 v0 = acc[ai][bj][m][0], v1 = acc[ai][bj][m][1];
                    u32x4 w; w.x = cvt_pk_bf16(v0[0], v0[1]); w.y = cvt_pk_bf16(v0[2], v0[3]); w.z = cvt_pk_bf16(v1[0], v1[1]); w.w = cvt_pk_bf16(v1[2], v1[3]);
                    const size_t off = mode == 0 ? (((size_t)u.pm * 1024 + head * 256 + r) * 2048 + u.pn * 256 + c) : (((size_t)u.pn * 2048 + u.pm * 256 + r) * 1024 + head * 256 + c);
                    *(u32x4*)((mode == 0 ? wqk : vwt) + off) = w; } }
    }
};
struct EpiKV {
    static constexpr bool PERM = true, AFTER_DRAIN = false;
    float* outk; size_t voff; bf16_t* kb; bf16_t* vt; bf16_t* vb; const float* rstd;
    __device__ __forceinline__ void operator()(const f32x4 (&acc)[2][2][4][2], const Unit& u, int wr, int wc, int fr, int fq) const {
        const int row0 = u.pm * BM + wr * 64 + fr; const int colt = u.pn * BM, which = colt >> 11, l = which >> 1, isv = which & 1;
        const int col0 = (colt & 2047) + wc * 32 + 8 * fq;
        float sv[2][4];
#pragma unroll
        for (int ai = 0; ai < 2; ++ai)
#pragma unroll
            for (int m = 0; m < 4; ++m) sv[ai][m] = rstd[row0 + ai * HALF + m * 16];
#pragma unroll
        for (int ai = 0; ai < 2; ++ai)
#pragma unroll
            for (int m = 0; m < 4; ++m) asm volatile("" : "+v"(sv[ai][m]));
#pragma unroll
        for (int ai = 0; ai < 2; ++ai)
#pragma unroll
            for (int m = 0; m < 4; ++m) { const int row = row0 + ai * HALF + m * 16; const float rs = sv[ai][m];
#pragma unroll
                for (int bj = 0; bj < 2; ++bj) { const f32x4 v0 = acc[ai][bj][m][0] * rs, v1 = acc[ai][bj][m][1] * rs; const int col = col0 + bj * HALF;
                    float* op = outk + (isv ? voff : (size_t)0) + ((size_t)l * 1024 + row) * 2048 + col;
                    *(f32x4*)op = v0; *(f32x4*)(op + 4) = v1;
                    if (!isv) { u32x4 w; w.x = cvt_pk_bf16(v0[0], v0[1]); w.y = cvt_pk_bf16(v0[2], v0[3]); w.z = cvt_pk_bf16(v1[0], v1[1]); w.w = cvt_pk_bf16(v1[2], v1[3]);
                        *(u32x4*)(kb + ((size_t)l * 1024 + row) * 2048 + col) = w; }
                    else { { u32x4 w; w.x = cvt_pk_bf16(v0[0], v0[1]); w.y = cvt_pk_bf16(v0[2], v0[3]); w.z = cvt_pk_bf16(v1[0], v1[1]); w.w = cvt_pk_bf16(v1[2], v1[3]); *(u32x4*)(vb + ((size_t)l * 1024 + row) * 2048 + col) = w; }
                    } } }
    }
};
template <class Epi, class Sched, bool ALIGN_EPI = false, bool SP2 = false>
__device__ __forceinline__ void gemm_phase(PG8_LAS unsigned char* lds, const Gemm g, const Sched& S, const Epi& E, int tid) {
    asm volatile("" : "+v"(tid));
    const int wid = __builtin_amdgcn_readfirstlane(tid >> 6), lane = tid & 63, wr = wid >> 2, wc = wid & 3, fr = lane & 15, fq = lane >> 4;
    const int K = g.K, nt = K / BK, lda = g.lda ? g.lda : K, ldb = g.ldb ? g.ldb : K;
    unsigned voffA[2], voffB[2];
#pragma unroll
    for (int i = 0; i < 2; ++i) { int R, C; stage_rc(tid * 16 + i * 8192, R, C); const int Rb = Epi::PERM ? ((R & ~31) + perm32(R & 31)) : R;
        voffA[i] = (unsigned)(R * lda + C) * 2u; voffB[i] = (unsigned)(Rb * ldb + C) * 2u; }
    const size_t kstep = (size_t)(BK * 2);
    const size_t hstepA = (size_t)HALF * lda * 2, hstepB = (size_t)HALF * ldb * 2;
    const unsigned ldsw = (unsigned)wid * 1024u;
    const int aoff = lds_byte(wr * 64 + fr, fq * 8), boff = lds_byte(wc * 32 + fr, fq * 8);
#define PG8_SA(b, h) (((b) * 2 + (h)) * HTB)
#define PG8_SB(b, h) ((4 + (b) * 2 + (h)) * HTB)
#define PG8_STAGE(bufoff, gbase, voff) do { _Pragma("unroll") for (int _i = 0; _i < 2; ++_i) \
        __builtin_amdgcn_global_load_lds((const unsigned*)((const char*)(gbase) + (voff)[_i]), (PG8_LAS unsigned*)(lds + (bufoff) + ldsw + _i * 8192), 16, 0, 0); } while (0)
#define PG8_LDA(dst, b, h) do { _Pragma("unroll") for (int m = 0; m < 4; ++m) _Pragma("unroll") for (int k = 0; k < 2; ++k) dst[m][k] = *(const PG8_LAS bf16x8*)(lds + PG8_SA(b, h) + aoff + m * 2048 + k * 1024); } while (0)
#define PG8_LDB(dst, b, h) do { _Pragma("unroll") for (int n = 0; n < 2; ++n) _Pragma("unroll") for (int k = 0; k < 2; ++k) dst[n][k] = *(const PG8_LAS bf16x8*)(lds + PG8_SB(b, h) + boff + n * 2048 + k * 1024); } while (0)
#define PG8_MMA(ai, bj, At, Bt) do { __builtin_amdgcn_s_setprio(1); _Pragma("unroll") for (int m = 0; m < 4; ++m) _Pragma("unroll") for (int n = 0; n < 2; ++n) _Pragma("unroll") for (int k = 0; k < 2; ++k) \
        acc[ai][bj][m][n] = __builtin_amdgcn_mfma_f32_16x16x32_bf16(Bt[n][k], At[m][k], acc[ai][bj][m][n], 0, 0, 0); __builtin_amdgcn_s_setprio(0); } while (0)
#define PG8_WAIT_V(n) asm volatile("s_waitcnt vmcnt(" #n ")" ::: "memory")
#define PG8_WAIT_L(n) asm volatile("s_waitcnt lgkmcnt(" #n ")" ::: "memory")
#define PG8_BAR __builtin_amdgcn_s_barrier()
#define PG8_SCHED __builtin_amdgcn_sched_barrier(0)
    Unit cur, nxt; int ui = 0;
    if (!S.next(0, cur)) return;
    f32x4 acc[2][2][4][2];
#pragma unroll
    for (int a = 0; a < 2; ++a)
#pragma unroll
        for (int b = 0; b < 2; ++b)
#pragma unroll
            for (int m = 0; m < 4; ++m)
#pragma unroll
                for (int n = 0; n < 2; ++n) acc[a][b][m][n] = (f32x4){0.f, 0.f, 0.f, 0.f};
    bf16x8 At[4][2], B0[2][2], B1[2][2];
    const char* cA = S.abase(g, cur); const char* cB = S.bbase(g, cur);
    S.a_ready(cur);
    if constexpr (SP2) {
        PG8_STAGE(PG8_SB(0, 0), cB, voffB); PG8_STAGE(PG8_SB(0, 1), cB + hstepB, voffB); PG8_STAGE(PG8_SA(0, 0), cA, voffA); PG8_STAGE(PG8_SA(0, 1), cA + hstepA, voffA);
        if (wr == 1) PG8_BAR;
        PG8_WAIT_V(2); PG8_BAR;
        PG8_STAGE(PG8_SB(1, 0), cB + kstep, voffB); PG8_STAGE(PG8_SA(1, 0), cA + kstep, voffA); PG8_STAGE(PG8_SB(1, 1), cB + hstepB + kstep, voffB);
        PG8_WAIT_V(6); PG8_BAR;
    } else {
        PG8_STAGE(PG8_SB(0, 0), cB, voffB); PG8_STAGE(PG8_SA(0, 0), cA, voffA); PG8_STAGE(PG8_SB(0, 1), cB + hstepB, voffB); PG8_STAGE(PG8_SA(0, 1), cA + hstepA, voffA);
        if (wr == 1) PG8_BAR;
        PG8_WAIT_V(4); PG8_BAR;
        PG8_STAGE(PG8_SB(1, 0), cB + kstep, voffB); PG8_STAGE(PG8_SA(1, 0), cA + kstep, voffA); PG8_STAGE(PG8_SB(1, 1), cB + hstepB + kstep, voffB);
        PG8_WAIT_V(6); PG8_BAR;
    }
    for (;;) {
        const bool has_next = S.next(ui + 1, nxt);
        const char* nA = has_next ? S.abase(g, nxt) : cA; const char* nB = has_next ? S.bbase(g, nxt) : cB;
        for (int t = 0; t < nt; t += 2) {
            const bool last = (t == nt - 2);
            const char* a1 = cA + (size_t)(t + 1) * kstep;
            const char* a2 = last ? nA : cA + (size_t)(t + 2) * kstep; const char* b2 = last ? nB : cB + (size_t)(t + 2) * kstep;
            const char* a3 = a2 + kstep; const char* b3 = b2 + kstep;
            if (last && has_next) S.a_ready(nxt);
            if constexpr (SP2) {
            PG8_LDB(B0, 0, 0); PG8_LDB(B1, 0, 1); PG8_SCHED; PG8_LDA(At, 0, 0); PG8_STAGE(PG8_SA(1, 1), a1 + hstepA, voffA);
            PG8_WAIT_V(8); PG8_WAIT_L(0); PG8_BAR; PG8_MMA(0, 0, At, B0); PG8_MMA(0, 1, At, B1); PG8_BAR; PG8_SCHED;
            PG8_LDA(At, 0, 1); PG8_STAGE(PG8_SB(0, 0), b2, voffB); PG8_STAGE(PG8_SB(0, 1), b2 + hstepB, voffB); PG8_STAGE(PG8_SA(0, 0), a2, voffA);
            PG8_WAIT_V(8); PG8_WAIT_L(0); PG8_BAR; PG8_MMA(1, 0, At, B0); PG8_MMA(1, 1, At, B1); PG8_BAR; PG8_SCHED;
            PG8_LDB(B0, 1, 0); PG8_LDB(B1, 1, 1); PG8_SCHED; PG8_LDA(At, 1, 0); PG8_STAGE(PG8_SA(0, 1), a2 + hstepA, voffA);
            PG8_WAIT_V(8); PG8_WAIT_L(0); PG8_BAR; PG8_MMA(0, 0, At, B0); PG8_MMA(0, 1, At, B1); PG8_BAR; PG8_SCHED;
            PG8_LDA(At, 1, 1); PG8_STAGE(PG8_SB(1, 0), b3, voffB); PG8_STAGE(PG8_SB(1, 1), b3 + hstepB, voffB); PG8_STAGE(PG8_SA(1, 0), a3, voffA);
            PG8_WAIT_V(8); PG8_WAIT_L(0); PG8_BAR; PG8_MMA(1, 0, At, B0); PG8_MMA(1, 1, At, B1); PG8_BAR; PG8_SCHED;
            } else {
            PG8_LDB(B0, 0, 0); PG8_SCHED; PG8_LDA(At, 0, 0); PG8_STAGE(PG8_SA(1, 1), a1 + hstepA, voffA);
            PG8_WAIT_L(8); PG8_BAR; PG8_WAIT_L(0); PG8_MMA(0, 0, At, B0); PG8_BAR; PG8_SCHED;
            PG8_LDB(B1, 0, 1); PG8_STAGE(PG8_SB(0, 0), b2, voffB);
            PG8_BAR; PG8_WAIT_L(0); PG8_MMA(0, 1, At, B1); PG8_BAR;
            PG8_LDA(At, 0, 1); PG8_STAGE(PG8_SA(0, 0), a2, voffA);
            PG8_BAR; PG8_WAIT_L(0); PG8_MMA(1, 0, At, B0); PG8_BAR; PG8_SCHED;
            PG8_STAGE(PG8_SB(0, 1), b2 + hstepB, voffB);
            PG8_WAIT_V(6); PG8_BAR; PG8_MMA(1, 1, At, B1); PG8_BAR;
            PG8_LDB(B0, 1, 0); PG8_SCHED; PG8_LDA(At, 1, 0); PG8_STAGE(PG8_SA(0, 1), a2 + hstepA, voffA);
            PG8_WAIT_L(8); PG8_BAR; PG8_WAIT_L(0); PG8_MMA(0, 0, At, B0); PG8_BAR; PG8_SCHED;
            PG8_LDB(B1, 1, 1); PG8_STAGE(PG8_SB(1, 0), b3, voffB);
            PG8_BAR; PG8_WAIT_L(0); PG8_MMA(0, 1, At, B1); PG8_BAR;
            PG8_LDA(At, 1, 1); PG8_STAGE(PG8_SA(1, 0), a3, voffA);
            PG8_BAR; PG8_WAIT_L(0); PG8_MMA(1, 0, At, B0); PG8_BAR; PG8_SCHED;
            PG8_STAGE(PG8_SB(1, 1), b3 + hstepB, voffB);
            PG8_WAIT_V(6); PG8_BAR; PG8_MMA(1, 1, At, B1); PG8_BAR;
            }
        }
        if constexpr (ALIGN_EPI) { if (wr == 0) PG8_BAR; }
        if constexpr (!Epi::AFTER_DRAIN) { E(acc, cur, wr, wc, fr, fq); S.done(cur); }
        if (!has_next) break;
#pragma unroll
        for (int a = 0; a < 2; ++a)
#pragma unroll
            for (int b = 0; b < 2; ++b)
#pragma unroll
                for (int m = 0; m < 4; ++m)
#pragma unroll
                    for (int n = 0; n < 2; ++n) acc[a][b][m][n] = (f32x4){0.f, 0.f, 0.f, 0.f};
        cur = nxt; cA = nA; cB = nB; ++ui;
        if constexpr (ALIGN_EPI) { if (wr == 1) PG8_BAR; }
    }
    PG8_WAIT_V(0);
    if constexpr (!ALIGN_EPI) { if (wr == 0) PG8_BAR; }
    PG8_BAR;
    if constexpr (Epi::AFTER_DRAIN) { E.fused(acc, cur, wr, wc, fr, fq, lds, wid, lane); S.done(cur); }
#undef PG8_SA
#undef PG8_SB
#undef PG8_STAGE
#undef PG8_LDA
#undef PG8_LDB
#undef PG8_MMA
#undef PG8_WAIT_V
#undef PG8_WAIT_L
#undef PG8_BAR
#undef PG8_SCHED
}
}

constexpr int NWAVES = 8, NTHR = NWAVES * 64;
#ifndef MK_PER_PHASE
#define MK_PER_PHASE 0
#endif

constexpr int D = 2048, NB = 4, T = 2048, MP = NB * T, MS = 128, MR = MP + MS, MPAD = 8448, NL = 2;
constexpr int NIN = 3840, INW = 3848, FF = 8192, NMEM = 256, MROWS = NB * NMEM, NHX = 4, HDX = 512;
constexpr int C_Z = 0, C_XBC = 512, C_BM = 1024, C_CM = 1152, C_U5 = 1280, C_GB = 1792, C_GC = 2304, C_HV = 2816, C_UP = 3328;
constexpr float EPS = 1e-6f;
constexpr int SSD_L = 64, SSD_NC = T / SSD_L;
constexpr int S5_L = 32, S5_NC = T / S5_L;

constexpr size_t O_YP = 0, O_YS = O_YP + (size_t)MP * D, O_PCONV = O_YS + (size_t)MS * D, O_PSSD = O_PCONV + NL * NB * 3 * 768, O_PS5R = O_PSSD + NL * NB * 8 * 4096,
    O_PS5I = O_PS5R + NL * NB * 2048, O_PSC = O_PS5I + NL * NB * 2048, O_PPOOL = O_PSC + NL * NB * 2 * 512, O_PMK = O_PPOOL + NL * NB * 15 * 512, O_PMV = O_PMK + (size_t)NL * MROWS * D,
    O_SCONV = O_PMV + (size_t)NL * MROWS * D, O_SSSD = O_SCONV + NL * MS * 3 * 768, O_SS5R = O_SSSD + (size_t)NL * MS * 8 * 4096, O_SS5I = O_SS5R + NL * MS * 2048, O_SSC = O_SS5I + NL * MS * 2048,
    O_SPOOL = O_SSC + NL * MS * 2 * 512, O_END = O_SPOOL + NL * MS * 15 * 512;
static_assert(O_END == 38066176, "output size");

enum In { I_XP = 0, I_XS, I_MEM, I_ST_CONV, I_ST_SSD, I_ST_S5R, I_ST_S5I, I_ST_SC, I_ST_POOL, I_CK, I_CV, I_G_MIX, I_W_IN, I_CONV_W, I_CONV_B, I_DT_BIAS, I_A_LOG, I_SSD_D,
          I_LAM_RE, I_LAM_IM, I_LOG_DT, I_B_RE, I_B_IM, I_C_RE, I_C_IM, I_S5_D, I_W_GLU, I_B_GLU, I_SC_W, I_POOL_W, I_POOL_SCALE, I_G_MIXOUT, I_W_OUT, I_G_XA, I_G_MEM,
          I_W_Q, I_W_K, I_W_V, I_W_O, I_G_MLP, I_W_UP, I_W_DOWN, I_G_FINAL, N_IN };
static_assert(N_IN == 43, "inputs");

constexpr size_t MiB = 1u << 20;
constexpr size_t WS_CTL = 0, CTL_ZERO_BYTES = 1 * MiB;
constexpr int CW_TMO = 0, CW_BAR = 4096, CW_FCNT = 8192, CW_SSQ = 16384;
static_assert(CW_BAR + 3456 <= CW_FCNT && CW_FCNT + 32 * 64 <= CW_SSQ, "ctl words");
static_assert(CW_SSQ * 4 + 7 * MPAD * 8 <= (int)CTL_ZERO_BYTES, "ctl");
constexpr size_t WS_TAB = 1 * MiB, TAB_L = 2 * MiB;
constexpr size_t TB_ABAR = 0, TB_ABARL = 16384, TB_BBAR = 32768, TB_CMT = TB_BBAR + 262144, TB_WDT = TB_CMT + 131072, TB_WGLUT = TB_WDT + 65536, TB_WPT = TB_WGLUT + 524288, TB_BBT = TB_WPT + 131072, TB_END = TB_BBT + 131072;
static_assert(TB_END <= TAB_L, "tables");
constexpr size_t WS_W = 8 * MiB, W_L = 104 * MiB;
constexpr size_t WO_IN = 0, WO_OUT = 15 * MiB, WO_Q = 23 * MiB, WO_O = 31 * MiB, WO_UP = 39 * MiB, WO_DOWN = 71 * MiB;
static_assert(WO_DOWN + 32 * MiB <= W_L && (size_t)NIN * D * 2 == 15 * MiB, "weights");
constexpr size_t WS_WKV = WS_W + 2 * W_L;
constexpr size_t WS_H = 256 * MiB, WS_HB = 322 * MiB, WS_PROJ = 356 * MiB, WS_MIX = 418 * MiB, WS_Q = 452 * MiB, WS_O = 486 * MiB, WS_HID = 520 * MiB,
    WS_MEMB = 652 * MiB, WS_KB = 656 * MiB, WS_VT = 664 * MiB, WS_DTV = 672 * MiB, WS_RSTDM = 673 * MiB, WS_SS = 674 * MiB, WS_CD = 690 * MiB, WS_S5ER = 691 * MiB, WS_S5EI = 693 * MiB, WS_SA = 700 * MiB, WS_WQKD = 704 * MiB, WS_VB = 720 * MiB, WS_WQK = 728 * MiB, WS_VWT = 760 * MiB, WS_PATT = 792 * MiB, WS_END = 808 * MiB;
constexpr size_t SA_HB = 0, SA_MIX = 512 * 1024, SA_O = 1024 * 1024, SA_HID = 2048 * 1024;
static_assert(WS_WKV + 32 * MiB <= WS_H && WS_H + (size_t)MPAD * D * 4 <= WS_HB && WS_HB + (size_t)MPAD * D * 2 <= WS_PROJ && WS_PROJ + (size_t)MPAD * NIN * 2 <= WS_MIX, "ws map 1");
static_assert(WS_HID + (size_t)MPAD * FF * 2 <= WS_MEMB && WS_SS + (size_t)NB * SSD_NC * 8 * 4096 * 4 <= WS_CD && WS_S5ER + (size_t)NB * S5_NC * 2048 * 4 <= WS_S5EI, "ws map 2");

constexpr int RING_OFF = 0, RING_BYTES = 131072;
constexpr int LDSCTL_OFF = 136192, MISC_OFF = LDSCTL_OFF + 320;
constexpr int LDS_BYTES = 147456;
static_assert(MISC_OFF + 128 <= LDS_BYTES, "LDS map");
#define GAS __attribute__((address_space(1)))
#define LAS __attribute__((address_space(3)))
typedef unsigned short bf16;
typedef unsigned v4u __attribute__((ext_vector_type(4)));
typedef float f32x4 __attribute__((ext_vector_type(4)));
typedef short bf16x8 __attribute__((ext_vector_type(8)));
typedef GAS unsigned gu32;
typedef GAS unsigned long long gu64;
#define RLX_AGENT __ATOMIC_RELAXED, __HIP_MEMORY_SCOPE_AGENT
#define LDS_WAIT() asm volatile("s_waitcnt lgkmcnt(0)" ::: "memory")
#define VM_WAIT() asm volatile("s_waitcnt vmcnt(0)" ::: "memory")
__device__ __forceinline__ unsigned long long rt() { return __builtin_amdgcn_s_memrealtime(); }
__device__ __forceinline__ unsigned f2bf(float f) { unsigned u = __builtin_bit_cast(unsigned, f); return (u + 0x7fffu + ((u >> 16) & 1u)) >> 16; }
__device__ __forceinline__ unsigned pk2(float lo, float hi) { return f2bf(lo) | (f2bf(hi) << 16); }

#define XB_TMO      128
#define XB_XCNT(j)  (256  + 64 * (j))
#define XB_XSUB(j)  (1280 + 64 * (j))
#define XB_XGEN(j)  (2304 + 64 * (j))
#define XB_TOP      3328
#define XB_TOPGEN   3392
#define XCD_BAR_WORDS 3456
#define XB_SPIN_CAP (1u << 18)

__device__ __forceinline__ unsigned xb_ld(unsigned* p)              { return __hip_atomic_load(p, __ATOMIC_RELAXED, __HIP_MEMORY_SCOPE_AGENT); }
__device__ __forceinline__ unsigned xb_add(unsigned* p, unsigned v) { return __hip_atomic_fetch_add(p, v, __ATOMIC_RELAXED, __HIP_MEMORY_SCOPE_AGENT); }
__device__ __forceinline__ unsigned xb_xcc_id() { return (unsigned)__builtin_amdgcn_s_getreg((3 << 11) | 20) & 0xFu; }
#define XB_SPIN(cond, bar) do { unsigned _sp = 0; while (cond) { __builtin_amdgcn_s_sleep(1); \
    if ((++_sp & 255u) == 0u) { if (xb_ld(&(bar)[XB_TMO])) break; if (_sp > XB_SPIN_CAP) { atomicAdd(&(bar)[XB_TMO], 1u); break; } } } } while (0)

struct XcdBarrier {
    unsigned* bar; unsigned x;
    volatile LAS unsigned* st;
};

__device__ __forceinline__ XcdBarrier xcd_barrier_post(unsigned* bar, volatile LAS unsigned* st) {
    XcdBarrier b; b.bar = bar; b.x = xb_xcc_id(); b.st = st;
    if (threadIdx.x == 0) (void)xb_add(&bar[XB_XCNT(b.x)], 1u);
    return b;
}
__device__ __forceinline__ void xcd_barrier_complete(unsigned* bar, unsigned x, unsigned& nloc, unsigned& nx) {
    const unsigned G = gridDim.x * gridDim.y * gridDim.z;
    unsigned sum, cnt, mine, sp = 0u;
    for (;;) {
        sum = 0u; cnt = 0u; mine = 0u;
#pragma unroll
        for (unsigned j = 0; j < 16; ++j) { const unsigned c = xb_ld(&bar[XB_XCNT(j)]); sum += c; cnt += (c > 0u) ? 1u : 0u; mine = (j == x) ? c : mine; }
        if (sum == G) break;
        __builtin_amdgcn_s_sleep(1);
        if ((++sp & 255u) == 0u) { if (xb_ld(&bar[XB_TMO])) break; if (sp > XB_SPIN_CAP) { atomicAdd(&bar[XB_TMO], 1u); break; } }
    }
    nloc = mine > 0u ? mine : 1u; nx = cnt > 0u ? cnt : 1u;
}

__device__ __forceinline__ void xcd_barrier(const XcdBarrier& b) {
    asm volatile("s_waitcnt vmcnt(0)" ::: "memory");
    __syncthreads();
    if (threadIdx.x == 0) {
        unsigned* bar = b.bar;
        __builtin_amdgcn_s_waitcnt(0);
        unsigned nloc = b.st[0], nx = b.st[1];
        if (nloc == 0u) { xcd_barrier_complete(bar, b.x, nloc, nx); b.st[0] = nloc; b.st[1] = nx; }
        const unsigned old = xb_add(&bar[XB_XSUB(b.x)], 1u);
        const unsigned gen = old / nloc;
        if (old + 1u == (gen + 1u) * nloc) {
            __builtin_amdgcn_fence(__ATOMIC_RELEASE, "agent");
            asm volatile("s_waitcnt vmcnt(0)" ::: "memory");
            const unsigned og = xb_add(&bar[XB_TOP], 1u);
            const unsigned tg = og / nx;
            if (og + 1u == (tg + 1u) * nx) xb_add(&bar[XB_TOPGEN], 1u);
            else XB_SPIN(xb_ld(&bar[XB_TOPGEN]) == tg, bar);
            __builtin_amdgcn_fence(__ATOMIC_ACQUIRE, "agent");
            xb_add(&bar[XB_XGEN(b.x)], 1u);
            asm volatile("s_waitcnt vmcnt(0)" ::: "memory");
        } else {
            XB_SPIN(xb_ld(&bar[XB_XGEN(b.x)]) == gen, bar);
            __builtin_amdgcn_fence(__ATOMIC_ACQUIRE, "agent");
            asm volatile("s_waitcnt vmcnt(0)" ::: "memory");
        }
    }
    __syncthreads();
}

struct Args { const float* in[N_IN]; float* out; unsigned char* ws; int ph_lo, ph_hi; };
static_assert(sizeof(Args) == 45 * 8 + 8, "Args has no holes");
typedef float f32x2 __attribute__((ext_vector_type(2)));
typedef unsigned v2u __attribute__((ext_vector_type(2)));
#define PIN(x) asm volatile("" : "+v"(x))
#define WAVE_SYNC() asm volatile("s_waitcnt lgkmcnt(0)" ::: "memory")
#define BLOCK_SYNC() do { asm volatile("s_waitcnt vmcnt(0) lgkmcnt(0)" ::: "memory"); __builtin_amdgcn_s_barrier(); asm volatile("" ::: "memory"); } while (0)
__device__ __forceinline__ float bf_lo(unsigned u) { return __uint_as_float(u << 16); }
__device__ __forceinline__ float bf_hi(unsigned u) { return __uint_as_float(u & 0xffff0000u); }
__device__ __forceinline__ float bf2f(bf16 b) { return __uint_as_float((unsigned)b << 16); }
__device__ __forceinline__ unsigned cvtpk(float lo, float hi) { return pg8::cvt_pk_bf16(lo, hi); }
__device__ __forceinline__ bf16 f2b(float f) { return (bf16)(cvtpk(f, 0.f) & 0xffffu); }
template <int CTRL> __device__ __forceinline__ float dppf(float v) { return __builtin_bit_cast(float, __builtin_amdgcn_update_dpp(0, __builtin_bit_cast(int, v), CTRL, 0xf, 0xf, false)); }
__device__ __forceinline__ float sum16(float v) { v += dppf<0xB1>(v); v += dppf<0x4E>(v); v += dppf<0x141>(v); v += dppf<0x140>(v); return v; }
__device__ __forceinline__ float max16(float v) { v = fmaxf(v, dppf<0xB1>(v)); v = fmaxf(v, dppf<0x4E>(v)); v = fmaxf(v, dppf<0x141>(v)); v = fmaxf(v, dppf<0x140>(v)); return v; }
__device__ __forceinline__ float wave_sum(float v) { v = sum16(v);
    const float r0 = __builtin_bit_cast(float, __builtin_amdgcn_readlane(__builtin_bit_cast(int, v), 0)), r1 = __builtin_bit_cast(float, __builtin_amdgcn_readlane(__builtin_bit_cast(int, v), 16)),
                r2 = __builtin_bit_cast(float, __builtin_amdgcn_readlane(__builtin_bit_cast(int, v), 32)), r3 = __builtin_bit_cast(float, __builtin_amdgcn_readlane(__builtin_bit_cast(int, v), 48));
    return (r0 + r1) + (r2 + r3); }
__device__ __forceinline__ float wave_max(float v) { v = max16(v);
    const float r0 = __builtin_bit_cast(float, __builtin_amdgcn_readlane(__builtin_bit_cast(int, v), 0)), r1 = __builtin_bit_cast(float, __builtin_amdgcn_readlane(__builtin_bit_cast(int, v), 16)),
                r2 = __builtin_bit_cast(float, __builtin_amdgcn_readlane(__builtin_bit_cast(int, v), 32)), r3 = __builtin_bit_cast(float, __builtin_amdgcn_readlane(__builtin_bit_cast(int, v), 48));
    return fmaxf(fmaxf(r0, r1), fmaxf(r2, r3)); }
__device__ __forceinline__ float silu_f(float x) { return x * __builtin_amdgcn_rcpf(1.f + __expf(-x)); }
__device__ __forceinline__ float sigmoid_f(float x) { return __builtin_amdgcn_rcpf(1.f + __expf(-x)); }
__device__ __forceinline__ float softplus_f(float x) { return x > 20.f ? x : log1pf(expf(x)); }
__device__ __forceinline__ float gelu_tanh_f(float x) { const float u = 0.7978845608f * (x + 0.044715f * x * x * x); const float e = __expf(2.f * u); const float th = 1.f - 2.f * __builtin_amdgcn_rcpf(e + 1.f); return 0.5f * x * (1.f + th); }
__device__ __forceinline__ f32x4 mfma16(bf16x8 a, bf16x8 b, f32x4 c) { return __builtin_amdgcn_mfma_f32_16x16x32_bf16(a, b, c, 0, 0, 0); }
__device__ __forceinline__ bf16x8 ldsfrag(const LAS unsigned char* p) { return *(const LAS bf16x8*)p; }
__device__ __forceinline__ bf16x8 gfrag(const bf16* p) { return *(const bf16x8*)p; }
__device__ __forceinline__ bf16x8 pack8(f32x4 a, f32x4 b) { v4u w; w.x = cvtpk(a[0], a[1]); w.y = cvtpk(a[2], a[3]); w.z = cvtpk(b[0], b[1]); w.w = cvtpk(b[2], b[3]); return __builtin_bit_cast(bf16x8, w); }
__device__ __forceinline__ void unpack8(v4u w, float (&f)[8]) { f[0] = bf_lo(w.x); f[1] = bf_hi(w.x); f[2] = bf_lo(w.y); f[3] = bf_hi(w.y); f[4] = bf_lo(w.z); f[5] = bf_hi(w.z); f[6] = bf_lo(w.w); f[7] = bf_hi(w.w); }
__device__ __forceinline__ size_t sfrag(int r, int k, int K) { return ((size_t)((r >> 4) * (K >> 5) + (k >> 5)) << 9) + (size_t)(((((k >> 3) & 3) * 16 + (r & 15)) << 3) + (k & 7)); }
__device__ __forceinline__ void dsincos(double x, double& s, double& c) {
    const double k = rint(x * 0.63661977236758134308); double r = fma(-k, 1.57079632673412561417e+00, x); r = fma(-k, 6.07710050650619224932e-11, r);
    const double r2 = r * r;
    double sp = -7.6471637318198164759e-13; sp = fma(sp, r2, 1.6059043836821614599e-10); sp = fma(sp, r2, -2.5052108385441718775e-08); sp = fma(sp, r2, 2.7557319223985890653e-06); sp = fma(sp, r2, -1.9841269841269841270e-04);
    sp = fma(sp, r2, 8.3333333333333333333e-03); sp = fma(sp, r2, -1.6666666666666666667e-01); const double sr = fma(sp * r2, r, r);
    double cp = 4.7794773323873852974e-14; cp = fma(cp, r2, -1.1470745597729724714e-11); cp = fma(cp, r2, 2.0876756987868098979e-09); cp = fma(cp, r2, -2.7557319223985890653e-07); cp = fma(cp, r2, 2.4801587301587301587e-05);
    cp = fma(cp, r2, -1.3888888888888888889e-03); cp = fma(cp, r2, 4.1666666666666666667e-02); cp = fma(cp, r2, -0.5); const double cr = fma(cp, r2, 1.0);
    const int q = (int)k & 3;
    s = (q == 0) ? sr : (q == 1) ? cr : (q == 2) ? -sr : -cr; c = (q == 0) ? cr : (q == 1) ? -sr : (q == 2) ? -cr : sr;
}

__device__ __forceinline__ void p0_transpose_item(const float* W, int ldw, int scol0, int K, int k0, const float* gain, bf16* WT, int drow0, LAS unsigned char* scr, int lane, bool frag = false) {
    const int kq = lane >> 4, n4 = lane & 15;
    f32x4 t[8][2]; float g[8][2];
#pragma unroll
    for (int s = 0; s < 8; ++s)
#pragma unroll
        for (int h = 0; h < 2; ++h) { const int k = k0 + 8 * s + 2 * kq + h; t[s][h] = __builtin_nontemporal_load((const GAS f32x4*)(W + (size_t)k * ldw + scol0 + 4 * n4)); g[s][h] = gain ? gain[k] : 1.f; }
#pragma unroll
    for (int s = 0; s < 8; ++s) { PIN(t[s][0]); PIN(t[s][1]); }
#pragma unroll
    for (int s = 0; s < 8; ++s)
#pragma unroll
        for (int e = 0; e < 4; ++e) *(LAS unsigned*)(scr + ((4 * n4 + e) * 68 + 8 * s + 2 * kq) * 2) = cvtpk(t[s][0][e] * g[s][0], t[s][1][e] * g[s][1]);
    LDS_WAIT(); asm volatile("" ::: "memory");
    const int c = lane & 7;
#pragma unroll
    for (int j = 0; j < 8; ++j) { const int n = (lane >> 3) + 8 * j; const v2u a = *(const LAS v2u*)(scr + (n * 68 + 8 * c) * 2), b = *(const LAS v2u*)(scr + (n * 68 + 8 * c + 4) * 2);
        *(GAS v4u*)(WT + (frag ? sfrag(drow0 + n, k0 + 8 * c, K) : (size_t)(drow0 + n) * K + k0 + 8 * c)) = (v4u){a.x, a.y, b.x, b.y}; }
    LDS_WAIT(); asm volatile("" ::: "memory");
}
__device__ __forceinline__ void p0_mat(const float* W, int ldw, int K, int N, const float* gain, bf16* WT, int drow_base, int item, LAS unsigned char* scr, int lane, bool frag = false) {
    const int nblk = N / 64, kb = item / nblk, nb = item % nblk;
    p0_transpose_item(W, ldw, 64 * nb, K, 64 * kb, gain, WT, drow_base + 64 * nb, scr, lane, frag);
}
constexpr int P0W_IN = (D / 64) * (NIN / 64), P0W_SQ = (D / 64) * (D / 64), P0W_UP = (D / 64) * (FF / 64), P0W_DN = (FF / 64) * (D / 64), P0W_GLU = (512 / 64) * (512 / 64), P0W_PW = (128 / 64) * (128 / 64);
constexpr int P0W_LAYER = P0W_IN + 5 * P0W_SQ + P0W_UP + P0W_DN + P0W_GLU + 4 * P0W_PW, P0W_DEF_N = P0W_UP + P0W_DN + P0W_GLU + 4 * P0W_PW + P0W_IN + P0W_SQ, P0W_DEF_LO = NL * P0W_LAYER - P0W_DEF_N;
__device__ __forceinline__ void p0_weights(const Args& A, LAS unsigned char* lds, int gw, int NGW, int first, int count, int skip_at, int skip_n, int wave, int lane) {
    asm volatile("" : "+v"(lane));
    LAS unsigned char* scr = lds + RING_OFF + wave * 16384;
    unsigned char* ws = A.ws;
    constexpr int I_IN = P0W_IN, I_SQ = P0W_SQ, I_UP = P0W_UP, I_DN = P0W_DN, I_GLU = P0W_GLU, I_PW = P0W_PW, I_LAYER = P0W_LAYER;
#pragma unroll 1
    for (int i = gw; i < count; i += NGW) { int it = first + i; if (it >= skip_at) it += skip_n;
        const int l = it / I_LAYER; int r = it % I_LAYER + I_IN + I_SQ; if (r >= I_LAYER) r -= I_LAYER;
        bf16* wl = (bf16*)(ws + WS_W + (size_t)l * W_L); unsigned char* tb = ws + WS_TAB + (size_t)l * TAB_L;
        const float* W; const float* gain = nullptr; bf16* WT; int ldw, K, N, drow = 0; bool frag = false;
        if (r < I_IN) { const int nblk = NIN / 64, kb = r / nblk, nb = r % nblk, n0 = 64 * nb;
            p0_transpose_item(A.in[I_W_IN] + (size_t)l * D * INW, INW, n0 + (n0 >= 1280 ? 8 : 0), D, 64 * kb, A.in[I_G_MIX] + l * D, (bf16*)((unsigned char*)wl + WO_IN), n0, scr, lane); continue; } r -= I_IN;
        if (r < I_SQ) { W = A.in[I_W_OUT] + (size_t)l * D * D; gain = A.in[I_G_MIXOUT] + l * D; WT = (bf16*)((unsigned char*)wl + WO_OUT); ldw = D; K = D; N = D; }
        else if (r < 2 * I_SQ) { r -= I_SQ; W = A.in[I_W_Q] + (size_t)l * D * D; gain = A.in[I_G_XA] + l * D; WT = (bf16*)((unsigned char*)wl + WO_Q); ldw = D; K = D; N = D; }
        else if (r < 3 * I_SQ) { r -= 2 * I_SQ; W = A.in[I_W_O] + (size_t)l * D * D; WT = (bf16*)((unsigned char*)wl + WO_O); ldw = D; K = D; N = D; }
        else if (r < 4 * I_SQ) { r -= 3 * I_SQ; W = A.in[I_W_K] + (size_t)l * D * D; gain = A.in[I_G_MEM] + l * D; WT = (bf16*)(ws + WS_WKV); drow = l * 4096; ldw = D; K = D; N = D; }
        else if (r < 5 * I_SQ) { r -= 4 * I_SQ; W = A.in[I_W_V] + (size_t)l * D * D; gain = A.in[I_G_MEM] + l * D; WT = (bf16*)(ws + WS_WKV); drow = l * 4096 + 2048; ldw = D; K = D; N = D; }
        else if (r < 5 * I_SQ + I_UP) { r -= 5 * I_SQ; W = A.in[I_W_UP] + (size_t)l * D * FF; gain = A.in[I_G_MLP] + l * D; WT = (bf16*)((unsigned char*)wl + WO_UP); ldw = FF; K = D; N = FF; }
        else if (r < 5 * I_SQ + I_UP + I_DN) { r -= 5 * I_SQ + I_UP; W = A.in[I_W_DOWN] + (size_t)l * FF * D; WT = (bf16*)((unsigned char*)wl + WO_DOWN); ldw = D; K = FF; N = D; }
        else if (r < 5 * I_SQ + I_UP + I_DN + I_GLU) { r -= 5 * I_SQ + I_UP + I_DN; W = A.in[I_W_GLU] + (size_t)l * 512 * 512; WT = (bf16*)(tb + TB_WGLUT); ldw = 512; K = 512; N = 512; frag = true; }
        else { r -= 5 * I_SQ + I_UP + I_DN + I_GLU; const int gI = r / I_PW; r = r % I_PW; W = A.in[I_POOL_W] + ((size_t)l * 4 + gI) * 128 * 128; WT = (bf16*)(tb + TB_WPT) + gI * 128 * 128; ldw = 128; K = 128; N = 128; frag = true; }
        p0_mat(W, ldw, K, N, gain, WT, drow, r, scr, lane, frag);
    }
}
__device__ __forceinline__ void p0_prologue(const Args& A, LAS unsigned char* lds, int vcu, int G, int wave, int lane) {
    asm volatile("" : "+v"(lane));
    const int gw = vcu * NWAVES + wave, NGW = G * NWAVES;
    unsigned char* ws = A.ws;
    { const int nskip = G == 256 ? P0W_DEF_N : 0; p0_weights(A, lds, gw, NGW, 0, NL * P0W_LAYER - nskip, P0W_DEF_LO, nskip, wave, lane); }
    bf16* HB = (bf16*)(ws + WS_HB); unsigned long long* ssq0 = (unsigned long long*)((unsigned*)(ws + WS_CTL) + CW_SSQ);
#pragma unroll 1
    for (int m = gw; m < MR; m += NGW) {
        f32x4 v[8]; const GAS f32x4* xr = (const GAS f32x4*)(m < MP ? A.in[I_XP] + (size_t)m * D : A.in[I_XS] + (size_t)(m - MP) * D) + lane;
#pragma unroll
        for (int j = 0; j < 8; ++j) v[j] = __builtin_nontemporal_load(xr + 64 * j);
#pragma unroll
        for (int j = 0; j < 8; ++j) PIN(v[j]);
        float s = 0.f;
#pragma unroll
        for (int j = 0; j < 8; ++j) s += (v[j].x * v[j].x + v[j].y * v[j].y) + (v[j].z * v[j].z + v[j].w * v[j].w);
        s = wave_sum(s);
        GAS v2u* br = (GAS v2u*)(HB + (size_t)m * D) + lane;
#pragma unroll
        for (int j = 0; j < 8; ++j) { v2u w; w.x = cvtpk(v[j].x, v[j].y); w.y = cvtpk(v[j].z, v[j].w); br[64 * j] = w;
            if (m >= MP) *(GAS v2u*)((bf16*)(ws + WS_SA + SA_HB) + sfrag(m - MP, 4 * lane + 256 * j, D)) = w; }
        if (lane == 0) ssq0[m] = (unsigned long long)__float2ull_rn(s * 16777216.0f);
    }
    bf16* MEMB = (bf16*)(ws + WS_MEMB); float* RSTDM = (float*)(ws + WS_RSTDM);
#pragma unroll 1
    for (int m = gw; m < MROWS; m += NGW) {
        const GAS f32x4* xr = (const GAS f32x4*)(A.in[I_MEM] + (size_t)m * D) + lane; f32x4 v[8]; float s = 0.f;
#pragma unroll
        for (int j = 0; j < 8; ++j) v[j] = xr[64 * j];
#pragma unroll
        for (int j = 0; j < 8; ++j) PIN(v[j]);
#pragma unroll
        for (int j = 0; j < 8; ++j) s += (v[j].x * v[j].x + v[j].y * v[j].y) + (v[j].z * v[j].z + v[j].w * v[j].w);
        s = wave_sum(s);
        GAS v2u* br = (GAS v2u*)(MEMB + (size_t)m * D) + lane;
#pragma unroll
        for (int j = 0; j < 8; ++j) { v2u w; w.x = cvtpk(v[j].x, v[j].y); w.y = cvtpk(v[j].z, v[j].w); br[64 * j] = w; }
        if (lane == 0) RSTDM[m] = 1.0f / sqrtf(s * (1.0f / D) + EPS);
    }
    { bf16* WQKD = (bf16*)(ws + WS_WQKD);
#pragma unroll 1
        for (int m = gw; m < NL * D; m += NGW) { const int l = m >> 11, k = m & 2047; const float gk = A.in[I_G_XA][l * D + k];
            const GAS f32x4* xr = (const GAS f32x4*)(A.in[I_W_Q] + ((size_t)l * D + k) * D) + lane; f32x4 v[8];
#pragma unroll
            for (int j = 0; j < 8; ++j) v[j] = __builtin_nontemporal_load(xr + 64 * j);
#pragma unroll
            for (int j = 0; j < 8; ++j) PIN(v[j]);
            GAS v2u* br = (GAS v2u*)(WQKD + (size_t)m * D) + lane;
#pragma unroll
            for (int j = 0; j < 8; ++j) { v2u w; w.x = cvtpk(v[j].x * gk, v[j].y * gk); w.y = cvtpk(v[j].z * gk, v[j].w * gk); br[64 * j] = w; } } }
    const int gt = gw * 64 + lane, NGT = NGW * 64;
    for (int i2 = gt; i2 < NL * 2048 * 16 * 2; i2 += NGT) { if (i2 & 1) continue; const int i = i2 >> 5, k = (i2 >> 1) & 15;
        const int l = i >> 11, gn = i & 2047, g = gn >> 6, n = gn & 63; unsigned char* tb = ws + WS_TAB + (size_t)l * TAB_L;
        const double lr = (double)A.in[I_LAM_RE][l * 2048 + gn], li = (double)A.in[I_LAM_IM][l * 2048 + gn], dl = exp((double)A.in[I_LOG_DT][l * 32 + g]);
        const float bref = A.in[I_B_RE][((size_t)l * 2048 + gn) * 16 + k], bimf = A.in[I_B_IM][((size_t)l * 2048 + gn) * 16 + k];
        const float cref = A.in[I_C_RE][((size_t)l * 32 + g) * 1024 + k * 64 + n], cimf = A.in[I_C_IM][((size_t)l * 32 + g) * 1024 + k * 64 + n];
        double s1, c1, sL, cL; dsincos(li * dl, s1, c1); dsincos(li * dl * (double)S5_L, sL, cL);
        const double m1 = exp(lr * dl), mL = exp(lr * dl * (double)S5_L), ar = m1 * c1, ai = m1 * s1;
        if (k == 0) { ((f32x2*)(tb + TB_ABAR))[gn] = (f32x2){(float)ar, (float)ai}; ((f32x2*)(tb + TB_ABARL))[gn] = (f32x2){(float)(mL * cL), (float)(mL * sL)}; }
        const double den = lr * lr + li * li, cr = ((ar - 1.0) * lr + ai * li) / den, ci = (ai * lr - (ar - 1.0) * li) / den;
        f32x2* bb = (f32x2*)(tb + TB_BBAR) + (size_t)g * 16 * 64 + n; bf16* cmt = (bf16*)(tb + TB_CMT) + (size_t)g * 16 * 128;
        bf16* bbt = (bf16*)(tb + TB_BBT) + (size_t)g * 128 * 16;
        { const double br = bref, bi = bimf; bb[k * 64] = (f32x2){(float)(cr * br - ci * bi), (float)(cr * bi + ci * br)};
            bbt[n * 16 + k] = f2b((float)(cr * br - ci * bi)); bbt[(64 + n) * 16 + k] = f2b((float)(cr * bi + ci * br));
            cmt[k * 128 + n] = f2b(cref); cmt[k * 128 + 64 + n] = f2b(-cimf); }
    }
    for (int i2 = gt; i2 < NL * D * 32; i2 += NGT) { if (i2 & 31) continue; const int i = i2 >> 5;
        const int l = i >> 11, k = i & 2047; const float g = A.in[I_G_MIX][l * D + k]; const float* w = A.in[I_W_IN] + ((size_t)l * D + k) * INW + 1280;
        float* o = (float*)(ws + WS_TAB + (size_t)l * TAB_L + TB_WDT) + k * 8;
#pragma unroll
        for (int j = 0; j < 8; ++j) o[j] = g * w[j];
    }
}

__device__ __forceinline__ void dt_rows(const Args& A, LAS unsigned char* lds, int l, int vcu, int G, int tid) {
    asm volatile("" : "+v"(tid)); const int lane = tid & 63, wave = __builtin_amdgcn_readfirstlane(tid >> 6);
    unsigned char* ws = A.ws; const bf16* HB = (const bf16*)(ws + WS_HB); const float* WDT = (const float*)(ws + WS_TAB + (size_t)l * TAB_L + TB_WDT);
    const unsigned long long* ssq = (const unsigned long long*)((const unsigned*)(ws + WS_CTL) + CW_SSQ) + (3 * l) * MPAD; float* DTV = (float*)(ws + WS_DTV);
    { v4u t[8];
#pragma unroll
        for (int j = 0; j < 8; ++j) t[j] = *(const GAS v4u*)((const unsigned char*)WDT + (tid + NTHR * j) * 16);
#pragma unroll
        for (int j = 0; j < 8; ++j) PIN(t[j]);
#pragma unroll
        for (int j = 0; j < 8; ++j) { const int p = tid + NTHR * j, k = p >> 1; *(LAS v4u*)(lds + (k >> 3) * 272 + (k & 7) * 32 + (p & 1) * 16) = t[j]; } }
    BLOCK_SYNC();
    const int gw = vcu * NWAVES + wave, NGW = G * NWAVES; const float bias = A.in[I_DT_BIAS][l * 8 + (lane & 7)];
#pragma unroll 1
    for (int m0 = gw; m0 < MR; m0 += 2 * NGW) { const int m1 = m0 + NGW; const bool has1 = m1 < MR; const int m1c = has1 ? m1 : m0;
        v4u x0[4], x1[4];
#pragma unroll
        for (int i = 0; i < 4; ++i) { x0[i] = *(const GAS v4u*)(HB + (size_t)m0 * D + 8 * lane + 512 * i); x1[i] = *(const GAS v4u*)(HB + (size_t)m1c * D + 8 * lane + 512 * i); }
#pragma unroll
        for (int i = 0; i < 4; ++i) { PIN(x0[i]); PIN(x1[i]); }
        float a0[8], a1[8];
#pragma unroll
        for (int j = 0; j < 8; ++j) { a0[j] = 0.f; a1[j] = 0.f; }
#pragma unroll
        for (int i = 0; i < 4; ++i) { float f0[8], f1[8]; unpack8(x0[i], f0); unpack8(x1[i], f1);
#pragma unroll
            for (int e = 0; e < 8; ++e) { const LAS float* wp = (const LAS float*)(lds + (lane + 64 * i) * 272 + e * 32); const f32x4 w0 = *(const LAS f32x4*)wp, w1 = *(const LAS f32x4*)(wp + 4);
                a0[0] += f0[e] * w0.x; a0[1] += f0[e] * w0.y; a0[2] += f0[e] * w0.z; a0[3] += f0[e] * w0.w; a0[4] += f0[e] * w1.x; a0[5] += f0[e] * w1.y; a0[6] += f0[e] * w1.z; a0[7] += f0[e] * w1.w;
                a1[0] += f1[e] * w0.x; a1[1] += f1[e] * w0.y; a1[2] += f1[e] * w0.z; a1[3] += f1[e] * w0.w; a1[4] += f1[e] * w1.x; a1[5] += f1[e] * w1.y; a1[6] += f1[e] * w1.z; a1[7] += f1[e] * w1.w; } }
        float v0 = 0.f, v1 = 0.f;
#pragma unroll
        for (int j = 0; j < 8; ++j) { const float s0 = wave_sum(a0[j]), s1 = wave_sum(a1[j]); if ((lane & 7) == j) { v0 = s0; v1 = s1; } }
        if (lane < 8) { DTV[(size_t)m0 * 8 + lane] = softplus_f(v0 * pg8::ssq_rstd(ssq[m0]) + bias);
            if (has1) DTV[(size_t)m1 * 8 + lane] = softplus_f(v1 * pg8::ssq_rstd(ssq[m1]) + bias); }
    }
    BLOCK_SYNC();
}

__device__ __forceinline__ void lds_add(LAS float* p, float v) { (void)__hip_atomic_fetch_add(p, v, __ATOMIC_RELAXED, __HIP_MEMORY_SCOPE_WORKGROUP); }

__device__ __forceinline__ float wave_scan_incl(float v, int lane) {
#pragma unroll
    for (int o = 1; o < 64; o <<= 1) { const float t = __shfl_up(v, o); if (lane >= o) v += t; }
    return v;
}
template <int NCH> __device__ __forceinline__ void conv8(const bf16* proj, const float* cw, const float* cb, int grow0, int t0, bool seq_first, int cx0, float (&out)[8][NCH]) {
    float raw[11][NCH]; float w[4][NCH], bsv[NCH];
    unsigned rw[11][(NCH + 1) / 2];
#pragma unroll
    for (int r = 0; r < 11; ++r) { const int tt = t0 - 3 + r; const bf16* p = proj + (size_t)(grow0 + ((seq_first && tt < 0) ? 0 : tt)) * NIN + C_XBC + cx0;
        if constexpr (NCH == 4) { const v2u v = *(const GAS v2u*)p; rw[r][0] = v.x; rw[r][1] = v.y; }
        else if constexpr (NCH == 2) { rw[r][0] = *(const GAS unsigned*)p; }
        else { rw[r][0] = (unsigned)*p; } }
#pragma unroll
    for (int e = 0; e < NCH; ++e) { bsv[e] = cb[cx0 + e];
#pragma unroll
        for (int j = 0; j < 4; ++j) w[j][e] = cw[j * 768 + cx0 + e]; }
#pragma unroll
    for (int r = 0; r < 11; ++r)
#pragma unroll
        for (int q = 0; q < (NCH + 1) / 2; ++q) PIN(rw[r][q]);
#pragma unroll
    for (int r = 0; r < 11; ++r) { const bool z = seq_first && (t0 - 3 + r) < 0;
        if constexpr (NCH == 1) raw[r][0] = z ? 0.f : __uint_as_float(rw[r][0] << 16);
        else {
#pragma unroll
            for (int q = 0; q < NCH / 2; ++q) { raw[r][2 * q] = z ? 0.f : bf_lo(rw[r][q]); raw[r][2 * q + 1] = z ? 0.f : bf_hi(rw[r][q]); } } }
#pragma unroll
    for (int i = 0; i < 8; ++i)
#pragma unroll
        for (int e = 0; e < NCH; ++e) { const float v = bsv[e] + w[0][e] * raw[i][e] + w[1][e] * raw[i + 1][e] + w[2][e] * raw[i + 2][e] + w[3][e] * raw[i + 3][e]; out[i][e] = silu_f(v); }
}

__device__ __forceinline__ void ma_ssd_unit(const Args& A, LAS unsigned char* lds, int l, int b, int c, int grp, int tid, int lane, int wave) {
    asm volatile("" : "+v"(tid)); lane = tid & 63; wave = __builtin_amdgcn_readfirstlane(tid >> 6);
    unsigned char* ws = A.ws; const bf16* proj = (const bf16*)(ws + WS_PROJ); const float* DTV = (const float*)(ws + WS_DTV);
    LAS float* AC = (LAS float*)(lds); LAS float* DTs = (LAS float*)(lds + 1024); LAS unsigned char* XT = lds + 2048; LAS unsigned char* BT = lds + 2048 + 36864;
    const int grow0 = b * T + c * SSD_L;
    if (wave < 4) { const int h = 4 * grp + wave; const float an = -expf(A.in[I_A_LOG][l * 8 + h]); const float dt = DTV[(size_t)(grow0 + lane) * 8 + h];
        AC[wave * 64 + lane] = wave_scan_incl(dt * an, lane); DTs[wave * 64 + lane] = dt; }
    BLOCK_SYNC();
    { const int t0 = 8 * wave; const float* cw = A.in[I_CONV_W] + l * 4 * 768; const float* cb = A.in[I_CONV_B] + l * 768;
        float xs[8][4]; conv8<4>(proj, cw, cb, grow0, t0, c == 0, 256 * grp + 4 * lane, xs);
        const int hl = lane >> 4, p0 = 4 * (lane & 15); const float alast = AC[hl * 64 + 63];
        float sc[8];
#pragma unroll
        for (int i = 0; i < 8; ++i) sc[i] = DTs[hl * 64 + t0 + i] * __expf(alast - AC[hl * 64 + t0 + i]);
#pragma unroll
        for (int e = 0; e < 4; ++e) { v4u w; w.x = cvtpk(xs[0][e] * sc[0], xs[1][e] * sc[1]); w.y = cvtpk(xs[2][e] * sc[2], xs[3][e] * sc[3]); w.z = cvtpk(xs[4][e] * sc[4], xs[5][e] * sc[5]); w.w = cvtpk(xs[6][e] * sc[6], xs[7][e] * sc[7]);
            *(LAS v4u*)(XT + ((hl * 64 + p0 + e) * 72 + t0) * 2) = w; }
        float bm[8][1]; conv8<1>(proj, cw, cb, grow0, t0, c == 0, 512 + 64 * grp + lane, bm);
        v4u w; w.x = cvtpk(bm[0][0], bm[1][0]); w.y = cvtpk(bm[2][0], bm[3][0]); w.z = cvtpk(bm[4][0], bm[5][0]); w.w = cvtpk(bm[6][0], bm[7][0]);
        *(LAS v4u*)(BT + (lane * 72 + t0) * 2) = w; }
    BLOCK_SYNC();
    { const int hl = wave >> 1, ph = wave & 1, fr = lane & 15, fq = lane >> 4; f32x4 acc[2][4];
#pragma unroll
        for (int i = 0; i < 2; ++i)
#pragma unroll
            for (int j = 0; j < 4; ++j) acc[i][j] = (f32x4){0.f, 0.f, 0.f, 0.f};
#pragma unroll
        for (int ks = 0; ks < 2; ++ks) { bf16x8 fb[4], fx[2];
#pragma unroll
            for (int j = 0; j < 4; ++j) fb[j] = ldsfrag(BT + ((16 * j + fr) * 72 + 32 * ks + 8 * fq) * 2);
#pragma unroll
            for (int i = 0; i < 2; ++i) fx[i] = ldsfrag(XT + ((hl * 64 + 32 * ph + 16 * i + fr) * 72 + 32 * ks + 8 * fq) * 2);
#pragma unroll
            for (int i = 0; i < 2; ++i)
#pragma unroll
                for (int j = 0; j < 4; ++j) acc[i][j] = mfma16(fb[j], fx[i], acc[i][j]); }
        float* SS = (float*)(ws + WS_SS) + ((size_t)(b * SSD_NC + c) * 8 + 4 * grp + hl) * 4096;
#pragma unroll
        for (int i = 0; i < 2; ++i)
#pragma unroll
            for (int j = 0; j < 4; ++j) *(GAS f32x4*)(SS + (32 * ph + 16 * i + fr) * 64 + 16 * j + 4 * fq) = acc[i][j]; }
    if (tid < 4) ((float*)(ws + WS_CD))[(b * SSD_NC + c) * 8 + 4 * grp + tid] = expf(AC[tid * 64 + 63]);
    BLOCK_SYNC();
}

__device__ __forceinline__ void s5_bu(const Args& A, int l, int g, int grow0, int lane, LAS unsigned char* HS, float& ar, float& ai) {
    const unsigned char* tb = A.ws + WS_TAB + (size_t)l * TAB_L; const bf16* proj = (const bf16*)(A.ws + WS_PROJ); const int fr = lane & 15, fq = lane >> 4;
    const bf16* up = proj + (size_t)(grow0 + fr) * NIN + C_U5 + 16 * g + 8 * (fq & 1); const bf16* bp = (const bf16*)(tb + TB_BBT) + ((size_t)g * 128 + fr) * 16 + 8 * (fq & 1);
    v4u fu[2], fb[8];
#pragma unroll
    for (int rt = 0; rt < 2; ++rt) fu[rt] = *(const GAS v4u*)(up + (size_t)rt * 16 * NIN);
#pragma unroll
    for (int ct = 0; ct < 8; ++ct) fb[ct] = *(const GAS v4u*)(bp + ct * 256);
    f32x2 a = ((const f32x2*)(tb + TB_ABAR))[g * 64 + lane];
    PIN(fu[0]); PIN(fu[1]); PIN(a);
#pragma unroll
    for (int ct = 0; ct < 8; ++ct) PIN(fb[ct]);
    const v4u z = (v4u){0u, 0u, 0u, 0u}; const bool hi2 = fq >= 2;
#pragma unroll
    for (int rt = 0; rt < 2; ++rt) fu[rt] = hi2 ? z : fu[rt];
#pragma unroll
    for (int ct = 0; ct < 8; ++ct) fb[ct] = hi2 ? z : fb[ct];
#pragma unroll
    for (int rt = 0; rt < 2; ++rt)
#pragma unroll
        for (int ct = 0; ct < 8; ++ct) { const f32x4 d = mfma16(__builtin_bit_cast(bf16x8, fu[rt]), __builtin_bit_cast(bf16x8, fb[ct]), (f32x4){0.f, 0.f, 0.f, 0.f});
#pragma unroll
            for (int e = 0; e < 4; ++e) *(LAS bf16*)(HS + ((16 * rt + 4 * fq + e) * 136 + 16 * ct + fr) * 2) = f2b(d[e]); }
    ar = a.x; ai = a.y;
    WAVE_SYNC();
}
template <bool WRITEBACK> __device__ __forceinline__ void s5_scan(LAS unsigned char* HS, int lane, float ar, float ai, float& hr, float& hi) {
#pragma unroll 1
    for (int t0 = 0; t0 < S5_L; t0 += 8) { unsigned short br[8], bi[8];
#pragma unroll
        for (int i = 0; i < 8; ++i) { br[i] = *(const LAS bf16*)(HS + ((t0 + i) * 136 + lane) * 2); bi[i] = *(const LAS bf16*)(HS + ((t0 + i) * 136 + 64 + lane) * 2); }
#pragma unroll
        for (int i = 0; i < 8; ++i) { const float nr = ar * hr - ai * hi + bf2f(br[i]), ni = ar * hi + ai * hr + bf2f(bi[i]); hr = nr; hi = ni;
            if (WRITEBACK) { *(LAS bf16*)(HS + ((t0 + i) * 136 + lane) * 2) = f2b(hr); *(LAS bf16*)(HS + ((t0 + i) * 136 + 64 + lane) * 2) = f2b(hi); } } }
}
__device__ __forceinline__ void ma_s5_unit(const Args& A, LAS unsigned char* lds, int l, int b, int c, int lane, int wave) {
    asm volatile("" : "+v"(lane));
    LAS unsigned char* HS = lds + wave * 8704; const int grow0 = b * T + c * S5_L;
    float* ER = (float*)(A.ws + WS_S5ER); float* EI = (float*)(A.ws + WS_S5EI);
#pragma unroll 1
    for (int gi = 0; gi < 4; ++gi) { const int g = 4 * wave + gi; float ar, ai; s5_bu(A, l, g, grow0, lane, HS, ar, ai);
        float hr = 0.f, hi = 0.f; s5_scan<false>(HS, lane, ar, ai, hr, hi);
        const size_t o = ((size_t)(b * S5_NC + c) * 32 + g) * 64 + lane; ER[o] = hr; EI[o] = hi;
        WAVE_SYNC(); }
    BLOCK_SYNC();
}

__device__ __forceinline__ void mb_scan(const Args& A, int l, int vcu, int G, int tid, int dm = 0) {
    asm volatile("" : "+v"(tid));
    unsigned char* ws = A.ws; const int gt = vcu * NTHR + tid, NGT = G * NTHR;
    float* SS = (float*)(ws + (dm ? WS_END + 200 * MiB : WS_SS)); const float* CD = (const float*)(ws + WS_CD); float* outp = dm ? (float*)(ws + WS_END + 240 * MiB) : A.out;
#pragma unroll 1
    for (int i = gt; i < NB * 8 * 4096; i += NGT) { const int b = i >> 15, h = (i >> 12) & 7, pn = i & 4095; float run = 0.f; float s[SSD_NC], d[SSD_NC];
        float* p = SS + ((size_t)(b * SSD_NC) * 8 + h) * 4096 + pn; const float* dp = CD + (b * SSD_NC) * 8 + h;
#pragma unroll
        for (int c = 0; c < SSD_NC; ++c) { s[c] = p[(size_t)c * 8 * 4096]; d[c] = dp[c * 8]; }
#pragma unroll
        for (int c = 0; c < SSD_NC; ++c) { PIN(s[c]); PIN(d[c]); }
#pragma unroll
        for (int c = 0; c < SSD_NC; ++c) { p[(size_t)c * 8 * 4096] = run; run = run * d[c] + s[c]; }
        outp[O_PSSD + (size_t)l * NB * 8 * 4096 + i] = run; }
    float* ER = (float*)(ws + (dm ? WS_END + 220 * MiB : WS_S5ER)); float* EI = (float*)(ws + (dm ? WS_END + 224 * MiB : WS_S5EI)); const f32x2* AL = (const f32x2*)(ws + WS_TAB + (size_t)l * TAB_L + TB_ABARL);
#pragma unroll 1
    for (int i = gt; i < NB * 2048; i += NGT) { const int b = i >> 11, gn = i & 2047; const f32x2 a = AL[gn]; float rr = 0.f, ri = 0.f;
#pragma unroll 1
        for (int c0 = 0; c0 < S5_NC; c0 += 32) { float er[32], ei[32]; const size_t o = (size_t)(b * S5_NC + c0) * 2048 + gn;
#pragma unroll
            for (int c = 0; c < 32; ++c) { er[c] = ER[o + (size_t)c * 2048]; ei[c] = EI[o + (size_t)c * 2048]; }
#pragma unroll
            for (int c = 0; c < 32; ++c) { PIN(er[c]); PIN(ei[c]); }
#pragma unroll
            for (int c = 0; c < 32; ++c) { ER[o + (size_t)c * 2048] = rr; EI[o + (size_t)c * 2048] = ri; const float nr = a.x * rr - a.y * ri + er[c], ni = a.x * ri + a.y * rr + ei[c]; rr = nr; ri = ni; } }
        outp[O_PS5R + (size_t)l * NB * 2048 + i] = rr; outp[O_PS5I + (size_t)l * NB * 2048 + i] = ri; }
}

__device__ __forceinline__ void mc_s5_unit(const Args& A, LAS unsigned char* lds, int l, int b, int c, int tid, int lane, int wave) {
    asm volatile("" : "+v"(tid)); lane = tid & 63; wave = __builtin_amdgcn_readfirstlane(tid >> 6);
    unsigned char* ws = A.ws; const unsigned char* tb = ws + WS_TAB + (size_t)l * TAB_L;
    LAS unsigned char* HS = lds + 16384 + wave * 8704;
    LAS unsigned char* Y = lds + 16384 + 8 * 8704; LAS float* SQ = (LAS float*)(lds + 16384 + 8 * 8704 + 33280);
    const int grow0 = b * T + c * S5_L, fr = lane & 15, fq = lane >> 4;
    const float* ER = (const float*)(ws + WS_S5ER); const float* EI = (const float*)(ws + WS_S5EI);
#pragma unroll 1
    for (int gi = 0; gi < 4; ++gi) { const int g = 4 * wave + gi;
        const size_t o = ((size_t)(b * S5_NC + c) * 32 + g) * 64 + lane; float hr = ER[o], hi = EI[o];
        const bf16* cmt = (const bf16*)(tb + TB_CMT) + (size_t)g * 16 * 128; float dsk = A.in[I_S5_D][l * 512 + 16 * g + fr]; bf16x8 fc[4]; unsigned uk[2][4];
        const bf16* proj = (const bf16*)(ws + WS_PROJ);
#pragma unroll
        for (int ks = 0; ks < 4; ++ks) fc[ks] = gfrag(cmt + fr * 128 + 32 * ks + 8 * fq);
#pragma unroll
        for (int rt = 0; rt < 2; ++rt)
#pragma unroll
            for (int e = 0; e < 4; ++e) uk[rt][e] = (unsigned)proj[(size_t)(grow0 + 16 * rt + 4 * fq + e) * NIN + C_U5 + 16 * g + fr];
        float ar, ai; s5_bu(A, l, g, grow0, lane, HS, ar, ai);
        PIN(hr); PIN(hi); PIN(dsk);
#pragma unroll
        for (int ks = 0; ks < 4; ++ks) PIN(fc[ks]);
#pragma unroll
        for (int rt = 0; rt < 2; ++rt)
#pragma unroll
            for (int e = 0; e < 4; ++e) PIN(uk[rt][e]);
        s5_scan<true>(HS, lane, ar, ai, hr, hi);
        WAVE_SYNC();
        f32x4 acc[2] = {(f32x4){0.f, 0.f, 0.f, 0.f}, (f32x4){0.f, 0.f, 0.f, 0.f}};
#pragma unroll
        for (int ks = 0; ks < 4; ++ks)
#pragma unroll
            for (int rt = 0; rt < 2; ++rt) acc[rt] = mfma16(ldsfrag(HS + ((16 * rt + fr) * 136 + 32 * ks + 8 * fq) * 2), fc[ks], acc[rt]);
#pragma unroll
        for (int rt = 0; rt < 2; ++rt)
#pragma unroll
            for (int e = 0; e < 4; ++e) { const int t = 16 * rt + 4 * fq + e; const float y = acc[rt][e] + dsk * __uint_as_float(uk[rt][e] << 16); *(LAS bf16*)(Y + (t * 520 + 16 * g + fr) * 2) = f2b(gelu_tanh_f(y)); }
        WAVE_SYNC(); }
    BLOCK_SYNC();
    const bf16* wg = (const bf16*)(tb + TB_WGLUT); f32x4 acc[2][4];
#pragma unroll
    for (int i = 0; i < 2; ++i)
#pragma unroll
        for (int j = 0; j < 4; ++j) acc[i][j] = (f32x4){0.f, 0.f, 0.f, 0.f};
    float bgl[4];
#pragma unroll
    for (int j = 0; j < 4; ++j) bgl[j] = A.in[I_B_GLU][l * 512 + 64 * wave + 16 * j + fr];
#pragma unroll 1
    for (int k4 = 0; k4 < 16; k4 += 4) { bf16x8 fb[4][4];
#pragma unroll
        for (int q = 0; q < 4; ++q)
#pragma unroll
            for (int j = 0; j < 4; ++j) fb[q][j] = gfrag(wg + sfrag(64 * wave + 16 * j, 32 * (k4 + q), 512) + 8 * lane);
#pragma unroll
        for (int q = 0; q < 4; ++q)
#pragma unroll
            for (int j = 0; j < 4; ++j) PIN(fb[q][j]);
#pragma unroll
        for (int q = 0; q < 4; ++q) { bf16x8 fa[2];
#pragma unroll
            for (int i = 0; i < 2; ++i) fa[i] = ldsfrag(Y + ((16 * i + fr) * 520 + 32 * (k4 + q) + 8 * fq) * 2);
#pragma unroll
            for (int i = 0; i < 2; ++i)
#pragma unroll
                for (int j = 0; j < 4; ++j) acc[i][j] = mfma16(fa[i], fb[q][j], acc[i][j]); } }
#pragma unroll
    for (int i = 0; i < 2; ++i)
#pragma unroll
        for (int e = 0; e < 4; ++e) { const int t = 16 * i + 4 * fq + e; float sq = 0.f;
#pragma unroll
            for (int j = 0; j < 4; ++j) { const int col = 64 * wave + 16 * j + fr; const float yv = bf2f(*(const LAS bf16*)(Y + (t * 520 + col) * 2));
                const float o = yv * sigmoid_f(acc[i][j][e] + bgl[j]); acc[i][j][e] = o; sq += o * o; }
            sq = sum16(sq); if (fr == 0) SQ[wave * 32 + t] = sq; }
    BLOCK_SYNC();
    bf16* mix = (bf16*)(ws + WS_MIX);
#pragma unroll
    for (int i = 0; i < 2; ++i)
#pragma unroll
        for (int e = 0; e < 4; ++e) { const int t = 16 * i + 4 * fq + e; float sq = 0.f;
#pragma unroll
            for (int w = 0; w < 8; ++w) sq += SQ[w * 32 + t];
            const float rs = __builtin_amdgcn_rsqf(sq * (1.0f / 512.0f) + EPS);
#pragma unroll
            for (int j = 0; j < 4; ++j) mix[(size_t)(grow0 + t) * D + 512 + 64 * wave + 16 * j + fr] = f2b(acc[i][j][e] * rs); }
    BLOCK_SYNC();
}


#define RELANE() do { asm volatile("" : "+v"(tid)); lane = tid & 63; fr = lane & 15; fq = lane >> 4; } while (0)
__device__ __forceinline__ void mc_rest_unit(const Args& A, LAS unsigned char* lds, int l, int b, int c, int tid, int lane, int wave) {
    asm volatile("" : "+v"(tid)); lane = tid & 63; wave = __builtin_amdgcn_readfirstlane(tid >> 6);
    unsigned char* ws = A.ws; const bf16* proj = (const bf16*)(ws + WS_PROJ); const float* DTV = (const float*)(ws + WS_DTV); bf16* mix = (bf16*)(ws + WS_MIX);
    LAS float* AC = (LAS float*)lds; LAS float* DTs = (LAS float*)(lds + 2048); LAS float* SQ = (LAS float*)(lds + 96768); LAS float* SQ2 = (LAS float*)(lds + 98816);
    LAS unsigned char* XT = lds + 4608; LAS unsigned char* BMs = lds + 41472; LAS unsigned char* CMs = lds + 50688; LAS unsigned char* PW = lds + 59904 + wave * 4608;
    LAS unsigned char* PL = lds + 4608;
    const int grow0 = b * T + c * SSD_L; int fr = lane & 15, fq = lane >> 4; const bool first = (c == 0), lastc = (c == SSD_NC - 1);
    const float* cw = A.in[I_CONV_W] + l * 4 * 768; const float* cb = A.in[I_CONV_B] + l * 768;
    { const float an = -expf(A.in[I_A_LOG][l * 8 + wave]); const float dt = DTV[(size_t)(grow0 + lane) * 8 + wave];
        AC[wave * 64 + lane] = wave_scan_incl(dt * an, lane); DTs[wave * 64 + lane] = dt; }
    BLOCK_SYNC();
    f32x4 yv[2][2][4];
#pragma unroll
    for (int half = 0; half < 2; ++half) {
        RELANE();
        { const int t0 = 8 * wave; float xs[8][4]; conv8<4>(proj, cw, cb, grow0, t0, first, 256 * half + 4 * lane, xs);
            const int hl = lane >> 4, p0 = 4 * (lane & 15);
#pragma unroll
            for (int e = 0; e < 4; ++e) { v4u w; w.x = cvtpk(xs[0][e], xs[1][e]); w.y = cvtpk(xs[2][e], xs[3][e]); w.z = cvtpk(xs[4][e], xs[5][e]); w.w = cvtpk(xs[6][e], xs[7][e]);
                *(LAS v4u*)(XT + ((hl * 64 + p0 + e) * 72 + t0) * 2) = w; }
            float bc[8][2]; const int isc = lane >> 5, n0 = 2 * (lane & 31); conv8<2>(proj, cw, cb, grow0, t0, first, 512 + 128 * isc + 64 * half + n0, bc);
            LAS unsigned char* dst = isc ? CMs : BMs;
#pragma unroll
            for (int i = 0; i < 8; ++i) *(LAS unsigned*)(dst + ((t0 + i) * 72 + n0) * 2) = cvtpk(bc[i][0], bc[i][1]); }
        BLOCK_SYNC(); RELANE();
        { const int hl = wave >> 1, th = wave & 1, h = 4 * half + hl;
#pragma unroll
            for (int rt = 0; rt < 2; ++rt) { const bf16x8 fc0 = ldsfrag(CMs + ((32 * th + 16 * rt + fr) * 72 + 8 * fq) * 2), fc1 = ldsfrag(CMs + ((32 * th + 16 * rt + fr) * 72 + 32 + 8 * fq) * 2);
#pragma unroll
                for (int st = 0; st < 4; ++st) { f32x4 g = (f32x4){0.f, 0.f, 0.f, 0.f};
                    g = mfma16(fc0, ldsfrag(BMs + ((16 * st + fr) * 72 + 8 * fq) * 2), g); g = mfma16(fc1, ldsfrag(BMs + ((16 * st + fr) * 72 + 32 + 8 * fq) * 2), g);
                    const int s = 16 * st + fr; const float as = AC[h * 64 + s], ds = DTs[h * 64 + s];
#pragma unroll
                    for (int e = 0; e < 4; ++e) { const int tl = 16 * rt + 4 * fq + e, t = 32 * th + tl; const float pv = (s <= t) ? g[e] * __expf(AC[h * 64 + t] - as) * ds : 0.f;
                        *(LAS bf16*)(PW + (tl * 72 + s) * 2) = f2b(pv); } asm volatile("" ::: "memory"); } }
            WAVE_SYNC(); RELANE();
            const float* HP = (const float*)(ws + WS_SS) + ((size_t)(b * SSD_NC + c) * 8 + h) * 4096; float dsk = A.in[I_SSD_D][l * 8 + h]; float sqp[2][4];
            bf16x8 hpf[4][2];
            { f32x4 hq[4][4];
#pragma unroll
                for (int pt = 0; pt < 4; ++pt) { const float* hp = HP + (16 * pt + fr) * 64 + 8 * fq; hq[pt][0] = *(const GAS f32x4*)hp; hq[pt][1] = *(const GAS f32x4*)(hp + 4); hq[pt][2] = *(const GAS f32x4*)(hp + 32); hq[pt][3] = *(const GAS f32x4*)(hp + 36); }
#pragma unroll
                for (int pt = 0; pt < 4; ++pt)
#pragma unroll
                    for (int q = 0; q < 4; ++q) PIN(hq[pt][q]);
#pragma unroll
                for (int pt = 0; pt < 4; ++pt) { hpf[pt][0] = pack8(hq[pt][0], hq[pt][1]); hpf[pt][1] = pack8(hq[pt][2], hq[pt][3]); } }
            PIN(dsk);
#pragma unroll
            for (int rt = 0; rt < 2; ++rt) { const bf16x8 fp0 = ldsfrag(PW + ((16 * rt + fr) * 72 + 8 * fq) * 2), fp1 = ldsfrag(PW + ((16 * rt + fr) * 72 + 32 + 8 * fq) * 2);
                const bf16x8 fc0 = ldsfrag(CMs + ((32 * th + 16 * rt + fr) * 72 + 8 * fq) * 2), fc1 = ldsfrag(CMs + ((32 * th + 16 * rt + fr) * 72 + 32 + 8 * fq) * 2);
                unsigned zr[4][4];
#pragma unroll
                for (int pt = 0; pt < 4; ++pt)
#pragma unroll
                    for (int e = 0; e < 4; ++e) zr[pt][e] = (unsigned)proj[(size_t)(grow0 + 32 * th + 16 * rt + 4 * fq + e) * NIN + C_Z + 64 * h + 16 * pt + fr];
#pragma unroll
                for (int pt = 0; pt < 4; ++pt)
#pragma unroll
                    for (int e = 0; e < 4; ++e) PIN(zr[pt][e]);
#pragma unroll
                for (int e = 0; e < 4; ++e) sqp[rt][e] = 0.f;
#pragma unroll
                for (int pt = 0; pt < 4; ++pt) { const int p = 16 * pt + fr; f32x4 y = (f32x4){0.f, 0.f, 0.f, 0.f}, yo = (f32x4){0.f, 0.f, 0.f, 0.f};
                    y = mfma16(fp0, ldsfrag(XT + ((hl * 64 + p) * 72 + 8 * fq) * 2), y); y = mfma16(fp1, ldsfrag(XT + ((hl * 64 + p) * 72 + 32 + 8 * fq) * 2), y);
                    yo = mfma16(fc0, hpf[pt][0], yo); yo = mfma16(fc1, hpf[pt][1], yo);
                    const v2u xw = *(const LAS v2u*)(XT + ((hl * 64 + p) * 72 + 32 * th + 16 * rt + 4 * fq) * 2); const float xv[4] = {bf_lo(xw.x), bf_hi(xw.x), bf_lo(xw.y), bf_hi(xw.y)};
#pragma unroll
                    for (int e = 0; e < 4; ++e) { const int t = 32 * th + 16 * rt + 4 * fq + e; const float z = __uint_as_float(zr[pt][e] << 16);
                        const float v = (y[e] + __expf(AC[h * 64 + t]) * yo[e] + dsk * xv[e]) * silu_f(z); y[e] = v; sqp[rt][e] += v * v; }
                    yv[half][rt][pt] = y; }
#pragma unroll
                for (int e = 0; e < 4; ++e) { const float s = sum16(sqp[rt][e]); if (fr == 0) SQ[(half * 4 + hl) * 64 + 32 * th + 16 * rt + 4 * fq + e] = s; } } }
        BLOCK_SYNC();
    }
    RELANE();
    { const int hl = wave >> 1, th = wave & 1;
#pragma unroll
        for (int half = 0; half < 2; ++half)
#pragma unroll
            for (int rt = 0; rt < 2; ++rt)
#pragma unroll
                for (int e = 0; e < 4; ++e) { const int t = 32 * th + 16 * rt + 4 * fq + e; float sq = 0.f;
#pragma unroll
                    for (int w = 0; w < 8; ++w) sq += SQ[w * 64 + t];
                    const float rs = __builtin_amdgcn_rsqf(sq * (1.0f / 512.0f) + EPS);
#pragma unroll
                    for (int pt = 0; pt < 4; ++pt) mix[(size_t)(grow0 + t) * D + 64 * (4 * half + hl) + 16 * pt + fr] = f2b(yv[half][rt][pt][e] * rs); } }
    RELANE();
    { const int t0 = 8 * wave, ch = 8 * lane; v4u gcr[10], hvr[10], gbr[8]; float w[3][8];
#pragma unroll
        for (int r = 0; r < 10; ++r) { const int tt = t0 - 2 + r; const bf16* p = proj + (size_t)(grow0 + ((first && tt < 0) ? 0 : tt)) * NIN; gcr[r] = *(const GAS v4u*)(p + C_GC + ch); hvr[r] = *(const GAS v4u*)(p + C_HV + ch); }
#pragma unroll
        for (int i = 0; i < 8; ++i) gbr[i] = *(const GAS v4u*)(proj + (size_t)(grow0 + t0 + i) * NIN + C_GB + ch);
#pragma unroll
        for (int j = 0; j < 3; ++j)
#pragma unroll
            for (int e = 0; e < 8; ++e) w[j][e] = A.in[I_SC_W][(l * 3 + j) * 512 + ch + e];
#pragma unroll
        for (int r = 0; r < 10; ++r) { PIN(gcr[r]); PIN(hvr[r]); }
#pragma unroll
        for (int i = 0; i < 8; ++i) PIN(gbr[i]);
        float v2[8], v1[8];
#pragma unroll
        for (int r = 0; r < 10; ++r) { float gc[8], hv[8], v0[8]; unpack8(gcr[r], gc); unpack8(hvr[r], hv); const bool z = first && (t0 - 2 + r) < 0;
#pragma unroll
            for (int e = 0; e < 8; ++e) v0[e] = z ? 0.f : gc[e] * hv[e];
            if (r >= 2) { const int tt = t0 + r - 2; float gb[8], y[8]; unpack8(gbr[r - 2], gb); float sq = 0.f;
#pragma unroll
                for (int e = 0; e < 8; ++e) { y[e] = gb[e] * (w[0][e] * v2[e] + w[1][e] * v1[e] + w[2][e] * v0[e]); sq += y[e] * y[e]; }
                const float rs = __builtin_amdgcn_rsqf(wave_sum(sq) * (1.0f / 512.0f) + EPS);
                v4u o; o.x = cvtpk(y[0] * rs, y[1] * rs); o.y = cvtpk(y[2] * rs, y[3] * rs); o.z = cvtpk(y[4] * rs, y[5] * rs); o.w = cvtpk(y[6] * rs, y[7] * rs);
                *(GAS v4u*)(mix + (size_t)(grow0 + tt) * D + 1024 + ch) = o;
                if (lastc && tt >= 62) { float* o2 = A.out + O_PSC + ((size_t)(l * NB + b) * 2 + (tt - 62)) * 512 + ch; *(GAS f32x4*)o2 = (f32x4){v0[0], v0[1], v0[2], v0[3]}; *(GAS f32x4*)(o2 + 4) = (f32x4){v0[4], v0[5], v0[6], v0[7]}; } }
#pragma unroll
            for (int e = 0; e < 8; ++e) { v2[e] = v1[e]; v1[e] = v0[e]; } }
    }
    BLOCK_SYNC();
#pragma unroll 1
    for (int hh = 0; hh < 2; ++hh) { RELANE(); const int t0 = 8 * wave, ch = 4 * lane + 256 * hh, gI = ch >> 7;
        float u[23][4]; v2u ur[23];
#pragma unroll
        for (int r = 0; r < 23; ++r) { const int tt = t0 - 15 + r; ur[r] = *(const GAS v2u*)(proj + (size_t)(grow0 + ((first && tt < 0) ? 0 : tt)) * NIN + C_UP + ch); }
#pragma unroll
        for (int r = 0; r < 23; ++r) PIN(ur[r]);
#pragma unroll
        for (int r = 0; r < 23; ++r) { const bool z = first && (t0 - 15 + r) < 0; u[r][0] = z ? 0.f : bf_lo(ur[r].x); u[r][1] = z ? 0.f : bf_hi(ur[r].x); u[r][2] = z ? 0.f : bf_lo(ur[r].y); u[r][3] = z ? 0.f : bf_hi(ur[r].y); }
        const int win = 2 << gI;
#pragma unroll
        for (int i = 0; i < 8; ++i) { const int r = 15 + i; float pv[4]; const int pos = c * SSD_L + t0 + i; const float inv = 1.0f / (float)(pos + 1 < win ? pos + 1 : win);
#pragma unroll
            for (int e = 0; e < 4; ++e) { const float s2 = u[r][e] + u[r - 1][e], s4 = s2 + u[r - 2][e] + u[r - 3][e], s8 = s4 + (u[r - 4][e] + u[r - 5][e]) + (u[r - 6][e] + u[r - 7][e]);
                const float s16 = s8 + ((u[r - 8][e] + u[r - 9][e]) + (u[r - 10][e] + u[r - 11][e])) + ((u[r - 12][e] + u[r - 13][e]) + (u[r - 14][e] + u[r - 15][e]));
                const float cs = gI == 0 ? s2 : gI == 1 ? s4 : gI == 2 ? s8 : s16; pv[e] = cs * inv - u[r][e]; }
            v2u o; o.x = cvtpk(pv[0], pv[1]); o.y = cvtpk(pv[2], pv[3]); *(LAS v2u*)(PL + ((t0 + i) * 520 + ch) * 2) = o;
            if (lastc && t0 + i >= 49) *(GAS f32x4*)(A.out + O_PPOOL + ((size_t)(l * NB + b) * 15 + (t0 + i - 49)) * 512 + ch) = (f32x4){u[r][0], u[r][1], u[r][2], u[r][3]}; }
    }
    BLOCK_SYNC(); RELANE();
    { const int gI = wave >> 1, dh = wave & 1; const bf16* wp = (const bf16*)(ws + WS_TAB + (size_t)l * TAB_L + TB_WPT) + (size_t)gI * 128 * 128; f32x4 acc[4][4];
#pragma unroll
        for (int i = 0; i < 4; ++i)
#pragma unroll
            for (int j = 0; j < 4; ++j) acc[i][j] = (f32x4){0.f, 0.f, 0.f, 0.f};
        bf16x8 fbw[4][4]; float psc[4];
#pragma unroll
        for (int ks = 0; ks < 4; ++ks)
#pragma unroll
            for (int j = 0; j < 4; ++j) fbw[ks][j] = gfrag(wp + sfrag(64 * dh + 16 * j, 32 * ks, 128) + 8 * lane);
#pragma unroll
        for (int j = 0; j < 4; ++j) psc[j] = A.in[I_POOL_SCALE][l * 512 + 128 * gI + 64 * dh + 16 * j + fr];
#pragma unroll
        for (int ks = 0; ks < 4; ++ks)
#pragma unroll
            for (int j = 0; j < 4; ++j) PIN(fbw[ks][j]);
#pragma unroll
        for (int ks = 0; ks < 4; ++ks) { bf16x8 fa[4];
#pragma unroll
            for (int i = 0; i < 4; ++i) fa[i] = ldsfrag(PL + ((16 * i + fr) * 520 + 128 * gI + 32 * ks + 8 * fq) * 2);
#pragma unroll
            for (int i = 0; i < 4; ++i)
#pragma unroll
                for (int j = 0; j < 4; ++j) acc[i][j] = mfma16(fa[i], fbw[ks][j], acc[i][j]); }
#pragma unroll
        for (int i = 0; i < 4; ++i)
#pragma unroll
            for (int e = 0; e < 4; ++e) { float sq = 0.f;
#pragma unroll
                for (int j = 0; j < 4; ++j) { const float o = acc[i][j][e] * psc[j]; acc[i][j][e] = o; sq += o * o; }
                sq = sum16(sq); if (fr == 0) SQ2[wave * 64 + 16 * i + 4 * fq + e] = sq; }
        BLOCK_SYNC();
#pragma unroll
        for (int i = 0; i < 4; ++i)
#pragma unroll
            for (int e = 0; e < 4; ++e) { const int t = 16 * i + 4 * fq + e; float sq = 0.f;
#pragma unroll
                for (int w = 0; w < 8; ++w) sq += SQ2[w * 64 + t];
                const float rs = __builtin_amdgcn_rsqf(sq * (1.0f / 512.0f) + EPS);
#pragma unroll
                for (int j = 0; j < 4; ++j) mix[(size_t)(grow0 + t) * D + 1536 + 128 * gI + 64 * dh + 16 * j + fr] = f2b(acc[i][j][e] * rs); }
    }
    if (lastc) for (int i = tid; i < 3 * 768; i += NTHR) { const int r = i / 768, ch = i % 768; A.out[O_PCONV + ((size_t)(l * NB + b) * 3 + r) * 768 + ch] = bf2f(proj[(size_t)(grow0 + 61 + r) * NIN + C_XBC + ch]); }
    BLOCK_SYNC();
}

__device__ __forceinline__ void mc_sample_unit(const Args& A, LAS unsigned char* lds, int l, int s, int tid, int lane, int wave) {
    asm volatile("" : "+v"(tid)); lane = tid & 63; wave = __builtin_amdgcn_readfirstlane(tid >> 6);
    unsigned char* ws = A.ws; const bf16* proj = (const bf16*)(ws + WS_PROJ) + (size_t)(MP + s) * NIN; const unsigned char* tb = ws + WS_TAB + (size_t)l * TAB_L; float* out = A.out;
    LAS float* XC = (LAS float*)lds; LAS float* U5 = (LAS float*)(lds + 5120); LAS float* Y5 = (LAS float*)(lds + 7168); LAS float* PLs = (LAS float*)(lds + 9216); LAS float* OUT = (LAS float*)(lds + 11264); LAS float* ZP = (LAS float*)(lds + 19456);
    const int ls = l * MS + s;
    { const int c1 = tid < 256 ? tid + 512 : tid; const float* st0 = A.in[I_ST_CONV] + (size_t)ls * 3 * 768; const float* cw = A.in[I_CONV_W] + l * 4 * 768;
        float a[2][3], nwv[2], wv[2][4], bsv[2]; const int chs[2] = {tid, c1};
#pragma unroll
        for (int q = 0; q < 2; ++q) { const int ch = chs[q]; a[q][0] = st0[ch]; a[q][1] = st0[768 + ch]; a[q][2] = st0[1536 + ch]; nwv[q] = bf2f(proj[C_XBC + ch]); bsv[q] = A.in[I_CONV_B][l * 768 + ch];
#pragma unroll
            for (int j = 0; j < 4; ++j) wv[q][j] = cw[j * 768 + ch]; }
        float u5v = bf2f(proj[C_U5 + tid]);
#pragma unroll
        for (int q = 0; q < 2; ++q) { PIN(a[q][0]); PIN(a[q][1]); PIN(a[q][2]); PIN(nwv[q]); PIN(bsv[q]); PIN(wv[q][0]); PIN(wv[q][1]); PIN(wv[q][2]); PIN(wv[q][3]); }
        PIN(u5v);
#pragma unroll
        for (int q = 0; q < 2; ++q) if (q == 0 || tid < 256) { const int ch = chs[q]; XC[ch] = silu_f(bsv[q] + wv[q][0] * a[q][0] + wv[q][1] * a[q][1] + wv[q][2] * a[q][2] + wv[q][3] * nwv[q]);
            float* o = out + O_SCONV + (size_t)ls * 3 * 768 + ch; o[0] = a[q][1]; o[768] = a[q][2]; o[1536] = nwv[q]; }
        U5[tid] = u5v; }
    BLOCK_SYNC();
    { const int h = wave; const float dt = ((const float*)(ws + WS_DTV))[(size_t)(MP + s) * 8 + h], dec = expf(-dt * expf(A.in[I_A_LOG][l * 8 + h])), dsk = A.in[I_SSD_D][l * 8 + h];
        const int n4 = 4 * (lane & 15); const f32x4 Bv = *(const LAS f32x4*)(XC + 512 + 64 * (h >> 2) + n4), Cv = *(const LAS f32x4*)(XC + 640 + 64 * (h >> 2) + n4);
        const size_t o0 = (((size_t)ls * 8 + h) * 64 + (lane >> 4)) * 64 + n4; f32x4 h0[16]; unsigned zr[16];
#pragma unroll
        for (int it = 0; it < 16; ++it) { h0[it] = __builtin_nontemporal_load((const GAS f32x4*)(A.in[I_ST_SSD] + o0 + (size_t)it * 256)); zr[it] = (unsigned)proj[C_Z + 64 * h + it * 4 + (lane >> 4)]; }
#pragma unroll
        for (int it = 0; it < 16; ++it) { PIN(h0[it]); PIN(zr[it]); }
#pragma unroll
        for (int it = 0; it < 16; ++it) { const int p = it * 4 + (lane >> 4); const float x = XC[64 * h + p]; const f32x4 hn = h0[it] * dec + Bv * (dt * x);
            __builtin_nontemporal_store(hn, (GAS f32x4*)(out + O_SSSD + o0 + (size_t)it * 256));
            float y = (hn.x * Cv.x + hn.y * Cv.y) + (hn.z * Cv.z + hn.w * Cv.w); y = sum16(y);
            if ((lane & 15) == 0) OUT[64 * h + p] = (y + dsk * x) * silu_f(__uint_as_float(zr[it] << 16)); } }
#pragma unroll 1
    for (int gi = 0; gi < 4; ++gi) { const int g = 4 * wave + gi; const f32x2* bb = (const f32x2*)(tb + TB_BBAR) + (size_t)g * 16 * 64 + lane; f32x2 bv[16]; float cr[16], ci[16];
        const float* cre = A.in[I_C_RE] + ((size_t)l * 32 + g) * 1024 + lane; const float* cim = A.in[I_C_IM] + ((size_t)l * 32 + g) * 1024 + lane;
#pragma unroll
        for (int k = 0; k < 16; ++k) { bv[k] = bb[k * 64]; cr[k] = cre[k * 64]; ci[k] = cim[k * 64]; }
        f32x2 a = ((const f32x2*)(tb + TB_ABAR))[g * 64 + lane]; const size_t o = ((size_t)ls * 32 + g) * 64 + lane; float h0r = A.in[I_ST_S5R][o], h0i = A.in[I_ST_S5I][o]; float dv = A.in[I_S5_D][l * 512 + 16 * g + (lane & 15)];
        PIN(a); PIN(h0r); PIN(h0i); PIN(dv);
#pragma unroll
        for (int k = 0; k < 16; ++k) { PIN(bv[k]); PIN(cr[k]); PIN(ci[k]); }
        float br = 0.f, bi = 0.f;
#pragma unroll
        for (int k = 0; k < 16; ++k) { const float u = U5[16 * g + k]; br += bv[k].x * u; bi += bv[k].y * u; }
        const float hr = a.x * h0r - a.y * h0i + br, hi = a.x * h0i + a.y * h0r + bi; out[O_SS5R + o] = hr; out[O_SS5I + o] = hi;
        float mine = 0.f;
#pragma unroll
        for (int k = 0; k < 16; ++k) { const float v = wave_sum(cr[k] * hr - ci[k] * hi); mine = (lane == k) ? v : mine; }
        if (lane < 16) Y5[16 * g + lane] = gelu_tanh_f(mine + dv * U5[16 * g + lane]); }
    { const int c = tid, gI = c >> 7, win = 2 << gI; const float* st = A.in[I_ST_SC] + (size_t)ls * 2 * 512 + c; const float* w = A.in[I_SC_W] + l * 3 * 512 + c; const float* sp = A.in[I_ST_POOL] + (size_t)ls * 15 * 512 + c;
        float s0 = st[0], s1 = st[512], gc = bf2f(proj[C_GC + c]), hvv = bf2f(proj[C_HV + c]), gb = bf2f(proj[C_GB + c]), w0 = w[0], w1 = w[512], w2 = w[1024], u = bf2f(proj[C_UP + c]); float hh[15];
#pragma unroll
        for (int r = 0; r < 15; ++r) hh[r] = sp[r * 512];
        PIN(s0); PIN(s1); PIN(gc); PIN(hvv); PIN(gb); PIN(w0); PIN(w1); PIN(w2); PIN(u);
#pragma unroll
        for (int r = 0; r < 15; ++r) PIN(hh[r]);
        const float v = gc * hvv; OUT[1024 + c] = gb * (w0 * s0 + w1 * s1 + w2 * v); float* o = out + O_SSC + (size_t)ls * 2 * 512 + c; o[0] = s1; o[512] = v;
        float* op = out + O_SPOOL + (size_t)ls * 15 * 512 + c; float sum = u;
#pragma unroll
        for (int r = 0; r < 15; ++r) { if (15 - r < win) sum += hh[r]; if (r > 0) op[(r - 1) * 512] = hh[r]; }
        op[14 * 512] = u; PLs[c] = sum / (float)win - u; }
    BLOCK_SYNC();
    { const int ig = tid >> 7, j4 = tid & 127; const float* wg = A.in[I_W_GLU] + (size_t)l * 512 * 512 + (size_t)(128 * ig) * 512 + 4 * j4; f32x4 z = (f32x4){0.f, 0.f, 0.f, 0.f};
#pragma unroll 1
        for (int i0 = 0; i0 < 128; i0 += 32) { f32x4 wv[32];
#pragma unroll
            for (int i = 0; i < 32; ++i) wv[i] = *(const GAS f32x4*)(wg + (size_t)(i0 + i) * 512);
#pragma unroll
            for (int i = 0; i < 32; ++i) PIN(wv[i]);
#pragma unroll
            for (int i = 0; i < 32; ++i) z += wv[i] * Y5[128 * ig + i0 + i]; }
        *(LAS f32x4*)(ZP + ig * 512 + 4 * j4) = z;
        const int gI = tid >> 7, d = tid & 127; const float* wp = A.in[I_POOL_W] + ((size_t)l * 4 + gI) * 128 * 128 + d; float acc = 0.f;
#pragma unroll 1
        for (int c0 = 0; c0 < 128; c0 += 32) { float wv[32];
#pragma unroll
            for (int c = 0; c < 32; ++c) wv[c] = wp[(c0 + c) * 128];
#pragma unroll
            for (int c = 0; c < 32; ++c) PIN(wv[c]);
#pragma unroll
            for (int c = 0; c < 32; ++c) acc += PLs[128 * gI + c0 + c] * wv[c]; }
        OUT[1536 + tid] = acc * A.in[I_POOL_SCALE][l * 512 + tid]; }
    BLOCK_SYNC();
    { const int j = tid; const float z = A.in[I_B_GLU][l * 512 + j] + (ZP[j] + ZP[512 + j]) + (ZP[1024 + j] + ZP[1536 + j]); OUT[512 + j] = Y5[j] * sigmoid_f(z); }
    BLOCK_SYNC();
    if (wave < 4) { float v[8]; float sq = 0.f;
#pragma unroll
        for (int e = 0; e < 8; ++e) { v[e] = OUT[512 * wave + 8 * lane + e]; sq += v[e] * v[e]; }
        const float rs = __builtin_amdgcn_rsqf(wave_sum(sq) * (1.0f / 512.0f) + EPS);
        v4u o; o.x = cvtpk(v[0] * rs, v[1] * rs); o.y = cvtpk(v[2] * rs, v[3] * rs); o.z = cvtpk(v[4] * rs, v[5] * rs); o.w = cvtpk(v[6] * rs, v[7] * rs);
        *(GAS v4u*)((bf16*)(ws + WS_SA + SA_MIX) + sfrag(s, 512 * wave + 8 * lane, D)) = o; }
    BLOCK_SYNC();
}

__device__ __forceinline__ void att_prompt_unit(const Args& A, LAS unsigned char* lds, int l, int b, int hd, int qb, int tid, int lane, int wave) {
    asm volatile("" : "+v"(tid)); lane = tid & 63; wave = __builtin_amdgcn_readfirstlane(tid >> 6);
    unsigned char* ws = A.ws; const int fr = lane & 15, fq = lane >> 4, grow0 = b * T + qb * 128;
    const bf16* Q = (const bf16*)(ws + WS_Q) + (size_t)grow0 * D + hd * HDX; const bf16* K = (const bf16*)(ws + WS_KB) + ((size_t)l * MROWS + b * NMEM) * D + hd * HDX;
    const bf16* V = (const bf16*)(ws + WS_VT) + (((size_t)l * NB + b) * D + hd * HDX) * NMEM; bf16* O = (bf16*)(ws + WS_O) + (size_t)grow0 * D + hd * HDX;
    LAS unsigned char* PS = lds; LAS unsigned char* KS = lds + 67584; LAS unsigned char* QS = lds + 104448; LAS unsigned char* VS = lds + 67584;
    f32x4 acc[16];
#pragma unroll
    for (int i = 0; i < 16; ++i) acc[i] = (f32x4){0.f, 0.f, 0.f, 0.f};
#pragma unroll 1
    for (int ds = 0; ds < 8; ++ds) {
        { v4u tk[4], tq[2];
#pragma unroll
            for (int i = 0; i < 4; ++i) { const int id = tid + NTHR * i, key = id >> 3, part = id & 7; tk[i] = *(const GAS v4u*)(K + (size_t)key * D + 64 * ds + 8 * part); }
#pragma unroll
            for (int i = 0; i < 2; ++i) { const int id = tid + NTHR * i, r = id >> 3, part = id & 7; tq[i] = *(const GAS v4u*)(Q + (size_t)r * D + 64 * ds + 8 * part); }
#pragma unroll
            for (int i = 0; i < 4; ++i) PIN(tk[i]);
            PIN(tq[0]); PIN(tq[1]);
#pragma unroll
            for (int i = 0; i < 4; ++i) { const int id = tid + NTHR * i, key = id >> 3, part = id & 7; *(LAS v4u*)(KS + (key * 72 + 8 * part) * 2) = tk[i]; }
#pragma unroll
            for (int i = 0; i < 2; ++i) { const int id = tid + NTHR * i, r = id >> 3, part = id & 7; *(LAS v4u*)(QS + (r * 72 + 8 * part) * 2) = tq[i]; } }
        BLOCK_SYNC();
#pragma unroll
        for (int ks = 0; ks < 2; ++ks) { const bf16x8 fa = ldsfrag(QS + ((16 * wave + fr) * 72 + 32 * ks + 8 * fq) * 2);
#pragma unroll
            for (int kt = 0; kt < 16; ++kt) acc[kt] = mfma16(fa, ldsfrag(KS + ((16 * kt + fr) * 72 + 32 * ks + 8 * fq) * 2), acc[kt]); }
        BLOCK_SYNC();
    }
    float inv[4]; const float scale = 0.044194173824159216f;
#pragma unroll
    for (int e = 0; e < 4; ++e) { float m = acc[0][e];
#pragma unroll
        for (int kt = 1; kt < 16; ++kt) m = fmaxf(m, acc[kt][e]);
        m = max16(m); float sum = 0.f;
#pragma unroll
        for (int kt = 0; kt < 16; ++kt) { const float p = __expf((acc[kt][e] - m) * scale); sum += p; *(LAS bf16*)(PS + ((16 * wave + 4 * fq + e) * 264 + 16 * kt + fr) * 2) = f2b(p); }
        inv[e] = __builtin_amdgcn_rcpf(sum16(sum)); }
#pragma unroll 1
    for (int ds = 0; ds < 8; ++ds) {
        { v4u tv[4];
#pragma unroll
            for (int i = 0; i < 4; ++i) { const int id = tid + NTHR * i, dr = id >> 5, part = id & 31; tv[i] = *(const GAS v4u*)(V + (size_t)(64 * ds + dr) * NMEM + 8 * part); }
#pragma unroll
            for (int i = 0; i < 4; ++i) PIN(tv[i]);
#pragma unroll
            for (int i = 0; i < 4; ++i) { const int id = tid + NTHR * i, dr = id >> 5, part = id & 31; *(LAS v4u*)(VS + (dr * 264 + 8 * part) * 2) = tv[i]; } }
        BLOCK_SYNC();
        f32x4 o[4] = {(f32x4){0.f, 0.f, 0.f, 0.f}, (f32x4){0.f, 0.f, 0.f, 0.f}, (f32x4){0.f, 0.f, 0.f, 0.f}, (f32x4){0.f, 0.f, 0.f, 0.f}};
#pragma unroll
        for (int ks = 0; ks < 8; ++ks) { const bf16x8 fa = ldsfrag(PS + ((16 * wave + fr) * 264 + 32 * ks + 8 * fq) * 2);
#pragma unroll
            for (int dt = 0; dt < 4; ++dt) o[dt] = mfma16(fa, ldsfrag(VS + ((16 * dt + fr) * 264 + 32 * ks + 8 * fq) * 2), o[dt]); }
#pragma unroll
        for (int dt = 0; dt < 4; ++dt)
#pragma unroll
            for (int e = 0; e < 4; ++e) O[(size_t)(16 * wave + 4 * fq + e) * D + 64 * ds + 16 * dt + fr] = f2b(o[dt][e] * inv[e]);
        BLOCK_SYNC();
    }
}
__device__ __forceinline__ void att_sample_unit(const Args& A, LAS unsigned char* lds, int l, int s, int hp, int tid, int lane, int wave) {
    asm volatile("" : "+v"(tid)); lane = tid & 63; wave = __builtin_amdgcn_readfirstlane(tid >> 6);
    unsigned char* ws = A.ws; const bf16* Q = (const bf16*)(ws + WS_Q) + (size_t)(MP + s) * D + hp * 1024;
    const float* K = A.in[I_CK] + (((size_t)l * MS + s) * NMEM) * D + hp * 1024; const float* V = A.in[I_CV] + (((size_t)l * MS + s) * NMEM) * D + hp * 1024;
    LAS float* SC = (LAS float*)lds; LAS float* RED = (LAS float*)(lds + 2048);
    f32x4 q[4];
#pragma unroll
    for (int j = 0; j < 4; ++j) { const v2u w = *(const GAS v2u*)(Q + 4 * lane + 256 * j); q[j] = (f32x4){bf_lo(w.x), bf_hi(w.x), bf_lo(w.y), bf_hi(w.y)}; }
#pragma unroll 1
    for (int kk = 0; kk < 32; kk += 8) { f32x4 kv[8][4];
        const char* kp = (const char*)(K + (size_t)(32 * wave + kk) * D) + (size_t)lane * 16; asm volatile("" : "+v"(kp));
#pragma unroll
        for (int i = 0; i < 8; ++i)
#pragma unroll
            for (int j = 0; j < 4; ++j) kv[i][j] = __builtin_nontemporal_load((const GAS f32x4*)(kp + (size_t)i * (D * 4) + j * 1024));
#pragma unroll
        for (int i = 0; i < 8; ++i)
#pragma unroll
            for (int j = 0; j < 4; ++j) PIN(kv[i][j]);
#pragma unroll
        for (int i = 0; i < 8; ++i) { const f32x4 a = kv[i][0], b2 = kv[i][1], c = kv[i][2], d = kv[i][3];
            float p0 = (a.x * q[0].x + a.y * q[0].y) + (a.z * q[0].z + a.w * q[0].w) + (b2.x * q[1].x + b2.y * q[1].y) + (b2.z * q[1].z + b2.w * q[1].w);
            float p1 = (c.x * q[2].x + c.y * q[2].y) + (c.z * q[2].z + c.w * q[2].w) + (d.x * q[3].x + d.y * q[3].y) + (d.z * q[3].z + d.w * q[3].w);
            p0 = wave_sum(p0); p1 = wave_sum(p1);
            if (lane == 0) { SC[32 * wave + kk + i] = p0; SC[256 + 32 * wave + kk + i] = p1; } } }
    BLOCK_SYNC();
    if (wave < 2) { const float scale = 0.044194173824159216f; float v[4]; float m = -3.0e38f;
#pragma unroll
        for (int e = 0; e < 4; ++e) { v[e] = SC[256 * wave + lane + 64 * e]; m = fmaxf(m, v[e]); }
        m = wave_max(m);
        float sum = 0.f;
#pragma unroll
        for (int e = 0; e < 4; ++e) { v[e] = __expf((v[e] - m) * scale); sum += v[e]; }
        const float inv = __builtin_amdgcn_rcpf(wave_sum(sum));
#pragma unroll
        for (int e = 0; e < 4; ++e) SC[256 * wave + lane + 64 * e] = v[e] * inv; }
    BLOCK_SYNC();
    f32x4 o[4] = {(f32x4){0.f, 0.f, 0.f, 0.f}, (f32x4){0.f, 0.f, 0.f, 0.f}, (f32x4){0.f, 0.f, 0.f, 0.f}, (f32x4){0.f, 0.f, 0.f, 0.f}};
#pragma unroll 1
    for (int kk = 0; kk < 32; kk += 8) { f32x4 vv[8][4];
        const char* vp = (const char*)(V + (size_t)(32 * wave + kk) * D) + (size_t)lane * 16; asm volatile("" : "+v"(vp));
#pragma unroll
        for (int i = 0; i < 8; ++i)
#pragma unroll
            for (int j = 0; j < 4; ++j) vv[i][j] = __builtin_nontemporal_load((const GAS f32x4*)(vp + (size_t)i * (D * 4) + j * 1024));
#pragma unroll
        for (int i = 0; i < 8; ++i)
#pragma unroll
            for (int j = 0; j < 4; ++j) PIN(vv[i][j]);
#pragma unroll
        for (int i = 0; i < 8; ++i) { const float p0 = SC[32 * wave + kk + i], p1 = SC[256 + 32 * wave + kk + i]; o[0] += vv[i][0] * p0; o[1] += vv[i][1] * p0; o[2] += vv[i][2] * p1; o[3] += vv[i][3] * p1; } }
#pragma unroll
    for (int j = 0; j < 4; ++j) *(LAS f32x4*)(RED + wave * 1024 + 4 * lane + 256 * j) = o[j];
    BLOCK_SYNC();
    { float a0 = 0.f, a1 = 0.f;
#pragma unroll
        for (int w = 0; w < 8; ++w) { const f32x2 v = *(const LAS f32x2*)(RED + w * 1024 + 2 * tid); a0 += v.x; a1 += v.y; }
        *(GAS unsigned*)((bf16*)(ws + WS_SA + SA_O) + sfrag(s, hp * 1024 + 2 * tid, D)) = cvtpk(a0, a1); }
    BLOCK_SYNC();
}

struct SEpiScale {
    bf16* O; int ldc; const unsigned long long* ssq; int act, frag;
    __device__ __forceinline__ void operator()(const f32x4& acc, int r, int c) const { const float rs = pg8::ssq_rstd(ssq[MP + r]); f32x4 v = acc * rs;
        if (act) {
#pragma unroll
            for (int e = 0; e < 4; ++e) { const float a = v[e] > 0.f ? v[e] : 0.f; v[e] = a * a; } }
        v2u w; w.x = cvtpk(v[0], v[1]); w.y = cvtpk(v[2], v[3]); *(GAS v2u*)(O + (frag ? sfrag(r, c, ldc) : (size_t)(MP + r) * ldc + c)) = w; }
};
struct SEpiRes {
    const float* hin; float* h; bf16* hb; bf16* hbf; unsigned long long* ssq_out;
    __device__ __forceinline__ void operator()(const f32x4& acc, int r, int c) const { float* hp = h + (size_t)(MP + r) * D + c; const f32x4 v = *(const GAS f32x4*)(hin + (size_t)r * D + c) + acc; *(GAS f32x4*)hp = v;
        v2u w; w.x = cvtpk(v[0], v[1]); w.y = cvtpk(v[2], v[3]); *(GAS v2u*)(hb + (size_t)(MP + r) * D + c) = w; *(GAS v2u*)(hbf + sfrag(r, c, D)) = w;
        float sq = (v[0] * v[0] + v[1] * v[1]) + (v[2] * v[2] + v[3] * v[3]); sq += __shfl_xor(sq, 16); sq += __shfl_xor(sq, 32);
        if ((threadIdx.x & 48) == 0) pg8::ssq_add(ssq_out + MP + r, sq); }
};
constexpr int SG_RED_OFF = 32 * 4112;
static_assert(SG_RED_OFF + 4096 <= LDSCTL_OFF, "sample_gemm LDS");
template <int ROWS, class Epi> __device__ __forceinline__ void sample_gemm(LAS unsigned char* lds, const bf16* Af, const bf16* Bt, int N, int K, const Epi& E, int nwg_main, int kq, int bx, int G, int tid) {
    asm volatile("" : "+v"(tid)); const int lane = tid & 63, wave = __builtin_amdgcn_readfirstlane(tid >> 6), fr = lane & 15, fq = lane >> 4;
    constexpr int RG = 128 / ROWS;
    const int first = nwg_main % G, ns = first ? G - first : G, nunits = (N / 32) * RG;
    int u0, st, cnt;
    if (first == 0) { u0 = bx; st = G; cnt = u0 < nunits ? (nunits - u0 + st - 1) / st : 0; }
    else if (bx >= first) { u0 = bx - first; st = ns; cnt = u0 < nunits ? (nunits - u0 + st - 1) / st : 0; cnt = cnt < kq ? cnt : kq; }
    else { u0 = ns * kq + bx; st = first; cnt = u0 < nunits ? (nunits - u0 + st - 1) / st : 0; }
    if (cnt == 0) return;
    const int rtl = ROWS == 128 ? wave : ((wave & 3) >> 1), ctw = ROWS == 128 ? 0 : (wave & 1), kh = ROWS == 128 ? 0 : (wave >> 2);
#pragma unroll 1
    for (int j = 0; j < cnt; ++j) { const int u = u0 + j * st, cg = u / RG, rg = u % RG, c0 = 32 * cg, R = rg * (ROWS / 16) + rtl;
        f32x4 acc0 = (f32x4){0.f, 0.f, 0.f, 0.f}, acc1 = (f32x4){0.f, 0.f, 0.f, 0.f};
#pragma unroll 1
        for (int kc = 0; kc < K; kc += 2048) {
            const char* apu = (const char*)(Af + ((size_t)(R * (K >> 5) + ((kc + kh * 1024) >> 5)) << 9)) + (size_t)lane * 16; asm volatile("" : "+v"(apu));
            const char* bsrc = (const char*)(Bt + (size_t)(c0 + 4 * wave) * K + kc) + (size_t)lane * 16; asm volatile("" : "+v"(bsrc));
            LAS unsigned char* bdst = lds + wave * (4 * 4112);
            BLOCK_SYNC();
#pragma unroll
            for (int r = 0; r < 4; ++r) { const char* rowp = bsrc + (size_t)r * K * 2; asm volatile("" : "+v"(rowp));
#pragma unroll
                for (int seg = 0; seg < 4; ++seg) __builtin_amdgcn_global_load_lds((const unsigned*)(rowp + seg * 1024), (LAS unsigned*)(bdst + r * 4112 + seg * 1024), 16, 0, 0); }
            bf16x8 a[32];
#pragma unroll
            for (int i = 0; i < 32; ++i) a[i] = *(const bf16x8*)(apu + (size_t)i * 1024);
#pragma unroll
            for (int i = 0; i < 32; ++i) PIN(a[i]);
            BLOCK_SYNC();
            if constexpr (ROWS == 32) {
                const LAS unsigned char* bp = lds + (16 * ctw + fr) * 4112 + kh * 2048 + 16 * fq;
#pragma unroll
                for (int i = 0; i < 32; i += 2) { acc0 = mfma16(ldsfrag(bp + 64 * i), a[i], acc0); acc1 = mfma16(ldsfrag(bp + 64 * (i + 1)), a[i + 1], acc1); }
            } else {
                const LAS unsigned char* bp = lds + fr * 4112 + 16 * fq;
#pragma unroll
                for (int i = 0; i < 32; ++i) { acc0 = mfma16(ldsfrag(bp + 64 * i), a[i], acc0); acc1 = mfma16(ldsfrag(bp + 16 * 4112 + 64 * i), a[i], acc1); }
                const char* apu2 = apu + 32 * 1024; asm volatile("" : "+v"(apu2), "+v"(acc0), "+v"(acc1));
#pragma unroll
                for (int i = 0; i < 32; ++i) a[i] = *(const bf16x8*)(apu2 + (size_t)i * 1024);
#pragma unroll
                for (int i = 0; i < 32; ++i) PIN(a[i]);
#pragma unroll
                for (int i = 0; i < 32; ++i) { acc0 = mfma16(ldsfrag(bp + 64 * (32 + i)), a[i], acc0); acc1 = mfma16(ldsfrag(bp + 16 * 4112 + 64 * (32 + i)), a[i], acc1); }
            } }
        if constexpr (ROWS == 32) {
            f32x4 acc = acc0 + acc1; LAS f32x4* red = (LAS f32x4*)(lds + SG_RED_OFF) + (wave & 3) * 64 + lane;
            if (kh == 1) *red = acc;
            BLOCK_SYNC();
            if (kh == 0) { acc += *red; E(acc, 32 * rg + 16 * rtl + fr, c0 + 16 * ctw + 4 * fq); }
        } else { E(acc0, 16 * wave + fr, c0 + 4 * fq); E(acc1, 16 * wave + fr, c0 + 16 + 4 * fq); } }
    BLOCK_SYNC();
}

__device__ __forceinline__ void final_norm(const Args& A, int vcu, int G, int wave, int lane, int mb = 0) {
    asm volatile("" : "+v"(lane));
    unsigned char* ws = A.ws; const float* H = (const float*)(ws + WS_H); const unsigned long long* ssq = (const unsigned long long*)((const unsigned*)(ws + WS_CTL) + CW_SSQ) + 6 * MPAD; const int gw = vcu * NWAVES + wave, NGW = G * NWAVES;
    f32x4 g[8];
#pragma unroll
    for (int j = 0; j < 8; ++j) g[j] = ((const GAS f32x4*)A.in[I_G_FINAL])[lane + 64 * j];
#pragma unroll 1
    for (int m0 = mb + gw; m0 < MR; m0 += 2 * NGW) { const int m1 = m0 + NGW; const bool has1 = m1 < MR; const int m1c = has1 ? m1 : m0;
        const GAS f32x4* h0 = (const GAS f32x4*)(H + (size_t)m0 * D) + lane; const GAS f32x4* h1 = (const GAS f32x4*)(H + (size_t)m1c * D) + lane; f32x4 v0[8], v1[8];
        const GAS v2u* b0 = (const GAS v2u*)((const bf16*)(ws + WS_HB) + (size_t)m0 * D) + lane; const GAS v2u* b1 = (const GAS v2u*)((const bf16*)(ws + WS_HB) + (size_t)m1c * D) + lane;
        if (m0 < MP) {
#pragma unroll
            for (int j = 0; j < 8; ++j) { const v2u w = b0[64 * j]; v0[j] = (f32x4){bf_lo(w.x), bf_hi(w.x), bf_lo(w.y), bf_hi(w.y)}; } }
        else {
#pragma unroll
            for (int j = 0; j < 8; ++j) v0[j] = __builtin_nontemporal_load(h0 + 64 * j); }
        if (m1c < MP) {
#pragma unroll
            for (int j = 0; j < 8; ++j) { const v2u w = b1[64 * j]; v1[j] = (f32x4){bf_lo(w.x), bf_hi(w.x), bf_lo(w.y), bf_hi(w.y)}; } }
        else {
#pragma unroll
            for (int j = 0; j < 8; ++j) v1[j] = __builtin_nontemporal_load(h1 + 64 * j); }
        const float rs0 = pg8::ssq_rstd(ssq[m0]), rs1 = pg8::ssq_rstd(ssq[m1c]);
#pragma unroll
        for (int j = 0; j < 8; ++j) { PIN(v0[j]); PIN(v1[j]); }
        GAS f32x4* o0 = (GAS f32x4*)(A.out + (m0 < MP ? O_YP + (size_t)m0 * D : O_YS + (size_t)(m0 - MP) * D)) + lane;
#pragma unroll
        for (int j = 0; j < 8; ++j) __builtin_nontemporal_store(v0[j] * g[j] * rs0, o0 + 64 * j);
        if (has1) { GAS f32x4* o1 = (GAS f32x4*)(A.out + (m1 < MP ? O_YP + (size_t)m1 * D : O_YS + (size_t)(m1 - MP) * D)) + lane;
#pragma unroll
            for (int j = 0; j < 8; ++j) __builtin_nontemporal_store(v1[j] * g[j] * rs1, o1 + 64 * j); } }
}

#ifndef PROBE_P0
#define PROBE_P0 1
#endif
#ifndef PROBE_MA
#define PROBE_MA 1
#endif
#ifndef PROBE_MC
#define PROBE_MC 1
#endif
#ifndef PROBE_ATT
#define PROBE_ATT 1
#endif
#ifndef PROBE_BAR
#define PROBE_BAR 1
#endif
#ifndef PROBE_KV
#define PROBE_KV 1
#endif
#ifndef PROBE_RES_O
#define PROBE_RES_O 0
#endif
#ifndef PROBE_RES_DOWN
#define PROBE_RES_DOWN 0
#endif
#ifndef PROBE_THIN
#define PROBE_THIN 0
#endif
#ifndef PROBE_SG_IN
#define PROBE_SG_IN 1
#endif
#ifndef PROBE_SG_Q
#define PROBE_SG_Q 1
#endif
#ifndef PROBE_SG_UP
#define PROBE_SG_UP 1
#endif
#ifndef PROBE_UP
#define PROBE_UP 1
#endif
#ifndef PROBE_Q
#define PROBE_Q 1
#endif
constexpr int PH_PER_LAYER = 10, PH_L0 = 3, PH_FINAL = PH_L0 + NL * PH_PER_LAYER, NPHASE = PH_FINAL + 1;
__global__ void __launch_bounds__(NTHR, 2) mk_fwd(Args args) {
    extern __shared__ __attribute__((aligned(16))) unsigned char lds_raw[];
    LAS unsigned char* lds = (LAS unsigned char*)lds_raw;
    volatile LAS unsigned* MISC = (volatile LAS unsigned*)(lds + MISC_OFF);
    int tid = threadIdx.x, lane = tid & 63, wave = __builtin_amdgcn_readfirstlane(tid >> 6);
#define RETID() do { asm volatile("" : "+v"(tid)); lane = tid & 63; wave = __builtin_amdgcn_readfirstlane(tid >> 6); asm volatile("" : "+s"(ws)); } while (0)
    const int G = gridDim.x; const int bx = blockIdx.x; const int vcu = (G % 8 == 0) ? (bx % 8) * (G / 8) + bx / 8 : bx;
    unsigned char* ws = args.ws;
    for (int u = tid; u < (LDS_BYTES - LDSCTL_OFF) / 4; u += NTHR) ((LAS unsigned*)(lds + LDSCTL_OFF))[u] = 0u;
    __syncthreads();
    XcdBarrier bar; bar.bar = (unsigned*)(ws + WS_CTL) + CW_BAR; bar.x = 0; bar.st = nullptr;
    if (!MK_PER_PHASE) bar = xcd_barrier_post((unsigned*)(ws + WS_CTL) + CW_BAR, MISC + 8);
    const int lo = args.ph_lo, hi = args.ph_hi;
#ifdef ONLY_PH
#define IN(k) (((k) < PH_L0 || (k) >= PH_FINAL) ? ((k) == ONLY_PH) : (((k) - PH_L0) % PH_PER_LAYER + PH_L0 == ONLY_PH) && lo <= (k) && (k) < hi)
#else
#define IN(k) (lo <= (k) && (k) < hi)
#endif
#define GRID_BAR() do { if (!MK_PER_PHASE) { for (int rep_ = 0; rep_ < PROBE_BAR; ++rep_) xcd_barrier(bar); } } while (0)
#define SSQ(s) ((unsigned long long*)((unsigned*)(ws + WS_CTL) + CW_SSQ) + (s) * MPAD)
    if (IN(0)) { RETID(); for (int rep = 0; rep < PROBE_P0; ++rep) { p0_prologue(args, lds, vcu, G, wave, lane); __syncthreads(); } GRID_BAR(); }
    if (IN(1)) { RETID();
        pg8::Gemm g{(const bf16*)(ws + WS_MEMB), (const bf16*)(ws + WS_WKV), MROWS, 4 * D, D}; pg8::StaticOrder S; S.init(MROWS, 4 * D, G, bx);
        pg8::EpiKV E{args.out + O_PMK, (size_t)(O_PMV - O_PMK), (bf16*)(ws + WS_KB), (bf16*)(ws + WS_VT), (bf16*)(ws + WS_VB), (const float*)(ws + WS_RSTDM)};
        for (int rep = 0; rep < PROBE_KV; ++rep) pg8::gemm_phase<pg8::EpiKV, pg8::StaticOrder, true, true>(lds + RING_OFF, g, S, E, tid);
        if (G == 256 && bx >= 128) p0_weights(args, lds, (bx - 128) * NWAVES + wave, 128 * NWAVES, P0W_DEF_LO, P0W_DEF_N, 1 << 30, 0, wave, lane);
        GRID_BAR(); }
#define SETUP_LAYER(LL, GG, CC) do { const int ll_ = (LL); pg8::Gemm g{nullptr, nullptr, 1024, 2048, 512, 2048, 2048}; \
        pg8::PreOrder S{(GG), (CC), (const bf16*)(ws + WS_KB) + (size_t)ll_ * 1024 * 2048, (const bf16*)(ws + WS_WQKD) + (size_t)ll_ * 2048 * 2048, (const bf16*)(ws + WS_W + (size_t)ll_ * W_L + WO_O), (const bf16*)(ws + WS_VB) + (size_t)ll_ * 1024 * 2048}; \
        pg8::EpiPre E{(bf16*)(ws + WS_WQK) + (size_t)ll_ * 4 * 1024 * 2048, (bf16*)(ws + WS_VWT) + (size_t)ll_ * 4 * 2048 * 1024}; \
        pg8::gemm_phase<pg8::EpiPre, pg8::PreOrder, true, true>(lds + RING_OFF, g, S, E, tid); } while (0)
    if (IN(2)) { RETID();
        SETUP_LAYER(0, G, bx);
        SETUP_LAYER(1, G, bx);
        GRID_BAR(); }
#pragma unroll 1
    for (int l = 0; l < NL; ++l) {
        const int pb = PH_L0 + l * PH_PER_LAYER; const bf16* wl = (const bf16*)(ws + WS_W + (size_t)l * W_L);
#define GEMM_MAIN(EPI, Aptr, Woff, NN, KK, ...) do { pg8::Gemm g{(const bf16*)(Aptr), (const bf16*)((const unsigned char*)wl + (Woff)), MP, (NN), (KK)}; pg8::StaticOrder S; S.init(MP, (NN), G, bx); \
            EPI E{__VA_ARGS__}; pg8::gemm_phase<EPI, pg8::StaticOrder, true, true>(lds + RING_OFF, g, S, E, tid); } while (0)
        if (IN(pb + 0)) { RETID();
#ifndef NO_DT
            dt_rows(args, lds, l, vcu, G, tid); for (int rep = 0; rep < PROBE_THIN; ++rep) dt_rows(args, lds, l, vcu, G, tid);
#endif
            GEMM_MAIN(pg8::EpiScaleBf16<0>, ws + WS_HB, WO_IN, NIN, D, (bf16*)(ws + WS_PROJ), NIN, SSQ(3 * l));
            for (int rep = 0; rep < PROBE_SG_IN; ++rep)
            sample_gemm<128>(lds, (const bf16*)(ws + WS_SA + SA_HB), (const bf16*)((const unsigned char*)wl + WO_IN), NIN, D, SEpiScale{(bf16*)(ws + WS_PROJ), NIN, SSQ(3 * l), 0, 0}, (MP / 256) * (NIN / 256), 4, bx, G, tid);
            GRID_BAR(); }
        if (IN(pb + 1)) { RETID();
            for (int rep = 0; rep < PROBE_MA; ++rep)
#pragma unroll 1
            for (int u = vcu; u < 512; u += G) { if (u < 256) ma_s5_unit(args, lds, l, u >> 6, u & 63, lane, wave); else { const int v = u - 256; ma_ssd_unit(args, lds, l, v >> 6, (v >> 1) & 31, v & 1, tid, lane, wave); } }
            GRID_BAR(); }
        if (IN(pb + 2)) { RETID(); mb_scan(args, l, vcu, G, tid); for (int rep = 0; rep < PROBE_THIN; ++rep) mb_scan(args, l, vcu, G, tid, 1); GRID_BAR(); }
        if (IN(pb + 3)) { RETID();
            for (int rep = 0; rep < PROBE_MC; ++rep)
#pragma unroll 1
            for (int u = vcu; u < 512; u += G) {
#ifndef NO_MC_S5
                if (u < 256) mc_s5_unit(args, lds, l, u >> 6, u & 63, tid, lane, wave); else
#endif
#ifndef NO_MC_REST
                if (u >= 256 && u < 384) { const int v = u - 256; mc_rest_unit(args, lds, l, v >> 5, v & 31, tid, lane, wave); } else
#endif
#ifndef NO_MC_SAMPLE
                if (u >= 384) mc_sample_unit(args, lds, l, u - 384, tid, lane, wave);
#endif
                { } }
            GRID_BAR(); }
        if (IN(pb + 4)) { RETID();
            GEMM_MAIN(pg8::EpiResB, ws + WS_MIX, WO_OUT, D, D, (bf16*)(ws + WS_HB), SSQ(3 * l + 1), D, (l == 0 ? args.in[I_XP] : (const float*)nullptr));
            sample_gemm<32>(lds, (const bf16*)(ws + WS_SA + SA_MIX), (const bf16*)((const unsigned char*)wl + WO_OUT), D, D, SEpiRes{(l == 0 ? args.in[I_XS] : (const float*)(ws + WS_H) + (size_t)MP * D), (float*)(ws + WS_H), (bf16*)(ws + WS_HB), (bf16*)(ws + WS_SA + SA_HB), SSQ(3 * l + 1)}, (MP / 256) * (D / 256), 1, bx, G, tid);
            if (G == 256) {
                GRID_BAR();
                sample_gemm<32>(lds, (const bf16*)(ws + WS_SA + SA_HB), (const bf16*)((const unsigned char*)wl + WO_Q), D, D, SEpiScale{(bf16*)(ws + WS_Q), D, SSQ(3 * l + 1), 0, 0}, 0, 1, bx, G, tid); }
            GRID_BAR(); }
        if (IN(pb + 5)) { RETID();
            { pg8::Gemm g{(const bf16*)(ws + WS_HB), (const bf16*)(ws + WS_WQK) + (size_t)l * 4 * 1024 * 2048, MP, 1024, D}; pg8::BatchBOrder S; S.init(MP, 1024, G, bx); S.pmb = 8; S.bbs = (size_t)1024 * 2048;
                pg8::EpiSoftmax E{(bf16*)(ws + WS_PATT), 1024, SSQ(3 * l + 1), 0.044194173824159216f};
                pg8::gemm_phase<pg8::EpiSoftmax, pg8::BatchBOrder, false, true>(lds + RING_OFF, g, S, E, tid); }
            if (G == 256) { if (bx >= 128) att_sample_unit(args, lds, l, bx - 128, 0, tid, lane, wave); }
            else
            sample_gemm<32>(lds, (const bf16*)(ws + WS_SA + SA_HB), (const bf16*)((const unsigned char*)wl + WO_Q), D, D, SEpiScale{(bf16*)(ws + WS_Q), D, SSQ(3 * l + 1), 0, 0}, 128, 2, bx, G, tid);
            GRID_BAR(); }
        if (IN(pb + 6)) { RETID();
            if (bx < 128 || G != 256) { pg8::Gemm g{(const bf16*)(ws + WS_PATT), (const bf16*)(ws + WS_VWT) + (size_t)l * 4 * 2048 * 1024, MP, D, 1024}; pg8::BatchBOrder S; S.init(MP, D, G == 256 ? 128 : G, bx); S.pmb = 8; S.bbs = (size_t)2048 * 1024;
                pg8::EpiResB E{(bf16*)(ws + WS_HB), SSQ(3 * l + 2), D, nullptr};
                pg8::gemm_phase<pg8::EpiResB, pg8::BatchBOrder, true, true>(lds + RING_OFF, g, S, E, tid); }
            if (bx >= 128 || G != 256) {
#pragma unroll 1
                for (int i = (G == 256) ? 1 : 0; i < 2; ++i) for (int c = (G == 256 ? bx - 128 : bx); c < 128; c += (G == 256 ? 128 : G)) { const int u = c * 2 + i; att_sample_unit(args, lds, l, u >> 1, u & 1, tid, lane, wave); }
                }
            GRID_BAR(); }
        if (IN(pb + 7)) { RETID();
            sample_gemm<32>(lds, (const bf16*)(ws + WS_SA + SA_O), (const bf16*)((const unsigned char*)wl + WO_O), D, D, SEpiRes{(const float*)(ws + WS_H) + (size_t)MP * D, (float*)(ws + WS_H), (bf16*)(ws + WS_HB), (bf16*)(ws + WS_SA + SA_HB), SSQ(3 * l + 2)}, 0, 1, bx, G, tid);
            GRID_BAR(); }
        if (IN(pb + 8)) { RETID();
            for (int rep = 0; rep < PROBE_UP; ++rep)
            GEMM_MAIN(pg8::EpiScaleBf16<1>, ws + WS_HB, WO_UP, FF, D, (bf16*)(ws + WS_HID), FF, SSQ(3 * l + 2));
            for (int rep = 0; rep < PROBE_SG_UP; ++rep)
            sample_gemm<128>(lds, (const bf16*)(ws + WS_SA + SA_HB), (const bf16*)((const unsigned char*)wl + WO_UP), FF, D, SEpiScale{(bf16*)(ws + WS_SA + SA_HID), FF, SSQ(3 * l + 2), 1, 1}, (MP / 256) * (FF / 256), 1, bx, G, tid);
            GRID_BAR(); }
        if (IN(pb + 9)) { RETID();
#define SFIRST() ([&]() { pg8::StaticOrder S0; S0.init(MP, D, G, bx); pg8::Unit u0; return G == 256 && S0.next(0, u0) && (u0.pm & 1) != 0; }())
            if (SFIRST()) { sample_gemm<32>(lds, (const bf16*)(ws + WS_SA + SA_HID), (const bf16*)((const unsigned char*)wl + WO_DOWN), D, FF, SEpiRes{(const float*)(ws + WS_H) + (size_t)MP * D, (float*)(ws + WS_H), (bf16*)(ws + WS_HB), (bf16*)(ws + WS_SA + SA_HB), SSQ(3 * l + 3)}, (MP / 256) * (D / 256), 1, bx, G, tid); }
            if (l == NL - 1 && G == 256) { pg8::Gemm g{(const bf16*)(ws + WS_HID), (const bf16*)((const unsigned char*)wl + WO_DOWN), MP, D, FF}; pg8::StaticOrder S; S.init(MP, D, G, bx);
                pg8::EpiResFinal E{(const bf16*)(ws + WS_HB), args.out + O_YP, args.in[I_G_FINAL], SSQ(3 * l + 3), (unsigned*)(ws + WS_CTL) + CW_FCNT, D};
                pg8::gemm_phase<pg8::EpiResFinal, pg8::StaticOrder, false, true>(lds + RING_OFF, g, S, E, tid); }
            else
            GEMM_MAIN(pg8::EpiResB, ws + WS_HID, WO_DOWN, D, FF, (bf16*)(ws + WS_HB), SSQ(3 * l + 3), D, nullptr);
            if (!SFIRST()) { sample_gemm<32>(lds, (const bf16*)(ws + WS_SA + SA_HID), (const bf16*)((const unsigned char*)wl + WO_DOWN), D, FF, SEpiRes{(const float*)(ws + WS_H) + (size_t)MP * D, (float*)(ws + WS_H), (bf16*)(ws + WS_HB), (bf16*)(ws + WS_SA + SA_HB), SSQ(3 * l + 3)}, (MP / 256) * (D / 256), 1, bx, G, tid); }
#undef SFIRST
            GRID_BAR(); }
#undef GEMM_MAIN
    }
    if (IN(PH_FINAL)) { final_norm(args, vcu, G, wave, lane, G == 256 ? MP : 0); }
#undef IN
#undef GRID_BAR
#undef SSQ
}

extern "C" void kernel_launch(void* const* d_in, const int* in_sizes, int n_in, void* d_out, int out_size, void* d_ws, size_t ws_size, hipStream_t stream) {
    static int grid = 0;
    if (grid == 0) {
        if (n_in != N_IN || in_sizes[0] != MP * D || (size_t)out_size != O_END || ws_size < WS_END) { fprintf(stderr, "kernel_launch: unexpected problem (n_in %d, in0 %d, out %d, ws %zu); nothing launched\n", n_in, n_in > 0 ? in_sizes[0] : -1, out_size, ws_size); grid = -1; return; }
        int dev = 0, cus = 0, per_cu = 0;
        if (hipGetDevice(&dev) != hipSuccess || hipDeviceGetAttribute(&cus, hipDeviceAttributeMultiprocessorCount, dev) != hipSuccess) { fprintf(stderr, "kernel_launch: device query failed\n"); grid = -1; return; }
        if (hipFuncSetAttribute((const void*)mk_fwd, hipFuncAttributeMaxDynamicSharedMemorySize, LDS_BYTES) != hipSuccess) { fprintf(stderr, "kernel_launch: hipFuncSetAttribute failed\n"); grid = -1; return; }
        if (hipOccupancyMaxActiveBlocksPerMultiprocessor(&per_cu, (const void*)mk_fwd, NTHR, LDS_BYTES) != hipSuccess || per_cu < 1) fprintf(stderr, "kernel_launch: note: occupancy query reports %d workgroups per CU\n", per_cu);
        (void)hipGetLastError();
        grid = cus;
    }
    if (grid < 0) return;
    if (hipMemsetAsync((char*)d_ws + WS_CTL, 0, CTL_ZERO_BYTES, stream) != hipSuccess) { fprintf(stderr, "kernel_launch: hipMemsetAsync failed\n"); return; }
    Args a{};
    for (int i = 0; i < N_IN; ++i) a.in[i] = (const float*)d_in[i];
    a.out = (float*)d_out; a.ws = (unsigned char*)d_ws;
#if MK_PER_PHASE
    for (int p = 0; p < NPHASE; ++p) { a.ph_lo = p; a.ph_hi = p + 1; hipLaunchKernelGGL(mk_fwd, dim3(grid), dim3(NTHR), LDS_BYTES, stream, a); }
#else
    a.ph_lo = 0; a.ph_hi = NPHASE; hipLaunchKernelGGL(mk_fwd, dim3(grid), dim3(NTHR), LDS_BYTES, stream, a);
#endif
    const hipError_t le = hipPeekAtLastError();
    if (le != hipSuccess) fprintf(stderr, "kernel_launch: launch failed: %s\n", hipGetErrorName(le));
}
```

```cpp
#include <hip/hip_runtime.h>
#include <cstdio>
#include <cstdint>
namespace pg8 {
#define PG8_LAS __attribute__((address_space(3)))
typedef unsigned short bf16_t;
typedef short bf16x8 __attribute__((ext_vector_type(8)));
typedef float f32x4 __attribute__((ext_vector_type(4)));
typedef unsigned u32x4 __attribute__((ext_vector_type(4)));
constexpr int BM = 256, BK = 64, HALF = 128, HTB = HALF * BK * 2  , STAGE_BYTES = 8 * HTB, NXCD = 8, WGM = 8;

__host__ __device__ __forceinline__ int lds_byte(int r, int c) { const int st = (r >> 4) * 2 + (c >> 5), rr = r & 15, cc = c & 31, ob = rr * 64 + cc * 2; return st * 1024 + (ob ^ (((ob >> 9) & 1) << 5)); }
__host__ __device__ __forceinline__ void stage_rc(int b, int& R, int& C) { const int st = b / 1024, sb = b % 1024, swz = sb ^ (((sb >> 9) & 1) << 5); R = (st >> 1) * 16 + swz / 64; C = (st & 1) * 32 + (swz % 64) / 2; }
__host__ __device__ __forceinline__ int perm32(int rho) { const int n = rho >> 4, i = rho & 15; return 8 * (i >> 2) + 4 * n + (i & 3); }

struct Unit { int pm, pn, z; };
struct Gemm { const bf16_t* A; const bf16_t* Bt; int M, N, K; int lda = 0, ldb = 0; };

struct StaticOrder {
    int nM, nN, nwg, G, c;
    __host__ __device__ void init(int M, int N, int G_, int c_) { nM = M / BM; nN = N / BM; nwg = nM * nN; G = G_; c = c_; }
    __host__ __device__ bool next(int i, Unit& u) const {
        const long L = (long)i * G + c; if (L >= nwg) return false;
        int wgid = (int)L; { const int q = nwg / NXCD, r = nwg % NXCD, xcd = wgid % NXCD, off = wgid / NXCD; wgid = (xcd < r ? xcd * (q + 1) : r * (q + 1) + (xcd - r) * q) + off; }
        const int nig = WGM * nN, gid = wgid / nig, fm = gid * WGM, gsz = (nM - fm) < WGM ? (nM - fm) : WGM;
        u.pm = fm + ((wgid % nig) % gsz); u.pn = (wgid % nig) / gsz; u.z = 0; return true;
    }
    __device__ __forceinline__ void a_ready(const Unit&) const {}
    __device__ __forceinline__ void done(const Unit&) const {}
    __device__ __forceinline__ const char* abase(const Gemm& g, const Unit& u) const { return (const char*)g.A + (size_t)u.pm * 256 * (size_t)(g.lda ? g.lda : g.K) * 2; }
    __device__ __forceinline__ const char* bbase(const Gemm& g, const Unit& u) const { return (const char*)g.Bt + (size_t)u.pn * 256 * (size_t)(g.ldb ? g.ldb : g.K) * 2; }
};


struct PreOrder {
    int G, c; const bf16_t* a0; const bf16_t* b0; const bf16_t* a1; const bf16_t* b1;
    __device__ __forceinline__ bool next(int i, Unit& u) const { const long L = (long)i * G + c; if (L >= 256) return false; const int mode = (int)(L >> 7), head = (int)((L & 127) >> 5), x = (int)((L & 31) >> 3), y = (int)(L & 7);
        u.z = mode * 4 + head; u.pm = mode ? y : x; u.pn = mode ? x : y; return true; }
    __device__ __forceinline__ void a_ready(const Unit&) const {}
    __device__ __forceinline__ void done(const Unit&) const {}
    __device__ __forceinline__ const char* abase(const Gemm&, const Unit& u) const { return (const char*)((u.z >> 2) ? a1 : a0) + ((size_t)u.pm * 256 * 2048 + (size_t)(u.z & 3) * 512) * 2; }
    __device__ __forceinline__ const char* bbase(const Gemm&, const Unit& u) const { return (const char*)((u.z >> 2) ? b1 : b0) + ((size_t)u.pn * 256 * 2048 + (size_t)(u.z & 3) * 512) * 2; }
};
typedef float cvt_f32x2 __attribute__((ext_vector_type(2)));
typedef __bf16 cvt_bf16x2 __attribute__((ext_vector_type(2)));
__device__ __forceinline__ unsigned cvt_pk_bf16(float lo, float hi) { const cvt_f32x2 v = {lo, hi}; return __builtin_bit_cast(unsigned, __builtin_convertvector(v, cvt_bf16x2)); }

__device__ __forceinline__ void ssq_add(unsigned long long* p, float v) { (void)__hip_atomic_fetch_add(p, (unsigned long long)__float2ull_rn(v * 16777216.0f), __ATOMIC_RELAXED, __HIP_MEMORY_SCOPE_AGENT); }
__device__ __forceinline__ float ssq_rstd(unsigned long long v) { return __builtin_amdgcn_rsqf((float)v * (1.0f / (16777216.0f * 2048.0f)) + 1e-6f); }
template <int ACT> struct EpiScaleBf16 {
    static constexpr bool PERM = true, AFTER_DRAIN = false;
    bf16_t* O; int ldc; const unsigned long long* ssq;
    __device__ __forceinline__ void operator()(const f32x4 (&acc)[2][2][4][2], const Unit& u, int wr, int wc, int fr, int fq) const {
        const int row0 = u.pm * BM + wr * 64 + fr, col0 = u.pn * BM + wc * 32 + 8 * fq;
        unsigned long long sv[2][4];
#pragma unroll
        for (int ai = 0; ai < 2; ++ai)
#pragma unroll
            for (int m = 0; m < 4; ++m) sv[ai][m] = ssq[row0 + ai * HALF + m * 16];
#pragma unroll
        for (int ai = 0; ai < 2; ++ai)
#pragma unroll
            for (int m = 0; m < 4; ++m) asm volatile("" : "+v"(sv[ai][m]));
#pragma unroll
        for (int ai = 0; ai < 2; ++ai)
#pragma unroll
            for (int m = 0; m < 4; ++m) { const int row = row0 + ai * HALF + m * 16; const float rs = ssq_rstd(sv[ai][m]);
                bf16_t* rowp = O + (size_t)row * ldc + col0;
#pragma unroll
                for (int bj = 0; bj < 2; ++bj) { f32x4 v0 = acc[ai][bj][m][0] * rs, v1 = acc[ai][bj][m][1] * rs;
                    if (ACT == 1) {
#pragma unroll
                        for (int e = 0; e < 4; ++e) { const float a0 = v0[e] > 0.f ? v0[e] : 0.f, a1 = v1[e] > 0.f ? v1[e] : 0.f; v0[e] = a0 * a0; v1[e] = a1 * a1; } }
                    u32x4 w; w.x = cvt_pk_bf16(v0[0], v0[1]); w.y = cvt_pk_bf16(v0[2], v0[3]); w.z = cvt_pk_bf16(v1[0], v1[1]); w.w = cvt_pk_bf16(v1[2], v1[3]);
                    *(u32x4*)(rowp + bj * HALF) = w; } }
    }
};
struct EpiRes {
    static constexpr bool PERM = true, AFTER_DRAIN = false;
    const float* hin; float* h; bf16_t* hb; unsigned long long* ssq_out; int ldc;
    __device__ __forceinline__ void operator()(const f32x4 (&acc)[2][2][4][2], const Unit& u, int wr, int wc, int fr, int fq) const {
        const int row0 = u.pm * BM + wr * 64 + fr, col0 = u.pn * BM + wc * 32 + 8 * fq;
#pragma unroll
        for (int ai = 0; ai < 2; ++ai) {
            f32x4 hv[4][2][2];
#pragma unroll
            for (int m = 0; m < 4; ++m) { const float* hp = hin + (size_t)(row0 + ai * HALF + m * 16) * ldc + col0;
#pragma unroll
                for (int bj = 0; bj < 2; ++bj) { hv[m][bj][0] = *(const f32x4*)(hp + bj * HALF); hv[m][bj][1] = *(const f32x4*)(hp + bj * HALF + 4); } }
#pragma unroll
            for (int m = 0; m < 4; ++m)
#pragma unroll
                for (int bj = 0; bj < 2; ++bj) { asm volatile("" : "+v"(hv[m][bj][0])); asm volatile("" : "+v"(hv[m][bj][1])); }
#pragma unroll
            for (int m = 0; m < 4; ++m) { const int row = row0 + ai * HALF + m * 16; float sq = 0.f;
                float* hp = h + (size_t)row * ldc + col0; bf16_t* bp = hb + (size_t)row * ldc + col0;
#pragma unroll
                for (int bj = 0; bj < 2; ++bj) { f32x4 v0 = hv[m][bj][0] + acc[ai][bj][m][0], v1 = hv[m][bj][1] + acc[ai][bj][m][1];
                    *(f32x4*)(hp + bj * HALF) = v0; *(f32x4*)(hp + bj * HALF + 4) = v1;
                    sq += (v0[0] * v0[0] + v0[1] * v0[1]) + (v0[2] * v0[2] + v0[3] * v0[3]) + (v1[0] * v1[0] + v1[1] * v1[1]) + (v1[2] * v1[2] + v1[3] * v1[3]);
                    u32x4 w; w.x = cvt_pk_bf16(v0[0], v0[1]); w.y = cvt_pk_bf16(v0[2], v0[3]); w.z = cvt_pk_bf16(v1[0], v1[1]); w.w = cvt_pk_bf16(v1[2], v1[3]);
                    *(u32x4*)(bp + bj * HALF) = w; }
                sq += __shfl_xor(sq, 16); sq += __shfl_xor(sq, 32);
                if (fq == 0) ssq_add(ssq_out + row, sq); } }
    }
};
struct EpiResB {
    static constexpr bool PERM = true, AFTER_DRAIN = false;
    bf16_t* hb; unsigned long long* ssq_out; int ldc; const float* xin;
    __device__ __forceinline__ void operator()(const f32x4 (&acc)[2][2][4][2], const Unit& u, int wr, int wc, int fr, int fq) const {
        const int row0 = u.pm * BM + wr * 64 + fr, col0 = u.pn * BM + wc * 32 + 8 * fq;
        if (xin) {
#pragma unroll
            for (int ai = 0; ai < 2; ++ai) {
                f32x4 xv[4][2][2];
#pragma unroll
                for (int m = 0; m < 4; ++m) { const float* hp = xin + (size_t)(row0 + ai * HALF + m * 16) * ldc + col0;
#pragma unroll
                    for (int bj = 0; bj < 2; ++bj) { xv[m][bj][0] = *(const f32x4*)(hp + bj * HALF); xv[m][bj][1] = *(const f32x4*)(hp + bj * HALF + 4); } }
#pragma unroll
                for (int m = 0; m < 4; ++m)
#pragma unroll
                    for (int bj = 0; bj < 2; ++bj) { asm volatile("" : "+v"(xv[m][bj][0])); asm volatile("" : "+v"(xv[m][bj][1])); }
#pragma unroll
                for (int m = 0; m < 4; ++m) { const int row = row0 + ai * HALF + m * 16; float sq = 0.f; bf16_t* bp = hb + (size_t)row * ldc + col0;
#pragma unroll
                    for (int bj = 0; bj < 2; ++bj) { const f32x4 v0 = xv[m][bj][0] + acc[ai][bj][m][0], v1 = xv[m][bj][1] + acc[ai][bj][m][1];
                        sq += (v0[0] * v0[0] + v0[1] * v0[1]) + (v0[2] * v0[2] + v0[3] * v0[3]) + (v1[0] * v1[0] + v1[1] * v1[1]) + (v1[2] * v1[2] + v1[3] * v1[3]);
                        u32x4 w; w.x = cvt_pk_bf16(v0[0], v0[1]); w.y = cvt_pk_bf16(v0[2], v0[3]); w.z = cvt_pk_bf16(v1[0], v1[1]); w.w = cvt_pk_bf16(v1[2], v1[3]);
                        *(u32x4*)(bp + bj * HALF) = w; }
                    sq += __shfl_xor(sq, 16); sq += __shfl_xor(sq, 32);
                    if (fq == 0) ssq_add(ssq_out + row, sq); } }
            return; }
        u32x4 hv[2][4][2];
#pragma unroll
        for (int ai = 0; ai < 2; ++ai)
#pragma unroll
            for (int m = 0; m < 4; ++m) { const bf16_t* bp = hb + (size_t)(row0 + ai * HALF + m * 16) * ldc + col0;
#pragma unroll
                for (int bj = 0; bj < 2; ++bj) hv[ai][m][bj] = *(const u32x4*)(bp + bj * HALF); }
#pragma unroll
        for (int ai = 0; ai < 2; ++ai)
#pragma unroll
            for (int m = 0; m < 4; ++m) { asm volatile("" : "+v"(hv[ai][m][0])); asm volatile("" : "+v"(hv[ai][m][1])); }
#pragma unroll
        for (int ai = 0; ai < 2; ++ai)
#pragma unroll
            for (int m = 0; m < 4; ++m) { const int row = row0 + ai * HALF + m * 16; float sq = 0.f; bf16_t* bp = hb + (size_t)row * ldc + col0;
#pragma unroll
                for (int bj = 0; bj < 2; ++bj) { const u32x4 w0 = hv[ai][m][bj];
                    const f32x4 v0 = (f32x4){__uint_as_float(w0.x << 16), __uint_as_float(w0.x & 0xffff0000u), __uint_as_float(w0.y << 16), __uint_as_float(w0.y & 0xffff0000u)} + acc[ai][bj][m][0];
                    const f32x4 v1 = (f32x4){__uint_as_float(w0.z << 16), __uint_as_float(w0.z & 0xffff0000u), __uint_as_float(w0.w << 16), __uint_as_float(w0.w & 0xffff0000u)} + acc[ai][bj][m][1];
                    sq += (v0[0] * v0[0] + v0[1] * v0[1]) + (v0[2] * v0[2] + v0[3] * v0[3]) + (v1[0] * v1[0] + v1[1] * v1[1]) + (v1[2] * v1[2] + v1[3] * v1[3]);
                    u32x4 w; w.x = cvt_pk_bf16(v0[0], v0[1]); w.y = cvt_pk_bf16(v0[2], v0[3]); w.z = cvt_pk_bf16(v1[0], v1[1]); w.w = cvt_pk_bf16(v1[2], v1[3]);
                    *(u32x4*)(bp + bj * HALF) = w; }
                sq += __shfl_xor(sq, 16); sq += __shfl_xor(sq, 32);
                if (fq == 0) ssq_add(ssq_out + row, sq); }
    }
};
struct EpiResFinal {
    static constexpr bool PERM = true, AFTER_DRAIN = true;
    const bf16_t* hin; float* y; const float* gfin; unsigned long long* ssq_out; unsigned* cnt; int ldc;
    __device__ __forceinline__ void operator()(const f32x4 (&)[2][2][4][2], const Unit&, int, int, int, int) const {}
    __device__ __forceinline__ void fused(f32x4 (&acc)[2][2][4][2], const Unit& u, int wr, int wc, int fr, int fq, PG8_LAS unsigned char*, int wid, int lane) const {
        const int row0 = u.pm * BM + wr * 64 + fr, col0 = u.pn * BM + wc * 32 + 8 * fq;
#pragma unroll
        for (int ai = 0; ai < 2; ++ai) {
            u32x4 hv[4][2];
#pragma unroll
            for (int m = 0; m < 4; ++m) { const bf16_t* hp = hin + (size_t)(row0 + ai * HALF + m * 16) * ldc + col0;
#pragma unroll
                for (int bj = 0; bj < 2; ++bj) hv[m][bj] = *(const u32x4*)(hp + bj * HALF); }
#pragma unroll
            for (int m = 0; m < 4; ++m) { asm volatile("" : "+v"(hv[m][0])); asm volatile("" : "+v"(hv[m][1])); }
#pragma unroll
            for (int m = 0; m < 4; ++m) { const int row = row0 + ai * HALF + m * 16; float sq = 0.f;
#pragma unroll
                for (int bj = 0; bj < 2; ++bj) { const u32x4 w0 = hv[m][bj];
                    const f32x4 v0 = (f32x4){__uint_as_float(w0.x << 16), __uint_as_float(w0.x & 0xffff0000u), __uint_as_float(w0.y << 16), __uint_as_float(w0.y & 0xffff0000u)} + acc[ai][bj][m][0];
                    const f32x4 v1 = (f32x4){__uint_as_float(w0.z << 16), __uint_as_float(w0.z & 0xffff0000u), __uint_as_float(w0.w << 16), __uint_as_float(w0.w & 0xffff0000u)} + acc[ai][bj][m][1];
                    acc[ai][bj][m][0] = v0; acc[ai][bj][m][1] = v1;
                    sq += (v0[0] * v0[0] + v0[1] * v0[1]) + (v0[2] * v0[2] + v0[3] * v0[3]) + (v1[0] * v1[0] + v1[1] * v1[1]) + (v1[2] * v1[2] + v1[3] * v1[3]); }
                sq += __shfl_xor(sq, 16); sq += __shfl_xor(sq, 32);
                if (fq == 0) ssq_add(ssq_out + row, sq); } }
        asm volatile("s_waitcnt vmcnt(0)" ::: "memory");
        __builtin_amdgcn_s_barrier(); asm volatile("" ::: "memory");
        if (wid == 0 && lane == 0) { unsigned* c = cnt + u.pm * 64;
            (void)__hip_atomic_fetch_add(c, 1u, __ATOMIC_RELAXED, __HIP_MEMORY_SCOPE_AGENT);
            unsigned sp = 0; while (__hip_atomic_load(c, __ATOMIC_RELAXED, __HIP_MEMORY_SCOPE_AGENT) < 8u) { __builtin_amdgcn_s_sleep(1); if (++sp > (1u << 22)) break; } }
        __builtin_amdgcn_s_barrier(); asm volatile("" ::: "memory");
        unsigned long long sv[2][4];
#pragma unroll
        for (int ai = 0; ai < 2; ++ai)
#pragma unroll
            for (int m = 0; m < 4; ++m) sv[ai][m] = __hip_atomic_load(ssq_out + row0 + ai * HALF + m * 16, __ATOMIC_RELAXED, __HIP_MEMORY_SCOPE_AGENT);
        f32x4 gv[2][2];
#pragma unroll
        for (int bj = 0; bj < 2; ++bj) { gv[bj][0] = *(const f32x4*)(gfin + col0 + bj * HALF); gv[bj][1] = *(const f32x4*)(gfin + col0 + bj * HALF + 4); }
#pragma unroll
        for (int ai = 0; ai < 2; ++ai)
#pragma unroll
            for (int m = 0; m < 4; ++m) asm volatile("" : "+v"(sv[ai][m]));
#pragma unroll
        for (int ai = 0; ai < 2; ++ai)
#pragma unroll
            for (int m = 0; m < 4; ++m) { const float rs = ssq_rstd(sv[ai][m]); float* yp = y + (size_t)(row0 + ai * HALF + m * 16) * ldc + col0;
#pragma unroll
                for (int bj = 0; bj < 2; ++bj) { *(f32x4*)(yp + bj * HALF) = acc[ai][bj][m][0] * gv[bj][0] * rs; *(f32x4*)(yp + bj * HALF + 4) = acc[ai][bj][m][1] * gv[bj][1] * rs; } }
    }
};
struct BatchBOrder : StaticOrder {
    int pmb; size_t bbs;
    __device__ __forceinline__ const char* bbase(const Gemm& g, const Unit& u) const { return (const char*)g.Bt + ((size_t)(u.pm / pmb) * bbs + (size_t)u.pn * 256 * (size_t)(g.ldb ? g.ldb : g.K)) * 2; }
};
struct EpiSoftmax {
    static constexpr bool PERM = true, AFTER_DRAIN = true;
    bf16_t* P; int ldc; const unsigned long long* ssq; float scale;
    __device__ __forceinline__ void operator()(const f32x4 (&)[2][2][4][2], const Unit&, int, int, int, int) const {}
    __device__ __forceinline__ void fused(f32x4 (&acc)[2][2][4][2], const Unit& u, int wr, int wc, int fr, int fq, PG8_LAS unsigned char* lds, int wid, int lane) const {
        PG8_LAS float* RM = (PG8_LAS float*)lds; PG8_LAS float* RS = (PG8_LAS float*)(lds + 4096);
        const int r0 = wr * 64 + fr, row0 = u.pm * BM + r0, col0 = u.pn * BM + wc * 32 + 8 * fq;
        unsigned long long sv[2][4];
#pragma unroll
        for (int ai = 0; ai < 2; ++ai)
#pragma unroll
            for (int m = 0; m < 4; ++m) sv[ai][m] = ssq[row0 + ai * HALF + m * 16];
#pragma unroll
        for (int ai = 0; ai < 2; ++ai)
#pragma unroll
            for (int m = 0; m < 4; ++m) asm volatile("" : "+v"(sv[ai][m]));
#pragma unroll
        for (int ai = 0; ai < 2; ++ai)
#pragma unroll
            for (int m = 0; m < 4; ++m) { const float sc = ssq_rstd(sv[ai][m]) * scale; float mx = -3.0e38f;
#pragma unroll
                for (int bj = 0; bj < 2; ++bj)
#pragma unroll
                    for (int n = 0; n < 2; ++n) { f32x4 v = acc[ai][bj][m][n] * sc; acc[ai][bj][m][n] = v; mx = fmaxf(fmaxf(mx, fmaxf(v[0], v[1])), fmaxf(v[2], v[3])); }
                mx = fmaxf(mx, __shfl_xor(mx, 16)); mx = fmaxf(mx, __shfl_xor(mx, 32));
                if (fq == 0) RM[(r0 + ai * HALF + m * 16) * 4 + wc] = mx; }
        asm volatile("s_waitcnt lgkmcnt(0)" ::: "memory"); __builtin_amdgcn_s_barrier(); asm volatile("" ::: "memory");
#pragma unroll
        for (int ai = 0; ai < 2; ++ai)
#pragma unroll
            for (int m = 0; m < 4; ++m) { const f32x4 q = *(const PG8_LAS f32x4*)(RM + (r0 + ai * HALF + m * 16) * 4); const float mx = fmaxf(fmaxf(q[0], q[1]), fmaxf(q[2], q[3])); float sm = 0.f;
#pragma unroll
                for (int bj = 0; bj < 2; ++bj)
#pragma unroll
                    for (int n = 0; n < 2; ++n) { f32x4 v = acc[ai][bj][m][n];
#pragma unroll
                        for (int e = 0; e < 4; ++e) { v[e] = __expf(v[e] - mx); sm += v[e]; }
                        acc[ai][bj][m][n] = v; }
                sm += __shfl_xor(sm, 16); sm += __shfl_xor(sm, 32);
                if (fq == 0) RS[(r0 + ai * HALF + m * 16) * 4 + wc] = sm; }
        asm volatile("s_waitcnt lgkmcnt(0)" ::: "memory"); __builtin_amdgcn_s_barrier(); asm volatile("" ::: "memory");
#pragma unroll
        for (int ai = 0; ai < 2; ++ai)
#pragma unroll
            for (int m = 0; m < 4; ++m) { const f32x4 q = *(const PG8_LAS f32x4*)(RS + (r0 + ai * HALF + m * 16) * 4); const float inv = __builtin_amdgcn_rcpf((q[0] + q[1]) + (q[2] + q[3]));
                bf16_t* rowp = P + (size_t)(row0 + ai * HALF + m * 16) * ldc + col0;
#pragma unroll
                for (int bj = 0; bj < 2; ++bj) { const f32x4 v0 = acc[ai][bj][m][0] * inv, v1 = acc[ai][bj][m][1] * inv;
                    u32x4 w; w.x = cvt_pk_bf16(v0[0], v0[1]); w.y = cvt_pk_bf16(v0[2], v0[3]); w.z = cvt_pk_bf16(v1[0], v1[1]); w.w = cvt_pk_bf16(v1[2], v1[3]);
                    *(u32x4*)(rowp + bj * HALF) = w; } }
    }
};
struct EpiPre {
    static constexpr bool PERM = true, AFTER_DRAIN = false;
    bf16_t* wqk; bf16_t* vwt;
    __device__ __forceinline__ void operator()(const f32x4 (&acc)[2][2][4][2], const Unit& u, int wr, int wc, int fr, int fq) const {
        const int mode = u.z >> 2, head = u.z & 3, r0 = wr * 64 + fr, c0 = wc * 32 + 8 * fq;
#pragma unroll
        for (int ai = 0; ai < 2; ++ai)
#pragma unroll
            for (int m = 0; m < 4; ++m) { const int r = r0 + ai * HALF + m * 16;
#pragma unroll
                for (int bj = 0; bj < 2; ++bj) { const int c = c0 + bj * HALF; const f32x4 v0 = acc[ai][bj][m][0], v1 = acc[ai][bj][m][1];
                    u32x4 w; w.x = cvt_pk_bf16(v0[0], v0[1]); w.y = cvt_pk_bf16(v0[2], v0[3]); w.z = cvt_pk_bf16(v1[0], v1[1]); w.w = cvt_pk_bf16(v1[2], v1[3]);
                    const size_t off = mode == 0 ? (((size_t)u.pm * 1024 + head * 256 + r) * 2048 + u.pn * 256 + c) : (((size_t)u.pn * 2048 + u.pm * 256 + r) * 1024 + head * 256 + c);
                    *(u32x4*)((mode == 0 ? wqk : vwt) + off) = w; } }
    }
};
struct EpiKV {
    static constexpr bool PERM = true, AFTER_DRAIN = false;
    float* outk; size_t voff; bf16_t* kb; bf16_t* vt; bf16_t* vb; const float* rstd;
    __device__ __forceinline__ void operator()(const f32x4 (&acc)[2][2][4][2], const Unit& u, int wr, int wc, int fr, int fq) const {
        const int row0 = u.pm * BM + wr * 64 + fr; const int colt = u.pn * BM, which = colt >> 11, l = which >> 1, isv = which & 1;
        const int col0 = (colt & 2047) + wc * 32 + 8 * fq;
        float sv[2][4];
#pragma unroll
        for (int ai = 0; ai < 2; ++ai)
#pragma unroll
            for (int m = 0; m < 4; ++m) sv[ai][m] = rstd[row0 + ai * HALF + m * 16];
#pragma unroll
        for (int ai = 0; ai < 2; ++ai)
#pragma unroll
            for (int m = 0; m < 4; ++m) asm volatile("" : "+v"(sv[ai][m]));
#pragma unroll
        for (int ai = 0; ai < 2; ++ai)
#pragma unroll
            for (int m = 0; m < 4; ++m) { const int row = row0 + ai * HALF + m * 16; const float rs = sv[ai][m];
#pragma unroll
                for (int bj = 0; bj < 2; ++bj) { const f32x4 v0 = acc[ai][bj][m][0] * rs, v1 = acc[ai][bj][m][1] * rs; const int col = col0 + bj * HALF;
                    float* op = outk + (isv ? voff : (size_t)0) + ((size_t)l * 1024 + row) * 2048 + col;
                    *(f32x4*)op = v0; *(f32x4*)(op + 4) = v1;
                    if (!isv) { u32x4 w; w.x = cvt_pk_bf16(v0[0], v0[1]); w.y = cvt_pk_bf16(v0[2], v0[3]); w.z = cvt_pk_bf16(v1[0], v1[1]); w.w = cvt_pk_bf16(v1[2], v1[3]);
                        *(u32x4*)(kb + ((size_t)l * 1024 + row) * 2048 + col) = w; }
                    else { { u32x4 w; w.x = cvt_pk_bf16(v0[0], v0[1]); w.y = cvt_pk_bf16(v0[2], v0[3]); w.z = cvt_pk_bf16(v1[0], v1[1]); w.w = cvt_pk_bf16(v1[2], v1[3]); *(u32x4*)(vb + ((size_t)l * 1024 + row) * 2048 + col) = w; }
                    } } }
    }
};
template <class Epi, class Sched, bool ALIGN_EPI = false, bool SP2 = false>
__device__ __forceinline__ void gemm_phase(PG8_LAS unsigned char* lds, const Gemm g, const Sched& S, const Epi& E, int tid) {
    asm volatile("" : "+v"(tid));
    const int wid = __builtin_amdgcn_readfirstlane(tid >> 6), lane = tid & 63, wr = wid >> 2, wc = wid & 3, fr = lane & 15, fq = lane >> 4;
    const int K = g.K, nt = K / BK, lda = g.lda ? g.lda : K, ldb = g.ldb ? g.ldb : K;
    unsigned voffA[2], voffB[2];
#pragma unroll
    for (int i = 0; i < 2; ++i) { int R, C; stage_rc(tid * 16 + i * 8192, R, C); const int Rb = Epi::PERM ? ((R & ~31) + perm32(R & 31)) : R;
        voffA[i] = (unsigned)(R * lda + C) * 2u; voffB[i] = (unsigned)(Rb * ldb + C) * 2u; }
    const size_t kstep = (size_t)(BK * 2);
    const size_t hstepA = (size_t)HALF * lda * 2, hstepB = (size_t)HALF * ldb * 2;
    const unsigned ldsw = (unsigned)wid * 1024u;
    const int aoff = lds_byte(wr * 64 + fr, fq * 8), boff = lds_byte(wc * 32 + fr, fq * 8);
#define PG8_SA(b, h) (((b) * 2 + (h)) * HTB)
#define PG8_SB(b, h) ((4 + (b) * 2 + (h)) * HTB)
#define PG8_STAGE(bufoff, gbase, voff) do { _Pragma("unroll") for (int _i = 0; _i < 2; ++_i) \
        __builtin_amdgcn_global_load_lds((const unsigned*)((const char*)(gbase) + (voff)[_i]), (PG8_LAS unsigned*)(lds + (bufoff) + ldsw + _i * 8192), 16, 0, 0); } while (0)
#define PG8_LDA(dst, b, h) do { _Pragma("unroll") for (int m = 0; m < 4; ++m) _Pragma("unroll") for (int k = 0; k < 2; ++k) dst[m][k] = *(const PG8_LAS bf16x8*)(lds + PG8_SA(b, h) + aoff + m * 2048 + k * 1024); } while (0)
#define PG8_LDB(dst, b, h) do { _Pragma("unroll") for (int n = 0; n < 2; ++n) _Pragma("unroll") for (int k = 0; k < 2; ++k) dst[n][k] = *(const PG8_LAS bf16x8*)(lds + PG8_SB(b, h) + boff + n * 2048 + k * 1024); } while (0)
#define PG8_MMA(ai, bj, At, Bt) do { __builtin_amdgcn_s_setprio(1); _Pragma("unroll") for (int m = 0; m < 4; ++m) _Pragma("unroll") for (int n = 0; n < 2; ++n) _Pragma("unroll") for (int k = 0; k < 2; ++k) \
        acc[ai][bj][m][n] = __builtin_amdgcn_mfma_f32_16x16x32_bf16(Bt[n][k], At[m][k], acc[ai][bj][m][n], 0, 0, 0); __builtin_amdgcn_s_setprio(0); } while (0)
#define PG8_WAIT_V(n) asm volatile("s_waitcnt vmcnt(" #n ")" ::: "memory")
#define PG8_WAIT_L(n) asm volatile("s_waitcnt lgkmcnt(" #n ")" ::: "memory")
#define PG8_BAR __builtin_amdgcn_s_barrier()
#define PG8_SCHED __builtin_amdgcn_sched_barrier(0)
    Unit cur, nxt; int ui = 0;
    if (!S.next(0, cur)) return;
    f32x4 acc[2][2][4][2];
#pragma unroll
    for (int a = 0; a < 2; ++a)
#pragma unroll
        for (int b = 0; b < 2; ++b)
#pragma unroll
            for (int m = 0; m < 4; ++m)
#pragma unroll
                for (int n = 0; n < 2; ++n) acc[a][b][m][n] = (f32x4){0.f, 0.f, 0.f, 0.f};
    bf16x8 At[4][2], B0[2][2], B1[2][2];
    const char* cA = S.abase(g, cur); const char* cB = S.bbase(g, cur);
    S.a_ready(cur);
    if constexpr (SP2) {
        PG8_STAGE(PG8_SB(0, 0), cB, voffB); PG8_STAGE(PG8_SB(0, 1), cB + hstepB, voffB); PG8_STAGE(PG8_SA(0, 0), cA, voffA); PG8_STAGE(PG8_SA(0, 1), cA + hstepA, voffA);
        if (wr == 1) PG8_BAR;
        PG8_WAIT_V(2); PG8_BAR;
        PG8_STAGE(PG8_SB(1, 0), cB + kstep, voffB); PG8_STAGE(PG8_SA(1, 0), cA + kstep, voffA); PG8_STAGE(PG8_SB(1, 1), cB + hstepB + kstep, voffB);
        PG8_WAIT_V(6); PG8_BAR;
    } else {
        PG8_STAGE(PG8_SB(0, 0), cB, voffB); PG8_STAGE(PG8_SA(0, 0), cA, voffA); PG8_STAGE(PG8_SB(0, 1), cB + hstepB, voffB); PG8_STAGE(PG8_SA(0, 1), cA + hstepA, voffA);
        if (wr == 1) PG8_BAR;
        PG8_WAIT_V(4); PG8_BAR;
        PG8_STAGE(PG8_SB(1, 0), cB + kstep, voffB); PG8_STAGE(PG8_SA(1, 0), cA + kstep, voffA); PG8_STAGE(PG8_SB(1, 1), cB + hstepB + kstep, voffB);
        PG8_WAIT_V(6); PG8_BAR;
    }
    for (;;) {
        const bool has_next = S.next(ui + 1, nxt);
        const char* nA = has_next ? S.abase(g, nxt) : cA; const char* nB = has_next ? S.bbase(g, nxt) : cB;
        for (int t = 0; t < nt; t += 2) {
            const bool last = (t == nt - 2);
            const char* a1 = cA + (size_t)(t + 1) * kstep;
            const char* a2 = last ? nA : cA + (size_t)(t + 2) * kstep; const char* b2 = last ? nB : cB + (size_t)(t + 2) * kstep;
            const char* a3 = a2 + kstep; const char* b3 = b2 + kstep;
            if (last && has_next) S.a_ready(nxt);
            if constexpr (SP2) {
            PG8_LDB(B0, 0, 0); PG8_LDB(B1, 0, 1); PG8_SCHED; PG8_LDA(At, 0, 0); PG8_STAGE(PG8_SA(1, 1), a1 + hstepA, voffA);
            PG8_WAIT_V(8); PG8_WAIT_L(0); PG8_BAR; PG8_MMA(0, 0, At, B0); PG8_MMA(0, 1, At, B1); PG8_BAR; PG8_SCHED;
            PG8_LDA(At, 0, 1); PG8_STAGE(PG8_SB(0, 0), b2, voffB); PG8_STAGE(PG8_SB(0, 1), b2 + hstepB, voffB); PG8_STAGE(PG8_SA(0, 0), a2, voffA);
            PG8_WAIT_V(8); PG8_WAIT_L(0); PG8_BAR; PG8_MMA(1, 0, At, B0); PG8_MMA(1, 1, At, B1); PG8_BAR; PG8_SCHED;
            PG8_LDB(B0, 1, 0); PG8_LDB(B1, 1, 1); PG8_SCHED; PG8_LDA(At, 1, 0); PG8_STAGE(PG8_SA(0, 1), a2 + hstepA, voffA);
            PG8_WAIT_V(8); PG8_WAIT_L(0); PG8_BAR; PG8_MMA(0, 0, At, B0); PG8_MMA(0, 1, At, B1); PG8_BAR; PG8_SCHED;
            PG8_LDA(At, 1, 1); PG8_STAGE(PG8_SB(1, 0), b3, voffB); PG8_STAGE(PG8_SB(1, 1), b3 + hstepB, voffB); PG8_STAGE(PG8_SA(1, 0), a3, voffA);
            PG8_WAIT_V(8); PG8_WAIT_L(0); PG8_BAR; PG8_MMA(1, 0, At, B0); PG8_MMA(1, 1, At, B1); PG8_BAR; PG8_SCHED;
            } else {
            PG8_LDB(B0, 0, 0); PG8_SCHED; PG8_LDA(At, 0, 0); PG8_STAGE(PG8_SA(1, 1), a1 + hstepA, voffA);
            PG8_WAIT_L(8); PG8_BAR; PG8_WAIT_L(0); PG8_MMA(0, 0, At, B0); PG8_BAR; PG8_SCHED;
            PG8_LDB(B1, 0, 1); PG8_STAGE(PG8_SB(0, 0), b2, voffB);
            PG8_BAR; PG8_WAIT_L(0); PG8_MMA(0, 1, At, B1); PG8_BAR;
            PG8_LDA(At, 0, 1); PG8_STAGE(PG8_SA(0, 0), a2, voffA);
            PG8_BAR; PG8_WAIT_L(0); PG8_MMA(1, 0, At, B0); PG8_BAR; PG8_SCHED;
            PG8_STAGE(PG8_SB(0, 1), b2 + hstepB, voffB);
            PG8_WAIT_V(6); PG8_BAR; PG8_MMA(1, 1, At, B1); PG8_BAR;
            PG8_LDB(B0, 1, 0); PG8_SCHED; PG8_LDA(At, 1, 0); PG8_STAGE(PG8_SA(0, 1), a2 + hstepA, voffA);
            PG8_WAIT_L(8); PG8_BAR; PG8_WAIT_L(0); PG8_MMA(0, 0, At, B0); PG8_BAR; PG8_SCHED;
            PG8_LDB(B1, 1, 1); PG8_STAGE(PG8_SB(1, 0), b3, voffB);
            PG8_BAR; PG8_WAIT_L(0); PG8_MMA(0, 1, At, B1); PG8_BAR;
            PG8_LDA(At, 1, 1); PG8_STAGE(PG8_SA(1, 0), a3, voffA);
            PG8_BAR; PG8_WAIT_L(0); PG8_MMA(1, 0, At, B0); PG8_BAR; PG8_SCHED;
            PG8_STAGE(PG8_SB(1, 1), b3 + hstepB, voffB);
            PG8_WAIT_V(6); PG8_BAR; PG8_MMA(1, 1, At, B1); PG8_BAR;
            }
        }
        if constexpr (ALIGN_EPI) { if (wr == 0) PG8_BAR; }
        if constexpr (!Epi::AFTER_DRAIN) { E(acc, cur, wr, wc, fr, fq); S.done(cur); }
        if (!has_next) break;
#pragma unroll
        for (int a = 0; a < 2; ++a)
#pragma unroll
            for (int b = 0; b < 2; ++b)
#pragma unroll
                for (int m = 0; m < 4; ++m)
#pragma unroll
                    for (int n = 0; n < 2; ++n) acc[a][b][m][n] = (f32x4){0.f, 0.f, 0.f, 0.f};
        cur = nxt; cA = nA; cB = nB; ++ui;
        if constexpr (ALIGN_EPI) { if (wr == 1) PG8_BAR; }
    }
    PG8_WAIT_V(0);
    if constexpr (!ALIGN_EPI) { if (wr == 0) PG8_BAR; }
    PG8_BAR;
    if constexpr (Epi::AFTER_DRAIN) { E.fused(acc, cur, wr, wc, fr, fq, lds, wid, lane); S.done(cur); }
#undef PG8_SA
#undef PG8_SB
#undef PG8_STAGE
#undef PG8_LDA
#undef PG8_LDB
#undef PG8_MMA
#undef PG8_WAIT_V
#undef PG8_WAIT_L
#undef PG8_BAR
#undef PG8_SCHED
}
}

constexpr int NWAVES = 8, NTHR = NWAVES * 64;
#ifndef MK_PER_PHASE
#define MK_PER_PHASE 0
#endif

constexpr int D = 2048, NB = 4, T = 2048, MP = NB * T, MS = 128, MR = MP + MS, MPAD = 8448, NL = 2;
constexpr int NIN = 3840, INW = 3848, FF = 8192, NMEM = 256, MROWS = NB * NMEM, NHX = 4, HDX = 512;
constexpr int C_Z = 0, C_XBC = 512, C_BM = 1024, C_CM = 1152, C_U5 = 1280, C_GB = 1792, C_GC = 2304, C_HV = 2816, C_UP = 3328;
constexpr float EPS = 1e-6f;
constexpr int SSD_L = 64, SSD_NC = T / SSD_L;
constexpr int S5_L = 32, S5_NC = T / S5_L;

constexpr size_t O_YP = 0, O_YS = O_YP + (size_t)MP * D, O_PCONV = O_YS + (size_t)MS * D, O_PSSD = O_PCONV + NL * NB * 3 * 768, O_PS5R = O_PSSD + NL * NB * 8 * 4096,
    O_PS5I = O_PS5R + NL * NB * 2048, O_PSC = O_PS5I + NL * NB * 2048, O_PPOOL = O_PSC + NL * NB * 2 * 512, O_PMK = O_PPOOL + NL * NB * 15 * 512, O_PMV = O_PMK + (size_t)NL * MROWS * D,
    O_SCONV = O_PMV + (size_t)NL * MROWS * D, O_SSSD = O_SCONV + NL * MS * 3 * 768, O_SS5R = O_SSSD + (size_t)NL * MS * 8 * 4096, O_SS5I = O_SS5R + NL * MS * 2048, O_SSC = O_SS5I + NL * MS * 2048,
    O_SPOOL = O_SSC + NL * MS * 2 * 512, O_END = O_SPOOL + NL * MS * 15 * 512;
static_assert(O_END == 38066176, "output size");

enum In { I_XP = 0, I_XS, I_MEM, I_ST_CONV, I_ST_SSD, I_ST_S5R, I_ST_S5I, I_ST_SC, I_ST_POOL, I_CK, I_CV, I_G_MIX, I_W_IN, I_CONV_W, I_CONV_B, I_DT_BIAS, I_A_LOG, I_SSD_D,
          I_LAM_RE, I_LAM_IM, I_LOG_DT, I_B_RE, I_B_IM, I_C_RE, I_C_IM, I_S5_D, I_W_GLU, I_B_GLU, I_SC_W, I_POOL_W, I_POOL_SCALE, I_G_MIXOUT, I_W_OUT, I_G_XA, I_G_MEM,
          I_W_Q, I_W_K, I_W_V, I_W_O, I_G_MLP, I_W_UP, I_W_DOWN, I_G_FINAL, N_IN };
static_assert(N_IN == 43, "inputs");

constexpr size_t MiB = 1u << 20;
constexpr size_t WS_CTL = 0, CTL_ZERO_BYTES = 1 * MiB;
constexpr int CW_TMO = 0, CW_BAR = 4096, CW_FCNT = 8192, CW_SSQ = 16384;
static_assert(CW_BAR + 3456 <= CW_FCNT && CW_FCNT + 32 * 64 <= CW_SSQ, "ctl words");
static_assert(CW_SSQ * 4 + 7 * MPAD * 8 <= (int)CTL_ZERO_BYTES, "ctl");
constexpr size_t WS_TAB = 1 * MiB, TAB_L = 2 * MiB;
constexpr size_t TB_ABAR = 0, TB_ABARL = 16384, TB_BBAR = 32768, TB_CMT = TB_BBAR + 262144, TB_WDT = TB_CMT + 131072, TB_WGLUT = TB_WDT + 65536, TB_WPT = TB_WGLUT + 524288, TB_BBT = TB_WPT + 131072, TB_END = TB_BBT + 131072;
static_assert(TB_END <= TAB_L, "tables");
constexpr size_t WS_W = 8 * MiB, W_L = 104 * MiB;
constexpr size_t WO_IN = 0, WO_OUT = 15 * MiB, WO_Q = 23 * MiB, WO_O = 31 * MiB, WO_UP = 39 * MiB, WO_DOWN = 71 * MiB;
static_assert(WO_DOWN + 32 * MiB <= W_L && (size_t)NIN * D * 2 == 15 * MiB, "weights");
constexpr size_t WS_WKV = WS_W + 2 * W_L;
constexpr size_t WS_H = 256 * MiB, WS_HB = 322 * MiB, WS_PROJ = 356 * MiB, WS_MIX = 418 * MiB, WS_Q = 452 * MiB, WS_O = 486 * MiB, WS_HID = 520 * MiB,
    WS_MEMB = 652 * MiB, WS_KB = 656 * MiB, WS_VT = 664 * MiB, WS_DTV = 672 * MiB, WS_RSTDM = 673 * MiB, WS_SS = 674 * MiB, WS_CD = 690 * MiB, WS_S5ER = 691 * MiB, WS_S5EI = 693 * MiB, WS_SA = 700 * MiB, WS_WQKD = 704 * MiB, WS_VB = 720 * MiB, WS_WQK = 728 * MiB, WS_VWT = 760 * MiB, WS_PATT = 792 * MiB, WS_END = 808 * MiB;
constexpr size_t SA_HB = 0, SA_MIX = 512 * 1024, SA_O = 1024 * 1024, SA_HID = 2048 * 1024;
static_assert(WS_WKV + 32 * MiB <= WS_H && WS_H + (size_t)MPAD * D * 4 <= WS_HB && WS_HB + (size_t)MPAD * D * 2 <= WS_PROJ && WS_PROJ + (size_t)MPAD * NIN * 2 <= WS_MIX, "ws map 1");
static_assert(WS_HID + (size_t)MPAD * FF * 2 <= WS_MEMB && WS_SS + (size_t)NB * SSD_NC * 8 * 4096 * 4 <= WS_CD && WS_S5ER + (size_t)NB * S5_NC * 2048 * 4 <= WS_S5EI, "ws map 2");

constexpr int RING_OFF = 0, RING_BYTES = 131072;
constexpr int LDSCTL_OFF = 136192, MISC_OFF = LDSCTL_OFF + 320;
constexpr int LDS_BYTES = 147456;
static_assert(MISC_OFF + 128 <= LDS_BYTES, "LDS map");
#define GAS __attribute__((address_space(1)))
#define LAS __attribute__((address_space(3)))
typedef unsigned short bf16;
typedef unsigned v4u __attribute__((ext_vector_type(4)));
typedef float f32x4 __attribute__((ext_vector_type(4)));
typedef short bf16x8 __attribute__((ext_vector_type(8)));
typedef GAS unsigned gu32;
typedef GAS unsigned long long gu64;
#define RLX_AGENT __ATOMIC_RELAXED, __HIP_MEMORY_SCOPE_AGENT
#define LDS_WAIT() asm volatile("s_waitcnt lgkmcnt(0)" ::: "memory")
#define VM_WAIT() asm volatile("s_waitcnt vmcnt(0)" ::: "memory")
__device__ __forceinline__ unsigned long long rt() { return __builtin_amdgcn_s_memrealtime(); }
__device__ __forceinline__ unsigned f2bf(float f) { unsigned u = __builtin_bit_cast(unsigned, f); return (u + 0x7fffu + ((u >> 16) & 1u)) >> 16; }
__device__ __forceinline__ unsigned pk2(float lo, float hi) { return f2bf(lo) | (f2bf(hi) << 16); }

#define XB_TMO      128
#define XB_XCNT(j)  (256  + 64 * (j))
#define XB_XSUB(j)  (1280 + 64 * (j))
#define XB_XGEN(j)  (2304 + 64 * (j))
#define XB_TOP      3328
#define XB_TOPGEN   3392
#define XCD_BAR_WORDS 3456
#define XB_SPIN_CAP (1u << 18)

__device__ __forceinline__ unsigned xb_ld(unsigned* p)              { return __hip_atomic_load(p, __ATOMIC_RELAXED, __HIP_MEMORY_SCOPE_AGENT); }
__device__ __forceinline__ unsigned xb_add(unsigned* p, unsigned v) { return __hip_atomic_fetch_add(p, v, __ATOMIC_RELAXED, __HIP_MEMORY_SCOPE_AGENT); }
__device__ __forceinline__ unsigned xb_xcc_id() { return (unsigned)__builtin_amdgcn_s_getreg((3 << 11) | 20) & 0xFu; }
#define XB_SPIN(cond, bar) do { unsigned _sp = 0; while (cond) { __builtin_amdgcn_s_sleep(1); \
    if ((++_sp & 255u) == 0u) { if (xb_ld(&(bar)[XB_TMO])) break; if (_sp > XB_SPIN_CAP) { atomicAdd(&(bar)[XB_TMO], 1u); break; } } } } while (0)

struct XcdBarrier {
    unsigned* bar; unsigned x;
    volatile LAS unsigned* st;
};

__device__ __forceinline__ XcdBarrier xcd_barrier_post(unsigned* bar, volatile LAS unsigned* st) {
    XcdBarrier b; b.bar = bar; b.x = xb_xcc_id(); b.st = st;
    if (threadIdx.x == 0) (void)xb_add(&bar[XB_XCNT(b.x)], 1u);
    return b;
}
__device__ __forceinline__ void xcd_barrier_complete(unsigned* bar, unsigned x, unsigned& nloc, unsigned& nx) {
    const unsigned G = gridDim.x * gridDim.y * gridDim.z;
    unsigned sum, cnt, mine, sp = 0u;
    for (;;) {
        sum = 0u; cnt = 0u; mine = 0u;
#pragma unroll
        for (unsigned j = 0; j < 16; ++j) { const unsigned c = xb_ld(&bar[XB_XCNT(j)]); sum += c; cnt += (c > 0u) ? 1u : 0u; mine = (j == x) ? c : mine; }
        if (sum == G) break;
        __builtin_amdgcn_s_sleep(1);
        if ((++sp & 255u) == 0u) { if (xb_ld(&bar[XB_TMO])) break; if (sp > XB_SPIN_CAP) { atomicAdd(&bar[XB_TMO], 1u); break; } }
    }
    nloc = mine > 0u ? mine : 1u; nx = cnt > 0u ? cnt : 1u;
}

__device__ __forceinline__ void xcd_barrier(const XcdBarrier& b) {
    asm volatile("s_waitcnt vmcnt(0)" ::: "memory");
    __syncthreads();
    if (threadIdx.x == 0) {
        unsigned* bar = b.bar;
        __builtin_amdgcn_s_waitcnt(0);
        unsigned nloc = b.st[0], nx = b.st[1];
        if (nloc == 0u) { xcd_barrier_complete(bar, b.x, nloc, nx); b.st[0] = nloc; b.st[1] = nx; }
        const unsigned old = xb_add(&bar[XB_XSUB(b.x)], 1u);
        const unsigned gen = old / nloc;
        if (old + 1u == (gen + 1u) * nloc) {
            __builtin_amdgcn_fence(__ATOMIC_RELEASE, "agent");
            asm volatile("s_waitcnt vmcnt(0)" ::: "memory");
            const unsigned og = xb_add(&bar[XB_TOP], 1u);
            const unsigned tg = og / nx;
            if (og + 1u == (tg + 1u) * nx) xb_add(&bar[XB_TOPGEN], 1u);
            else XB_SPIN(xb_ld(&bar[XB_TOPGEN]) == tg, bar);
            __builtin_amdgcn_fence(__ATOMIC_ACQUIRE, "agent");
            xb_add(&bar[XB_XGEN(b.x)], 1u);
            asm volatile("s_waitcnt vmcnt(0)" ::: "memory");
        } else {
            XB_SPIN(xb_ld(&bar[XB_XGEN(b.x)]) == gen, bar);
            __builtin_amdgcn_fence(__ATOMIC_ACQUIRE, "agent");
            asm volatile("s_waitcnt vmcnt(0)" ::: "memory");
        }
    }
    __syncthreads();
}

struct Args { const float* in[N_IN]; float* out; unsigned char* ws; int ph_lo, ph_hi; };
static_assert(sizeof(Args) == 45 * 8 + 8, "Args has no holes");
typedef float f32x2 __attribute__((ext_vector_type(2)));
typedef unsigned v2u __attribute__((ext_vector_type(2)));
#define PIN(x) asm volatile("" : "+v"(x))
#define WAVE_SYNC() asm volatile("s_waitcnt lgkmcnt(0)" ::: "memory")
#define BLOCK_SYNC() do { asm volatile("s_waitcnt vmcnt(0) lgkmcnt(0)" ::: "memory"); __builtin_amdgcn_s_barrier(); asm volatile("" ::: "memory"); } while (0)
__device__ __forceinline__ float bf_lo(unsigned u) { return __uint_as_float(u << 16); }
__device__ __forceinline__ float bf_hi(unsigned u) { return __uint_as_float(u & 0xffff0000u); }
__device__ __forceinline__ float bf2f(bf16 b) { return __uint_as_float((unsigned)b << 16); }
__device__ __forceinline__ unsigned cvtpk(float lo, float hi) { return pg8::cvt_pk_bf16(lo, hi); }
__device__ __forceinline__ bf16 f2b(float f) { return (bf16)(cvtpk(f, 0.f) & 0xffffu); }
template <int CTRL> __device__ __forceinline__ float dppf(float v) { return __builtin_bit_cast(float, __builtin_amdgcn_update_dpp(0, __builtin_bit_cast(int, v), CTRL, 0xf, 0xf, false)); }
__device__ __forceinline__ float sum16(float v) { v += dppf<0xB1>(v); v += dppf<0x4E>(v); v += dppf<0x141>(v); v += dppf<0x140>(v); return v; }
__device__ __forceinline__ float max16(float v) { v = fmaxf(v, dppf<0xB1>(v)); v = fmaxf(v, dppf<0x4E>(v)); v = fmaxf(v, dppf<0x141>(v)); v = fmaxf(v, dppf<0x140>(v)); return v; }
__device__ __forceinline__ float wave_sum(float v) { v = sum16(v);
    const float r0 = __builtin_bit_cast(float, __builtin_amdgcn_readlane(__builtin_bit_cast(int, v), 0)), r1 = __builtin_bit_cast(float, __builtin_amdgcn_readlane(__builtin_bit_cast(int, v), 16)),
                r2 = __builtin_bit_cast(float, __builtin_amdgcn_readlane(__builtin_bit_cast(int, v), 32)), r3 = __builtin_bit_cast(float, __builtin_amdgcn_readlane(__builtin_bit_cast(int, v), 48));
    return (r0 + r1) + (r2 + r3); }
__device__ __forceinline__ float wave_max(float v) { v = max16(v);
    const float r0 = __builtin_bit_cast(float, __builtin_amdgcn_readlane(__builtin_bit_cast(int, v), 0)), r1 = __builtin_bit_cast(float, __builtin_amdgcn_readlane(__builtin_bit_cast(int, v), 16)),
                r2 = __builtin_bit_cast(float, __builtin_amdgcn_readlane(__builtin_bit_cast(int, v), 32)), r3 = __builtin_bit_cast(float, __builtin_amdgcn_readlane(__builtin_bit_cast(int, v), 48));
    return fmaxf(fmaxf(r0, r1), fmaxf(r2, r3)); }
__device__ __forceinline__ float silu_f(float x) { return x * __builtin_amdgcn_rcpf(1.f + __expf(-x)); }
__device__ __forceinline__ float sigmoid_f(float x) { return __builtin_amdgcn_rcpf(1.f + __expf(-x)); }
__device__ __forceinline__ float softplus_f(float x) { return x > 20.f ? x : log1pf(expf(x)); }
__device__ __forceinline__ float gelu_tanh_f(float x) { const float u = 0.7978845608f * (x + 0.044715f * x * x * x); const float e = __expf(2.f * u); const float th = 1.f - 2.f * __builtin_amdgcn_rcpf(e + 1.f); return 0.5f * x * (1.f + th); }
__device__ __forceinline__ f32x4 mfma16(bf16x8 a, bf16x8 b, f32x4 c) { return __builtin_amdgcn_mfma_f32_16x16x32_bf16(a, b, c, 0, 0, 0); }
__device__ __forceinline__ bf16x8 ldsfrag(const LAS unsigned char* p) { return *(const LAS bf16x8*)p; }
__device__ __forceinline__ bf16x8 gfrag(const bf16* p) { return *(const bf16x8*)p; }
__device__ __forceinline__ bf16x8 pack8(f32x4 a, f32x4 b) { v4u w; w.x = cvtpk(a[0], a[1]); w.y = cvtpk(a[2], a[3]); w.z = cvtpk(b[0], b[1]); w.w = cvtpk(b[2], b[3]); return __builtin_bit_cast(bf16x8, w); }
__device__ __forceinline__ void unpack8(v4u w, float (&f)[8]) { f[0] = bf_lo(w.x); f[1] = bf_hi(w.x); f[2] = bf_lo(w.y); f[3] = bf_hi(w.y); f[4] = bf_lo(w.z); f[5] = bf_hi(w.z); f[6] = bf_lo(w.w); f[7] = bf_hi(w.w); }
__device__ __forceinline__ size_t sfrag(int r, int k, int K) { return ((size_t)((r >> 4) * (K >> 5) + (k >> 5)) << 9) + (size_t)(((((k >> 3) & 3) * 16 + (r & 15)) << 3) + (k & 7)); }
__device__ __forceinline__ void dsincos(double x, double& s, double& c) {
    const double k = rint(x * 0.63661977236758134308); double r = fma(-k, 1.57079632673412561417e+00, x); r = fma(-k, 6.07710050650619224932e-11, r);
    const double r2 = r * r;
    double sp = -7.6471637318198164759e-13; sp = fma(sp, r2, 1.6059043836821614599e-10); sp = fma(sp, r2, -2.5052108385441718775e-08); sp = fma(sp, r2, 2.7557319223985890653e-06); sp = fma(sp, r2, -1.9841269841269841270e-04);
    sp = fma(sp, r2, 8.3333333333333333333e-03); sp = fma(sp, r2, -1.6666666666666666667e-01); const double sr = fma(sp * r2, r, r);
    double cp = 4.7794773323873852974e-14; cp = fma(cp, r2, -1.1470745597729724714e-11); cp = fma(cp, r2, 2.0876756987868098979e-09); cp = fma(cp, r2, -2.7557319223985890653e-07); cp = fma(cp, r2, 2.4801587301587301587e-05);
    cp = fma(cp, r2, -1.3888888888888888889e-03); cp = fma(cp, r2, 4.1666666666666666667e-02); cp = fma(cp, r2, -0.5); const double cr = fma(cp, r2, 1.0);
    const int q = (int)k & 3;
    s = (q == 0) ? sr : (q == 1) ? cr : (q == 2) ? -sr : -cr; c = (q == 0) ? cr : (q == 1) ? -sr : (q == 2) ? -cr : sr;
}

__device__ __forceinline__ void p0_transpose_item(const float* W, int ldw, int scol0, int K, int k0, const float* gain, bf16* WT, int drow0, LAS unsigned char* scr, int lane, bool frag = false) {
    const int kq = lane >> 4, n4 = lane & 15;
    f32x4 t[8][2]; float g[8][2];
#pragma unroll
    for (int s = 0; s < 8; ++s)
#pragma unroll
        for (int h = 0; h < 2; ++h) { const int k = k0 + 8 * s + 2 * kq + h; t[s][h] = __builtin_nontemporal_load((const GAS f32x4*)(W + (size_t)k * ldw + scol0 + 4 * n4)); g[s][h] = gain ? gain[k] : 1.f; }
#pragma unroll
    for (int s = 0; s < 8; ++s) { PIN(t[s][0]); PIN(t[s][1]); }
#pragma unroll
    for (int s = 0; s < 8; ++s)
#pragma unroll
        for (int e = 0; e < 4; ++e) *(LAS unsigned*)(scr + ((4 * n4 + e) * 68 + 8 * s + 2 * kq) * 2) = cvtpk(t[s][0][e] * g[s][0], t[s][1][e] * g[s][1]);
    LDS_WAIT(); asm volatile("" ::: "memory");
    const int c = lane & 7;
#pragma unroll
    for (int j = 0; j < 8; ++j) { const int n = (lane >> 3) + 8 * j; const v2u a = *(const LAS v2u*)(scr + (n * 68 + 8 * c) * 2), b = *(const LAS v2u*)(scr + (n * 68 + 8 * c + 4) * 2);
        *(GAS v4u*)(WT + (frag ? sfrag(drow0 + n, k0 + 8 * c, K) : (size_t)(drow0 + n) * K + k0 + 8 * c)) = (v4u){a.x, a.y, b.x, b.y}; }
    LDS_WAIT(); asm volatile("" ::: "memory");
}
__device__ __forceinline__ void p0_mat(const float* W, int ldw, int K, int N, const float* gain, bf16* WT, int drow_base, int item, LAS unsigned char* scr, int lane, bool frag = false) {
    const int nblk = N / 64, kb = item / nblk, nb = item % nblk;
    p0_transpose_item(W, ldw, 64 * nb, K, 64 * kb, gain, WT, drow_base + 64 * nb, scr, lane, frag);
}
constexpr int P0W_IN = (D / 64) * (NIN / 64), P0W_SQ = (D / 64) * (D / 64), P0W_UP = (D / 64) * (FF / 64), P0W_DN = (FF / 64) * (D / 64), P0W_GLU = (512 / 64) * (512 / 64), P0W_PW = (128 / 64) * (128 / 64);
constexpr int P0W_LAYER = P0W_IN + 5 * P0W_SQ + P0W_UP + P0W_DN + P0W_GLU + 4 * P0W_PW, P0W_DEF_N = P0W_UP + P0W_DN + P0W_GLU + 4 * P0W_PW + P0W_IN + P0W_SQ, P0W_DEF_LO = NL * P0W_LAYER - P0W_DEF_N;
__device__ __forceinline__ void p0_weights(const Args& A, LAS unsigned char* lds, int gw, int NGW, int first, int count, int skip_at, int skip_n, int wave, int lane) {
    asm volatile("" : "+v"(lane));
    LAS unsigned char* scr = lds + RING_OFF + wave * 16384;
    unsigned char* ws = A.ws;
    constexpr int I_IN = P0W_IN, I_SQ = P0W_SQ, I_UP = P0W_UP, I_DN = P0W_DN, I_GLU = P0W_GLU, I_PW = P0W_PW, I_LAYER = P0W_LAYER;
#pragma unroll 1
    for (int i = gw; i < count; i += NGW) { int it = first + i; if (it >= skip_at) it += skip_n;
        const int l = it / I_LAYER; int r = it % I_LAYER + I_IN + I_SQ; if (r >= I_LAYER) r -= I_LAYER;
        bf16* wl = (bf16*)(ws + WS_W + (size_t)l * W_L); unsigned char* tb = ws + WS_TAB + (size_t)l * TAB_L;
        const float* W; const float* gain = nullptr; bf16* WT; int ldw, K, N, drow = 0; bool frag = false;
        if (r < I_IN) { const int nblk = NIN / 64, kb = r / nblk, nb = r % nblk, n0 = 64 * nb;
            p0_transpose_item(A.in[I_W_IN] + (size_t)l * D * INW, INW, n0 + (n0 >= 1280 ? 8 : 0), D, 64 * kb, A.in[I_G_MIX] + l * D, (bf16*)((unsigned char*)wl + WO_IN), n0, scr, lane); continue; } r -= I_IN;
        if (r < I_SQ) { W = A.in[I_W_OUT] + (size_t)l * D * D; gain = A.in[I_G_MIXOUT] + l * D; WT = (bf16*)((unsigned char*)wl + WO_OUT); ldw = D; K = D; N = D; }
        else if (r < 2 * I_SQ) { r -= I_SQ; W = A.in[I_W_Q] + (size_t)l * D * D; gain = A.in[I_G_XA] + l * D; WT = (bf16*)((unsigned char*)wl + WO_Q); ldw = D; K = D; N = D; }
        else if (r < 3 * I_SQ) { r -= 2 * I_SQ; W = A.in[I_W_O] + (size_t)l * D * D; WT = (bf16*)((unsigned char*)wl + WO_O); ldw = D; K = D; N = D; }
        else if (r < 4 * I_SQ) { r -= 3 * I_SQ; W = A.in[I_W_K] + (size_t)l * D * D; gain = A.in[I_G_MEM] + l * D; WT = (bf16*)(ws + WS_WKV); drow = l * 4096; ldw = D; K = D; N = D; }
        else if (r < 5 * I_SQ) { r -= 4 * I_SQ; W = A.in[I_W_V] + (size_t)l * D * D; gain = A.in[I_G_MEM] + l * D; WT = (bf16*)(ws + WS_WKV); drow = l * 4096 + 2048; ldw = D; K = D; N = D; }
        else if (r < 5 * I_SQ + I_UP) { r -= 5 * I_SQ; W = A.in[I_W_UP] + (size_t)l * D * FF; gain = A.in[I_G_MLP] + l * D; WT = (bf16*)((unsigned char*)wl + WO_UP); ldw = FF; K = D; N = FF; }
        else if (r < 5 * I_SQ + I_UP + I_DN) { r -= 5 * I_SQ + I_UP; W = A.in[I_W_DOWN] + (size_t)l * FF * D; WT = (bf16*)((unsigned char*)wl + WO_DOWN); ldw = D; K = FF; N = D; }
        else if (r < 5 * I_SQ + I_UP + I_DN + I_GLU) { r -= 5 * I_SQ + I_UP + I_DN; W = A.in[I_W_GLU] + (size_t)l * 512 * 512; WT = (bf16*)(tb + TB_WGLUT); ldw = 512; K = 512; N = 512; frag = true; }
        else { r -= 5 * I_SQ + I_UP + I_DN + I_GLU; const int gI = r / I_PW; r = r % I_PW; W = A.in[I_POOL_W] + ((size_t)l * 4 + gI) * 128 * 128; WT = (bf16*)(tb + TB_WPT) + gI * 128 * 128; ldw = 128; K = 128; N = 128; frag = true; }
        p0_mat(W, ldw, K, N, gain, WT, drow, r, scr, lane, frag);
    }
}
__device__ __forceinline__ void p0_prologue(const Args& A, LAS unsigned char* lds, int vcu, int G, int wave, int lane) {
    asm volatile("" : "+v"(lane));
    const int gw = vcu * NWAVES + wave, NGW = G * NWAVES;
    unsigned char* ws = A.ws;
    { const int nskip = G == 256 ? P0W_DEF_N : 0; p0_weights(A, lds, gw, NGW, 0, NL * P0W_LAYER - nskip, P0W_DEF_LO, nskip, wave, lane); }
    bf16* HB = (bf16*)(ws + WS_HB); unsigned long long* ssq0 = (unsigned long long*)((unsigned*)(ws + WS_CTL) + CW_SSQ);
#pragma unroll 1
    for (int m = gw; m < MR; m += NGW) {
        f32x4 v[8]; const GAS f32x4* xr = (const GAS f32x4*)(m < MP ? A.in[I_XP] + (size_t)m * D : A.in[I_XS] + (size_t)(m - MP) * D) + lane;
#pragma unroll
        for (int j = 0; j < 8; ++j) v[j] = __builtin_nontemporal_load(xr + 64 * j);
#pragma unroll
        for (int j = 0; j < 8; ++j) PIN(v[j]);
        float s = 0.f;
#pragma unroll
        for (int j = 0; j < 8; ++j) s += (v[j].x * v[j].x + v[j].y * v[j].y) + (v[j].z * v[j].z + v[j].w * v[j].w);
        s = wave_sum(s);
        GAS v2u* br = (GAS v2u*)(HB + (size_t)m * D) + lane;
#pragma unroll
        for (int j = 0; j < 8; ++j) { v2u w; w.x = cvtpk(v[j].x, v[j].y); w.y = cvtpk(v[j].z, v[j].w); br[64 * j] = w;
            if (m >= MP) *(GAS v2u*)((bf16*)(ws + WS_SA + SA_HB) + sfrag(m - MP, 4 * lane + 256 * j, D)) = w; }
        if (lane == 0) ssq0[m] = (unsigned long long)__float2ull_rn(s * 16777216.0f);
    }
    bf16* MEMB = (bf16*)(ws + WS_MEMB); float* RSTDM = (float*)(ws + WS_RSTDM);
#pragma unroll 1
    for (int m = gw; m < MROWS; m += NGW) {
        const GAS f32x4* xr = (const GAS f32x4*)(A.in[I_MEM] + (size_t)m * D) + lane; f32x4 v[8]; float s = 0.f;
#pragma unroll
        for (int j = 0; j < 8; ++j) v[j] = xr[64 * j];
#pragma unroll
        for (int j = 0; j < 8; ++j) PIN(v[j]);
#pragma unroll
        for (int j = 0; j < 8; ++j) s += (v[j].x * v[j].x + v[j].y * v[j].y) + (v[j].z * v[j].z + v[j].w * v[j].w);
        s = wave_sum(s);
        GAS v2u* br = (GAS v2u*)(MEMB + (size_t)m * D) + lane;
#pragma unroll
        for (int j = 0; j < 8; ++j) { v2u w; w.x = cvtpk(v[j].x, v[j].y); w.y = cvtpk(v[j].z, v[j].w); br[64 * j] = w; }
        if (lane == 0) RSTDM[m] = 1.0f / sqrtf(s * (1.0f / D) + EPS);
    }
    { bf16* WQKD = (bf16*)(ws + WS_WQKD);
#pragma unroll 1
        for (int m = gw; m < NL * D; m += NGW) { const int l = m >> 11, k = m & 2047; const float gk = A.in[I_G_XA][l * D + k];
            const GAS f32x4* xr = (const GAS f32x4*)(A.in[I_W_Q] + ((size_t)l * D + k) * D) + lane; f32x4 v[8];
#pragma unroll
            for (int j = 0; j < 8; ++j) v[j] = __builtin_nontemporal_load(xr + 64 * j);
#pragma unroll
            for (int j = 0; j < 8; ++j) PIN(v[j]);
            GAS v2u* br = (GAS v2u*)(WQKD + (size_t)m * D) + lane;
#pragma unroll
            for (int j = 0; j < 8; ++j) { v2u w; w.x = cvtpk(v[j].x * gk, v[j].y * gk); w.y = cvtpk(v[j].z * gk, v[j].w * gk); br[64 * j] = w; } } }
    const int gt = gw * 64 + lane, NGT = NGW * 64;
    for (int i2 = gt; i2 < NL * 2048 * 16 * 2; i2 += NGT) { if (i2 & 1) continue; const int i = i2 >> 5, k = (i2 >> 1) & 15;
        const int l = i >> 11, gn = i & 2047, g = gn >> 6, n = gn & 63; unsigned char* tb = ws + WS_TAB + (size_t)l * TAB_L;
        const double lr = (double)A.in[I_LAM_RE][l * 2048 + gn], li = (double)A.in[I_LAM_IM][l * 2048 + gn], dl = exp((double)A.in[I_LOG_DT][l * 32 + g]);
        const float bref = A.in[I_B_RE][((size_t)l * 2048 + gn) * 16 + k], bimf = A.in[I_B_IM][((size_t)l * 2048 + gn) * 16 + k];
        const float cref = A.in[I_C_RE][((size_t)l * 32 + g) * 1024 + k * 64 + n], cimf = A.in[I_C_IM][((size_t)l * 32 + g) * 1024 + k * 64 + n];
        double s1, c1, sL, cL; dsincos(li * dl, s1, c1); dsincos(li * dl * (double)S5_L, sL, cL);
        const double m1 = exp(lr * dl), mL = exp(lr * dl * (double)S5_L), ar = m1 * c1, ai = m1 * s1;
        if (k == 0) { ((f32x2*)(tb + TB_ABAR))[gn] = (f32x2){(float)ar, (float)ai}; ((f32x2*)(tb + TB_ABARL))[gn] = (f32x2){(float)(mL * cL), (float)(mL * sL)}; }
        const double den = lr * lr + li * li, cr = ((ar - 1.0) * lr + ai * li) / den, ci = (ai * lr - (ar - 1.0) * li) / den;
        f32x2* bb = (f32x2*)(tb + TB_BBAR) + (size_t)g * 16 * 64 + n; bf16* cmt = (bf16*)(tb + TB_CMT) + (size_t)g * 16 * 128;
        bf16* bbt = (bf16*)(tb + TB_BBT) + (size_t)g * 128 * 16;
        { const double br = bref, bi = bimf; bb[k * 64] = (f32x2){(float)(cr * br - ci * bi), (float)(cr * bi + ci * br)};
            bbt[n * 16 + k] = f2b((float)(cr * br - ci * bi)); bbt[(64 + n) * 16 + k] = f2b((float)(cr * bi + ci * br));
            cmt[k * 128 + n] = f2b(cref); cmt[k * 128 + 64 + n] = f2b(-cimf); }
    }
    for (int i2 = gt; i2 < NL * D * 32; i2 += NGT) { if (i2 & 31) continue; const int i = i2 >> 5;
        const int l = i >> 11, k = i & 2047; const float g = A.in[I_G_MIX][l * D + k]; const float* w = A.in[I_W_IN] + ((size_t)l * D + k) * INW + 1280;
        float* o = (float*)(ws + WS_TAB + (size_t)l * TAB_L + TB_WDT) + k * 8;
#pragma unroll
        for (int j = 0; j < 8; ++j) o[j] = g * w[j];
    }
}

__device__ __forceinline__ void dt_rows(const Args& A, LAS unsigned char* lds, int l, int vcu, int G, int tid) {
    asm volatile("" : "+v"(tid)); const int lane = tid & 63, wave = __builtin_amdgcn_readfirstlane(tid >> 6);
    unsigned char* ws = A.ws; const bf16* HB = (const bf16*)(ws + WS_HB); const float* WDT = (const float*)(ws + WS_TAB + (size_t)l * TAB_L + TB_WDT);
    const unsigned long long* ssq = (const unsigned long long*)((const unsigned*)(ws + WS_CTL) + CW_SSQ) + (3 * l) * MPAD; float* DTV = (float*)(ws + WS_DTV);
    { v4u t[8];
#pragma unroll
        for (int j = 0; j < 8; ++j) t[j] = *(const GAS v4u*)((const unsigned char*)WDT + (tid + NTHR * j) * 16);
#pragma unroll
        for (int j = 0; j < 8; ++j) PIN(t[j]);
#pragma unroll
        for (int j = 0; j < 8; ++j) { const int p = tid + NTHR * j, k = p >> 1; *(LAS v4u*)(lds + (k >> 3) * 272 + (k & 7) * 32 + (p & 1) * 16) = t[j]; } }
    BLOCK_SYNC();
    const int gw = vcu * NWAVES + wave, NGW = G * NWAVES; const float bias = A.in[I_DT_BIAS][l * 8 + (lane & 7)];
#pragma unroll 1
    for (int m0 = gw; m0 < MR; m0 += 2 * NGW) { const int m1 = m0 + NGW; const bool has1 = m1 < MR; const int m1c = has1 ? m1 : m0;
        v4u x0[4], x1[4];
#pragma unroll
        for (int i = 0; i < 4; ++i) { x0[i] = *(const GAS v4u*)(HB + (size_t)m0 * D + 8 * lane + 512 * i); x1[i] = *(const GAS v4u*)(HB + (size_t)m1c * D + 8 * lane + 512 * i); }
#pragma unroll
        for (int i = 0; i < 4; ++i) { PIN(x0[i]); PIN(x1[i]); }
        float a0[8], a1[8];
#pragma unroll
        for (int j = 0; j < 8; ++j) { a0[j] = 0.f; a1[j] = 0.f; }
#pragma unroll
        for (int i = 0; i < 4; ++i) { float f0[8], f1[8]; unpack8(x0[i], f0); unpack8(x1[i], f1);
#pragma unroll
            for (int e = 0; e < 8; ++e) { const LAS float* wp = (const LAS float*)(lds + (lane + 64 * i) * 272 + e * 32); const f32x4 w0 = *(const LAS f32x4*)wp, w1 = *(const LAS f32x4*)(wp + 4);
                a0[0] += f0[e] * w0.x; a0[1] += f0[e] * w0.y; a0[2] += f0[e] * w0.z; a0[3] += f0[e] * w0.w; a0[4] += f0[e] * w1.x; a0[5] += f0[e] * w1.y; a0[6] += f0[e] * w1.z; a0[7] += f0[e] * w1.w;
                a1[0] += f1[e] * w0.x; a1[1] += f1[e] * w0.y; a1[2] += f1[e] * w0.z; a1[3] += f1[e] * w0.w; a1[4] += f1[e] * w1.x; a1[5] += f1[e] * w1.y; a1[6] += f1[e] * w1.z; a1[7] += f1[e] * w1.w; } }
        float v0 = 0.f, v1 = 0.f;
#pragma unroll
        for (int j = 0; j < 8; ++j) { const float s0 = wave_sum(a0[j]), s1 = wave_sum(a1[j]); if ((lane & 7) == j) { v0 = s0; v1 = s1; } }
        if (lane < 8) { DTV[(size_t)m0 * 8 + lane] = softplus_f(v0 * pg8::ssq_rstd(ssq[m0]) + bias);
            if (has1) DTV[(size_t)m1 * 8 + lane] = softplus_f(v1 * pg8::ssq_rstd(ssq[m1]) + bias); }
    }
    BLOCK_SYNC();
}

__device__ __forceinline__ void lds_add(LAS float* p, float v) { (void)__hip_atomic_fetch_add(p, v, __ATOMIC_RELAXED, __HIP_MEMORY_SCOPE_WORKGROUP); }

__device__ __forceinline__ float wave_scan_incl(float v, int lane) {
#pragma unroll
    for (int o = 1; o < 64; o <<= 1) { const float t = __shfl_up(v, o); if (lane >= o) v += t; }
    return v;
}
template <int NCH> __device__ __forceinline__ void conv8(const bf16* proj, const float* cw, const float* cb, int grow0, int t0, bool seq_first, int cx0, float (&out)[8][NCH]) {
    float raw[11][NCH]; float w[4][NCH], bsv[NCH];
    unsigned rw[11][(NCH + 1) / 2];
#pragma unroll
    for (int r = 0; r < 11; ++r) { const int tt = t0 - 3 + r; const bf16* p = proj + (size_t)(grow0 + ((seq_first && tt < 0) ? 0 : tt)) * NIN + C_XBC + cx0;
        if constexpr (NCH == 4) { const v2u v = *(const GAS v2u*)p; rw[r][0] = v.x; rw[r][1] = v.y; }
        else if constexpr (NCH == 2) { rw[r][0] = *(const GAS unsigned*)p; }
        else { rw[r][0] = (unsigned)*p; } }
#pragma unroll
    for (int e = 0; e < NCH; ++e) { bsv[e] = cb[cx0 + e];
#pragma unroll
        for (int j = 0; j < 4; ++j) w[j][e] = cw[j * 768 + cx0 + e]; }
#pragma unroll
    for (int r = 0; r < 11; ++r)
#pragma unroll
        for (int q = 0; q < (NCH + 1) / 2; ++q) PIN(rw[r][q]);
#pragma unroll
    for (int r = 0; r < 11; ++r) { const bool z = seq_first && (t0 - 3 + r) < 0;
        if constexpr (NCH == 1) raw[r][0] = z ? 0.f : __uint_as_float(rw[r][0] << 16);
        else {
#pragma unroll
            for (int q = 0; q < NCH / 2; ++q) { raw[r][2 * q] = z ? 0.f : bf_lo(rw[r][q]); raw[r][2 * q + 1] = z ? 0.f : bf_hi(rw[r][q]); } } }
#pragma unroll
    for (int i = 0; i < 8; ++i)
#pragma unroll
        for (int e = 0; e < NCH; ++e) { const float v = bsv[e] + w[0][e] * raw[i][e] + w[1][e] * raw[i + 1][e] + w[2][e] * raw[i + 2][e] + w[3][e] * raw[i + 3][e]; out[i][e] = silu_f(v); }
}

__device__ __forceinline__ void ma_ssd_unit(const Args& A, LAS unsigned char* lds, int l, int b, int c, int grp, int tid, int lane, int wave) {
    asm volatile("" : "+v"(tid)); lane = tid & 63; wave = __builtin_amdgcn_readfirstlane(tid >> 6);
    unsigned char* ws = A.ws; const bf16* proj = (const bf16*)(ws + WS_PROJ); const float* DTV = (const float*)(ws + WS_DTV);
    LAS float* AC = (LAS float*)(lds); LAS float* DTs = (LAS float*)(lds + 1024); LAS unsigned char* XT = lds + 2048; LAS unsigned char* BT = lds + 2048 + 36864;
    const int grow0 = b * T + c * SSD_L;
    if (wave < 4) { const int h = 4 * grp + wave; const float an = -expf(A.in[I_A_LOG][l * 8 + h]); const float dt = DTV[(size_t)(grow0 + lane) * 8 + h];
        AC[wave * 64 + lane] = wave_scan_incl(dt * an, lane); DTs[wave * 64 + lane] = dt; }
    BLOCK_SYNC();
    { const int t0 = 8 * wave; const float* cw = A.in[I_CONV_W] + l * 4 * 768; const float* cb = A.in[I_CONV_B] + l * 768;
        float xs[8][4]; conv8<4>(proj, cw, cb, grow0, t0, c == 0, 256 * grp + 4 * lane, xs);
        const int hl = lane >> 4, p0 = 4 * (lane & 15); const float alast = AC[hl * 64 + 63];
        float sc[8];
#pragma unroll
        for (int i = 0; i < 8; ++i) sc[i] = DTs[hl * 64 + t0 + i] * __expf(alast - AC[hl * 64 + t0 + i]);
#pragma unroll
        for (int e = 0; e < 4; ++e) { v4u w; w.x = cvtpk(xs[0][e] * sc[0], xs[1][e] * sc[1]); w.y = cvtpk(xs[2][e] * sc[2], xs[3][e] * sc[3]); w.z = cvtpk(xs[4][e] * sc[4], xs[5][e] * sc[5]); w.w = cvtpk(xs[6][e] * sc[6], xs[7][e] * sc[7]);
            *(LAS v4u*)(XT + ((hl * 64 + p0 + e) * 72 + t0) * 2) = w; }
        float bm[8][1]; conv8<1>(proj, cw, cb, grow0, t0, c == 0, 512 + 64 * grp + lane, bm);
        v4u w; w.x = cvtpk(bm[0][0], bm[1][0]); w.y = cvtpk(bm[2][0], bm[3][0]); w.z = cvtpk(bm[4][0], bm[5][0]); w.w = cvtpk(bm[6][0], bm[7][0]);
        *(LAS v4u*)(BT + (lane * 72 + t0) * 2) = w; }
    BLOCK_SYNC();
    { const int hl = wave >> 1, ph = wave & 1, fr = lane & 15, fq = lane >> 4; f32x4 acc[2][4];
#pragma unroll
        for (int i = 0; i < 2; ++i)
#pragma unroll
            for (int j = 0; j < 4; ++j) acc[i][j] = (f32x4){0.f, 0.f, 0.f, 0.f};
#pragma unroll
        for (int ks = 0; ks < 2; ++ks) { bf16x8 fb[4], fx[2];
#pragma unroll
            for (int j = 0; j < 4; ++j) fb[j] = ldsfrag(BT + ((16 * j + fr) * 72 + 32 * ks + 8 * fq) * 2);
#pragma unroll
            for (int i = 0; i < 2; ++i) fx[i] = ldsfrag(XT + ((hl * 64 + 32 * ph + 16 * i + fr) * 72 + 32 * ks + 8 * fq) * 2);
#pragma unroll
            for (int i = 0; i < 2; ++i)
#pragma unroll
                for (int j = 0; j < 4; ++j) acc[i][j] = mfma16(fb[j], fx[i], acc[i][j]); }
        float* SS = (float*)(ws + WS_SS) + ((size_t)(b * SSD_NC + c) * 8 + 4 * grp + hl) * 4096;
#pragma unroll
        for (int i = 0; i < 2; ++i)
#pragma unroll
            for (int j = 0; j < 4; ++j) *(GAS f32x4*)(SS + (32 * ph + 16 * i + fr) * 64 + 16 * j + 4 * fq) = acc[i][j]; }
    if (tid < 4) ((float*)(ws + WS_CD))[(b * SSD_NC + c) * 8 + 4 * grp + tid] = expf(AC[tid * 64 + 63]);
    BLOCK_SYNC();
}

__device__ __forceinline__ void s5_bu(const Args& A, int l, int g, int grow0, int lane, LAS unsigned char* HS, float& ar, float& ai) {
    const unsigned char* tb = A.ws + WS_TAB + (size_t)l * TAB_L; const bf16* proj = (const bf16*)(A.ws + WS_PROJ); const int fr = lane & 15, fq = lane >> 4;
    const bf16* up = proj + (size_t)(grow0 + fr) * NIN + C_U5 + 16 * g + 8 * (fq & 1); const bf16* bp = (const bf16*)(tb + TB_BBT) + ((size_t)g * 128 + fr) * 16 + 8 * (fq & 1);
    v4u fu[2], fb[8];
#pragma unroll
    for (int rt = 0; rt < 2; ++rt) fu[rt] = *(const GAS v4u*)(up + (size_t)rt * 16 * NIN);
#pragma unroll
    for (int ct = 0; ct < 8; ++ct) fb[ct] = *(const GAS v4u*)(bp + ct * 256);
    f32x2 a = ((const f32x2*)(tb + TB_ABAR))[g * 64 + lane];
    PIN(fu[0]); PIN(fu[1]); PIN(a);
#pragma unroll
    for (int ct = 0; ct < 8; ++ct) PIN(fb[ct]);
    const v4u z = (v4u){0u, 0u, 0u, 0u}; const bool hi2 = fq >= 2;
#pragma unroll
    for (int rt = 0; rt < 2; ++rt) fu[rt] = hi2 ? z : fu[rt];
#pragma unroll
    for (int ct = 0; ct < 8; ++ct) fb[ct] = hi2 ? z : fb[ct];
#pragma unroll
    for (int rt = 0; rt < 2; ++rt)
#pragma unroll
        for (int ct = 0; ct < 8; ++ct) { const f32x4 d = mfma16(__builtin_bit_cast(bf16x8, fu[rt]), __builtin_bit_cast(bf16x8, fb[ct]), (f32x4){0.f, 0.f, 0.f, 0.f});
#pragma unroll
            for (int e = 0; e < 4; ++e) *(LAS bf16*)(HS + ((16 * rt + 4 * fq + e) * 136 + 16 * ct + fr) * 2) = f2b(d[e]); }
    ar = a.x; ai = a.y;
    WAVE_SYNC();
}
template <bool WRITEBACK> __device__ __forceinline__ void s5_scan(LAS unsigned char* HS, int lane, float ar, float ai, float& hr, float& hi) {
#pragma unroll 1
    for (int t0 = 0; t0 < S5_L; t0 += 8) { unsigned short br[8], bi[8];
#pragma unroll
        for (int i = 0; i < 8; ++i) { br[i] = *(const LAS bf16*)(HS + ((t0 + i) * 136 + lane) * 2); bi[i] = *(const LAS bf16*)(HS + ((t0 + i) * 136 + 64 + lane) * 2); }
#pragma unroll
        for (int i = 0; i < 8; ++i) { const float nr = ar * hr - ai * hi + bf2f(br[i]), ni = ar * hi + ai * hr + bf2f(bi[i]); hr = nr; hi = ni;
            if (WRITEBACK) { *(LAS bf16*)(HS + ((t0 + i) * 136 + lane) * 2) = f2b(hr); *(LAS bf16*)(HS + ((t0 + i) * 136 + 64 + lane) * 2) = f2b(hi); } } }
}
__device__ __forceinline__ void ma_s5_unit(const Args& A, LAS unsigned char* lds, int l, int b, int c, int lane, int wave) {
    asm volatile("" : "+v"(lane));
    LAS unsigned char* HS = lds + wave * 8704; const int grow0 = b * T + c * S5_L;
    float* ER = (float*)(A.ws + WS_S5ER); float* EI = (float*)(A.ws + WS_S5EI);
#pragma unroll 1
    for (int gi = 0; gi < 4; ++gi) { const int g = 4 * wave + gi; float ar, ai; s5_bu(A, l, g, grow0, lane, HS, ar, ai);
        float hr = 0.f, hi = 0.f; s5_scan<false>(HS, lane, ar, ai, hr, hi);
        const size_t o = ((size_t)(b * S5_NC + c) * 32 + g) * 64 + lane; ER[o] = hr; EI[o] = hi;
        WAVE_SYNC(); }
    BLOCK_SYNC();
}

__device__ __forceinline__ void mb_scan(const Args& A, int l, int vcu, int G, int tid, int dm = 0) {
    asm volatile("" : "+v"(tid));
    unsigned char* ws = A.ws; const int gt = vcu * NTHR + tid, NGT = G * NTHR;
    float* SS = (float*)(ws + (dm ? WS_END + 200 * MiB : WS_SS)); const float* CD = (const float*)(ws + WS_CD); float* outp = dm ? (float*)(ws + WS_END + 240 * MiB) : A.out;
#pragma unroll 1
    for (int i = gt; i < NB * 8 * 4096; i += NGT) { const int b = i >> 15, h = (i >> 12) & 7, pn = i & 4095; float run = 0.f; float s[SSD_NC], d[SSD_NC];
        float* p = SS + ((size_t)(b * SSD_NC) * 8 + h) * 4096 + pn; const float* dp = CD + (b * SSD_NC) * 8 + h;
#pragma unroll
        for (int c = 0; c < SSD_NC; ++c) { s[c] = p[(size_t)c * 8 * 4096]; d[c] = dp[c * 8]; }
#pragma unroll
        for (int c = 0; c < SSD_NC; ++c) { PIN(s[c]); PIN(d[c]); }
#pragma unroll
        for (int c = 0; c < SSD_NC; ++c) { p[(size_t)c * 8 * 4096] = run; run = run * d[c] + s[c]; }
        outp[O_PSSD + (size_t)l * NB * 8 * 4096 + i] = run; }
    float* ER = (float*)(ws + (dm ? WS_END + 220 * MiB : WS_S5ER)); float* EI = (float*)(ws + (dm ? WS_END + 224 * MiB : WS_S5EI)); const f32x2* AL = (const f32x2*)(ws + WS_TAB + (size_t)l * TAB_L + TB_ABARL);
#pragma unroll 1
    for (int i = gt; i < NB * 2048; i += NGT) { const int b = i >> 11, gn = i & 2047; const f32x2 a = AL[gn]; float rr = 0.f, ri = 0.f;
#pragma unroll 1
        for (int c0 = 0; c0 < S5_NC; c0 += 32) { float er[32], ei[32]; const size_t o = (size_t)(b * S5_NC + c0) * 2048 + gn;
#pragma unroll
            for (int c = 0; c < 32; ++c) { er[c] = ER[o + (size_t)c * 2048]; ei[c] = EI[o + (size_t)c * 2048]; }
#pragma unroll
            for (int c = 0; c < 32; ++c) { PIN(er[c]); PIN(ei[c]); }
#pragma unroll
            for (int c = 0; c < 32; ++c) { ER[o + (size_t)c * 2048] = rr; EI[o + (size_t)c * 2048] = ri; const float nr = a.x * rr - a.y * ri + er[c], ni = a.x * ri + a.y * rr + ei[c]; rr = nr; ri = ni; } }
        outp[O_PS5R + (size_t)l * NB * 2048 + i] = rr; outp[O_PS5I + (size_t)l * NB * 2048 + i] = ri; }
}

__device__ __forceinline__ void mc_s5_unit(const Args& A, LAS unsigned char* lds, int l, int b, int c, int tid, int lane, int wave) {
    asm volatile("" : "+v"(tid)); lane = tid & 63; wave = __builtin_amdgcn_readfirstlane(tid >> 6);
    unsigned char* ws = A.ws; const unsigned char* tb = ws + WS_TAB + (size_t)l * TAB_L;
    LAS unsigned char* HS = lds + 16384 + wave * 8704;
    LAS unsigned char* Y = lds + 16384 + 8 * 8704; LAS float* SQ = (LAS float*)(lds + 16384 + 8 * 8704 + 33280);
    const int grow0 = b * T + c * S5_L, fr = lane & 15, fq = lane >> 4;
    const float* ER = (const float*)(ws + WS_S5ER); const float* EI = (const float*)(ws + WS_S5EI);
#pragma unroll 1
    for (int gi = 0; gi < 4; ++gi) { const int g = 4 * wave + gi;
        const size_t o = ((size_t)(b * S5_NC + c) * 32 + g) * 64 + lane; float hr = ER[o], hi = EI[o];
        const bf16* cmt = (const bf16*)(tb + TB_CMT) + (size_t)g * 16 * 128; float dsk = A.in[I_S5_D][l * 512 + 16 * g + fr]; bf16x8 fc[4]; unsigned uk[2][4];
        const bf16* proj = (const bf16*)(ws + WS_PROJ);
#pragma unroll
        for (int ks = 0; ks < 4; ++ks) fc[ks] = gfrag(cmt + fr * 128 + 32 * ks + 8 * fq);
#pragma unroll
        for (int rt = 0; rt < 2; ++rt)
#pragma unroll
            for (int e = 0; e < 4; ++e) uk[rt][e] = (unsigned)proj[(size_t)(grow0 + 16 * rt + 4 * fq + e) * NIN + C_U5 + 16 * g + fr];
        float ar, ai; s5_bu(A, l, g, grow0, lane, HS, ar, ai);
        PIN(hr); PIN(hi); PIN(dsk);
#pragma unroll
        for (int ks = 0; ks < 4; ++ks) PIN(fc[ks]);
#pragma unroll
        for (int rt = 0; rt < 2; ++rt)
#pragma unroll
            for (int e = 0; e < 4; ++e) PIN(uk[rt][e]);
        s5_scan<true>(HS, lane, ar, ai, hr, hi);
        WAVE_SYNC();
        f32x4 acc[2] = {(f32x4){0.f, 0.f, 0.f, 0.f}, (f32x4){0.f, 0.f, 0.f, 0.f}};
#pragma unroll
        for (int ks = 0; ks < 4; ++ks)
#pragma unroll
            for (int rt = 0; rt < 2; ++rt) acc[rt] = mfma16(ldsfrag(HS + ((16 * rt + fr) * 136 + 32 * ks + 8 * fq) * 2), fc[ks], acc[rt]);
#pragma unroll
        for (int rt = 0; rt < 2; ++rt)
#pragma unroll
            for (int e = 0; e < 4; ++e) { const int t = 16 * rt + 4 * fq + e; const float y = acc[rt][e] + dsk * __uint_as_float(uk[rt][e] << 16); *(LAS bf16*)(Y + (t * 520 + 16 * g + fr) * 2) = f2b(gelu_tanh_f(y)); }
        WAVE_SYNC(); }
    BLOCK_SYNC();
    const bf16* wg = (const bf16*)(tb + TB_WGLUT); f32x4 acc[2][4];
#pragma unroll
    for (int i = 0; i < 2; ++i)
#pragma unroll
        for (int j = 0; j < 4; ++j) acc[i][j] = (f32x4){0.f, 0.f, 0.f, 0.f};
    float bgl[4];
#pragma unroll
    for (int j = 0; j < 4; ++j) bgl[j] = A.in[I_B_GLU][l * 512 + 64 * wave + 16 * j + fr];
#pragma unroll 1
    for (int k4 = 0; k4 < 16; k4 += 4) { bf16x8 fb[4][4];
#pragma unroll
        for (int q = 0; q < 4; ++q)
#pragma unroll
            for (int j = 0; j < 4; ++j) fb[q][j] = gfrag(wg + sfrag(64 * wave + 16 * j, 32 * (k4 + q), 512) + 8 * lane);
#pragma unroll
        for (int q = 0; q < 4; ++q)
#pragma unroll
            for (int j = 0; j < 4; ++j) PIN(fb[q][j]);
#pragma unroll
        for (int q = 0; q < 4; ++q) { bf16x8 fa[2];
#pragma unroll
            for (int i = 0; i < 2; ++i) fa[i] = ldsfrag(Y + ((16 * i + fr) * 520 + 32 * (k4 + q) + 8 * fq) * 2);
#pragma unroll
            for (int i = 0; i < 2; ++i)
#pragma unroll
                for (int j = 0; j < 4; ++j) acc[i][j] = mfma16(fa[i], fb[q][j], acc[i][j]); } }
#pragma unroll
    for (int i = 0; i < 2; ++i)
#pragma unroll
        for (int e = 0; e < 4; ++e) { const int t = 16 * i + 4 * fq + e; float sq = 0.f;
#pragma unroll
            for (int j = 0; j < 4; ++j) { const int col = 64 * wave + 16 * j + fr; const float yv = bf2f(*(const LAS bf16*)(Y + (t * 520 + col) * 2));
                const float o = yv * sigmoid_f(acc[i][j][e] + bgl[j]); acc[i][j][e] = o; sq += o * o; }
            sq = sum16(sq); if (fr == 0) SQ[wave * 32 + t] = sq; }
    BLOCK_SYNC();
    bf16* mix = (bf16*)(ws + WS_MIX);
#pragma unroll
    for (int i = 0; i < 2; ++i)
#pragma unroll
        for (int e = 0; e < 4; ++e) { const int t = 16 * i + 4 * fq + e; float sq = 0.f;
#pragma unroll
            for (int w = 0; w < 8; ++w) sq += SQ[w * 32 + t];
            const float rs = __builtin_amdgcn_rsqf(sq * (1.0f / 512.0f) + EPS);
#pragma unroll
            for (int j = 0; j < 4; ++j) mix[(size_t)(grow0 + t) * D + 512 + 64 * wave + 16 * j + fr] = f2b(acc[i][j][e] * rs); }
    BLOCK_SYNC();
}


#define RELANE() do { asm volatile("" : "+v"(tid)); lane = tid & 63; fr = lane & 15; fq = lane >> 4; } while (0)
__device__ __forceinline__ void mc_rest_unit(const Args& A, LAS unsigned char* lds, int l, int b, int c, int tid, int lane, int wave) {
    asm volatile("" : "+v"(tid)); lane = tid & 63; wave = __builtin_amdgcn_readfirstlane(tid >> 6);
    unsigned char* ws = A.ws; const bf16* proj = (const bf16*)(ws + WS_PROJ); const float* DTV = (const float*)(ws + WS_DTV); bf16* mix = (bf16*)(ws + WS_MIX);
    LAS float* AC = (LAS float*)lds; LAS float* DTs = (LAS float*)(lds + 2048); LAS float* SQ = (LAS float*)(lds + 96768); LAS float* SQ2 = (LAS float*)(lds + 98816);
    LAS unsigned char* XT = lds + 4608; LAS unsigned char* BMs = lds + 41472; LAS unsigned char* CMs = lds + 50688; LAS unsigned char* PW = lds + 59904 + wave * 4608;
    LAS unsigned char* PL = lds + 4608;
    const int grow0 = b * T + c * SSD_L; int fr = lane & 15, fq = lane >> 4; const bool first = (c == 0), lastc = (c == SSD_NC - 1);
    const float* cw = A.in[I_CONV_W] + l * 4 * 768; const float* cb = A.in[I_CONV_B] + l * 768;
    { const float an = -expf(A.in[I_A_LOG][l * 8 + wave]); const float dt = DTV[(size_t)(grow0 + lane) * 8 + wave];
        AC[wave * 64 + lane] = wave_scan_incl(dt * an, lane); DTs[wave * 64 + lane] = dt; }
    BLOCK_SYNC();
    f32x4 yv[2][2][4];
#pragma unroll
    for (int half = 0; half < 2; ++half) {
        RELANE();
        { const int t0 = 8 * wave; float xs[8][4]; conv8<4>(proj, cw, cb, grow0, t0, first, 256 * half + 4 * lane, xs);
            const int hl = lane >> 4, p0 = 4 * (lane & 15);
#pragma unroll
            for (int e = 0; e < 4; ++e) { v4u w; w.x = cvtpk(xs[0][e], xs[1][e]); w.y = cvtpk(xs[2][e], xs[3][e]); w.z = cvtpk(xs[4][e], xs[5][e]); w.w = cvtpk(xs[6][e], xs[7][e]);
                *(LAS v4u*)(XT + ((hl * 64 + p0 + e) * 72 + t0) * 2) = w; }
            float bc[8][2]; const int isc = lane >> 5, n0 = 2 * (lane & 31); conv8<2>(proj, cw, cb, grow0, t0, first, 512 + 128 * isc + 64 * half + n0, bc);
            LAS unsigned char* dst = isc ? CMs : BMs;
#pragma unroll
            for (int i = 0; i < 8; ++i) *(LAS unsigned*)(dst + ((t0 + i) * 72 + n0) * 2) = cvtpk(bc[i][0], bc[i][1]); }
        BLOCK_SYNC(); RELANE();
        { const int hl = wave >> 1, th = wave & 1, h = 4 * half + hl;
#pragma unroll
            for (int rt = 0; rt < 2; ++rt) { const bf16x8 fc0 = ldsfrag(CMs + ((32 * th + 16 * rt + fr) * 72 + 8 * fq) * 2), fc1 = ldsfrag(CMs + ((32 * th + 16 * rt + fr) * 72 + 32 + 8 * fq) * 2);
#pragma unroll
                for (int st = 0; st < 4; ++st) { f32x4 g = (f32x4){0.f, 0.f, 0.f, 0.f};
                    g = mfma16(fc0, ldsfrag(BMs + ((16 * st + fr) * 72 + 8 * fq) * 2), g); g = mfma16(fc1, ldsfrag(BMs + ((16 * st + fr) * 72 + 32 + 8 * fq) * 2), g);
                    const int s = 16 * st + fr; const float as = AC[h * 64 + s], ds = DTs[h * 64 + s];
#pragma unroll
                    for (int e = 0; e < 4; ++e) { const int tl = 16 * rt + 4 * fq + e, t = 32 * th + tl; const float pv = (s <= t) ? g[e] * __expf(AC[h * 64 + t] - as) * ds : 0.f;
                        *(LAS bf16*)(PW + (tl * 72 + s) * 2) = f2b(pv); } asm volatile("" ::: "memory"); } }
            WAVE_SYNC(); RELANE();
            const float* HP = (const float*)(ws + WS_SS) + ((size_t)(b * SSD_NC + c) * 8 + h) * 4096; float dsk = A.in[I_SSD_D][l * 8 + h]; float sqp[2][4];
            bf16x8 hpf[4][2];
            { f32x4 hq[4][4];
#pragma unroll
                for (int pt = 0; pt < 4; ++pt) { const float* hp = HP + (16 * pt + fr) * 64 + 8 * fq; hq[pt][0] = *(const GAS f32x4*)hp; hq[pt][1] = *(const GAS f32x4*)(hp + 4); hq[pt][2] = *(const GAS f32x4*)(hp + 32); hq[pt][3] = *(const GAS f32x4*)(hp + 36); }
#pragma unroll
                for (int pt = 0; pt < 4; ++pt)
#pragma unroll
                    for (int q = 0; q < 4; ++q) PIN(hq[pt][q]);
#pragma unroll
                for (int pt = 0; pt < 4; ++pt) { hpf[pt][0] = pack8(hq[pt][0], hq[pt][1]); hpf[pt][1] = pack8(hq[pt][2], hq[pt][3]); } }
            PIN(dsk);
#pragma unroll
            for (int rt = 0; rt < 2; ++rt) { const bf16x8 fp0 = ldsfrag(PW + ((16 * rt + fr) * 72 + 8 * fq) * 2), fp1 = ldsfrag(PW + ((16 * rt + fr) * 72 + 32 + 8 * fq) * 2);
                const bf16x8 fc0 = ldsfrag(CMs + ((32 * th + 16 * rt + fr) * 72 + 8 * fq) * 2), fc1 = ldsfrag(CMs + ((32 * th + 16 * rt + fr) * 72 + 32 + 8 * fq) * 2);
                unsigned zr[4][4];
#pragma unroll
                for (int pt = 0; pt < 4; ++pt)
#pragma unroll
                    for (int e = 0; e < 4; ++e) zr[pt][e] = (unsigned)proj[(size_t)(grow0 + 32 * th + 16 * rt + 4 * fq + e) * NIN + C_Z + 64 * h + 16 * pt + fr];
#pragma unroll
                for (int pt = 0; pt < 4; ++pt)
#pragma unroll
                    for (int e = 0; e < 4; ++e) PIN(zr[pt][e]);
#pragma unroll
                for (int e = 0; e < 4; ++e) sqp[rt][e] = 0.f;
#pragma unroll
                for (int pt = 0; pt < 4; ++pt) { const int p = 16 * pt + fr; f32x4 y = (f32x4){0.f, 0.f, 0.f, 0.f}, yo = (f32x4){0.f, 0.f, 0.f, 0.f};
                    y = mfma16(fp0, ldsfrag(XT + ((hl * 64 + p) * 72 + 8 * fq) * 2), y); y = mfma16(fp1, ldsfrag(XT + ((hl * 64 + p) * 72 + 32 + 8 * fq) * 2), y);
                    yo = mfma16(fc0, hpf[pt][0], yo); yo = mfma16(fc1, hpf[pt][1], yo);
                    const v2u xw = *(const LAS v2u*)(XT + ((hl * 64 + p) * 72 + 32 * th + 16 * rt + 4 * fq) * 2); const float xv[4] = {bf_lo(xw.x), bf_hi(xw.x), bf_lo(xw.y), bf_hi(xw.y)};
#pragma unroll
                    for (int e = 0; e < 4; ++e) { const int t = 32 * th + 16 * rt + 4 * fq + e; const float z = __uint_as_float(zr[pt][e] << 16);
                        const float v = (y[e] + __expf(AC[h * 64 + t]) * yo[e] + dsk * xv[e]) * silu_f(z); y[e] = v; sqp[rt][e] += v * v; }
                    yv[half][rt][pt] = y; }
#pragma unroll
                for (int e = 0; e < 4; ++e) { const float s = sum16(sqp[rt][e]); if (fr == 0) SQ[(half * 4 + hl) * 64 + 32 * th + 16 * rt + 4 * fq + e] = s; } } }
        BLOCK_SYNC();
    }
    RELANE();
    { const int hl = wave >> 1, th = wave & 1;
#pragma unroll
        for (int half = 0; half < 2; ++half)
#pragma unroll
            for (int rt = 0; rt < 2; ++rt)
#pragma unroll
                for (int e = 0; e < 4; ++e) { const int t = 32 * th + 16 * rt + 4 * fq + e; float sq = 0.f;
#pragma unroll
                    for (int w = 0; w < 8; ++w) sq += SQ[w * 64 + t];
                    const float rs = __builtin_amdgcn_rsqf(sq * (1.0f / 512.0f) + EPS);
#pragma unroll
                    for (int pt = 0; pt < 4; ++pt) mix[(size_t)(grow0 + t) * D + 64 * (4 * half + hl) + 16 * pt + fr] = f2b(yv[half][rt][pt][e] * rs); } }
    RELANE();
    { const int t0 = 8 * wave, ch = 8 * lane; v4u gcr[10], hvr[10], gbr[8]; float w[3][8];
#pragma unroll
        for (int r = 0; r < 10; ++r) { const int tt = t0 - 2 + r; const bf16* p = proj + (size_t)(grow0 + ((first && tt < 0) ? 0 : tt)) * NIN; gcr[r] = *(const GAS v4u*)(p + C_GC + ch); hvr[r] = *(const GAS v4u*)(p + C_HV + ch); }
#pragma unroll
        for (int i = 0; i < 8; ++i) gbr[i] = *(const GAS v4u*)(proj + (size_t)(grow0 + t0 + i) * NIN + C_GB + ch);
#pragma unroll
        for (int j = 0; j < 3; ++j)
#pragma unroll
            for (int e = 0; e < 8; ++e) w[j][e] = A.in[I_SC_W][(l * 3 + j) * 512 + ch + e];
#pragma unroll
        for (int r = 0; r < 10; ++r) { PIN(gcr[r]); PIN(hvr[r]); }
#pragma unroll
        for (int i = 0; i < 8; ++i) PIN(gbr[i]);
        float v2[8], v1[8];
#pragma unroll
        for (int r = 0; r < 10; ++r) { float gc[8], hv[8], v0[8]; unpack8(gcr[r], gc); unpack8(hvr[r], hv); const bool z = first && (t0 - 2 + r) < 0;
#pragma unroll
            for (int e = 0; e < 8; ++e) v0[e] = z ? 0.f : gc[e] * hv[e];
            if (r >= 2) { const int tt = t0 + r - 2; float gb[8], y[8]; unpack8(gbr[r - 2], gb); float sq = 0.f;
#pragma unroll
                for (int e = 0; e < 8; ++e) { y[e] = gb[e] * (w[0][e] * v2[e] + w[1][e] * v1[e] + w[2][e] * v0[e]); sq += y[e] * y[e]; }
                const float rs = __builtin_amdgcn_rsqf(wave_sum(sq) * (1.0f / 512.0f) + EPS);
                v4u o; o.x = cvtpk(y[0] * rs, y[1] * rs); o.y = cvtpk(y[2] * rs, y[3] * rs); o.z = cvtpk(y[4] * rs, y[5] * rs); o.w = cvtpk(y[6] * rs, y[7] * rs);
                *(GAS v4u*)(mix + (size_t)(grow0 + tt) * D + 1024 + ch) = o;
                if (lastc && tt >= 62) { float* o2 = A.out + O_PSC + ((size_t)(l * NB + b) * 2 + (tt - 62)) * 512 + ch; *(GAS f32x4*)o2 = (f32x4){v0[0], v0[1], v0[2], v0[3]}; *(GAS f32x4*)(o2 + 4) = (f32x4){v0[4], v0[5], v0[6], v0[7]}; } }
#pragma unroll
            for (int e = 0; e < 8; ++e) { v2[e] = v1[e]; v1[e] = v0[e]; } }
    }
    BLOCK_SYNC();
#pragma unroll 1
    for (int hh = 0; hh < 2; ++hh) { RELANE(); const int t0 = 8 * wave, ch = 4 * lane + 256 * hh, gI = ch >> 7;
        float u[23][4]; v2u ur[23];
#pragma unroll
        for (int r = 0; r < 23; ++r) { const int tt = t0 - 15 + r; ur[r] = *(const GAS v2u*)(proj + (size_t)(grow0 + ((first && tt < 0) ? 0 : tt)) * NIN + C_UP + ch); }
#pragma unroll
        for (int r = 0; r < 23; ++r) PIN(ur[r]);
#pragma unroll
        for (int r = 0; r < 23; ++r) { const bool z = first && (t0 - 15 + r) < 0; u[r][0] = z ? 0.f : bf_lo(ur[r].x); u[r][1] = z ? 0.f : bf_hi(ur[r].x); u[r][2] = z ? 0.f : bf_lo(ur[r].y); u[r][3] = z ? 0.f : bf_hi(ur[r].y); }
        const int win = 2 << gI;
#pragma unroll
        for (int i = 0; i < 8; ++i) { const int r = 15 + i; float pv[4]; const int pos = c * SSD_L + t0 + i; const float inv = 1.0f / (float)(pos + 1 < win ? pos + 1 : win);
#pragma unroll
            for (int e = 0; e < 4; ++e) { const float s2 = u[r][e] + u[r - 1][e], s4 = s2 + u[r - 2][e] + u[r - 3][e], s8 = s4 + (u[r - 4][e] + u[r - 5][e]) + (u[r - 6][e] + u[r - 7][e]);
                const float s16 = s8 + ((u[r - 8][e] + u[r - 9][e]) + (u[r - 10][e] + u[r - 11][e])) + ((u[r - 12][e] + u[r - 13][e]) + (u[r - 14][e] + u[r - 15][e]));
                const float cs = gI == 0 ? s2 : gI == 1 ? s4 : gI == 2 ? s8 : s16; pv[e] = cs * inv - u[r][e]; }
            v2u o; o.x = cvtpk(pv[0], pv[1]); o.y = cvtpk(pv[2], pv[3]); *(LAS v2u*)(PL + ((t0 + i) * 520 + ch) * 2) = o;
            if (lastc && t0 + i >= 49) *(GAS f32x4*)(A.out + O_PPOOL + ((size_t)(l * NB + b) * 15 + (t0 + i - 49)) * 512 + ch) = (f32x4){u[r][0], u[r][1], u[r][2], u[r][3]}; }
    }
    BLOCK_SYNC(); RELANE();
    { const int gI = wave >> 1, dh = wave & 1; const bf16* wp = (const bf16*)(ws + WS_TAB + (size_t)l * TAB_L + TB_WPT) + (size_t)gI * 128 * 128; f32x4 acc[4][4];
#pragma unroll
        for (int i = 0; i < 4; ++i)
#pragma unroll
            for (int j = 0; j < 4; ++j) acc[i][j] = (f32x4){0.f, 0.f, 0.f, 0.f};
        bf16x8 fbw[4][4]; float psc[4];
#pragma unroll
        for (int ks = 0; ks < 4; ++ks)
#pragma unroll
            for (int j = 0; j < 4; ++j) fbw[ks][j] = gfrag(wp + sfrag(64 * dh + 16 * j, 32 * ks, 128) + 8 * lane);
#pragma unroll
        for (int j = 0; j < 4; ++j) psc[j] = A.in[I_POOL_SCALE][l * 512 + 128 * gI + 64 * dh + 16 * j + fr];
#pragma unroll
        for (int ks = 0; ks < 4; ++ks)
#pragma unroll
            for (int j = 0; j < 4; ++j) PIN(fbw[ks][j]);
#pragma unroll
        for (int ks = 0; ks < 4; ++ks) { bf16x8 fa[4];
#pragma unroll
            for (int i = 0; i < 4; ++i) fa[i] = ldsfrag(PL + ((16 * i + fr) * 520 + 128 * gI + 32 * ks + 8 * fq) * 2);
#pragma unroll
            for (int i = 0; i < 4; ++i)
#pragma unroll
                for (int j = 0; j < 4; ++j) acc[i][j] = mfma16(fa[i], fbw[ks][j], acc[i][j]); }
#pragma unroll
        for (int i = 0; i < 4; ++i)
#pragma unroll
            for (int e = 0; e < 4; ++e) { float sq = 0.f;
#pragma unroll
                for (int j = 0; j < 4; ++j) { const float o = acc[i][j][e] * psc[j]; acc[i][j][e] = o; sq += o * o; }
                sq = sum16(sq); if (fr == 0) SQ2[wave * 64 + 16 * i + 4 * fq + e] = sq; }
        BLOCK_SYNC();
#pragma unroll
        for (int i = 0; i < 4; ++i)
#pragma unroll
            for (int e = 0; e < 4; ++e) { const int t = 16 * i + 4 * fq + e; float sq = 0.f;
#pragma unroll
                for (int w = 0; w < 8; ++w) sq += SQ2[w * 64 + t];
                const float rs = __builtin_amdgcn_rsqf(sq * (1.0f / 512.0f) + EPS);
#pragma unroll
                for (int j = 0; j < 4; ++j) mix[(size_t)(grow0 + t) * D + 1536 + 128 * gI + 64 * dh + 16 * j + fr] = f2b(acc[i][j][e] * rs); }
    }
    if (lastc) for (int i = tid; i < 3 * 768; i += NTHR) { const int r = i / 768, ch = i % 768; A.out[O_PCONV + ((size_t)(l * NB + b) * 3 + r) * 768 + ch] = bf2f(proj[(size_t)(grow0 + 61 + r) * NIN + C_XBC + ch]); }
    BLOCK_SYNC();
}

__device__ __forceinline__ void mc_sample_unit(const Args& A, LAS unsigned char* lds, int l, int s, int tid, int lane, int wave) {
    asm volatile("" : "+v"(tid)); lane = tid & 63; wave = __builtin_amdgcn_readfirstlane(tid >> 6);
    unsigned char* ws = A.ws; const bf16* proj = (const bf16*)(ws + WS_PROJ) + (size_t)(MP + s) * NIN; const unsigned char* tb = ws + WS_TAB + (size_t)l * TAB_L; float* out = A.out;
    LAS float* XC = (LAS float*)lds; LAS float* U5 = (LAS float*)(lds + 5120); LAS float* Y5 = (LAS float*)(lds + 7168); LAS float* PLs = (LAS float*)(lds + 9216); LAS float* OUT = (LAS float*)(lds + 11264); LAS float* ZP = (LAS float*)(lds + 19456);
    const int ls = l * MS + s;
    { const int c1 = tid < 256 ? tid + 512 : tid; const float* st0 = A.in[I_ST_CONV] + (size_t)ls * 3 * 768; const float* cw = A.in[I_CONV_W] + l * 4 * 768;
        float a[2][3], nwv[2], wv[2][4], bsv[2]; const int chs[2] = {tid, c1};
#pragma unroll
        for (int q = 0; q < 2; ++q) { const int ch = chs[q]; a[q][0] = st0[ch]; a[q][1] = st0[768 + ch]; a[q][2] = st0[1536 + ch]; nwv[q] = bf2f(proj[C_XBC + ch]); bsv[q] = A.in[I_CONV_B][l * 768 + ch];
#pragma unroll
            for (int j = 0; j < 4; ++j) wv[q][j] = cw[j * 768 + ch]; }
        float u5v = bf2f(proj[C_U5 + tid]);
#pragma unroll
        for (int q = 0; q < 2; ++q) { PIN(a[q][0]); PIN(a[q][1]); PIN(a[q][2]); PIN(nwv[q]); PIN(bsv[q]); PIN(wv[q][0]); PIN(wv[q][1]); PIN(wv[q][2]); PIN(wv[q][3]); }
        PIN(u5v);
#pragma unroll
        for (int q = 0; q < 2; ++q) if (q == 0 || tid < 256) { const int ch = chs[q]; XC[ch] = silu_f(bsv[q] + wv[q][0] * a[q][0] + wv[q][1] * a[q][1] + wv[q][2] * a[q][2] + wv[q][3] * nwv[q]);
            float* o = out + O_SCONV + (size_t)ls * 3 * 768 + ch; o[0] = a[q][1]; o[768] = a[q][2]; o[1536] = nwv[q]; }
        U5[tid] = u5v; }
    BLOCK_SYNC();
    { const int h = wave; const float dt = ((const float*)(ws + WS_DTV))[(size_t)(MP + s) * 8 + h], dec = expf(-dt * expf(A.in[I_A_LOG][l * 8 + h])), dsk = A.in[I_SSD_D][l * 8 + h];
        const int n4 = 4 * (lane & 15); const f32x4 Bv = *(const LAS f32x4*)(XC + 512 + 64 * (h >> 2) + n4), Cv = *(const LAS f32x4*)(XC + 640 + 64 * (h >> 2) + n4);
        const size_t o0 = (((size_t)ls * 8 + h) * 64 + (lane >> 4)) * 64 + n4; f32x4 h0[16]; unsigned zr[16];
#pragma unroll
        for (int it = 0; it < 16; ++it) { h0[it] = __builtin_nontemporal_load((const GAS f32x4*)(A.in[I_ST_SSD] + o0 + (size_t)it * 256)); zr[it] = (unsigned)proj[C_Z + 64 * h + it * 4 + (lane >> 4)]; }
#pragma unroll
        for (int it = 0; it < 16; ++it) { PIN(h0[it]); PIN(zr[it]); }
#pragma unroll
        for (int it = 0; it < 16; ++it) { const int p = it * 4 + (lane >> 4); const float x = XC[64 * h + p]; const f32x4 hn = h0[it] * dec + Bv * (dt * x);
            __builtin_nontemporal_store(hn, (GAS f32x4*)(out + O_SSSD + o0 + (size_t)it * 256));
            float y = (hn.x * Cv.x + hn.y * Cv.y) + (hn.z * Cv.z + hn.w * Cv.w); y = sum16(y);
            if ((lane & 15) == 0) OUT[64 * h + p] = (y + dsk * x) * silu_f(__uint_as_float(zr[it] << 16)); } }
#pragma unroll 1
    for (int gi = 0; gi < 4; ++gi) { const int g = 4 * wave + gi; const f32x2* bb = (const f32x2*)(tb + TB_BBAR) + (size_t)g * 16 * 64 + lane; f32x2 bv[16]; float cr[16], ci[16];
        const float* cre = A.in[I_C_RE] + ((size_t)l * 32 + g) * 1024 + lane; const float* cim = A.in[I_C_IM] + ((size_t)l * 32 + g) * 1024 + lane;
#pragma unroll
        for (int k = 0; k < 16; ++k) { bv[k] = bb[k * 64]; cr[k] = cre[k * 64]; ci[k] = cim[k * 64]; }
        f32x2 a = ((const f32x2*)(tb + TB_ABAR))[g * 64 + lane]; const size_t o = ((size_t)ls * 32 + g) * 64 + lane; float h0r = A.in[I_ST_S5R][o], h0i = A.in[I_ST_S5I][o]; float dv = A.in[I_S5_D][l * 512 + 16 * g + (lane & 15)];
        PIN(a); PIN(h0r); PIN(h0i); PIN(dv);
#pragma unroll
        for (int k = 0; k < 16; ++k) { PIN(bv[k]); PIN(cr[k]); PIN(ci[k]); }
        float br = 0.f, bi = 0.f;
#pragma unroll
        for (int k = 0; k < 16; ++k) { const float u = U5[16 * g + k]; br += bv[k].x * u; bi += bv[k].y * u; }
        const float hr = a.x * h0r - a.y * h0i + br, hi = a.x * h0i + a.y * h0r + bi; out[O_SS5R + o] = hr; out[O_SS5I + o] = hi;
        float mine = 0.f;
#pragma unroll
        for (int k = 0; k < 16; ++k) { const float v = wave_sum(cr[k] * hr - ci[k] * hi); mine = (lane == k) ? v : mine; }
        if (lane < 16) Y5[16 * g + lane] = gelu_tanh_f(mine + dv * U5[16 * g + lane]); }
    { const int c = tid, gI = c >> 7, win = 2 << gI; const float* st = A.in[I_ST_SC] + (size_t)ls * 2 * 512 + c; const float* w = A.in[I_SC_W] + l * 3 * 512 + c; const float* sp = A.in[I_ST_POOL] + (size_t)ls * 15 * 512 + c;
        float s0 = st[0], s1 = st[512], gc = bf2f(proj[C_GC + c]), hvv = bf2f(proj[C_HV + c]), gb = bf2f(proj[C_GB + c]), w0 = w[0], w1 = w[512], w2 = w[1024], u = bf2f(proj[C_UP + c]); float hh[15];
#pragma unroll
        for (int r = 0; r < 15; ++r) hh[r] = sp[r * 512];
        PIN(s0); PIN(s1); PIN(gc); PIN(hvv); PIN(gb); PIN(w0); PIN(w1); PIN(w2); PIN(u);
#pragma unroll
        for (int r = 0; r < 15; ++r) PIN(hh[r]);
        const float v = gc * hvv; OUT[1024 + c] = gb * (w0 * s0 + w1 * s1 + w2 * v); float* o = out + O_SSC + (size_t)ls * 2 * 512 + c; o[0] = s1; o[512] = v;
        float* op = out + O_SPOOL + (size_t)ls * 15 * 512 + c; float sum = u;
#pragma unroll
        for (int r = 0; r < 15; ++r) { if (15 - r < win) sum += hh[r]; if (r > 0) op[(r - 1) * 512] = hh[r]; }
        op[14 * 512] = u; PLs[c] = sum / (float)win - u; }
    BLOCK_SYNC();
    { const int fq = lane >> 4;
        { const int gI = wave >> 1; const bf16* wp = (const bf16*)(tb + TB_WPT) + (size_t)gI * 128 * 128 + (size_t)(4 * (wave & 1)) * 4 * 512 + 8 * lane;
            v4u pw[4][4]; float pa[4] = {0.f, 0.f, 0.f, 0.f};
#pragma unroll
            for (int ks = 0; ks < 4; ++ks)
#pragma unroll
                for (int j = 0; j < 4; ++j) pw[ks][j] = *(const GAS v4u*)(wp + ((size_t)(j * 4 + ks) << 9));
            const float psc = A.in[I_POOL_SCALE][l * 512 + 64 * wave + lane];
#pragma unroll
            for (int ks = 0; ks < 4; ++ks)
#pragma unroll
                for (int j = 0; j < 4; ++j) PIN(pw[ks][j]);
#pragma unroll
            for (int ks = 0; ks < 4; ++ks) { const LAS float* yp = PLs + 128 * gI + 32 * ks + 8 * fq; const f32x4 y0 = *(const LAS f32x4*)yp, y1 = *(const LAS f32x4*)(yp + 4);
#pragma unroll
                for (int j = 0; j < 4; ++j) { float f[8]; unpack8(pw[ks][j], f);
                    pa[j] += (f[0] * y0.x + f[1] * y0.y) + (f[2] * y0.z + f[3] * y0.w) + (f[4] * y1.x + f[5] * y1.y) + (f[6] * y1.z + f[7] * y1.w); } }
            float mine = 0.f;
#pragma unroll
            for (int j = 0; j < 4; ++j) { float t = pa[j]; t += __shfl_xor(t, 16); t += __shfl_xor(t, 32); mine = (fq == j) ? t : mine; }
            OUT[1536 + 64 * wave + lane] = mine * psc; }
        { const bf16* wg = (const bf16*)(tb + TB_WGLUT) + (size_t)(4 * wave) * 16 * 512 + 8 * lane;
            float ga[4] = {0.f, 0.f, 0.f, 0.f}; const float bgl = A.in[I_B_GLU][l * 512 + 64 * wave + lane];
#pragma unroll 1
            for (int kb = 0; kb < 16; kb += 4) { v4u wv[4][4]; const bf16* wk = wg + ((size_t)kb << 9); asm volatile("" : "+v"(wk));
#pragma unroll
                for (int q = 0; q < 4; ++q)
#pragma unroll
                    for (int j = 0; j < 4; ++j) wv[q][j] = *(const GAS v4u*)(wk + ((size_t)(j * 16 + q) << 9));
#pragma unroll
                for (int q = 0; q < 4; ++q)
#pragma unroll
                    for (int j = 0; j < 4; ++j) PIN(wv[q][j]);
#pragma unroll
                for (int q = 0; q < 4; ++q) { const LAS float* yp = Y5 + 32 * (kb + q) + 8 * fq; const f32x4 y0 = *(const LAS f32x4*)yp, y1 = *(const LAS f32x4*)(yp + 4);
#pragma unroll
                    for (int j = 0; j < 4; ++j) { float f[8]; unpack8(wv[q][j], f);
                        ga[j] += (f[0] * y0.x + f[1] * y0.y) + (f[2] * y0.z + f[3] * y0.w) + (f[4] * y1.x + f[5] * y1.y) + (f[6] * y1.z + f[7] * y1.w); } } }
            float mine = 0.f;
#pragma unroll
            for (int j = 0; j < 4; ++j) { float t = ga[j]; t += __shfl_xor(t, 16); t += __shfl_xor(t, 32); mine = (fq == j) ? t : mine; }
            { const int n = 64 * wave + lane; OUT[512 + n] = Y5[n] * sigmoid_f(bgl + mine); } } }
    BLOCK_SYNC();
    if (wave < 4) { float v[8]; float sq = 0.f;
#pragma unroll
        for (int e = 0; e < 8; ++e) { v[e] = OUT[512 * wave + 8 * lane + e]; sq += v[e] * v[e]; }
        const float rs = __builtin_amdgcn_rsqf(wave_sum(sq) * (1.0f / 512.0f) + EPS);
        v4u o; o.x = cvtpk(v[0] * rs, v[1] * rs); o.y = cvtpk(v[2] * rs, v[3] * rs); o.z = cvtpk(v[4] * rs, v[5] * rs); o.w = cvtpk(v[6] * rs, v[7] * rs);
        *(GAS v4u*)((bf16*)(ws + WS_SA + SA_MIX) + sfrag(s, 512 * wave + 8 * lane, D)) = o; }
    BLOCK_SYNC();
}

__device__ __forceinline__ void att_prompt_unit(const Args& A, LAS unsigned char* lds, int l, int b, int hd, int qb, int tid, int lane, int wave) {
    asm volatile("" : "+v"(tid)); lane = tid & 63; wave = __builtin_amdgcn_readfirstlane(tid >> 6);
    unsigned char* ws = A.ws; const int fr = lane & 15, fq = lane >> 4, grow0 = b * T + qb * 128;
    const bf16* Q = (const bf16*)(ws + WS_Q) + (size_t)grow0 * D + hd * HDX; const bf16* K = (const bf16*)(ws + WS_KB) + ((size_t)l * MROWS + b * NMEM) * D + hd * HDX;
    const bf16* V = (const bf16*)(ws + WS_VT) + (((size_t)l * NB + b) * D + hd * HDX) * NMEM; bf16* O = (bf16*)(ws + WS_O) + (size_t)grow0 * D + hd * HDX;
    LAS unsigned char* PS = lds; LAS unsigned char* KS = lds + 67584; LAS unsigned char* QS = lds + 104448; LAS unsigned char* VS = lds + 67584;
    f32x4 acc[16];
#pragma unroll
    for (int i = 0; i < 16; ++i) acc[i] = (f32x4){0.f, 0.f, 0.f, 0.f};
#pragma unroll 1
    for (int ds = 0; ds < 8; ++ds) {
        { v4u tk[4], tq[2];
#pragma unroll
            for (int i = 0; i < 4; ++i) { const int id = tid + NTHR * i, key = id >> 3, part = id & 7; tk[i] = *(const GAS v4u*)(K + (size_t)key * D + 64 * ds + 8 * part); }
#pragma unroll
            for (int i = 0; i < 2; ++i) { const int id = tid + NTHR * i, r = id >> 3, part = id & 7; tq[i] = *(const GAS v4u*)(Q + (size_t)r * D + 64 * ds + 8 * part); }
#pragma unroll
            for (int i = 0; i < 4; ++i) PIN(tk[i]);
            PIN(tq[0]); PIN(tq[1]);
#pragma unroll
            for (int i = 0; i < 4; ++i) { const int id = tid + NTHR * i, key = id >> 3, part = id & 7; *(LAS v4u*)(KS + (key * 72 + 8 * part) * 2) = tk[i]; }
#pragma unroll
            for (int i = 0; i < 2; ++i) { const int id = tid + NTHR * i, r = id >> 3, part = id & 7; *(LAS v4u*)(QS + (r * 72 + 8 * part) * 2) = tq[i]; } }
        BLOCK_SYNC();
#pragma unroll
        for (int ks = 0; ks < 2; ++ks) { const bf16x8 fa = ldsfrag(QS + ((16 * wave + fr) * 72 + 32 * ks + 8 * fq) * 2);
#pragma unroll
            for (int kt = 0; kt < 16; ++kt) acc[kt] = mfma16(fa, ldsfrag(KS + ((16 * kt + fr) * 72 + 32 * ks + 8 * fq) * 2), acc[kt]); }
        BLOCK_SYNC();
    }
    float inv[4]; const float scale = 0.044194173824159216f;
#pragma unroll
    for (int e = 0; e < 4; ++e) { float m = acc[0][e];
#pragma unroll
        for (int kt = 1; kt < 16; ++kt) m = fmaxf(m, acc[kt][e]);
        m = max16(m); float sum = 0.f;
#pragma unroll
        for (int kt = 0; kt < 16; ++kt) { const float p = __expf((acc[kt][e] - m) * scale); sum += p; *(LAS bf16*)(PS + ((16 * wave + 4 * fq + e) * 264 + 16 * kt + fr) * 2) = f2b(p); }
        inv[e] = __builtin_amdgcn_rcpf(sum16(sum)); }
#pragma unroll 1
    for (int ds = 0; ds < 8; ++ds) {
        { v4u tv[4];
#pragma unroll
            for (int i = 0; i < 4; ++i) { const int id = tid + NTHR * i, dr = id >> 5, part = id & 31; tv[i] = *(const GAS v4u*)(V + (size_t)(64 * ds + dr) * NMEM + 8 * part); }
#pragma unroll
            for (int i = 0; i < 4; ++i) PIN(tv[i]);
#pragma unroll
            for (int i = 0; i < 4; ++i) { const int id = tid + NTHR * i, dr = id >> 5, part = id & 31; *(LAS v4u*)(VS + (dr * 264 + 8 * part) * 2) = tv[i]; } }
        BLOCK_SYNC();
        f32x4 o[4] = {(f32x4){0.f, 0.f, 0.f, 0.f}, (f32x4){0.f, 0.f, 0.f, 0.f}, (f32x4){0.f, 0.f, 0.f, 0.f}, (f32x4){0.f, 0.f, 0.f, 0.f}};
#pragma unroll
        for (int ks = 0; ks < 8; ++ks) { const bf16x8 fa = ldsfrag(PS + ((16 * wave + fr) * 264 + 32 * ks + 8 * fq) * 2);
#pragma unroll
            for (int dt = 0; dt < 4; ++dt) o[dt] = mfma16(fa, ldsfrag(VS + ((16 * dt + fr) * 264 + 32 * ks + 8 * fq) * 2), o[dt]); }
#pragma unroll
        for (int dt = 0; dt < 4; ++dt)
#pragma unroll
            for (int e = 0; e < 4; ++e) O[(size_t)(16 * wave + 4 * fq + e) * D + 64 * ds + 16 * dt + fr] = f2b(o[dt][e] * inv[e]);
        BLOCK_SYNC();
    }
}
__device__ __forceinline__ void att_sample_unit(const Args& A, LAS unsigned char* lds, int l, int s, int hp, int tid, int lane, int wave) {
    asm volatile("" : "+v"(tid)); lane = tid & 63; wave = __builtin_amdgcn_readfirstlane(tid >> 6);
    unsigned char* ws = A.ws; const bf16* Q = (const bf16*)(ws + WS_Q) + (size_t)(MP + s) * D + hp * 1024;
    const float* K = A.in[I_CK] + (((size_t)l * MS + s) * NMEM) * D + hp * 1024; const float* V = A.in[I_CV] + (((size_t)l * MS + s) * NMEM) * D + hp * 1024;
    LAS float* SC = (LAS float*)lds; LAS float* RED = (LAS float*)(lds + 2048);
    f32x4 q[4];
#pragma unroll
    for (int j = 0; j < 4; ++j) { const v2u w = *(const GAS v2u*)(Q + 4 * lane + 256 * j); q[j] = (f32x4){bf_lo(w.x), bf_hi(w.x), bf_lo(w.y), bf_hi(w.y)}; }
#pragma unroll 1
    for (int kk = 0; kk < 32; kk += 8) { f32x4 kv[8][4];
        const char* kp = (const char*)(K + (size_t)(32 * wave + kk) * D) + (size_t)lane * 16; asm volatile("" : "+v"(kp));
#pragma unroll
        for (int i = 0; i < 8; ++i)
#pragma unroll
            for (int j = 0; j < 4; ++j) kv[i][j] = __builtin_nontemporal_load((const GAS f32x4*)(kp + (size_t)i * (D * 4) + j * 1024));
#pragma unroll
        for (int i = 0; i < 8; ++i)
#pragma unroll
            for (int j = 0; j < 4; ++j) PIN(kv[i][j]);
#pragma unroll
        for (int i = 0; i < 8; ++i) { const f32x4 a = kv[i][0], b2 = kv[i][1], c = kv[i][2], d = kv[i][3];
            float p0 = (a.x * q[0].x + a.y * q[0].y) + (a.z * q[0].z + a.w * q[0].w) + (b2.x * q[1].x + b2.y * q[1].y) + (b2.z * q[1].z + b2.w * q[1].w);
            float p1 = (c.x * q[2].x + c.y * q[2].y) + (c.z * q[2].z + c.w * q[2].w) + (d.x * q[3].x + d.y * q[3].y) + (d.z * q[3].z + d.w * q[3].w);
            p0 = wave_sum(p0); p1 = wave_sum(p1);
            if (lane == 0) { SC[32 * wave + kk + i] = p0; SC[256 + 32 * wave + kk + i] = p1; } } }
    BLOCK_SYNC();
    if (wave < 2) { const float scale = 0.044194173824159216f; float v[4]; float m = -3.0e38f;
#pragma unroll
        for (int e = 0; e < 4; ++e) { v[e] = SC[256 * wave + lane + 64 * e]; m = fmaxf(m, v[e]); }
        m = wave_max(m);
        float sum = 0.f;
#pragma unroll
        for (int e = 0; e < 4; ++e) { v[e] = __expf((v[e] - m) * scale); sum += v[e]; }
        const float inv = __builtin_amdgcn_rcpf(wave_sum(sum));
#pragma unroll
        for (int e = 0; e < 4; ++e) SC[256 * wave + lane + 64 * e] = v[e] * inv; }
    BLOCK_SYNC();
    f32x4 o[4] = {(f32x4){0.f, 0.f, 0.f, 0.f}, (f32x4){0.f, 0.f, 0.f, 0.f}, (f32x4){0.f, 0.f, 0.f, 0.f}, (f32x4){0.f, 0.f, 0.f, 0.f}};
#pragma unroll 1
    for (int kk = 0; kk < 32; kk += 8) { f32x4 vv[8][4];
        const char* vp = (const char*)(V + (size_t)(32 * wave + kk) * D) + (size_t)lane * 16; asm volatile("" : "+v"(vp));
#pragma unroll
        for (int i = 0; i < 8; ++i)
#pragma unroll
            for (int j = 0; j < 4; ++j) vv[i][j] = __builtin_nontemporal_load((const GAS f32x4*)(vp + (size_t)i * (D * 4) + j * 1024));
#pragma unroll
        for (int i = 0; i < 8; ++i)
#pragma unroll
            for (int j = 0; j < 4; ++j) PIN(vv[i][j]);
#pragma unroll
        for (int i = 0; i < 8; ++i) { const float p0 = SC[32 * wave + kk + i], p1 = SC[256 + 32 * wave + kk + i]; o[0] += vv[i][0] * p0; o[1] += vv[i][1] * p0; o[2] += vv[i][2] * p1; o[3] += vv[i][3] * p1; } }
#pragma unroll
    for (int j = 0; j < 4; ++j) *(LAS f32x4*)(RED + wave * 1024 + 4 * lane + 256 * j) = o[j];
    BLOCK_SYNC();
    { float a0 = 0.f, a1 = 0.f;
#pragma unroll
        for (int w = 0; w < 8; ++w) { const f32x2 v = *(const LAS f32x2*)(RED + w * 1024 + 2 * tid); a0 += v.x; a1 += v.y; }
        *(GAS unsigned*)((bf16*)(ws + WS_SA + SA_O) + sfrag(s, hp * 1024 + 2 * tid, D)) = cvtpk(a0, a1); }
    BLOCK_SYNC();
}

struct SEpiScale {
    bf16* O; int ldc; const unsigned long long* ssq; int act, frag;
    __device__ __forceinline__ void operator()(const f32x4& acc, int r, int c) const { const float rs = pg8::ssq_rstd(ssq[MP + r]); f32x4 v = acc * rs;
        if (act) {
#pragma unroll
            for (int e = 0; e < 4; ++e) { const float a = v[e] > 0.f ? v[e] : 0.f; v[e] = a * a; } }
        v2u w; w.x = cvtpk(v[0], v[1]); w.y = cvtpk(v[2], v[3]); *(GAS v2u*)(O + (frag ? sfrag(r, c, ldc) : (size_t)(MP + r) * ldc + c)) = w; }
};
struct SEpiRes {
    const float* hin; float* h; bf16* hb; bf16* hbf; unsigned long long* ssq_out;
    __device__ __forceinline__ void operator()(const f32x4& acc, int r, int c) const { float* hp = h + (size_t)(MP + r) * D + c; const f32x4 v = *(const GAS f32x4*)(hin + (size_t)r * D + c) + acc; *(GAS f32x4*)hp = v;
        v2u w; w.x = cvtpk(v[0], v[1]); w.y = cvtpk(v[2], v[3]); *(GAS v2u*)(hb + (size_t)(MP + r) * D + c) = w; *(GAS v2u*)(hbf + sfrag(r, c, D)) = w;
        float sq = (v[0] * v[0] + v[1] * v[1]) + (v[2] * v[2] + v[3] * v[3]); sq += __shfl_xor(sq, 16); sq += __shfl_xor(sq, 32);
        if ((threadIdx.x & 48) == 0) pg8::ssq_add(ssq_out + MP + r, sq); }
};
constexpr int SG_RED_OFF = 32 * 4112;
static_assert(SG_RED_OFF + 4096 <= LDSCTL_OFF, "sample_gemm LDS");
template <int ROWS, class Epi> __device__ __forceinline__ void sample_gemm(LAS unsigned char* lds, const bf16* Af, const bf16* Bt, int N, int K, const Epi& E, int nwg_main, int kq, int bx, int G, int tid) {
    asm volatile("" : "+v"(tid)); const int lane = tid & 63, wave = __builtin_amdgcn_readfirstlane(tid >> 6), fr = lane & 15, fq = lane >> 4;
    constexpr int RG = 128 / ROWS;
    const int first = nwg_main % G, ns = first ? G - first : G, nunits = (N / 32) * RG;
    int u0, st, cnt;
    if (first == 0) { u0 = bx; st = G; cnt = u0 < nunits ? (nunits - u0 + st - 1) / st : 0; }
    else if (bx >= first) { u0 = bx - first; st = ns; cnt = u0 < nunits ? (nunits - u0 + st - 1) / st : 0; cnt = cnt < kq ? cnt : kq; }
    else { u0 = ns * kq + bx; st = first; cnt = u0 < nunits ? (nunits - u0 + st - 1) / st : 0; }
    if (cnt == 0) return;
    const int rtl = ROWS == 128 ? wave : ((wave & 3) >> 1), ctw = ROWS == 128 ? 0 : (wave & 1), kh = ROWS == 128 ? 0 : (wave >> 2);
#pragma unroll 1
    for (int j = 0; j < cnt; ++j) { const int u = u0 + j * st, cg = u / RG, rg = u % RG, c0 = 32 * cg, R = rg * (ROWS / 16) + rtl;
        f32x4 acc0 = (f32x4){0.f, 0.f, 0.f, 0.f}, acc1 = (f32x4){0.f, 0.f, 0.f, 0.f};
#pragma unroll 1
        for (int kc = 0; kc < K; kc += 2048) {
            const char* apu = (const char*)(Af + ((size_t)(R * (K >> 5) + ((kc + kh * 1024) >> 5)) << 9)) + (size_t)lane * 16; asm volatile("" : "+v"(apu));
            const char* bsrc = (const char*)(Bt + (size_t)(c0 + 4 * wave) * K + kc) + (size_t)lane * 16; asm volatile("" : "+v"(bsrc));
            LAS unsigned char* bdst = lds + wave * (4 * 4112);
            BLOCK_SYNC();
#pragma unroll
            for (int r = 0; r < 4; ++r) { const char* rowp = bsrc + (size_t)r * K * 2; asm volatile("" : "+v"(rowp));
#pragma unroll
                for (int seg = 0; seg < 4; ++seg) __builtin_amdgcn_global_load_lds((const unsigned*)(rowp + seg * 1024), (LAS unsigned*)(bdst + r * 4112 + seg * 1024), 16, 0, 0); }
            bf16x8 a[32];
#pragma unroll
            for (int i = 0; i < 32; ++i) a[i] = *(const bf16x8*)(apu + (size_t)i * 1024);
#pragma unroll
            for (int i = 0; i < 32; ++i) PIN(a[i]);
            BLOCK_SYNC();
            if constexpr (ROWS == 32) {
                const LAS unsigned char* bp = lds + (16 * ctw + fr) * 4112 + kh * 2048 + 16 * fq;
#pragma unroll
                for (int i = 0; i < 32; i += 2) { acc0 = mfma16(ldsfrag(bp + 64 * i), a[i], acc0); acc1 = mfma16(ldsfrag(bp + 64 * (i + 1)), a[i + 1], acc1); }
            } else {
                const LAS unsigned char* bp = lds + fr * 4112 + 16 * fq;
#pragma unroll
                for (int i = 0; i < 32; ++i) { acc0 = mfma16(ldsfrag(bp + 64 * i), a[i], acc0); acc1 = mfma16(ldsfrag(bp + 16 * 4112 + 64 * i), a[i], acc1); }
                const char* apu2 = apu + 32 * 1024; asm volatile("" : "+v"(apu2), "+v"(acc0), "+v"(acc1));
#pragma unroll
                for (int i = 0; i < 32; ++i) a[i] = *(const bf16x8*)(apu2 + (size_t)i * 1024);
#pragma unroll
                for (int i = 0; i < 32; ++i) PIN(a[i]);
#pragma unroll
                for (int i = 0; i < 32; ++i) { acc0 = mfma16(ldsfrag(bp + 64 * (32 + i)), a[i], acc0); acc1 = mfma16(ldsfrag(bp + 16 * 4112 + 64 * (32 + i)), a[i], acc1); }
            } }
        if constexpr (ROWS == 32) {
            f32x4 acc = acc0 + acc1; LAS f32x4* red = (LAS f32x4*)(lds + SG_RED_OFF) + (wave & 3) * 64 + lane;
            if (kh == 1) *red = acc;
            BLOCK_SYNC();
            if (kh == 0) { acc += *red; E(acc, 32 * rg + 16 * rtl + fr, c0 + 16 * ctw + 4 * fq); }
        } else { E(acc0, 16 * wave + fr, c0 + 4 * fq); E(acc1, 16 * wave + fr, c0 + 16 + 4 * fq); } }
    BLOCK_SYNC();
}

__device__ __forceinline__ void final_norm(const Args& A, int vcu, int G, int wave, int lane, int mb = 0) {
    asm volatile("" : "+v"(lane));
    unsigned char* ws = A.ws; const float* H = (const float*)(ws + WS_H); const unsigned long long* ssq = (const unsigned long long*)((const unsigned*)(ws + WS_CTL) + CW_SSQ) + 6 * MPAD; const int gw = vcu * NWAVES + wave, NGW = G * NWAVES;
    f32x4 g[8];
#pragma unroll
    for (int j = 0; j < 8; ++j) g[j] = ((const GAS f32x4*)A.in[I_G_FINAL])[lane + 64 * j];
#pragma unroll 1
    for (int m0 = mb + gw; m0 < MR; m0 += 2 * NGW) { const int m1 = m0 + NGW; const bool has1 = m1 < MR; const int m1c = has1 ? m1 : m0;
        const GAS f32x4* h0 = (const GAS f32x4*)(H + (size_t)m0 * D) + lane; const GAS f32x4* h1 = (const GAS f32x4*)(H + (size_t)m1c * D) + lane; f32x4 v0[8], v1[8];
        const GAS v2u* b0 = (const GAS v2u*)((const bf16*)(ws + WS_HB) + (size_t)m0 * D) + lane; const GAS v2u* b1 = (const GAS v2u*)((const bf16*)(ws + WS_HB) + (size_t)m1c * D) + lane;
        if (m0 < MP) {
#pragma unroll
            for (int j = 0; j < 8; ++j) { const v2u w = b0[64 * j]; v0[j] = (f32x4){bf_lo(w.x), bf_hi(w.x), bf_lo(w.y), bf_hi(w.y)}; } }
        else {
#pragma unroll
            for (int j = 0; j < 8; ++j) v0[j] = __builtin_nontemporal_load(h0 + 64 * j); }
        if (m1c < MP) {
#pragma unroll
            for (int j = 0; j < 8; ++j) { const v2u w = b1[64 * j]; v1[j] = (f32x4){bf_lo(w.x), bf_hi(w.x), bf_lo(w.y), bf_hi(w.y)}; } }
        else {
#pragma unroll
            for (int j = 0; j < 8; ++j) v1[j] = __builtin_nontemporal_load(h1 + 64 * j); }
        const float rs0 = pg8::ssq_rstd(ssq[m0]), rs1 = pg8::ssq_rstd(ssq[m1c]);
#pragma unroll
        for (int j = 0; j < 8; ++j) { PIN(v0[j]); PIN(v1[j]); }
        GAS f32x4* o0 = (GAS f32x4*)(A.out + (m0 < MP ? O_YP + (size_t)m0 * D : O_YS + (size_t)(m0 - MP) * D)) + lane;
#pragma unroll
        for (int j = 0; j < 8; ++j) __builtin_nontemporal_store(v0[j] * g[j] * rs0, o0 + 64 * j);
        if (has1) { GAS f32x4* o1 = (GAS f32x4*)(A.out + (m1 < MP ? O_YP + (size_t)m1 * D : O_YS + (size_t)(m1 - MP) * D)) + lane;
#pragma unroll
            for (int j = 0; j < 8; ++j) __builtin_nontemporal_store(v1[j] * g[j] * rs1, o1 + 64 * j); } }
}

#ifndef PROBE_P0
#define PROBE_P0 1
#endif
#ifndef PROBE_MA
#define PROBE_MA 1
#endif
#ifndef PROBE_MC
#define PROBE_MC 1
#endif
#ifndef PROBE_ATT
#define PROBE_ATT 1
#endif
#ifndef PROBE_BAR
#define PROBE_BAR 1
#endif
#ifndef PROBE_KV
#define PROBE_KV 1
#endif
#ifndef PROBE_RES_O
#define PROBE_RES_O 0
#endif
#ifndef PROBE_RES_DOWN
#define PROBE_RES_DOWN 0
#endif
#ifndef PROBE_THIN
#define PROBE_THIN 0
#endif
#ifndef PROBE_SG_IN
#define PROBE_SG_IN 1
#endif
#ifndef PROBE_SG_Q
#define PROBE_SG_Q 1
#endif
#ifndef PROBE_SG_UP
#define PROBE_SG_UP 1
#endif
#ifndef PROBE_UP
#define PROBE_UP 1
#endif
#ifndef PROBE_Q
#define PROBE_Q 1
#endif
constexpr int PH_PER_LAYER = 10, PH_L0 = 3, PH_FINAL = PH_L0 + NL * PH_PER_LAYER, NPHASE = PH_FINAL + 1;
__global__ void __launch_bounds__(NTHR, 2) mk_fwd(Args args) {
    extern __shared__ __attribute__((aligned(16))) unsigned char lds_raw[];
    LAS unsigned char* lds = (LAS unsigned char*)lds_raw;
    volatile LAS unsigned* MISC = (volatile LAS unsigned*)(lds + MISC_OFF);
    int tid = threadIdx.x, lane = tid & 63, wave = __builtin_amdgcn_readfirstlane(tid >> 6);
#define RETID() do { asm volatile("" : "+v"(tid)); lane = tid & 63; wave = __builtin_amdgcn_readfirstlane(tid >> 6); asm volatile("" : "+s"(ws)); } while (0)
    const int G = gridDim.x; const int bx = blockIdx.x; const int vcu = (G % 8 == 0) ? (bx % 8) * (G / 8) + bx / 8 : bx;
    unsigned char* ws = args.ws;
    for (int u = tid; u < (LDS_BYTES - LDSCTL_OFF) / 4; u += NTHR) ((LAS unsigned*)(lds + LDSCTL_OFF))[u] = 0u;
    __syncthreads();
    XcdBarrier bar; bar.bar = (unsigned*)(ws + WS_CTL) + CW_BAR; bar.x = 0; bar.st = nullptr;
    if (!MK_PER_PHASE) bar = xcd_barrier_post((unsigned*)(ws + WS_CTL) + CW_BAR, MISC + 8);
    const int lo = args.ph_lo, hi = args.ph_hi;
#ifdef ONLY_PH
#define IN(k) (((k) < PH_L0 || (k) >= PH_FINAL) ? ((k) == ONLY_PH) : (((k) - PH_L0) % PH_PER_LAYER + PH_L0 == ONLY_PH) && lo <= (k) && (k) < hi)
#else
#define IN(k) (lo <= (k) && (k) < hi)
#endif
#define GRID_BAR() do { if (!MK_PER_PHASE) { for (int rep_ = 0; rep_ < PROBE_BAR; ++rep_) xcd_barrier(bar); } } while (0)
#define SSQ(s) ((unsigned long long*)((unsigned*)(ws + WS_CTL) + CW_SSQ) + (s) * MPAD)
    if (IN(0)) { RETID(); for (int rep = 0; rep < PROBE_P0; ++rep) { p0_prologue(args, lds, vcu, G, wave, lane); __syncthreads(); } GRID_BAR(); }
    if (IN(1)) { RETID();
        pg8::Gemm g{(const bf16*)(ws + WS_MEMB), (const bf16*)(ws + WS_WKV), MROWS, 4 * D, D}; pg8::StaticOrder S; S.init(MROWS, 4 * D, G, bx);
        pg8::EpiKV E{args.out + O_PMK, (size_t)(O_PMV - O_PMK), (bf16*)(ws + WS_KB), (bf16*)(ws + WS_VT), (bf16*)(ws + WS_VB), (const float*)(ws + WS_RSTDM)};
        for (int rep = 0; rep < PROBE_KV; ++rep) pg8::gemm_phase<pg8::EpiKV, pg8::StaticOrder, true, true>(lds + RING_OFF, g, S, E, tid);
        if (G == 256 && bx >= 128) p0_weights(args, lds, (bx - 128) * NWAVES + wave, 128 * NWAVES, P0W_DEF_LO, P0W_DEF_N, 1 << 30, 0, wave, lane);
        GRID_BAR(); }
#define SETUP_LAYER(LL, GG, CC) do { const int ll_ = (LL); pg8::Gemm g{nullptr, nullptr, 1024, 2048, 512, 2048, 2048}; \
        pg8::PreOrder S{(GG), (CC), (const bf16*)(ws + WS_KB) + (size_t)ll_ * 1024 * 2048, (const bf16*)(ws + WS_WQKD) + (size_t)ll_ * 2048 * 2048, (const bf16*)(ws + WS_W + (size_t)ll_ * W_L + WO_O), (const bf16*)(ws + WS_VB) + (size_t)ll_ * 1024 * 2048}; \
        pg8::EpiPre E{(bf16*)(ws + WS_WQK) + (size_t)ll_ * 4 * 1024 * 2048, (bf16*)(ws + WS_VWT) + (size_t)ll_ * 4 * 2048 * 1024}; \
        pg8::gemm_phase<pg8::EpiPre, pg8::PreOrder, true, true>(lds + RING_OFF, g, S, E, tid); } while (0)
    if (IN(2)) { RETID();
        SETUP_LAYER(0, G, bx);
        SETUP_LAYER(1, G, bx);
        GRID_BAR(); }
#pragma unroll 1
    for (int l = 0; l < NL; ++l) {
        const int pb = PH_L0 + l * PH_PER_LAYER; const bf16* wl = (const bf16*)(ws + WS_W + (size_t)l * W_L);
#define GEMM_MAIN(EPI, Aptr, Woff, NN, KK, ...) do { pg8::Gemm g{(const bf16*)(Aptr), (const bf16*)((const unsigned char*)wl + (Woff)), MP, (NN), (KK)}; pg8::StaticOrder S; S.init(MP, (NN), G, bx); \
            EPI E{__VA_ARGS__}; pg8::gemm_phase<EPI, pg8::StaticOrder, true, true>(lds + RING_OFF, g, S, E, tid); } while (0)
        if (IN(pb + 0)) { RETID();
#ifndef NO_DT
            dt_rows(args, lds, l, vcu, G, tid); for (int rep = 0; rep < PROBE_THIN; ++rep) dt_rows(args, lds, l, vcu, G, tid);
#endif
            GEMM_MAIN(pg8::EpiScaleBf16<0>, ws + WS_HB, WO_IN, NIN, D, (bf16*)(ws + WS_PROJ), NIN, SSQ(3 * l));
            for (int rep = 0; rep < PROBE_SG_IN; ++rep)
            sample_gemm<128>(lds, (const bf16*)(ws + WS_SA + SA_HB), (const bf16*)((const unsigned char*)wl + WO_IN), NIN, D, SEpiScale{(bf16*)(ws + WS_PROJ), NIN, SSQ(3 * l), 0, 0}, (MP / 256) * (NIN / 256), 4, bx, G, tid);
            GRID_BAR(); }
        if (IN(pb + 1)) { RETID();
            for (int rep = 0; rep < PROBE_MA; ++rep)
#pragma unroll 1
            for (int u = vcu; u < 512; u += G) { if (u < 256) ma_s5_unit(args, lds, l, u >> 6, u & 63, lane, wave); else { const int v = u - 256; ma_ssd_unit(args, lds, l, v >> 6, (v >> 1) & 31, v & 1, tid, lane, wave); } }
            GRID_BAR(); }
        if (IN(pb + 2)) { RETID(); mb_scan(args, l, vcu, G, tid); for (int rep = 0; rep < PROBE_THIN; ++rep) mb_scan(args, l, vcu, G, tid, 1); GRID_BAR(); }
        if (IN(pb + 3)) { RETID();
            for (int rep = 0; rep < PROBE_MC; ++rep)
#pragma unroll 1
            for (int u = vcu; u < 512; u += G) {
#ifndef NO_MC_S5
                if (u < 256) mc_s5_unit(args, lds, l, u >> 6, u & 63, tid, lane, wave); else
#endif
#ifndef NO_MC_REST
                if (u >= 256 && u < 384) { const int v = u - 256; mc_rest_unit(args, lds, l, v >> 5, v & 31, tid, lane, wave); } else
#endif
#ifndef NO_MC_SAMPLE
                if (u >= 384) mc_sample_unit(args, lds, l, u - 384, tid, lane, wave);
#endif
                { } }
            GRID_BAR(); }
        if (IN(pb + 4)) { RETID();
            GEMM_MAIN(pg8::EpiResB, ws + WS_MIX, WO_OUT, D, D, (bf16*)(ws + WS_HB), SSQ(3 * l + 1), D, (l == 0 ? args.in[I_XP] : (const float*)nullptr));
            sample_gemm<32>(lds, (const bf16*)(ws + WS_SA + SA_MIX), (const bf16*)((const unsigned char*)wl + WO_OUT), D, D, SEpiRes{(l == 0 ? args.in[I_XS] : (const float*)(ws + WS_H) + (size_t)MP * D), (float*)(ws + WS_H), (bf16*)(ws + WS_HB), (bf16*)(ws + WS_SA + SA_HB), SSQ(3 * l + 1)}, (MP / 256) * (D / 256), 1, bx, G, tid);
            if (G == 256) {
                GRID_BAR();
                sample_gemm<32>(lds, (const bf16*)(ws + WS_SA + SA_HB), (const bf16*)((const unsigned char*)wl + WO_Q), D, D, SEpiScale{(bf16*)(ws + WS_Q), D, SSQ(3 * l + 1), 0, 0}, 0, 1, bx, G, tid); }
            GRID_BAR(); }
        if (IN(pb + 5)) { RETID();
            { pg8::Gemm g{(const bf16*)(ws + WS_HB), (const bf16*)(ws + WS_WQK) + (size_t)l * 4 * 1024 * 2048, MP, 1024, D}; pg8::BatchBOrder S; S.init(MP, 1024, G, bx); S.pmb = 8; S.bbs = (size_t)1024 * 2048;
                pg8::EpiSoftmax E{(bf16*)(ws + WS_PATT), 1024, SSQ(3 * l + 1), 0.044194173824159216f};
                pg8::gemm_phase<pg8::EpiSoftmax, pg8::BatchBOrder, false, true>(lds + RING_OFF, g, S, E, tid); }
            if (G == 256) { if (bx >= 128) att_sample_unit(args, lds, l, bx - 128, 0, tid, lane, wave); }
            else
            sample_gemm<32>(lds, (const bf16*)(ws + WS_SA + SA_HB), (const bf16*)((const unsigned char*)wl + WO_Q), D, D, SEpiScale{(bf16*)(ws + WS_Q), D, SSQ(3 * l + 1), 0, 0}, 128, 2, bx, G, tid);
            GRID_BAR(); }
        if (IN(pb + 6)) { RETID();
            if (bx < 128 || G != 256) { pg8::Gemm g{(const bf16*)(ws + WS_PATT), (const bf16*)(ws + WS_VWT) + (size_t)l * 4 * 2048 * 1024, MP, D, 1024}; pg8::BatchBOrder S; S.init(MP, D, G == 256 ? 128 : G, bx); S.pmb = 8; S.bbs = (size_t)2048 * 1024;
                pg8::EpiResB E{(bf16*)(ws + WS_HB), SSQ(3 * l + 2), D, nullptr};
                pg8::gemm_phase<pg8::EpiResB, pg8::BatchBOrder, true, true>(lds + RING_OFF, g, S, E, tid); }
            if (bx >= 128 || G != 256) {
#pragma unroll 1
                for (int i = (G == 256) ? 1 : 0; i < 2; ++i) for (int c = (G == 256 ? bx - 128 : bx); c < 128; c += (G == 256 ? 128 : G)) { const int u = c * 2 + i; att_sample_unit(args, lds, l, u >> 1, u & 1, tid, lane, wave); }
                }
            GRID_BAR(); }
        if (IN(pb + 7)) { RETID();
            sample_gemm<32>(lds, (const bf16*)(ws + WS_SA + SA_O), (const bf16*)((const unsigned char*)wl + WO_O), D, D, SEpiRes{(const float*)(ws + WS_H) + (size_t)MP * D, (float*)(ws + WS_H), (bf16*)(ws + WS_HB), (bf16*)(ws + WS_SA + SA_HB), SSQ(3 * l + 2)}, 0, 1, bx, G, tid);
            GRID_BAR(); }
        if (IN(pb + 8)) { RETID();
            for (int rep = 0; rep < PROBE_UP; ++rep)
            GEMM_MAIN(pg8::EpiScaleBf16<1>, ws + WS_HB, WO_UP, FF, D, (bf16*)(ws + WS_HID), FF, SSQ(3 * l + 2));
            for (int rep = 0; rep < PROBE_SG_UP; ++rep)
            sample_gemm<128>(lds, (const bf16*)(ws + WS_SA + SA_HB), (const bf16*)((const unsigned char*)wl + WO_UP), FF, D, SEpiScale{(bf16*)(ws + WS_SA + SA_HID), FF, SSQ(3 * l + 2), 1, 1}, (MP / 256) * (FF / 256), 1, bx, G, tid);
            GRID_BAR(); }
        if (IN(pb + 9)) { RETID();
#define SFIRST() ([&]() { pg8::StaticOrder S0; S0.init(MP, D, G, bx); pg8::Unit u0; return G == 256 && S0.next(0, u0) && (u0.pm & 1) != 0; }())
            if (SFIRST()) { sample_gemm<32>(lds, (const bf16*)(ws + WS_SA + SA_HID), (const bf16*)((const unsigned char*)wl + WO_DOWN), D, FF, SEpiRes{(const float*)(ws + WS_H) + (size_t)MP * D, (float*)(ws + WS_H), (bf16*)(ws + WS_HB), (bf16*)(ws + WS_SA + SA_HB), SSQ(3 * l + 3)}, (MP / 256) * (D / 256), 1, bx, G, tid); }
            if (l == NL - 1 && G == 256) { pg8::Gemm g{(const bf16*)(ws + WS_HID), (const bf16*)((const unsigned char*)wl + WO_DOWN), MP, D, FF}; pg8::StaticOrder S; S.init(MP, D, G, bx);
                pg8::EpiResFinal E{(const bf16*)(ws + WS_HB), args.out + O_YP, args.in[I_G_FINAL], SSQ(3 * l + 3), (unsigned*)(ws + WS_CTL) + CW_FCNT, D};
                pg8::gemm_phase<pg8::EpiResFinal, pg8::StaticOrder, false, true>(lds + RING_OFF, g, S, E, tid); }
            else
            GEMM_MAIN(pg8::EpiResB, ws + WS_HID, WO_DOWN, D, FF, (bf16*)(ws + WS_HB), SSQ(3 * l + 3), D, nullptr);
            if (!SFIRST()) { sample_gemm<32>(lds, (const bf16*)(ws + WS_SA + SA_HID), (const bf16*)((const unsigned char*)wl + WO_DOWN), D, FF, SEpiRes{(const float*)(ws + WS_H) + (size_t)MP * D, (float*)(ws + WS_H), (bf16*)(ws + WS_HB), (bf16*)(ws + WS_SA + SA_HB), SSQ(3 * l + 3)}, (MP / 256) * (D / 256), 1, bx, G, tid); }
#undef SFIRST
            GRID_BAR(); }
#undef GEMM_MAIN
    }
    if (IN(PH_FINAL)) { final_norm(args, vcu, G, wave, lane, G == 256 ? MP : 0); }
#undef IN
#undef GRID_BAR
#undef SSQ
}

extern "C" void kernel_launch(void* const* d_in, const int* in_sizes, int n_in, void* d_out, int out_size, void* d_ws, size_t ws_size, hipStream_t stream) {
    static int grid = 0;
    if (grid == 0) {
        if (n_in != N_IN || in_sizes[0] != MP * D || (size_t)out_size != O_END || ws_size < WS_END) { fprintf(stderr, "kernel_launch: unexpected problem (n_in %d, in0 %d, out %d, ws %zu); nothing launched\n", n_in, n_in > 0 ? in_sizes[0] : -1, out_size, ws_size); grid = -1; return; }
        int dev = 0, cus = 0, per_cu = 0;
        if (hipGetDevice(&dev) != hipSuccess || hipDeviceGetAttribute(&cus, hipDeviceAttributeMultiprocessorCount, dev) != hipSuccess) { fprintf(stderr, "kernel_launch: device query failed\n"); grid = -1; return; }
        if (hipFuncSetAttribute((const void*)mk_fwd, hipFuncAttributeMaxDynamicSharedMemorySize, LDS_BYTES) != hipSuccess) { fprintf(stderr, "kernel_launch: hipFuncSetAttribute failed\n"); grid = -1; return; }
        if (hipOccupancyMaxActiveBlocksPerMultiprocessor(&per_cu, (const void*)mk_fwd, NTHR, LDS_BYTES) != hipSuccess || per_cu < 1) fprintf(stderr, "kernel_launch: note: occupancy query reports %d workgroups per CU\n", per_cu);
        (void)hipGetLastError();
        grid = cus;
    }
    if (grid < 0) return;
    if (hipMemsetAsync((char*)d_ws + WS_CTL, 0, CTL_ZERO_BYTES, stream) != hipSuccess) { fprintf(stderr, "kernel_launch: hipMemsetAsync failed\n"); return; }
    Args a{};
    for (int i = 0; i < N_IN; ++i) a.in[i] = (const float*)d_in[i];
    a.out = (float*)d_out; a.ws = (unsigned char*)d_ws;
#if MK_PER_PHASE
    for (int p = 0; p < NPHASE; ++p) { a.ph_lo = p; a.ph_hi = p + 1; hipLaunchKernelGGL(mk_fwd, dim3(grid), dim3(NTHR), LDS_BYTES, stream, a); }
#else
    a.ph_lo = 0; a.ph_hi = NPHASE; hipLaunchKernelGGL(mk_fwd, dim3(grid), dim3(NTHR), LDS_BYTES, stream, a);
#endif
    const hipError_t le = hipPeekAtLastError();
    if (le != hipSuccess) fprintf(stderr, "kernel_launch: launch failed: %s\n", hipGetErrorName(le));
}
```

```cpp
#include <hip/hip_runtime.h>
#include <cstdio>
#include <cstdint>
namespace pg8 {
#define PG8_LAS __attribute__((address_space(3)))
typedef unsigned short bf16_t;
typedef short bf16x8 __attribute__((ext_vector_type(8)));
typedef float f32x4 __attribute__((ext_vector_type(4)));
typedef unsigned u32x4 __attribute__((ext_vector_type(4)));
constexpr int BM = 256, BK = 64, HALF = 128, HTB = HALF * BK * 2  , STAGE_BYTES = 8 * HTB, NXCD = 8, WGM = 8;

__host__ __device__ __forceinline__ int lds_byte(int r, int c) { const int st = (r >> 4) * 2 + (c >> 5), rr = r & 15, cc = c & 31, ob = rr * 64 + cc * 2; return st * 1024 + (ob ^ (((ob >> 9) & 1) << 5)); }
__host__ __device__ __forceinline__ void stage_rc(int b, int& R, int& C) { const int st = b / 1024, sb = b % 1024, swz = sb ^ (((sb >> 9) & 1) << 5); R = (st >> 1) * 16 + swz / 64; C = (st & 1) * 32 + (swz % 64) / 2; }
__host__ __device__ __forceinline__ int perm32(int rho) { const int n = rho >> 4, i = rho & 15; return 8 * (i >> 2) + 4 * n + (i & 3); }

struct Unit { int pm, pn, z; };
struct Gemm { const bf16_t* A; const bf16_t* Bt; int M, N, K; int lda = 0, ldb = 0; };

struct StaticOrder {
    int nM, nN, nwg, G, c;
    __host__ __device__ void init(int M, int N, int G_, int c_) { nM = M / BM; nN = N / BM; nwg = nM * nN; G = G_; c = c_; }
    __host__ __device__ bool next(int i, Unit& u) const {
        const long L = (long)i * G + c; if (L >= nwg) return false;
        int wgid = (int)L; { const int q = nwg / NXCD, r = nwg % NXCD, xcd = wgid % NXCD, off = wgid / NXCD; wgid = (xcd < r ? xcd * (q + 1) : r * (q + 1) + (xcd - r) * q) + off; }
        const int nig = WGM * nN, gid = wgid / nig, fm = gid * WGM, gsz = (nM - fm) < WGM ? (nM - fm) : WGM;
        u.pm = fm + ((wgid % nig) % gsz); u.pn = (wgid % nig) / gsz; u.z = 0; return true;
    }
    __device__ __forceinline__ void a_ready(const Unit&) const {}
    __device__ __forceinline__ void done(const Unit&) const {}
    __device__ __forceinline__ const char* abase(const Gemm& g, const Unit& u) const { return (const char*)g.A + (size_t)u.pm * 256 * (size_t)(g.lda ? g.lda : g.K) * 2; }
    __device__ __forceinline__ const char* bbase(const Gemm& g, const Unit& u) const { return (const char*)g.Bt + (size_t)u.pn * 256 * (size_t)(g.ldb ? g.ldb : g.K) * 2; }
};


struct PreOrder {
    int G, c; const bf16_t* a0; const bf16_t* b0; const bf16_t* a1; const bf16_t* b1;
    __device__ __forceinline__ bool next(int i, Unit& u) const { const long L = (long)i * G + c; if (L >= 256) return false; const int mode = (int)(L >> 7), head = (int)((L & 127) >> 5), x = (int)((L & 31) >> 3), y = (int)(L & 7);
        u.z = mode * 4 + head; u.pm = mode ? y : x; u.pn = mode ? x : y; return true; }
    __device__ __forceinline__ void a_ready(const Unit&) const {}
    __device__ __forceinline__ void done(const Unit&) const {}
    __device__ __forceinline__ const char* abase(const Gemm&, const Unit& u) const { return (const char*)((u.z >> 2) ? a1 : a0) + ((size_t)u.pm * 256 * 2048 + (size_t)(u.z & 3) * 512) * 2; }
    __device__ __forceinline__ const char* bbase(const Gemm&, const Unit& u) const { return (const char*)((u.z >> 2) ? b1 : b0) + ((size_t)u.pn * 256 * 2048 + (size_t)(u.z & 3) * 512) * 2; }
};
typedef float cvt_f32x2 __attribute__((ext_vector_type(2)));
typedef __bf16 cvt_bf16x2 __attribute__((ext_vector_type(2)));
__device__ __forceinline__ unsigned cvt_pk_bf16(float lo, float hi) { const cvt_f32x2 v = {lo, hi}; return __builtin_bit_cast(unsigned, __builtin_convertvector(v, cvt_bf16x2)); }

__device__ __forceinline__ void ssq_add(unsigned long long* p, float v) { (void)__hip_atomic_fetch_add(p, (unsigned long long)__float2ull_rn(v * 16777216.0f), __ATOMIC_RELAXED, __HIP_MEMORY_SCOPE_AGENT); }
__device__ __forceinline__ float ssq_rstd(unsigned long long v) { return __builtin_amdgcn_rsqf((float)v * (1.0f / (16777216.0f * 2048.0f)) + 1e-6f); }
template <int ACT> struct EpiScaleBf16 {
    static constexpr bool PERM = true, AFTER_DRAIN = false;
    bf16_t* O; int ldc; const unsigned long long* ssq;
    __device__ __forceinline__ void operator()(const f32x4 (&acc)[2][2][4][2], const Unit& u, int wr, int wc, int fr, int fq) const {
        const int row0 = u.pm * BM + wr * 64 + fr, col0 = u.pn * BM + wc * 32 + 8 * fq;
        unsigned long long sv[2][4];
#pragma unroll
        for (int ai = 0; ai < 2; ++ai)
#pragma unroll
            for (int m = 0; m < 4; ++m) sv[ai][m] = ssq[row0 + ai * HALF + m * 16];
#pragma unroll
        for (int ai = 0; ai < 2; ++ai)
#pragma unroll
            for (int m = 0; m < 4; ++m) asm volatile("" : "+v"(sv[ai][m]));
#pragma unroll
        for (int ai = 0; ai < 2; ++ai)
#pragma unroll
            for (int m = 0; m < 4; ++m) { const int row = row0 + ai * HALF + m * 16; const float rs = ssq_rstd(sv[ai][m]);
                bf16_t* rowp = O + (size_t)row * ldc + col0;
#pragma unroll
                for (int bj = 0; bj < 2; ++bj) { f32x4 v0 = acc[ai][bj][m][0] * rs, v1 = acc[ai][bj][m][1] * rs;
                    if (ACT == 1) {
#pragma unroll
                        for (int e = 0; e < 4; ++e) { const float a0 = v0[e] > 0.f ? v0[e] : 0.f, a1 = v1[e] > 0.f ? v1[e] : 0.f; v0[e] = a0 * a0; v1[e] = a1 * a1; } }
                    u32x4 w; w.x = cvt_pk_bf16(v0[0], v0[1]); w.y = cvt_pk_bf16(v0[2], v0[3]); w.z = cvt_pk_bf16(v1[0], v1[1]); w.w = cvt_pk_bf16(v1[2], v1[3]);
                    *(u32x4*)(rowp + bj * HALF) = w; } }
    }
};
struct EpiRes {
    static constexpr bool PERM = true, AFTER_DRAIN = false;
    const float* hin; float* h; bf16_t* hb; unsigned long long* ssq_out; int ldc;
    __device__ __forceinline__ void operator()(const f32x4 (&acc)[2][2][4][2], const Unit& u, int wr, int wc, int fr, int fq) const {
        const int row0 = u.pm * BM + wr * 64 + fr, col0 = u.pn * BM + wc * 32 + 8 * fq;
#pragma unroll
        for (int ai = 0; ai < 2; ++ai) {
            f32x4 hv[4][2][2];
#pragma unroll
            for (int m = 0; m < 4; ++m) { const float* hp = hin + (size_t)(row0 + ai * HALF + m * 16) * ldc + col0;
#pragma unroll
                for (int bj = 0; bj < 2; ++bj) { hv[m][bj][0] = *(const f32x4*)(hp + bj * HALF); hv[m][bj][1] = *(const f32x4*)(hp + bj * HALF + 4); } }
#pragma unroll
            for (int m = 0; m < 4; ++m)
#pragma unroll
                for (int bj = 0; bj < 2; ++bj) { asm volatile("" : "+v"(hv[m][bj][0])); asm volatile("" : "+v"(hv[m][bj][1])); }
#pragma unroll
            for (int m = 0; m < 4; ++m) { const int row = row0 + ai * HALF + m * 16; float sq = 0.f;
                float* hp = h + (size_t)row * ldc + col0; bf16_t* bp = hb + (size_t)row * ldc + col0;
#pragma unroll
                for (int bj = 0; bj < 2; ++bj) { f32x4 v0 = hv[m][bj][0] + acc[ai][bj][m][0], v1 = hv[m][bj][1] + acc[ai][bj][m][1];
                    *(f32x4*)(hp + bj * HALF) = v0; *(f32x4*)(hp + bj * HALF + 4) = v1;
                    sq += (v0[0] * v0[0] + v0[1] * v0[1]) + (v0[2] * v0[2] + v0[3] * v0[3]) + (v1[0] * v1[0] + v1[1] * v1[1]) + (v1[2] * v1[2] + v1[3] * v1[3]);
                    u32x4 w; w.x = cvt_pk_bf16(v0[0], v0[1]); w.y = cvt_pk_bf16(v0[2], v0[3]); w.z = cvt_pk_bf16(v1[0], v1[1]); w.w = cvt_pk_bf16(v1[2], v1[3]);
                    *(u32x4*)(bp + bj * HALF) = w; }
                sq += __shfl_xor(sq, 16); sq += __shfl_xor(sq, 32);
                if (fq == 0) ssq_add(ssq_out + row, sq); } }
    }
};
struct EpiResB {
    static constexpr bool PERM = true, AFTER_DRAIN = false;
    bf16_t* hb; unsigned long long* ssq_out; int ldc; const float* xin;
    __device__ __forceinline__ void operator()(const f32x4 (&acc)[2][2][4][2], const Unit& u, int wr, int wc, int fr, int fq) const {
        const int row0 = u.pm * BM + wr * 64 + fr, col0 = u.pn * BM + wc * 32 + 8 * fq;
        if (xin) {
#pragma unroll
            for (int ai = 0; ai < 2; ++ai) {
                f32x4 xv[4][2][2];
#pragma unroll
                for (int m = 0; m < 4; ++m) { const float* hp = xin + (size_t)(row0 + ai * HALF + m * 16) * ldc + col0;
#pragma unroll
                    for (int bj = 0; bj < 2; ++bj) { xv[m][bj][0] = *(const f32x4*)(hp + bj * HALF); xv[m][bj][1] = *(const f32x4*)(hp + bj * HALF + 4); } }
#pragma unroll
                for (int m = 0; m < 4; ++m)
#pragma unroll
                    for (int bj = 0; bj < 2; ++bj) { asm volatile("" : "+v"(xv[m][bj][0])); asm volatile("" : "+v"(xv[m][bj][1])); }
#pragma unroll
                for (int m = 0; m < 4; ++m) { const int row = row0 + ai * HALF + m * 16; float sq = 0.f; bf16_t* bp = hb + (size_t)row * ldc + col0;
#pragma unroll
                    for (int bj = 0; bj < 2; ++bj) { const f32x4 v0 = xv[m][bj][0] + acc[ai][bj][m][0], v1 = xv[m][bj][1] + acc[ai][bj][m][1];
                        sq += (v0[0] * v0[0] + v0[1] * v0[1]) + (v0[2] * v0[2] + v0[3] * v0[3]) + (v1[0] * v1[0] + v1[1] * v1[1]) + (v1[2] * v1[2] + v1[3] * v1[3]);
                        u32x4 w; w.x = cvt_pk_bf16(v0[0], v0[1]); w.y = cvt_pk_bf16(v0[2], v0[3]); w.z = cvt_pk_bf16(v1[0], v1[1]); w.w = cvt_pk_bf16(v1[2], v1[3]);
                        *(u32x4*)(bp + bj * HALF) = w; }
                    sq += __shfl_xor(sq, 16); sq += __shfl_xor(sq, 32);
                    if (fq == 0) ssq_add(ssq_out + row, sq); } }
            return; }
        u32x4 hv[2][4][2];
#pragma unroll
        for (int ai = 0; ai < 2; ++ai)
#pragma unroll
            for (int m = 0; m < 4; ++m) { const bf16_t* bp = hb + (size_t)(row0 + ai * HALF + m * 16) * ldc + col0;
#pragma unroll
                for (int bj = 0; bj < 2; ++bj) hv[ai][m][bj] = *(const u32x4*)(bp + bj * HALF); }
#pragma unroll
        for (int ai = 0; ai < 2; ++ai)
#pragma unroll
            for (int m = 0; m < 4; ++m) { asm volatile("" : "+v"(hv[ai][m][0])); asm volatile("" : "+v"(hv[ai][m][1])); }
#pragma unroll
        for (int ai = 0; ai < 2; ++ai)
#pragma unroll
            for (int m = 0; m < 4; ++m) { const int row = row0 + ai * HALF + m * 16; float sq = 0.f; bf16_t* bp = hb + (size_t)row * ldc + col0;
#pragma unroll
                for (int bj = 0; bj < 2; ++bj) { const u32x4 w0 = hv[ai][m][bj];
                    const f32x4 v0 = (f32x4){__uint_as_float(w0.x << 16), __uint_as_float(w0.x & 0xffff0000u), __uint_as_float(w0.y << 16), __uint_as_float(w0.y & 0xffff0000u)} + acc[ai][bj][m][0];
                    const f32x4 v1 = (f32x4){__uint_as_float(w0.z << 16), __uint_as_float(w0.z & 0xffff0000u), __uint_as_float(w0.w << 16), __uint_as_float(w0.w & 0xffff0000u)} + acc[ai][bj][m][1];
                    sq += (v0[0] * v0[0] + v0[1] * v0[1]) + (v0[2] * v0[2] + v0[3] * v0[3]) + (v1[0] * v1[0] + v1[1] * v1[1]) + (v1[2] * v1[2] + v1[3] * v1[3]);
                    u32x4 w; w.x = cvt_pk_bf16(v0[0], v0[1]); w.y = cvt_pk_bf16(v0[2], v0[3]); w.z = cvt_pk_bf16(v1[0], v1[1]); w.w = cvt_pk_bf16(v1[2], v1[3]);
                    *(u32x4*)(bp + bj * HALF) = w; }
                sq += __shfl_xor(sq, 16); sq += __shfl_xor(sq, 32);
                if (fq == 0) ssq_add(ssq_out + row, sq); }
    }
};
struct EpiResFinal {
    static constexpr bool PERM = true, AFTER_DRAIN = true;
    const bf16_t* hin; float* y; const float* gfin; unsigned long long* ssq_out; unsigned* cnt; int ldc;
    __device__ __forceinline__ void operator()(const f32x4 (&)[2][2][4][2], const Unit&, int, int, int, int) const {}
    __device__ __forceinline__ void fused(f32x4 (&acc)[2][2][4][2], const Unit& u, int wr, int wc, int fr, int fq, PG8_LAS unsigned char*, int wid, int lane) const {
        const int row0 = u.pm * BM + wr * 64 + fr, col0 = u.pn * BM + wc * 32 + 8 * fq;
#pragma unroll
        for (int ai = 0; ai < 2; ++ai) {
            u32x4 hv[4][2];
#pragma unroll
            for (int m = 0; m < 4; ++m) { const bf16_t* hp = hin + (size_t)(row0 + ai * HALF + m * 16) * ldc + col0;
#pragma unroll
                for (int bj = 0; bj < 2; ++bj) hv[m][bj] = *(const u32x4*)(hp + bj * HALF); }
#pragma unroll
            for (int m = 0; m < 4; ++m) { asm volatile("" : "+v"(hv[m][0])); asm volatile("" : "+v"(hv[m][1])); }
#pragma unroll
            for (int m = 0; m < 4; ++m) { const int row = row0 + ai * HALF + m * 16; float sq = 0.f;
#pragma unroll
                for (int bj = 0; bj < 2; ++bj) { const u32x4 w0 = hv[m][bj];
                    const f32x4 v0 = (f32x4){__uint_as_float(w0.x << 16), __uint_as_float(w0.x & 0xffff0000u), __uint_as_float(w0.y << 16), __uint_as_float(w0.y & 0xffff0000u)} + acc[ai][bj][m][0];
                    const f32x4 v1 = (f32x4){__uint_as_float(w0.z << 16), __uint_as_float(w0.z & 0xffff0000u), __uint_as_float(w0.w << 16), __uint_as_float(w0.w & 0xffff0000u)} + acc[ai][bj][m][1];
                    acc[ai][bj][m][0] = v0; acc[ai][bj][m][1] = v1;
                    sq += (v0[0] * v0[0] + v0[1] * v0[1]) + (v0[2] * v0[2] + v0[3] * v0[3]) + (v1[0] * v1[0] + v1[1] * v1[1]) + (v1[2] * v1[2] + v1[3] * v1[3]); }
                sq += __shfl_xor(sq, 16); sq += __shfl_xor(sq, 32);
                if (fq == 0) ssq_add(ssq_out + row, sq); } }
        asm volatile("s_waitcnt vmcnt(0)" ::: "memory");
        __builtin_amdgcn_s_barrier(); asm volatile("" ::: "memory");
        if (wid == 0 && lane == 0) { unsigned* c = cnt + u.pm * 64;
            (void)__hip_atomic_fetch_add(c, 1u, __ATOMIC_RELAXED, __HIP_MEMORY_SCOPE_AGENT);
            unsigned sp = 0; while (__hip_atomic_load(c, __ATOMIC_RELAXED, __HIP_MEMORY_SCOPE_AGENT) < 8u) { __builtin_amdgcn_s_sleep(1); if (++sp > (1u << 22)) break; } }
        __builtin_amdgcn_s_barrier(); asm volatile("" ::: "memory");
        unsigned long long sv[2][4];
#pragma unroll
        for (int ai = 0; ai < 2; ++ai)
#pragma unroll
            for (int m = 0; m < 4; ++m) sv[ai][m] = __hip_atomic_load(ssq_out + row0 + ai * HALF + m * 16, __ATOMIC_RELAXED, __HIP_MEMORY_SCOPE_AGENT);
        f32x4 gv[2][2];
#pragma unroll
        for (int bj = 0; bj < 2; ++bj) { gv[bj][0] = *(const f32x4*)(gfin + col0 + bj * HALF); gv[bj][1] = *(const f32x4*)(gfin + col0 + bj * HALF + 4); }
#pragma unroll
        for (int ai = 0; ai < 2; ++ai)
#pragma unroll
            for (int m = 0; m < 4; ++m) asm volatile("" : "+v"(sv[ai][m]));
#pragma unroll
        for (int ai = 0; ai < 2; ++ai)
#pragma unroll
            for (int m = 0; m < 4; ++m) { const float rs = ssq_rstd(sv[ai][m]); float* yp = y + (size_t)(row0 + ai * HALF + m * 16) * ldc + col0;
#pragma unroll
                for (int bj = 0; bj < 2; ++bj) { *(f32x4*)(yp + bj * HALF) = acc[ai][bj][m][0] * gv[bj][0] * rs; *(f32x4*)(yp + bj * HALF + 4) = acc[ai][bj][m][1] * gv[bj][1] * rs; } }
    }
};
struct BatchBOrder : StaticOrder {
    int pmb; size_t bbs;
    __device__ __forceinline__ const char* bbase(const Gemm& g, const Unit& u) const { return (const char*)g.Bt + ((size_t)(u.pm / pmb) * bbs + (size_t)u.pn * 256 * (size_t)(g.ldb ? g.ldb : g.K)) * 2; }
};
struct EpiSoftmax {
    static constexpr bool PERM = true, AFTER_DRAIN = true;
    bf16_t* P; int ldc; const unsigned long long* ssq; float scale;
    __device__ __forceinline__ void operator()(const f32x4 (&)[2][2][4][2], const Unit&, int, int, int, int) const {}
    __device__ __forceinline__ void fused(f32x4 (&acc)[2][2][4][2], const Unit& u, int wr, int wc, int fr, int fq, PG8_LAS unsigned char* lds, int wid, int lane) const {
        PG8_LAS float* RM = (PG8_LAS float*)lds; PG8_LAS float* RS = (PG8_LAS float*)(lds + 4096);
        const int r0 = wr * 64 + fr, row0 = u.pm * BM + r0, col0 = u.pn * BM + wc * 32 + 8 * fq;
        unsigned long long sv[2][4];
#pragma unroll
        for (int ai = 0; ai < 2; ++ai)
#pragma unroll
            for (int m = 0; m < 4; ++m) sv[ai][m] = ssq[row0 + ai * HALF + m * 16];
#pragma unroll
        for (int ai = 0; ai < 2; ++ai)
#pragma unroll
            for (int m = 0; m < 4; ++m) asm volatile("" : "+v"(sv[ai][m]));
#pragma unroll
        for (int ai = 0; ai < 2; ++ai)
#pragma unroll
            for (int m = 0; m < 4; ++m) { const float sc = ssq_rstd(sv[ai][m]) * scale; float mx = -3.0e38f;
#pragma unroll
                for (int bj = 0; bj < 2; ++bj)
#pragma unroll
                    for (int n = 0; n < 2; ++n) { f32x4 v = acc[ai][bj][m][n] * sc; acc[ai][bj][m][n] = v; mx = fmaxf(fmaxf(mx, fmaxf(v[0], v[1])), fmaxf(v[2], v[3])); }
                mx = fmaxf(mx, __shfl_xor(mx, 16)); mx = fmaxf(mx, __shfl_xor(mx, 32));
                if (fq == 0) RM[(r0 + ai * HALF + m * 16) * 4 + wc] = mx; }
        asm volatile("s_waitcnt lgkmcnt(0)" ::: "memory"); __builtin_amdgcn_s_barrier(); asm volatile("" ::: "memory");
#pragma unroll
        for (int ai = 0; ai < 2; ++ai)
#pragma unroll
            for (int m = 0; m < 4; ++m) { const f32x4 q = *(const PG8_LAS f32x4*)(RM + (r0 + ai * HALF + m * 16) * 4); const float mx = fmaxf(fmaxf(q[0], q[1]), fmaxf(q[2], q[3])); float sm = 0.f;
#pragma unroll
                for (int bj = 0; bj < 2; ++bj)
#pragma unroll
                    for (int n = 0; n < 2; ++n) { f32x4 v = acc[ai][bj][m][n];
#pragma unroll
                        for (int e = 0; e < 4; ++e) { v[e] = __expf(v[e] - mx); sm += v[e]; }
                        acc[ai][bj][m][n] = v; }
                sm += __shfl_xor(sm, 16); sm += __shfl_xor(sm, 32);
                if (fq == 0) RS[(r0 + ai * HALF + m * 16) * 4 + wc] = sm; }
        asm volatile("s_waitcnt lgkmcnt(0)" ::: "memory"); __builtin_amdgcn_s_barrier(); asm volatile("" ::: "memory");
#pragma unroll
        for (int ai = 0; ai < 2; ++ai)
#pragma unroll
            for (int m = 0; m < 4; ++m) { const f32x4 q = *(const PG8_LAS f32x4*)(RS + (r0 + ai * HALF + m * 16) * 4); const float inv = __builtin_amdgcn_rcpf((q[0] + q[1]) + (q[2] + q[3]));
                bf16_t* rowp = P + (size_t)(row0 + ai * HALF + m * 16) * ldc + col0;
#pragma unroll
                for (int bj = 0; bj < 2; ++bj) { const f32x4 v0 = acc[ai][bj][m][0] * inv, v1 = acc[ai][bj][m][1] * inv;
                    u32x4 w; w.x = cvt_pk_bf16(v0[0], v0[1]); w.y = cvt_pk_bf16(v0[2], v0[3]); w.z = cvt_pk_bf16(v1[0], v1[1]); w.w = cvt_pk_bf16(v1[2], v1[3]);
                    *(u32x4*)(rowp + bj * HALF) = w; } }
    }
};
struct EpiPre {
    static constexpr bool PERM = true, AFTER_DRAIN = false;
    bf16_t* wqk; bf16_t* vwt;
    __device__ __forceinline__ void operator()(const f32x4 (&acc)[2][2][4][2], const Unit& u, int wr, int wc, int fr, int fq) const {
        const int mode = u.z >> 2, head = u.z & 3, r0 = wr * 64 + fr, c0 = wc * 32 + 8 * fq;
#pragma unroll
        for (int ai = 0; ai < 2; ++ai)
#pragma unroll
            for (int m = 0; m < 4; ++m) { const int r = r0 + ai * HALF + m * 16;
#pragma unroll
                for (int bj = 0; bj < 2; ++bj) { const int c = c0 + bj * HALF; const f32x4 v0 = acc[ai][bj][m][0], v1 = acc[ai][bj][m][1];
                    u32x4 w; w.x = cvt_pk_bf16(v0[0], v0[1]); w.y = cvt_pk_bf16(v0[2], v0[3]); w.z = cvt_pk_bf16(v1[0], v1[1]); w.w = cvt_pk_bf16(v1[2], v1[3]);
                    const size_t off = mode == 0 ? (((size_t)u.pm * 1024 + head * 256 + r) * 2048 + u.pn * 256 + c) : (((size_t)u.pn * 2048 + u.pm * 256 + r) * 1024 + head * 256 + c);
                    *(u32x4*)((mode == 0 ? wqk : vwt) + off) = w; } }
    }
};
struct EpiKV {
    static constexpr bool PERM = true, AFTER_DRAIN = false;
    float* outk; size_t voff; bf16_t* kb; bf16_t* vt; bf16_t* vb; const float* rstd;
    __device__ __forceinline__ void operator()(const f32x4 (&acc)[2][2][4][2], const Unit& u, int wr, int wc, int fr, int fq) const {
        const int row0 = u.pm * BM + wr * 64 + fr; const int colt = u.pn * BM, which = colt >> 11, l = which >> 1, isv = which & 1;
        const int col0 = (colt & 2047) + wc * 32 + 8 * fq;
        float sv[2][4];
#pragma unroll
        for (int ai = 0; ai < 2; ++ai)
#pragma unroll
            for (int m = 0; m < 4; ++m) sv[ai][m] = rstd[row0 + ai * HALF + m * 16];
#pragma unroll
        for (int ai = 0; ai < 2; ++ai)
#pragma unroll
            for (int m = 0; m < 4; ++m) asm volatile("" : "+v"(sv[ai][m]));
#pragma unroll
        for (int ai = 0; ai < 2; ++ai)
#pragma unroll
            for (int m = 0; m < 4; ++m) { const int row = row0 + ai * HALF + m * 16; const float rs = sv[ai][m];
#pragma unroll
                for (int bj = 0; bj < 2; ++bj) { const f32x4 v0 = acc[ai][bj][m][0] * rs, v1 = acc[ai][bj][m][1] * rs; const int col = col0 + bj * HALF;
                    float* op = outk + (isv ? voff : (size_t)0) + ((size_t)l * 1024 + row) * 2048 + col;
                    *(f32x4*)op = v0; *(f32x4*)(op + 4) = v1;
                    if (!isv) { u32x4 w; w.x = cvt_pk_bf16(v0[0], v0[1]); w.y = cvt_pk_bf16(v0[2], v0[3]); w.z = cvt_pk_bf16(v1[0], v1[1]); w.w = cvt_pk_bf16(v1[2], v1[3]);
                        *(u32x4*)(kb + ((size_t)l * 1024 + row) * 2048 + col) = w; }
                    else { { u32x4 w; w.x = cvt_pk_bf16(v0[0], v0[1]); w.y = cvt_pk_bf16(v0[2], v0[3]); w.z = cvt_pk_bf16(v1[0], v1[1]); w.w = cvt_pk_bf16(v1[2], v1[3]); *(u32x4*)(vb + ((size_t)l * 1024 + row) * 2048 + col) = w; }
                    } } }
    }
};
template <class Epi, class Sched, bool ALIGN_EPI = false, bool SP2 = false>
__device__ __forceinline__ void gemm_phase(PG8_LAS unsigned char* lds, const Gemm g, const Sched& S, const Epi& E, int tid) {
    asm volatile("" : "+v"(tid));
    const int wid = __builtin_amdgcn_readfirstlane(tid >> 6), lane = tid & 63, wr = wid >> 2, wc = wid & 3, fr = lane & 15, fq = lane >> 4;
    const int K = g.K, nt = K / BK, lda = g.lda ? g.lda : K, ldb = g.ldb ? g.ldb : K;
    unsigned voffA[2], voffB[2];
#pragma unroll
    for (int i = 0; i < 2; ++i) { int R, C; stage_rc(tid * 16 + i * 8192, R, C); const int Rb = Epi::PERM ? ((R & ~31) + perm32(R & 31)) : R;
        voffA[i] = (unsigned)(R * lda + C) * 2u; voffB[i] = (unsigned)(Rb * ldb + C) * 2u; }
    const size_t kstep = (size_t)(BK * 2);
    const size_t hstepA = (size_t)HALF * lda * 2, hstepB = (size_t)HALF * ldb * 2;
    const unsigned ldsw = (unsigned)wid * 1024u;
    const int aoff = lds_byte(wr * 64 + fr, fq * 8), boff = lds_byte(wc * 32 + fr, fq * 8);
#define PG8_SA(b, h) (((b) * 2 + (h)) * HTB)
#define PG8_SB(b, h) ((4 + (b) * 2 + (h)) * HTB)
#define PG8_STAGE(bufoff, gbase, voff) do { _Pragma("unroll") for (int _i = 0; _i < 2; ++_i) \
        __builtin_amdgcn_global_load_lds((const unsigned*)((const char*)(gbase) + (voff)[_i]), (PG8_LAS unsigned*)(lds + (bufoff) + ldsw + _i * 8192), 16, 0, 0); } while (0)
#define PG8_LDA(dst, b, h) do { _Pragma("unroll") for (int m = 0; m < 4; ++m) _Pragma("unroll") for (int k = 0; k < 2; ++k) dst[m][k] = *(const PG8_LAS bf16x8*)(lds + PG8_SA(b, h) + aoff + m * 2048 + k * 1024); } while (0)
#define PG8_LDB(dst, b, h) do { _Pragma("unroll") for (int n = 0; n < 2; ++n) _Pragma("unroll") for (int k = 0; k < 2; ++k) dst[n][k] = *(const PG8_LAS bf16x8*)(lds + PG8_SB(b, h) + boff + n * 2048 + k * 1024); } while (0)
#define PG8_MMA(ai, bj, At, Bt) do { __builtin_amdgcn_s_setprio(1); _Pragma("unroll") for (int m = 0; m < 4; ++m) _Pragma("unroll") for (int n = 0; n < 2; ++n) _Pragma("unroll") for (int k = 0; k < 2; ++k) \
        acc[ai][bj][m][n] = __builtin_amdgcn_mfma_f32_16x16x32_bf16(Bt[n][k], At[m][k], acc[ai][bj][m][n], 0, 0, 0); __builtin_amdgcn_s_setprio(0); } while (0)
#define PG8_WAIT_V(n) asm volatile("s_waitcnt vmcnt(" #n ")" ::: "memory")
#define PG8_WAIT_L(n) asm volatile("s_waitcnt lgkmcnt(" #n ")" ::: "memory")
#define PG8_BAR __builtin_amdgcn_s_barrier()
#define PG8_SCHED __builtin_amdgcn_sched_barrier(0)
    Unit cur, nxt; int ui = 0;
    if (!S.next(0, cur)) return;
    f32x4 acc[2][2][4][2];
#pragma unroll
    for (int a = 0; a < 2; ++a)
#pragma unroll
        for (int b = 0; b < 2; ++b)
#pragma unroll
            for (int m = 0; m < 4; ++m)
#pragma unroll
                for (int n = 0; n < 2; ++n) acc[a][b][m][n] = (f32x4){0.f, 0.f, 0.f, 0.f};
    bf16x8 At[4][2], B0[2][2], B1[2][2];
    const char* cA = S.abase(g, cur); const char* cB = S.bbase(g, cur);
    S.a_ready(cur);
    if constexpr (SP2) {
        PG8_STAGE(PG8_SB(0, 0), cB, voffB); PG8_STAGE(PG8_SB(0, 1), cB + hstepB, voffB); PG8_STAGE(PG8_SA(0, 0), cA, voffA); PG8_STAGE(PG8_SA(0, 1), cA + hstepA, voffA);
        if (wr == 1) PG8_BAR;
        PG8_WAIT_V(2); PG8_BAR;
        PG8_STAGE(PG8_SB(1, 0), cB + kstep, voffB); PG8_STAGE(PG8_SA(1, 0), cA + kstep, voffA); PG8_STAGE(PG8_SB(1, 1), cB + hstepB + kstep, voffB);
        PG8_WAIT_V(6); PG8_BAR;
    } else {
        PG8_STAGE(PG8_SB(0, 0), cB, voffB); PG8_STAGE(PG8_SA(0, 0), cA, voffA); PG8_STAGE(PG8_SB(0, 1), cB + hstepB, voffB); PG8_STAGE(PG8_SA(0, 1), cA + hstepA, voffA);
        if (wr == 1) PG8_BAR;
        PG8_WAIT_V(4); PG8_BAR;
        PG8_STAGE(PG8_SB(1, 0), cB + kstep, voffB); PG8_STAGE(PG8_SA(1, 0), cA + kstep, voffA); PG8_STAGE(PG8_SB(1, 1), cB + hstepB + kstep, voffB);
        PG8_WAIT_V(6); PG8_BAR;
    }
    for (;;) {
        const bool has_next = S.next(ui + 1, nxt);
        const char* nA = has_next ? S.abase(g, nxt) : cA; const char* nB = has_next ? S.bbase(g, nxt) : cB;
        for (int t = 0; t < nt; t += 2) {
            const bool last = (t == nt - 2);
            const char* a1 = cA + (size_t)(t + 1) * kstep;
            const char* a2 = last ? nA : cA + (size_t)(t + 2) * kstep; const char* b2 = last ? nB : cB + (size_t)(t + 2) * kstep;
            const char* a3 = a2 + kstep; const char* b3 = b2 + kstep;
            if (last && has_next) S.a_ready(nxt);
            if constexpr (SP2) {
            PG8_LDB(B0, 0, 0); PG8_LDB(B1, 0, 1); PG8_SCHED; PG8_LDA(At, 0, 0); PG8_STAGE(PG8_SA(1, 1), a1 + hstepA, voffA);
            PG8_WAIT_V(8); PG8_WAIT_L(0); PG8_BAR; PG8_MMA(0, 0, At, B0); PG8_MMA(0, 1, At, B1); PG8_BAR; PG8_SCHED;
            PG8_LDA(At, 0, 1); PG8_STAGE(PG8_SB(0, 0), b2, voffB); PG8_STAGE(PG8_SB(0, 1), b2 + hstepB, voffB); PG8_STAGE(PG8_SA(0, 0), a2, voffA);
            PG8_WAIT_V(8); PG8_WAIT_L(0); PG8_BAR; PG8_MMA(1, 0, At, B0); PG8_MMA(1, 1, At, B1); PG8_BAR; PG8_SCHED;
            PG8_LDB(B0, 1, 0); PG8_LDB(B1, 1, 1); PG8_SCHED; PG8_LDA(At, 1, 0); PG8_STAGE(PG8_SA(0, 1), a2 + hstepA, voffA);
            PG8_WAIT_V(8); PG8_WAIT_L(0); PG8_BAR; PG8_MMA(0, 0, At, B0); PG8_MMA(0, 1, At, B1); PG8_BAR; PG8_SCHED;
            PG8_LDA(At, 1, 1); PG8_STAGE(PG8_SB(1, 0), b3, voffB); PG8_STAGE(PG8_SB(1, 1), b3 + hstepB, voffB); PG8_STAGE(PG8_SA(1, 0), a3, voffA);
            PG8_WAIT_V(8); PG8_WAIT_L(0); PG8_BAR; PG8_MMA(1, 0, At, B0); PG8_MMA(1, 1, At, B1); PG8_BAR; PG8_SCHED;
            } else {
            PG8_LDB(B0, 0, 0); PG8_SCHED; PG8_LDA(At, 0, 0); PG8_STAGE(PG8_SA(1, 1), a1 + hstepA, voffA);
            PG8_WAIT_L(8); PG8_BAR; PG8_WAIT_L(0); PG8_MMA(0, 0, At, B0); PG8_BAR; PG8_SCHED;
            PG8_LDB(B1, 0, 1); PG8_STAGE(PG8_SB(0, 0), b2, voffB);
            PG8_BAR; PG8_WAIT_L(0); PG8_MMA(0, 1, At, B1); PG8_BAR;
            PG8_LDA(At, 0, 1); PG8_STAGE(PG8_SA(0, 0), a2, voffA);
            PG8_BAR; PG8_WAIT_L(0); PG8_MMA(1, 0, At, B0); PG8_BAR; PG8_SCHED;
            PG8_STAGE(PG8_SB(0, 1), b2 + hstepB, voffB);
            PG8_WAIT_V(6); PG8_BAR; PG8_MMA(1, 1, At, B1); PG8_BAR;
            PG8_LDB(B0, 1, 0); PG8_SCHED; PG8_LDA(At, 1, 0); PG8_STAGE(PG8_SA(0, 1), a2 + hstepA, voffA);
            PG8_WAIT_L(8); PG8_BAR; PG8_WAIT_L(0); PG8_MMA(0, 0, At, B0); PG8_BAR; PG8_SCHED;
            PG8_LDB(B1, 1, 1); PG8_STAGE(PG8_SB(1, 0), b3, voffB);
            PG8_BAR; PG8_WAIT_L(0); PG8_MMA(0, 1, At, B1); PG8_BAR;
            PG8_LDA(At, 1, 1); PG8_STAGE(PG8_SA(1, 0), a3, voffA);
            PG8_BAR; PG8_WAIT_L(0); PG8_MMA(1, 0, At, B0); PG8_BAR; PG8_SCHED;
            PG8_STAGE(PG8_SB(1, 1), b3 + hstepB, voffB);
            PG8_WAIT_V(6); PG8_BAR; PG8_MMA(1, 1, At, B1); PG8_BAR;
            }
        }
        if constexpr (ALIGN_EPI) { if (wr == 0) PG8_BAR; }
        if constexpr (!Epi::AFTER_DRAIN) { E(acc, cur, wr, wc, fr, fq); S.done(cur); }
        if (!has_next) break;
#pragma unroll
        for (int a = 0; a < 2; ++a)
#pragma unroll
            for (int b = 0; b < 2; ++b)
#pragma unroll
                for (int m = 0; m < 4; ++m)
#pragma unroll
                    for (int n = 0; n < 2; ++n) acc[a][b][m][n] = (f32x4){0.f, 0.f, 0.f, 0.f};
        cur = nxt; cA = nA; cB = nB; ++ui;
        if constexpr (ALIGN_EPI) { if (wr == 1) PG8_BAR; }
    }
    PG8_WAIT_V(0);
    if constexpr (!ALIGN_EPI) { if (wr == 0) PG8_BAR; }
    PG8_BAR;
    if constexpr (Epi::AFTER_DRAIN) { E.fused(acc, cur, wr, wc, fr, fq, lds, wid, lane); S.done(cur); }
#undef PG8_SA
#undef PG8_SB
#undef PG8_STAGE
#undef PG8_LDA
#undef PG8_LDB
#undef PG8_MMA
#undef PG8_WAIT_V
#undef PG8_WAIT_L
#undef PG8_BAR
#undef PG8_SCHED
}
}

constexpr int NWAVES = 8, NTHR = NWAVES * 64;
#ifndef MK_PER_PHASE
#define MK_PER_PHASE 0
#endif

constexpr int D = 2048, NB = 4, T = 2048, MP = NB * T, MS = 128, MR = MP + MS, MPAD = 8448, NL = 2;
constexpr int NIN = 3840, INW = 3848, FF = 8192, NMEM = 256, MROWS = NB * NMEM, NHX = 4, HDX = 512;
constexpr int C_Z = 0, C_XBC = 512, C_BM = 1024, C_CM = 1152, C_U5 = 1280, C_GB = 1792, C_GC = 2304, C_HV = 2816, C_UP = 3328;
constexpr float EPS = 1e-6f;
constexpr int SSD_L = 64, SSD_NC = T / SSD_L;
constexpr int S5_L = 32, S5_NC = T / S5_L;

constexpr size_t O_YP = 0, O_YS = O_YP + (size_t)MP * D, O_PCONV = O_YS + (size_t)MS * D, O_PSSD = O_PCONV + NL * NB * 3 * 768, O_PS5R = O_PSSD + NL * NB * 8 * 4096,
    O_PS5I = O_PS5R + NL * NB * 2048, O_PSC = O_PS5I + NL * NB * 2048, O_PPOOL = O_PSC + NL * NB * 2 * 512, O_PMK = O_PPOOL + NL * NB * 15 * 512, O_PMV = O_PMK + (size_t)NL * MROWS * D,
    O_SCONV = O_PMV + (size_t)NL * MROWS * D, O_SSSD = O_SCONV + NL * MS * 3 * 768, O_SS5R = O_SSSD + (size_t)NL * MS * 8 * 4096, O_SS5I = O_SS5R + NL * MS * 2048, O_SSC = O_SS5I + NL * MS * 2048,
    O_SPOOL = O_SSC + NL * MS * 2 * 512, O_END = O_SPOOL + NL * MS * 15 * 512;
static_assert(O_END == 38066176, "output size");

enum In { I_XP = 0, I_XS, I_MEM, I_ST_CONV, I_ST_SSD, I_ST_S5R, I_ST_S5I, I_ST_SC, I_ST_POOL, I_CK, I_CV, I_G_MIX, I_W_IN, I_CONV_W, I_CONV_B, I_DT_BIAS, I_A_LOG, I_SSD_D,
          I_LAM_RE, I_LAM_IM, I_LOG_DT, I_B_RE, I_B_IM, I_C_RE, I_C_IM, I_S5_D, I_W_GLU, I_B_GLU, I_SC_W, I_POOL_W, I_POOL_SCALE, I_G_MIXOUT, I_W_OUT, I_G_XA, I_G_MEM,
          I_W_Q, I_W_K, I_W_V, I_W_O, I_G_MLP, I_W_UP, I_W_DOWN, I_G_FINAL, N_IN };
static_assert(N_IN == 43, "inputs");

constexpr size_t MiB = 1u << 20;
constexpr size_t WS_CTL = 0, CTL_ZERO_BYTES = 1 * MiB;
constexpr int CW_TMO = 0, CW_BAR = 4096, CW_FCNT = 8192, CW_SSQ = 16384;
static_assert(CW_BAR + 3456 <= CW_FCNT && CW_FCNT + 32 * 64 <= CW_SSQ, "ctl words");
static_assert(CW_SSQ * 4 + 7 * MPAD * 8 <= (int)CTL_ZERO_BYTES, "ctl");
constexpr size_t WS_TAB = 1 * MiB, TAB_L = 2 * MiB;
constexpr size_t TB_ABAR = 0, TB_ABARL = 16384, TB_BBAR = 32768, TB_CMT = TB_BBAR + 262144, TB_WDT = TB_CMT + 131072, TB_WGLUT = TB_WDT + 65536, TB_WPT = TB_WGLUT + 524288, TB_BBT = TB_WPT + 131072, TB_END = TB_BBT + 131072;
static_assert(TB_END <= TAB_L, "tables");
constexpr size_t WS_W = 8 * MiB, W_L = 104 * MiB;
constexpr size_t WO_IN = 0, WO_OUT = 15 * MiB, WO_Q = 23 * MiB, WO_O = 31 * MiB, WO_UP = 39 * MiB, WO_DOWN = 71 * MiB;
static_assert(WO_DOWN + 32 * MiB <= W_L && (size_t)NIN * D * 2 == 15 * MiB, "weights");
constexpr size_t WS_WKV = WS_W + 2 * W_L;
constexpr size_t WS_H = 256 * MiB, WS_HB = 322 * MiB, WS_PROJ = 356 * MiB, WS_MIX = 418 * MiB, WS_Q = 452 * MiB, WS_O = 486 * MiB, WS_HID = 520 * MiB,
    WS_MEMB = 652 * MiB, WS_KB = 656 * MiB, WS_VT = 664 * MiB, WS_DTV = 672 * MiB, WS_RSTDM = 673 * MiB, WS_SS = 674 * MiB, WS_CD = 690 * MiB, WS_S5ER = 691 * MiB, WS_S5EI = 693 * MiB, WS_SA = 700 * MiB, WS_WQKD = 704 * MiB, WS_VB = 720 * MiB, WS_WQK = 728 * MiB, WS_VWT = 760 * MiB, WS_PATT = 792 * MiB, WS_END = 808 * MiB;
constexpr size_t SA_HB = 0, SA_MIX = 512 * 1024, SA_O = 1024 * 1024, SA_HID = 2048 * 1024;
static_assert(WS_WKV + 32 * MiB <= WS_H && WS_H + (size_t)MPAD * D * 4 <= WS_HB && WS_HB + (size_t)MPAD * D * 2 <= WS_PROJ && WS_PROJ + (size_t)MPAD * NIN * 2 <= WS_MIX, "ws map 1");
static_assert(WS_HID + (size_t)MPAD * FF * 2 <= WS_MEMB && WS_SS + (size_t)NB * SSD_NC * 8 * 4096 * 4 <= WS_CD && WS_S5ER + (size_t)NB * S5_NC * 2048 * 4 <= WS_S5EI, "ws map 2");

constexpr int RING_OFF = 0, RING_BYTES = 131072;
constexpr int LDSCTL_OFF = 136192, MISC_OFF = LDSCTL_OFF + 320;
constexpr int LDS_BYTES = 147456;
static_assert(MISC_OFF + 128 <= LDS_BYTES, "LDS map");
#define GAS __attribute__((address_space(1)))
#define LAS __attribute__((address_space(3)))
typedef unsigned short bf16;
typedef unsigned v4u __attribute__((ext_vector_type(4)));
typedef float f32x4 __attribute__((ext_vector_type(4)));
typedef short bf16x8 __attribute__((ext_vector_type(8)));
typedef GAS unsigned gu32;
typedef GAS unsigned long long gu64;
#define RLX_AGENT __ATOMIC_RELAXED, __HIP_MEMORY_SCOPE_AGENT
#define LDS_WAIT() asm volatile("s_waitcnt lgkmcnt(0)" ::: "memory")
#define VM_WAIT() asm volatile("s_waitcnt vmcnt(0)" ::: "memory")
__device__ __forceinline__ unsigned long long rt() { return __builtin_amdgcn_s_memrealtime(); }
__device__ __forceinline__ unsigned f2bf(float f) { unsigned u = __builtin_bit_cast(unsigned, f); return (u + 0x7fffu + ((u >> 16) & 1u)) >> 16; }
__device__ __forceinline__ unsigned pk2(float lo, float hi) { return f2bf(lo) | (f2bf(hi) << 16); }

#define XB_TMO      128
#define XB_XCNT(j)  (256  + 64 * (j))
#define XB_XSUB(j)  (1280 + 64 * (j))
#define XB_XGEN(j)  (2304 + 64 * (j))
#define XB_TOP      3328
#define XB_TOPGEN   3392
#define XCD_BAR_WORDS 3456
#define XB_SPIN_CAP (1u << 18)

__device__ __forceinline__ unsigned xb_ld(unsigned* p)              { return __hip_atomic_load(p, __ATOMIC_RELAXED, __HIP_MEMORY_SCOPE_AGENT); }
__device__ __forceinline__ unsigned xb_add(unsigned* p, unsigned v) { return __hip_atomic_fetch_add(p, v, __ATOMIC_RELAXED, __HIP_MEMORY_SCOPE_AGENT); }
__device__ __forceinline__ unsigned xb_xcc_id() { return (unsigned)__builtin_amdgcn_s_getreg((3 << 11) | 20) & 0xFu; }
#define XB_SPIN(cond, bar) do { unsigned _sp = 0; while (cond) { __builtin_amdgcn_s_sleep(1); \
    if ((++_sp & 255u) == 0u) { if (xb_ld(&(bar)[XB_TMO])) break; if (_sp > XB_SPIN_CAP) { atomicAdd(&(bar)[XB_TMO], 1u); break; } } } } while (0)

struct XcdBarrier {
    unsigned* bar; unsigned x;
    volatile LAS unsigned* st;
};

__device__ __forceinline__ XcdBarrier xcd_barrier_post(unsigned* bar, volatile LAS unsigned* st) {
    XcdBarrier b; b.bar = bar; b.x = xb_xcc_id(); b.st = st;
    if (threadIdx.x == 0) (void)xb_add(&bar[XB_XCNT(b.x)], 1u);
    return b;
}
__device__ __forceinline__ void xcd_barrier_complete(unsigned* bar, unsigned x, unsigned& nloc, unsigned& nx) {
    const unsigned G = gridDim.x * gridDim.y * gridDim.z;
    unsigned sum, cnt, mine, sp = 0u;
    for (;;) {
        sum = 0u; cnt = 0u; mine = 0u;
#pragma unroll
        for (unsigned j = 0; j < 16; ++j) { const unsigned c = xb_ld(&bar[XB_XCNT(j)]); sum += c; cnt += (c > 0u) ? 1u : 0u; mine = (j == x) ? c : mine; }
        if (sum == G) break;
        __builtin_amdgcn_s_sleep(1);
        if ((++sp & 255u) == 0u) { if (xb_ld(&bar[XB_TMO])) break; if (sp > XB_SPIN_CAP) { atomicAdd(&bar[XB_TMO], 1u); break; } }
    }
    nloc = mine > 0u ? mine : 1u; nx = cnt > 0u ? cnt : 1u;
}

__device__ __forceinline__ void xcd_barrier(const XcdBarrier& b) {
    asm volatile("s_waitcnt vmcnt(0)" ::: "memory");
    __syncthreads();
    if (threadIdx.x == 0) {
        unsigned* bar = b.bar;
        __builtin_amdgcn_s_waitcnt(0);
        unsigned nloc = b.st[0], nx = b.st[1];
        if (nloc == 0u) { xcd_barrier_complete(bar, b.x, nloc, nx); b.st[0] = nloc; b.st[1] = nx; }
        const unsigned old = xb_add(&bar[XB_XSUB(b.x)], 1u);
        const unsigned gen = old / nloc;
        if (old + 1u == (gen + 1u) * nloc) {
            __builtin_amdgcn_fence(__ATOMIC_RELEASE, "agent");
            asm volatile("s_waitcnt vmcnt(0)" ::: "memory");
            const unsigned og = xb_add(&bar[XB_TOP], 1u);
            const unsigned tg = og / nx;
            if (og + 1u == (tg + 1u) * nx) xb_add(&bar[XB_TOPGEN], 1u);
            else XB_SPIN(xb_ld(&bar[XB_TOPGEN]) == tg, bar);
            __builtin_amdgcn_fence(__ATOMIC_ACQUIRE, "agent");
            xb_add(&bar[XB_XGEN(b.x)], 1u);
            asm volatile("s_waitcnt vmcnt(0)" ::: "memory");
        } else {
            XB_SPIN(xb_ld(&bar[XB_XGEN(b.x)]) == gen, bar);
            __builtin_amdgcn_fence(__ATOMIC_ACQUIRE, "agent");
            asm volatile("s_waitcnt vmcnt(0)" ::: "memory");
        }
    }
    __syncthreads();
}

struct Args { const float* in[N_IN]; float* out; unsigned char* ws; int ph_lo, ph_hi; };
static_assert(sizeof(Args) == 45 * 8 + 8, "Args has no holes");
typedef float f32x2 __attribute__((ext_vector_type(2)));
typedef unsigned v2u __attribute__((ext_vector_type(2)));
#define PIN(x) asm volatile("" : "+v"(x))
#define WAVE_SYNC() asm volatile("s_waitcnt lgkmcnt(0)" ::: "memory")
#define BLOCK_SYNC() do { asm volatile("s_waitcnt vmcnt(0) lgkmcnt(0)" ::: "memory"); __builtin_amdgcn_s_barrier(); asm volatile("" ::: "memory"); } while (0)
__device__ __forceinline__ float bf_lo(unsigned u) { return __uint_as_float(u << 16); }
__device__ __forceinline__ float bf_hi(unsigned u) { return __uint_as_float(u & 0xffff0000u); }
__device__ __forceinline__ float bf2f(bf16 b) { return __uint_as_float((unsigned)b << 16); }
__device__ __forceinline__ unsigned cvtpk(float lo, float hi) { return pg8::cvt_pk_bf16(lo, hi); }
__device__ __forceinline__ bf16 f2b(float f) { return (bf16)(cvtpk(f, 0.f) & 0xffffu); }
template <int CTRL> __device__ __forceinline__ float dppf(float v) { return __builtin_bit_cast(float, __builtin_amdgcn_update_dpp(0, __builtin_bit_cast(int, v), CTRL, 0xf, 0xf, false)); }
__device__ __forceinline__ float sum16(float v) { v += dppf<0xB1>(v); v += dppf<0x4E>(v); v += dppf<0x141>(v); v += dppf<0x140>(v); return v; }
__device__ __forceinline__ float max16(float v) { v = fmaxf(v, dppf<0xB1>(v)); v = fmaxf(v, dppf<0x4E>(v)); v = fmaxf(v, dppf<0x141>(v)); v = fmaxf(v, dppf<0x140>(v)); return v; }
__device__ __forceinline__ float wave_sum(float v) { v = sum16(v);
    const float r0 = __builtin_bit_cast(float, __builtin_amdgcn_readlane(__builtin_bit_cast(int, v), 0)), r1 = __builtin_bit_cast(float, __builtin_amdgcn_readlane(__builtin_bit_cast(int, v), 16)),
                r2 = __builtin_bit_cast(float, __builtin_amdgcn_readlane(__builtin_bit_cast(int, v), 32)), r3 = __builtin_bit_cast(float, __builtin_amdgcn_readlane(__builtin_bit_cast(int, v), 48));
    return (r0 + r1) + (r2 + r3); }
__device__ __forceinline__ float wave_max(float v) { v = max16(v);
    const float r0 = __builtin_bit_cast(float, __builtin_amdgcn_readlane(__builtin_bit_cast(int, v), 0)), r1 = __builtin_bit_cast(float, __builtin_amdgcn_readlane(__builtin_bit_cast(int, v), 16)),
                r2 = __builtin_bit_cast(float, __builtin_amdgcn_readlane(__builtin_bit_cast(int, v), 32)), r3 = __builtin_bit_cast(float, __builtin_amdgcn_readlane(__builtin_bit_cast(int, v), 48));
    return fmaxf(fmaxf(r0, r1), fmaxf(r2, r3)); }
__device__ __forceinline__ float silu_f(float x) { return x * __builtin_amdgcn_rcpf(1.f + __expf(-x)); }
__device__ __forceinline__ float sigmoid_f(float x) { return __builtin_amdgcn_rcpf(1.f + __expf(-x)); }
__device__ __forceinline__ float softplus_f(float x) { return x > 20.f ? x : log1pf(expf(x)); }
__device__ __forceinline__ float gelu_tanh_f(float x) { const float u = 0.7978845608f * (x + 0.044715f * x * x * x); const float e = __expf(2.f * u); const float th = 1.f - 2.f * __builtin_amdgcn_rcpf(e + 1.f); return 0.5f * x * (1.f + th); }
__device__ __forceinline__ f32x4 mfma16(bf16x8 a, bf16x8 b, f32x4 c) { return __builtin_amdgcn_mfma_f32_16x16x32_bf16(a, b, c, 0, 0, 0); }
__device__ __forceinline__ bf16x8 ldsfrag(const LAS unsigned char* p) { return *(const LAS bf16x8*)p; }
__device__ __forceinline__ bf16x8 gfrag(const bf16* p) { return *(const bf16x8*)p; }
__device__ __forceinline__ bf16x8 pack8(f32x4 a, f32x4 b) { v4u w; w.x = cvtpk(a[0], a[1]); w.y = cvtpk(a[2], a[3]); w.z = cvtpk(b[0], b[1]); w.w = cvtpk(b[2], b[3]); return __builtin_bit_cast(bf16x8, w); }
__device__ __forceinline__ void unpack8(v4u w, float (&f)[8]) { f[0] = bf_lo(w.x); f[1] = bf_hi(w.x); f[2] = bf_lo(w.y); f[3] = bf_hi(w.y); f[4] = bf_lo(w.z); f[5] = bf_hi(w.z); f[6] = bf_lo(w.w); f[7] = bf_hi(w.w); }
__device__ __forceinline__ size_t sfrag(int r, int k, int K) { return ((size_t)((r >> 4) * (K >> 5) + (k >> 5)) << 9) + (size_t)(((((k >> 3) & 3) * 16 + (r & 15)) << 3) + (k & 7)); }
__device__ __forceinline__ void dsincos(double x, double& s, double& c) {
    const double k = rint(x * 0.63661977236758134308); double r = fma(-k, 1.57079632673412561417e+00, x); r = fma(-k, 6.07710050650619224932e-11, r);
    const double r2 = r * r;
    double sp = -7.6471637318198164759e-13; sp = fma(sp, r2, 1.6059043836821614599e-10); sp = fma(sp, r2, -2.5052108385441718775e-08); sp = fma(sp, r2, 2.7557319223985890653e-06); sp = fma(sp, r2, -1.9841269841269841270e-04);
    sp = fma(sp, r2, 8.3333333333333333333e-03); sp = fma(sp, r2, -1.6666666666666666667e-01); const double sr = fma(sp * r2, r, r);
    double cp = 4.7794773323873852974e-14; cp = fma(cp, r2, -1.1470745597729724714e-11); cp = fma(cp, r2, 2.0876756987868098979e-09); cp = fma(cp, r2, -2.7557319223985890653e-07); cp = fma(cp, r2, 2.4801587301587301587e-05);
    cp = fma(cp, r2, -1.3888888888888888889e-03); cp = fma(cp, r2, 4.1666666666666666667e-02); cp = fma(cp, r2, -0.5); const double cr = fma(cp, r2, 1.0);
    const int q = (int)k & 3;
    s = (q == 0) ? sr : (q == 1) ? cr : (q == 2) ? -sr : -cr; c = (q == 0) ? cr : (q == 1) ? -sr : (q == 2) ? -cr : sr;
}

__device__ __forceinline__ void p0_transpose_item(const float* W, int ldw, int scol0, int K, int k0, const float* gain, bf16* WT, int drow0, LAS unsigned char* scr, int lane, bool frag = false) {
    const int kq = lane >> 4, n4 = lane & 15;
    f32x4 t[8][2]; float g[8][2];
#pragma unroll
    for (int s = 0; s < 8; ++s)
#pragma unroll
        for (int h = 0; h < 2; ++h) { const int k = k0 + 8 * s + 2 * kq + h; t[s][h] = __builtin_nontemporal_load((const GAS f32x4*)(W + (size_t)k * ldw + scol0 + 4 * n4)); g[s][h] = gain ? gain[k] : 1.f; }
#pragma unroll
    for (int s = 0; s < 8; ++s) { PIN(t[s][0]); PIN(t[s][1]); }
#pragma unroll
    for (int s = 0; s < 8; ++s)
#pragma unroll
        for (int e = 0; e < 4; ++e) *(LAS unsigned*)(scr + ((4 * n4 + e) * 68 + 8 * s + 2 * kq) * 2) = cvtpk(t[s][0][e] * g[s][0], t[s][1][e] * g[s][1]);
    LDS_WAIT(); asm volatile("" ::: "memory");
    const int c = lane & 7;
#pragma unroll
    for (int j = 0; j < 8; ++j) { const int n = (lane >> 3) + 8 * j; const v2u a = *(const LAS v2u*)(scr + (n * 68 + 8 * c) * 2), b = *(const LAS v2u*)(scr + (n * 68 + 8 * c + 4) * 2);
        *(GAS v4u*)(WT + (frag ? sfrag(drow0 + n, k0 + 8 * c, K) : (size_t)(drow0 + n) * K + k0 + 8 * c)) = (v4u){a.x, a.y, b.x, b.y}; }
    LDS_WAIT(); asm volatile("" ::: "memory");
}
__device__ __forceinline__ void p0_mat(const float* W, int ldw, int K, int N, const float* gain, bf16* WT, int drow_base, int item, LAS unsigned char* scr, int lane, bool frag = false) {
    const int nblk = N / 64, kb = item / nblk, nb = item % nblk;
    p0_transpose_item(W, ldw, 64 * nb, K, 64 * kb, gain, WT, drow_base + 64 * nb, scr, lane, frag);
}
constexpr int P0W_IN = (D / 64) * (NIN / 64), P0W_SQ = (D / 64) * (D / 64), P0W_UP = (D / 64) * (FF / 64), P0W_DN = (FF / 64) * (D / 64), P0W_GLU = (512 / 64) * (512 / 64), P0W_PW = (128 / 64) * (128 / 64);
constexpr int P0W_LAYER = P0W_IN + 5 * P0W_SQ + P0W_UP + P0W_DN + P0W_GLU + 4 * P0W_PW, P0W_DEF_N = P0W_UP + P0W_DN + P0W_GLU + 4 * P0W_PW + P0W_IN + P0W_SQ, P0W_DEF_LO = NL * P0W_LAYER - P0W_DEF_N;
__device__ __forceinline__ void p0_weights(const Args& A, LAS unsigned char* lds, int gw, int NGW, int first, int count, int skip_at, int skip_n, int wave, int lane) {
    asm volatile("" : "+v"(lane));
    LAS unsigned char* scr = lds + RING_OFF + wave * 16384;
    unsigned char* ws = A.ws;
    constexpr int I_IN = P0W_IN, I_SQ = P0W_SQ, I_UP = P0W_UP, I_DN = P0W_DN, I_GLU = P0W_GLU, I_PW = P0W_PW, I_LAYER = P0W_LAYER;
#pragma unroll 1
    for (int i = gw; i < count; i += NGW) { int it = first + i; if (it >= skip_at) it += skip_n;
        const int l = it / I_LAYER; int r = it % I_LAYER + I_IN + I_SQ; if (r >= I_LAYER) r -= I_LAYER;
        bf16* wl = (bf16*)(ws + WS_W + (size_t)l * W_L); unsigned char* tb = ws + WS_TAB + (size_t)l * TAB_L;
        const float* W; const float* gain = nullptr; bf16* WT; int ldw, K, N, drow = 0; bool frag = false;
        if (r < I_IN) { const int nblk = NIN / 64, kb = r / nblk, nb = r % nblk, n0 = 64 * nb;
            p0_transpose_item(A.in[I_W_IN] + (size_t)l * D * INW, INW, n0 + (n0 >= 1280 ? 8 : 0), D, 64 * kb, A.in[I_G_MIX] + l * D, (bf16*)((unsigned char*)wl + WO_IN), n0, scr, lane); continue; } r -= I_IN;
        if (r < I_SQ) { W = A.in[I_W_OUT] + (size_t)l * D * D; gain = A.in[I_G_MIXOUT] + l * D; WT = (bf16*)((unsigned char*)wl + WO_OUT); ldw = D; K = D; N = D; }
        else if (r < 2 * I_SQ) { r -= I_SQ; W = A.in[I_W_Q] + (size_t)l * D * D; gain = A.in[I_G_XA] + l * D; WT = (bf16*)((unsigned char*)wl + WO_Q); ldw = D; K = D; N = D; }
        else if (r < 3 * I_SQ) { r -= 2 * I_SQ; W = A.in[I_W_O] + (size_t)l * D * D; WT = (bf16*)((unsigned char*)wl + WO_O); ldw = D; K = D; N = D; }
        else if (r < 4 * I_SQ) { r -= 3 * I_SQ; W = A.in[I_W_K] + (size_t)l * D * D; gain = A.in[I_G_MEM] + l * D; WT = (bf16*)(ws + WS_WKV); drow = l * 4096; ldw = D; K = D; N = D; }
        else if (r < 5 * I_SQ) { r -= 4 * I_SQ; W = A.in[I_W_V] + (size_t)l * D * D; gain = A.in[I_G_MEM] + l * D; WT = (bf16*)(ws + WS_WKV); drow = l * 4096 + 2048; ldw = D; K = D; N = D; }
        else if (r < 5 * I_SQ + I_UP) { r -= 5 * I_SQ; W = A.in[I_W_UP] + (size_t)l * D * FF; gain = A.in[I_G_MLP] + l * D; WT = (bf16*)((unsigned char*)wl + WO_UP); ldw = FF; K = D; N = FF; }
        else if (r < 5 * I_SQ + I_UP + I_DN) { r -= 5 * I_SQ + I_UP; W = A.in[I_W_DOWN] + (size_t)l * FF * D; WT = (bf16*)((unsigned char*)wl + WO_DOWN); ldw = D; K = FF; N = D; }
        else if (r < 5 * I_SQ + I_UP + I_DN + I_GLU) { r -= 5 * I_SQ + I_UP + I_DN; W = A.in[I_W_GLU] + (size_t)l * 512 * 512; WT = (bf16*)(tb + TB_WGLUT); ldw = 512; K = 512; N = 512; frag = true; }
        else { r -= 5 * I_SQ + I_UP + I_DN + I_GLU; const int gI = r / I_PW; r = r % I_PW; W = A.in[I_POOL_W] + ((size_t)l * 4 + gI) * 128 * 128; WT = (bf16*)(tb + TB_WPT) + gI * 128 * 128; ldw = 128; K = 128; N = 128; frag = true; }
        p0_mat(W, ldw, K, N, gain, WT, drow, r, scr, lane, frag);
    }
}
__device__ __forceinline__ void p0_prologue(const Args& A, LAS unsigned char* lds, int vcu, int G, int wave, int lane) {
    asm volatile("" : "+v"(lane));
    const int gw = vcu * NWAVES + wave, NGW = G * NWAVES;
    unsigned char* ws = A.ws;
    { const int nskip = G == 256 ? P0W_DEF_N : 0; p0_weights(A, lds, gw, NGW, 0, NL * P0W_LAYER - nskip, P0W_DEF_LO, nskip, wave, lane); }
    bf16* HB = (bf16*)(ws + WS_HB); unsigned long long* ssq0 = (unsigned long long*)((unsigned*)(ws + WS_CTL) + CW_SSQ);
#pragma unroll 1
    for (int m = gw; m < MR; m += NGW) {
        f32x4 v[8]; const GAS f32x4* xr = (const GAS f32x4*)(m < MP ? A.in[I_XP] + (size_t)m * D : A.in[I_XS] + (size_t)(m - MP) * D) + lane;
#pragma unroll
        for (int j = 0; j < 8; ++j) v[j] = __builtin_nontemporal_load(xr + 64 * j);
#pragma unroll
        for (int j = 0; j < 8; ++j) PIN(v[j]);
        float s = 0.f;
#pragma unroll
        for (int j = 0; j < 8; ++j) s += (v[j].x * v[j].x + v[j].y * v[j].y) + (v[j].z * v[j].z + v[j].w * v[j].w);
        s = wave_sum(s);
        GAS v2u* br = (GAS v2u*)(HB + (size_t)m * D) + lane;
#pragma unroll
        for (int j = 0; j < 8; ++j) { v2u w; w.x = cvtpk(v[j].x, v[j].y); w.y = cvtpk(v[j].z, v[j].w); br[64 * j] = w;
            if (m >= MP) *(GAS v2u*)((bf16*)(ws + WS_SA + SA_HB) + sfrag(m - MP, 4 * lane + 256 * j, D)) = w; }
        if (lane == 0) ssq0[m] = (unsigned long long)__float2ull_rn(s * 16777216.0f);
    }
    bf16* MEMB = (bf16*)(ws + WS_MEMB); float* RSTDM = (float*)(ws + WS_RSTDM);
#pragma unroll 1
    for (int m = gw; m < MROWS; m += NGW) {
        const GAS f32x4* xr = (const GAS f32x4*)(A.in[I_MEM] + (size_t)m * D) + lane; f32x4 v[8]; float s = 0.f;
#pragma unroll
        for (int j = 0; j < 8; ++j) v[j] = xr[64 * j];
#pragma unroll
        for (int j = 0; j < 8; ++j) PIN(v[j]);
#pragma unroll
        for (int j = 0; j < 8; ++j) s += (v[j].x * v[j].x + v[j].y * v[j].y) + (v[j].z * v[j].z + v[j].w * v[j].w);
        s = wave_sum(s);
        GAS v2u* br = (GAS v2u*)(MEMB + (size_t)m * D) + lane;
#pragma unroll
        for (int j = 0; j < 8; ++j) { v2u w; w.x = cvtpk(v[j].x, v[j].y); w.y = cvtpk(v[j].z, v[j].w); br[64 * j] = w; }
        if (lane == 0) RSTDM[m] = 1.0f / sqrtf(s * (1.0f / D) + EPS);
    }
    { bf16* WQKD = (bf16*)(ws + WS_WQKD);
#pragma unroll 1
        for (int m = gw; m < NL * D; m += NGW) { const int l = m >> 11, k = m & 2047; const float gk = A.in[I_G_XA][l * D + k];
            const GAS f32x4* xr = (const GAS f32x4*)(A.in[I_W_Q] + ((size_t)l * D + k) * D) + lane; f32x4 v[8];
#pragma unroll
            for (int j = 0; j < 8; ++j) v[j] = __builtin_nontemporal_load(xr + 64 * j);
#pragma unroll
            for (int j = 0; j < 8; ++j) PIN(v[j]);
            GAS v2u* br = (GAS v2u*)(WQKD + (size_t)m * D) + lane;
#pragma unroll
            for (int j = 0; j < 8; ++j) { v2u w; w.x = cvtpk(v[j].x * gk, v[j].y * gk); w.y = cvtpk(v[j].z * gk, v[j].w * gk); br[64 * j] = w; } } }
    const int gt = gw * 64 + lane, NGT = NGW * 64;
    for (int i2 = gt; i2 < NL * 2048 * 16 * 2; i2 += NGT) { if (i2 & 1) continue; const int i = i2 >> 5, k = (i2 >> 1) & 15;
        const int l = i >> 11, gn = i & 2047, g = gn >> 6, n = gn & 63; unsigned char* tb = ws + WS_TAB + (size_t)l * TAB_L;
        const double lr = (double)A.in[I_LAM_RE][l * 2048 + gn], li = (double)A.in[I_LAM_IM][l * 2048 + gn], dl = exp((double)A.in[I_LOG_DT][l * 32 + g]);
        const float bref = A.in[I_B_RE][((size_t)l * 2048 + gn) * 16 + k], bimf = A.in[I_B_IM][((size_t)l * 2048 + gn) * 16 + k];
        const float cref = A.in[I_C_RE][((size_t)l * 32 + g) * 1024 + k * 64 + n], cimf = A.in[I_C_IM][((size_t)l * 32 + g) * 1024 + k * 64 + n];
        double s1, c1, sL, cL; dsincos(li * dl, s1, c1); dsincos(li * dl * (double)S5_L, sL, cL);
        const double m1 = exp(lr * dl), mL = exp(lr * dl * (double)S5_L), ar = m1 * c1, ai = m1 * s1;
        if (k == 0) { ((f32x2*)(tb + TB_ABAR))[gn] = (f32x2){(float)ar, (float)ai}; ((f32x2*)(tb + TB_ABARL))[gn] = (f32x2){(float)(mL * cL), (float)(mL * sL)}; }
        const double den = lr * lr + li * li, cr = ((ar - 1.0) * lr + ai * li) / den, ci = (ai * lr - (ar - 1.0) * li) / den;
        f32x2* bb = (f32x2*)(tb + TB_BBAR) + (size_t)g * 16 * 64 + n; bf16* cmt = (bf16*)(tb + TB_CMT) + (size_t)g * 16 * 128;
        bf16* bbt = (bf16*)(tb + TB_BBT) + (size_t)g * 128 * 16;
        { const double br = bref, bi = bimf; bb[k * 64] = (f32x2){(float)(cr * br - ci * bi), (float)(cr * bi + ci * br)};
            bbt[n * 16 + k] = f2b((float)(cr * br - ci * bi)); bbt[(64 + n) * 16 + k] = f2b((float)(cr * bi + ci * br));
            cmt[k * 128 + n] = f2b(cref); cmt[k * 128 + 64 + n] = f2b(-cimf); }
    }
    for (int i2 = gt; i2 < NL * D * 32; i2 += NGT) { if (i2 & 31) continue; const int i = i2 >> 5;
        const int l = i >> 11, k = i & 2047; const float g = A.in[I_G_MIX][l * D + k]; const float* w = A.in[I_W_IN] + ((size_t)l * D + k) * INW + 1280;
        float* o = (float*)(ws + WS_TAB + (size_t)l * TAB_L + TB_WDT) + k * 8;
#pragma unroll
        for (int j = 0; j < 8; ++j) o[j] = g * w[j];
    }
}

__device__ __forceinline__ void dt_rows(const Args& A, LAS unsigned char* lds, int l, int vcu, int G, int tid) {
    asm volatile("" : "+v"(tid)); const int lane = tid & 63, wave = __builtin_amdgcn_readfirstlane(tid >> 6);
    unsigned char* ws = A.ws; const bf16* HB = (const bf16*)(ws + WS_HB); const float* WDT = (const float*)(ws + WS_TAB + (size_t)l * TAB_L + TB_WDT);
    const unsigned long long* ssq = (const unsigned long long*)((const unsigned*)(ws + WS_CTL) + CW_SSQ) + (3 * l) * MPAD; float* DTV = (float*)(ws + WS_DTV);
    { v4u t[8];
#pragma unroll
        for (int j = 0; j < 8; ++j) t[j] = *(const GAS v4u*)((const unsigned char*)WDT + (tid + NTHR * j) * 16);
#pragma unroll
        for (int j = 0; j < 8; ++j) PIN(t[j]);
#pragma unroll
        for (int j = 0; j < 8; ++j) { const int p = tid + NTHR * j, k = p >> 1; *(LAS v4u*)(lds + (k >> 3) * 272 + (k & 7) * 32 + (p & 1) * 16) = t[j]; } }
    BLOCK_SYNC();
    const int gw = vcu * NWAVES + wave, NGW = G * NWAVES; const float bias = A.in[I_DT_BIAS][l * 8 + (lane & 7)];
#pragma unroll 1
    for (int m0 = gw; m0 < MR; m0 += 2 * NGW) { const int m1 = m0 + NGW; const bool has1 = m1 < MR; const int m1c = has1 ? m1 : m0;
        v4u x0[4], x1[4];
#pragma unroll
        for (int i = 0; i < 4; ++i) { x0[i] = *(const GAS v4u*)(HB + (size_t)m0 * D + 8 * lane + 512 * i); x1[i] = *(const GAS v4u*)(HB + (size_t)m1c * D + 8 * lane + 512 * i); }
#pragma unroll
        for (int i = 0; i < 4; ++i) { PIN(x0[i]); PIN(x1[i]); }
        float a0[8], a1[8];
#pragma unroll
        for (int j = 0; j < 8; ++j) { a0[j] = 0.f; a1[j] = 0.f; }
#pragma unroll
        for (int i = 0; i < 4; ++i) { float f0[8], f1[8]; unpack8(x0[i], f0); unpack8(x1[i], f1);
#pragma unroll
            for (int e = 0; e < 8; ++e) { const LAS float* wp = (const LAS float*)(lds + (lane + 64 * i) * 272 + e * 32); const f32x4 w0 = *(const LAS f32x4*)wp, w1 = *(const LAS f32x4*)(wp + 4);
                a0[0] += f0[e] * w0.x; a0[1] += f0[e] * w0.y; a0[2] += f0[e] * w0.z; a0[3] += f0[e] * w0.w; a0[4] += f0[e] * w1.x; a0[5] += f0[e] * w1.y; a0[6] += f0[e] * w1.z; a0[7] += f0[e] * w1.w;
                a1[0] += f1[e] * w0.x; a1[1] += f1[e] * w0.y; a1[2] += f1[e] * w0.z; a1[3] += f1[e] * w0.w; a1[4] += f1[e] * w1.x; a1[5] += f1[e] * w1.y; a1[6] += f1[e] * w1.z; a1[7] += f1[e] * w1.w; } }
        float v0 = 0.f, v1 = 0.f;
#pragma unroll
        for (int j = 0; j < 8; ++j) { const float s0 = wave_sum(a0[j]), s1 = wave_sum(a1[j]); if ((lane & 7) == j) { v0 = s0; v1 = s1; } }
        if (lane < 8) { DTV[(size_t)m0 * 8 + lane] = softplus_f(v0 * pg8::ssq_rstd(ssq[m0]) + bias);
            if (has1) DTV[(size_t)m1 * 8 + lane] = softplus_f(v1 * pg8::ssq_rstd(ssq[m1]) + bias); }
    }
    BLOCK_SYNC();
}

__device__ __forceinline__ void lds_add(LAS float* p, float v) { (void)__hip_atomic_fetch_add(p, v, __ATOMIC_RELAXED, __HIP_MEMORY_SCOPE_WORKGROUP); }

__device__ __forceinline__ float wave_scan_incl(float v, int lane) {
#pragma unroll
    for (int o = 1; o < 64; o <<= 1) { const float t = __shfl_up(v, o); if (lane >= o) v += t; }
    return v;
}
template <int NCH> __device__ __forceinline__ void conv8(const bf16* proj, const float* cw, const float* cb, int grow0, int t0, bool seq_first, int cx0, float (&out)[8][NCH]) {
    float raw[11][NCH]; float w[4][NCH], bsv[NCH];
    unsigned rw[11][(NCH + 1) / 2];
#pragma unroll
    for (int r = 0; r < 11; ++r) { const int tt = t0 - 3 + r; const bf16* p = proj + (size_t)(grow0 + ((seq_first && tt < 0) ? 0 : tt)) * NIN + C_XBC + cx0;
        if constexpr (NCH == 4) { const v2u v = *(const GAS v2u*)p; rw[r][0] = v.x; rw[r][1] = v.y; }
        else if constexpr (NCH == 2) { rw[r][0] = *(const GAS unsigned*)p; }
        else { rw[r][0] = (unsigned)*p; } }
#pragma unroll
    for (int e = 0; e < NCH; ++e) { bsv[e] = cb[cx0 + e];
#pragma unroll
        for (int j = 0; j < 4; ++j) w[j][e] = cw[j * 768 + cx0 + e]; }
#pragma unroll
    for (int r = 0; r < 11; ++r)
#pragma unroll
        for (int q = 0; q < (NCH + 1) / 2; ++q) PIN(rw[r][q]);
#pragma unroll
    for (int r = 0; r < 11; ++r) { const bool z = seq_first && (t0 - 3 + r) < 0;
        if constexpr (NCH == 1) raw[r][0] = z ? 0.f : __uint_as_float(rw[r][0] << 16);
        else {
#pragma unroll
            for (int q = 0; q < NCH / 2; ++q) { raw[r][2 * q] = z ? 0.f : bf_lo(rw[r][q]); raw[r][2 * q + 1] = z ? 0.f : bf_hi(rw[r][q]); } } }
#pragma unroll
    for (int i = 0; i < 8; ++i)
#pragma unroll
        for (int e = 0; e < NCH; ++e) { const float v = bsv[e] + w[0][e] * raw[i][e] + w[1][e] * raw[i + 1][e] + w[2][e] * raw[i + 2][e] + w[3][e] * raw[i + 3][e]; out[i][e] = silu_f(v); }
}

__device__ __forceinline__ void ma_ssd_unit(const Args& A, LAS unsigned char* lds, int l, int b, int c, int grp, int tid, int lane, int wave) {
    asm volatile("" : "+v"(tid)); lane = tid & 63; wave = __builtin_amdgcn_readfirstlane(tid >> 6);
    unsigned char* ws = A.ws; const bf16* proj = (const bf16*)(ws + WS_PROJ); const float* DTV = (const float*)(ws + WS_DTV);
    LAS float* AC = (LAS float*)(lds); LAS float* DTs = (LAS float*)(lds + 1024); LAS unsigned char* XT = lds + 2048; LAS unsigned char* BT = lds + 2048 + 36864;
    const int grow0 = b * T + c * SSD_L;
    if (wave < 4) { const int h = 4 * grp + wave; const float an = -expf(A.in[I_A_LOG][l * 8 + h]); const float dt = DTV[(size_t)(grow0 + lane) * 8 + h];
        AC[wave * 64 + lane] = wave_scan_incl(dt * an, lane); DTs[wave * 64 + lane] = dt; }
    BLOCK_SYNC();
    { const int t0 = 8 * wave; const float* cw = A.in[I_CONV_W] + l * 4 * 768; const float* cb = A.in[I_CONV_B] + l * 768;
        float xs[8][4]; conv8<4>(proj, cw, cb, grow0, t0, c == 0, 256 * grp + 4 * lane, xs);
        const int hl = lane >> 4, p0 = 4 * (lane & 15); const float alast = AC[hl * 64 + 63];
        float sc[8];
#pragma unroll
        for (int i = 0; i < 8; ++i) sc[i] = DTs[hl * 64 + t0 + i] * __expf(alast - AC[hl * 64 + t0 + i]);
#pragma unroll
        for (int e = 0; e < 4; ++e) { v4u w; w.x = cvtpk(xs[0][e] * sc[0], xs[1][e] * sc[1]); w.y = cvtpk(xs[2][e] * sc[2], xs[3][e] * sc[3]); w.z = cvtpk(xs[4][e] * sc[4], xs[5][e] * sc[5]); w.w = cvtpk(xs[6][e] * sc[6], xs[7][e] * sc[7]);
            *(LAS v4u*)(XT + ((hl * 64 + p0 + e) * 72 + t0) * 2) = w; }
        float bm[8][1]; conv8<1>(proj, cw, cb, grow0, t0, c == 0, 512 + 64 * grp + lane, bm);
        v4u w; w.x = cvtpk(bm[0][0], bm[1][0]); w.y = cvtpk(bm[2][0], bm[3][0]); w.z = cvtpk(bm[4][0], bm[5][0]); w.w = cvtpk(bm[6][0], bm[7][0]);
        *(LAS v4u*)(BT + (lane * 72 + t0) * 2) = w; }
    BLOCK_SYNC();
    { const int hl = wave >> 1, ph = wave & 1, fr = lane & 15, fq = lane >> 4; f32x4 acc[2][4];
#pragma unroll
        for (int i = 0; i < 2; ++i)
#pragma unroll
            for (int j = 0; j < 4; ++j) acc[i][j] = (f32x4){0.f, 0.f, 0.f, 0.f};
#pragma unroll
        for (int ks = 0; ks < 2; ++ks) { bf16x8 fb[4], fx[2];
#pragma unroll
            for (int j = 0; j < 4; ++j) fb[j] = ldsfrag(BT + ((16 * j + fr) * 72 + 32 * ks + 8 * fq) * 2);
#pragma unroll
            for (int i = 0; i < 2; ++i) fx[i] = ldsfrag(XT + ((hl * 64 + 32 * ph + 16 * i + fr) * 72 + 32 * ks + 8 * fq) * 2);
#pragma unroll
            for (int i = 0; i < 2; ++i)
#pragma unroll
                for (int j = 0; j < 4; ++j) acc[i][j] = mfma16(fb[j], fx[i], acc[i][j]); }
        float* SS = (float*)(ws + WS_SS) + ((size_t)(b * SSD_NC + c) * 8 + 4 * grp + hl) * 4096;
#pragma unroll
        for (int i = 0; i < 2; ++i)
#pragma unroll
            for (int j = 0; j < 4; ++j) *(GAS f32x4*)(SS + (32 * ph + 16 * i + fr) * 64 + 16 * j + 4 * fq) = acc[i][j]; }
    if (tid < 4) ((float*)(ws + WS_CD))[(b * SSD_NC + c) * 8 + 4 * grp + tid] = expf(AC[tid * 64 + 63]);
    BLOCK_SYNC();
}

__device__ __forceinline__ void s5_bu(const Args& A, int l, int g, int grow0, int lane, LAS unsigned char* HS, float& ar, float& ai) {
    const unsigned char* tb = A.ws + WS_TAB + (size_t)l * TAB_L; const bf16* proj = (const bf16*)(A.ws + WS_PROJ); const int fr = lane & 15, fq = lane >> 4;
    const bf16* up = proj + (size_t)(grow0 + fr) * NIN + C_U5 + 16 * g + 8 * (fq & 1); const bf16* bp = (const bf16*)(tb + TB_BBT) + ((size_t)g * 128 + fr) * 16 + 8 * (fq & 1);
    v4u fu[2], fb[8];
#pragma unroll
    for (int rt = 0; rt < 2; ++rt) fu[rt] = *(const GAS v4u*)(up + (size_t)rt * 16 * NIN);
#pragma unroll
    for (int ct = 0; ct < 8; ++ct) fb[ct] = *(const GAS v4u*)(bp + ct * 256);
    f32x2 a = ((const f32x2*)(tb + TB_ABAR))[g * 64 + lane];
    PIN(fu[0]); PIN(fu[1]); PIN(a);
#pragma unroll
    for (int ct = 0; ct < 8; ++ct) PIN(fb[ct]);
    const v4u z = (v4u){0u, 0u, 0u, 0u}; const bool hi2 = fq >= 2;
#pragma unroll
    for (int rt = 0; rt < 2; ++rt) fu[rt] = hi2 ? z : fu[rt];
#pragma unroll
    for (int ct = 0; ct < 8; ++ct) fb[ct] = hi2 ? z : fb[ct];
#pragma unroll
    for (int rt = 0; rt < 2; ++rt)
#pragma unroll
        for (int ct = 0; ct < 8; ++ct) { const f32x4 d = mfma16(__builtin_bit_cast(bf16x8, fu[rt]), __builtin_bit_cast(bf16x8, fb[ct]), (f32x4){0.f, 0.f, 0.f, 0.f});
#pragma unroll
            for (int e = 0; e < 4; ++e) *(LAS bf16*)(HS + ((16 * rt + 4 * fq + e) * 136 + 16 * ct + fr) * 2) = f2b(d[e]); }
    ar = a.x; ai = a.y;
    WAVE_SYNC();
}
template <bool WRITEBACK> __device__ __forceinline__ void s5_scan(LAS unsigned char* HS, int lane, float ar, float ai, float& hr, float& hi) {
#pragma unroll 1
    for (int t0 = 0; t0 < S5_L; t0 += 8) { unsigned short br[8], bi[8];
#pragma unroll
        for (int i = 0; i < 8; ++i) { br[i] = *(const LAS bf16*)(HS + ((t0 + i) * 136 + lane) * 2); bi[i] = *(const LAS bf16*)(HS + ((t0 + i) * 136 + 64 + lane) * 2); }
#pragma unroll
        for (int i = 0; i < 8; ++i) { const float nr = ar * hr - ai * hi + bf2f(br[i]), ni = ar * hi + ai * hr + bf2f(bi[i]); hr = nr; hi = ni;
            if (WRITEBACK) { *(LAS bf16*)(HS + ((t0 + i) * 136 + lane) * 2) = f2b(hr); *(LAS bf16*)(HS + ((t0 + i) * 136 + 64 + lane) * 2) = f2b(hi); } } }
}
__device__ __forceinline__ void ma_s5_unit(const Args& A, LAS unsigned char* lds, int l, int b, int c, int lane, int wave) {
    asm volatile("" : "+v"(lane));
    LAS unsigned char* HS = lds + wave * 8704; const int grow0 = b * T + c * S5_L;
    float* ER = (float*)(A.ws + WS_S5ER); float* EI = (float*)(A.ws + WS_S5EI);
#pragma unroll 1
    for (int gi = 0; gi < 4; ++gi) { const int g = 4 * wave + gi; float ar, ai; s5_bu(A, l, g, grow0, lane, HS, ar, ai);
        float hr = 0.f, hi = 0.f; s5_scan<false>(HS, lane, ar, ai, hr, hi);
        const size_t o = ((size_t)(b * S5_NC + c) * 32 + g) * 64 + lane; ER[o] = hr; EI[o] = hi;
        WAVE_SYNC(); }
    BLOCK_SYNC();
}

__device__ __forceinline__ void mb_scan(const Args& A, int l, int vcu, int G, int tid, int dm = 0) {
    asm volatile("" : "+v"(tid));
    unsigned char* ws = A.ws; const int gt = vcu * NTHR + tid, NGT = G * NTHR;
    float* SS = (float*)(ws + (dm ? WS_END + 200 * MiB : WS_SS)); const float* CD = (const float*)(ws + WS_CD); float* outp = dm ? (float*)(ws + WS_END + 240 * MiB) : A.out;
#pragma unroll 1
    for (int i = gt; i < NB * 8 * 4096; i += NGT) { const int b = i >> 15, h = (i >> 12) & 7, pn = i & 4095; float run = 0.f; float s[SSD_NC], d[SSD_NC];
        float* p = SS + ((size_t)(b * SSD_NC) * 8 + h) * 4096 + pn; const float* dp = CD + (b * SSD_NC) * 8 + h;
#pragma unroll
        for (int c = 0; c < SSD_NC; ++c) { s[c] = p[(size_t)c * 8 * 4096]; d[c] = dp[c * 8]; }
#pragma unroll
        for (int c = 0; c < SSD_NC; ++c) { PIN(s[c]); PIN(d[c]); }
#pragma unroll
        for (int c = 0; c < SSD_NC; ++c) { p[(size_t)c * 8 * 4096] = run; run = run * d[c] + s[c]; }
        outp[O_PSSD + (size_t)l * NB * 8 * 4096 + i] = run; }
    float* ER = (float*)(ws + (dm ? WS_END + 220 * MiB : WS_S5ER)); float* EI = (float*)(ws + (dm ? WS_END + 224 * MiB : WS_S5EI)); const f32x2* AL = (const f32x2*)(ws + WS_TAB + (size_t)l * TAB_L + TB_ABARL);
#pragma unroll 1
    for (int i = gt; i < NB * 2048; i += NGT) { const int b = i >> 11, gn = i & 2047; const f32x2 a = AL[gn]; float rr = 0.f, ri = 0.f;
#pragma unroll 1
        for (int c0 = 0; c0 < S5_NC; c0 += 32) { float er[32], ei[32]; const size_t o = (size_t)(b * S5_NC + c0) * 2048 + gn;
#pragma unroll
            for (int c = 0; c < 32; ++c) { er[c] = ER[o + (size_t)c * 2048]; ei[c] = EI[o + (size_t)c * 2048]; }
#pragma unroll
            for (int c = 0; c < 32; ++c) { PIN(er[c]); PIN(ei[c]); }
#pragma unroll
            for (int c = 0; c < 32; ++c) { ER[o + (size_t)c * 2048] = rr; EI[o + (size_t)c * 2048] = ri; const float nr = a.x * rr - a.y * ri + er[c], ni = a.x * ri + a.y * rr + ei[c]; rr = nr; ri = ni; } }
        outp[O_PS5R + (size_t)l * NB * 2048 + i] = rr; outp[O_PS5I + (size_t)l * NB * 2048 + i] = ri; }
}

__device__ __forceinline__ void mc_s5_unit(const Args& A, LAS unsigned char* lds, int l, int b, int c, int tid, int lane, int wave) {
    asm volatile("" : "+v"(tid)); lane = tid & 63; wave = __builtin_amdgcn_readfirstlane(tid >> 6);
    unsigned char* ws = A.ws; const unsigned char* tb = ws + WS_TAB + (size_t)l * TAB_L;
    LAS unsigned char* HS = lds + 16384 + wave * 8704;
    LAS unsigned char* Y = lds + 16384 + 8 * 8704; LAS float* SQ = (LAS float*)(lds + 16384 + 8 * 8704 + 33280);
    const int grow0 = b * T + c * S5_L, fr = lane & 15, fq = lane >> 4;
    const float* ER = (const float*)(ws + WS_S5ER); const float* EI = (const float*)(ws + WS_S5EI);
#pragma unroll 1
    for (int gi = 0; gi < 4; ++gi) { const int g = 4 * wave + gi;
        const size_t o = ((size_t)(b * S5_NC + c) * 32 + g) * 64 + lane; float hr = ER[o], hi = EI[o];
        const bf16* cmt = (const bf16*)(tb + TB_CMT) + (size_t)g * 16 * 128; float dsk = A.in[I_S5_D][l * 512 + 16 * g + fr]; bf16x8 fc[4]; unsigned uk[2][4];
        const bf16* proj = (const bf16*)(ws + WS_PROJ);
#pragma unroll
        for (int ks = 0; ks < 4; ++ks) fc[ks] = gfrag(cmt + fr * 128 + 32 * ks + 8 * fq);
#pragma unroll
        for (int rt = 0; rt < 2; ++rt)
#pragma unroll
            for (int e = 0; e < 4; ++e) uk[rt][e] = (unsigned)proj[(size_t)(grow0 + 16 * rt + 4 * fq + e) * NIN + C_U5 + 16 * g + fr];
        float ar, ai; s5_bu(A, l, g, grow0, lane, HS, ar, ai);
        PIN(hr); PIN(hi); PIN(dsk);
#pragma unroll
        for (int ks = 0; ks < 4; ++ks) PIN(fc[ks]);
#pragma unroll
        for (int rt = 0; rt < 2; ++rt)
#pragma unroll
            for (int e = 0; e < 4; ++e) PIN(uk[rt][e]);
        s5_scan<true>(HS, lane, ar, ai, hr, hi);
        WAVE_SYNC();
        f32x4 acc[2] = {(f32x4){0.f, 0.f, 0.f, 0.f}, (f32x4){0.f, 0.f, 0.f, 0.f}};
#pragma unroll
        for (int ks = 0; ks < 4; ++ks)
#pragma unroll
            for (int rt = 0; rt < 2; ++rt) acc[rt] = mfma16(ldsfrag(HS + ((16 * rt + fr) * 136 + 32 * ks + 8 * fq) * 2), fc[ks], acc[rt]);
#pragma unroll
        for (int rt = 0; rt < 2; ++rt)
#pragma unroll
            for (int e = 0; e < 4; ++e) { const int t = 16 * rt + 4 * fq + e; const float y = acc[rt][e] + dsk * __uint_as_float(uk[rt][e] << 16); *(LAS bf16*)(Y + (t * 520 + 16 * g + fr) * 2) = f2b(gelu_tanh_f(y)); }
        WAVE_SYNC(); }
    BLOCK_SYNC();
    const bf16* wg = (const bf16*)(tb + TB_WGLUT); f32x4 acc[2][4];
#pragma unroll
    for (int i = 0; i < 2; ++i)
#pragma unroll
        for (int j = 0; j < 4; ++j) acc[i][j] = (f32x4){0.f, 0.f, 0.f, 0.f};
    float bgl[4];
#pragma unroll
    for (int j = 0; j < 4; ++j) bgl[j] = A.in[I_B_GLU][l * 512 + 64 * wave + 16 * j + fr];
#pragma unroll 1
    for (int k4 = 0; k4 < 16; k4 += 4) { bf16x8 fb[4][4];
#pragma unroll
        for (int q = 0; q < 4; ++q)
#pragma unroll
            for (int j = 0; j < 4; ++j) fb[q][j] = gfrag(wg + sfrag(64 * wave + 16 * j, 32 * (k4 + q), 512) + 8 * lane);
#pragma unroll
        for (int q = 0; q < 4; ++q)
#pragma unroll
            for (int j = 0; j < 4; ++j) PIN(fb[q][j]);
#pragma unroll
        for (int q = 0; q < 4; ++q) { bf16x8 fa[2];
#pragma unroll
            for (int i = 0; i < 2; ++i) fa[i] = ldsfrag(Y + ((16 * i + fr) * 520 + 32 * (k4 + q) + 8 * fq) * 2);
#pragma unroll
            for (int i = 0; i < 2; ++i)
#pragma unroll
                for (int j = 0; j < 4; ++j) acc[i][j] = mfma16(fa[i], fb[q][j], acc[i][j]); } }
#pragma unroll
    for (int i = 0; i < 2; ++i)
#pragma unroll
        for (int e = 0; e < 4; ++e) { const int t = 16 * i + 4 * fq + e; float sq = 0.f;
#pragma unroll
            for (int j = 0; j < 4; ++j) { const int col = 64 * wave + 16 * j + fr; const float yv = bf2f(*(const LAS bf16*)(Y + (t * 520 + col) * 2));
                const float o = yv * sigmoid_f(acc[i][j][e] + bgl[j]); acc[i][j][e] = o; sq += o * o; }
            sq = sum16(sq); if (fr == 0) SQ[wave * 32 + t] = sq; }
    BLOCK_SYNC();
    bf16* mix = (bf16*)(ws + WS_MIX);
#pragma unroll
    for (int i = 0; i < 2; ++i)
#pragma unroll
        for (int e = 0; e < 4; ++e) { const int t = 16 * i + 4 * fq + e; float sq = 0.f;
#pragma unroll
            for (int w = 0; w < 8; ++w) sq += SQ[w * 32 + t];
            const float rs = __builtin_amdgcn_rsqf(sq * (1.0f / 512.0f) + EPS);
#pragma unroll
            for (int j = 0; j < 4; ++j) mix[(size_t)(grow0 + t) * D + 512 + 64 * wave + 16 * j + fr] = f2b(acc[i][j][e] * rs); }
    BLOCK_SYNC();
}


#define RELANE() do { asm volatile("" : "+v"(tid)); lane = tid & 63; fr = lane & 15; fq = lane >> 4; } while (0)
__device__ __forceinline__ void mc_rest_unit(const Args& A, LAS unsigned char* lds, int l, int b, int c, int tid, int lane, int wave) {
    asm volatile("" : "+v"(tid)); lane = tid & 63; wave = __builtin_amdgcn_readfirstlane(tid >> 6);
    unsigned char* ws = A.ws; const bf16* proj = (const bf16*)(ws + WS_PROJ); const float* DTV = (const float*)(ws + WS_DTV); bf16* mix = (bf16*)(ws + WS_MIX);
    LAS float* AC = (LAS float*)lds; LAS float* DTs = (LAS float*)(lds + 2048); LAS float* SQ = (LAS float*)(lds + 96768); LAS float* SQ2 = (LAS float*)(lds + 98816);
    LAS unsigned char* XT = lds + 4608; LAS unsigned char* BMs = lds + 41472; LAS unsigned char* CMs = lds + 50688; LAS unsigned char* PW = lds + 59904 + wave * 4608;
    LAS unsigned char* PL = lds + 4608;
    const int grow0 = b * T + c * SSD_L; int fr = lane & 15, fq = lane >> 4; const bool first = (c == 0), lastc = (c == SSD_NC - 1);
    const float* cw = A.in[I_CONV_W] + l * 4 * 768; const float* cb = A.in[I_CONV_B] + l * 768;
    { const float an = -expf(A.in[I_A_LOG][l * 8 + wave]); const float dt = DTV[(size_t)(grow0 + lane) * 8 + wave];
        AC[wave * 64 + lane] = wave_scan_incl(dt * an, lane); DTs[wave * 64 + lane] = dt; }
    BLOCK_SYNC();
    f32x4 yv[2][2][4];
#pragma unroll
    for (int half = 0; half < 2; ++half) {
        RELANE();
        { const int t0 = 8 * wave; float xs[8][4]; conv8<4>(proj, cw, cb, grow0, t0, first, 256 * half + 4 * lane, xs);
            const int hl = lane >> 4, p0 = 4 * (lane & 15);
#pragma unroll
            for (int e = 0; e < 4; ++e) { v4u w; w.x = cvtpk(xs[0][e], xs[1][e]); w.y = cvtpk(xs[2][e], xs[3][e]); w.z = cvtpk(xs[4][e], xs[5][e]); w.w = cvtpk(xs[6][e], xs[7][e]);
                *(LAS v4u*)(XT + ((hl * 64 + p0 + e) * 72 + t0) * 2) = w; }
            float bc[8][2]; const int isc = lane >> 5, n0 = 2 * (lane & 31); conv8<2>(proj, cw, cb, grow0, t0, first, 512 + 128 * isc + 64 * half + n0, bc);
            LAS unsigned char* dst = isc ? CMs : BMs;
#pragma unroll
            for (int i = 0; i < 8; ++i) *(LAS unsigned*)(dst + ((t0 + i) * 72 + n0) * 2) = cvtpk(bc[i][0], bc[i][1]); }
        BLOCK_SYNC(); RELANE();
        { const int hl = wave >> 1, th = wave & 1, h = 4 * half + hl;
#pragma unroll
            for (int rt = 0; rt < 2; ++rt) { const bf16x8 fc0 = ldsfrag(CMs + ((32 * th + 16 * rt + fr) * 72 + 8 * fq) * 2), fc1 = ldsfrag(CMs + ((32 * th + 16 * rt + fr) * 72 + 32 + 8 * fq) * 2);
#pragma unroll
                for (int st = 0; st < 4; ++st) { f32x4 g = (f32x4){0.f, 0.f, 0.f, 0.f};
                    g = mfma16(fc0, ldsfrag(BMs + ((16 * st + fr) * 72 + 8 * fq) * 2), g); g = mfma16(fc1, ldsfrag(BMs + ((16 * st + fr) * 72 + 32 + 8 * fq) * 2), g);
                    const int s = 16 * st + fr; const float as = AC[h * 64 + s], ds = DTs[h * 64 + s];
#pragma unroll
                    for (int e = 0; e < 4; ++e) { const int tl = 16 * rt + 4 * fq + e, t = 32 * th + tl; const float pv = (s <= t) ? g[e] * __expf(AC[h * 64 + t] - as) * ds : 0.f;
                        *(LAS bf16*)(PW + (tl * 72 + s) * 2) = f2b(pv); } asm volatile("" ::: "memory"); } }
            WAVE_SYNC(); RELANE();
            const float* HP = (const float*)(ws + WS_SS) + ((size_t)(b * SSD_NC + c) * 8 + h) * 4096; float dsk = A.in[I_SSD_D][l * 8 + h]; float sqp[2][4];
            bf16x8 hpf[4][2];
            { f32x4 hq[4][4];
#pragma unroll
                for (int pt = 0; pt < 4; ++pt) { const float* hp = HP + (16 * pt + fr) * 64 + 8 * fq; hq[pt][0] = *(const GAS f32x4*)hp; hq[pt][1] = *(const GAS f32x4*)(hp + 4); hq[pt][2] = *(const GAS f32x4*)(hp + 32); hq[pt][3] = *(const GAS f32x4*)(hp + 36); }
#pragma unroll
                for (int pt = 0; pt < 4; ++pt)
#pragma unroll
                    for (int q = 0; q < 4; ++q) PIN(hq[pt][q]);
#pragma unroll
                for (int pt = 0; pt < 4; ++pt) { hpf[pt][0] = pack8(hq[pt][0], hq[pt][1]); hpf[pt][1] = pack8(hq[pt][2], hq[pt][3]); } }
            PIN(dsk);
#pragma unroll
            for (int rt = 0; rt < 2; ++rt) { const bf16x8 fp0 = ldsfrag(PW + ((16 * rt + fr) * 72 + 8 * fq) * 2), fp1 = ldsfrag(PW + ((16 * rt + fr) * 72 + 32 + 8 * fq) * 2);
                const bf16x8 fc0 = ldsfrag(CMs + ((32 * th + 16 * rt + fr) * 72 + 8 * fq) * 2), fc1 = ldsfrag(CMs + ((32 * th + 16 * rt + fr) * 72 + 32 + 8 * fq) * 2);
                unsigned zr[4][4];
#pragma unroll
                for (int pt = 0; pt < 4; ++pt)
#pragma unroll
                    for (int e = 0; e < 4; ++e) zr[pt][e] = (unsigned)proj[(size_t)(grow0 + 32 * th + 16 * rt + 4 * fq + e) * NIN + C_Z + 64 * h + 16 * pt + fr];
#pragma unroll
                for (int pt = 0; pt < 4; ++pt)
#pragma unroll
                    for (int e = 0; e < 4; ++e) PIN(zr[pt][e]);
#pragma unroll
                for (int e = 0; e < 4; ++e) sqp[rt][e] = 0.f;
#pragma unroll
                for (int pt = 0; pt < 4; ++pt) { const int p = 16 * pt + fr; f32x4 y = (f32x4){0.f, 0.f, 0.f, 0.f}, yo = (f32x4){0.f, 0.f, 0.f, 0.f};
                    y = mfma16(fp0, ldsfrag(XT + ((hl * 64 + p) * 72 + 8 * fq) * 2), y); y = mfma16(fp1, ldsfrag(XT + ((hl * 64 + p) * 72 + 32 + 8 * fq) * 2), y);
                    yo = mfma16(fc0, hpf[pt][0], yo); yo = mfma16(fc1, hpf[pt][1], yo);
                    const v2u xw = *(const LAS v2u*)(XT + ((hl * 64 + p) * 72 + 32 * th + 16 * rt + 4 * fq) * 2); const float xv[4] = {bf_lo(xw.x), bf_hi(xw.x), bf_lo(xw.y), bf_hi(xw.y)};
#pragma unroll
                    for (int e = 0; e < 4; ++e) { const int t = 32 * th + 16 * rt + 4 * fq + e; const float z = __uint_as_float(zr[pt][e] << 16);
                        const float v = (y[e] + __expf(AC[h * 64 + t]) * yo[e] + dsk * xv[e]) * silu_f(z); y[e] = v; sqp[rt][e] += v * v; }
                    yv[half][rt][pt] = y; }
#pragma unroll
                for (int e = 0; e < 4; ++e) { const float s = sum16(sqp[rt][e]); if (fr == 0) SQ[(half * 4 + hl) * 64 + 32 * th + 16 * rt + 4 * fq + e] = s; } } }
        BLOCK_SYNC();
    }
    RELANE();
    { const int hl = wave >> 1, th = wave & 1;
#pragma unroll
        for (int half = 0; half < 2; ++half)
#pragma unroll
            for (int rt = 0; rt < 2; ++rt)
#pragma unroll
                for (int e = 0; e < 4; ++e) { const int t = 32 * th + 16 * rt + 4 * fq + e; float sq = 0.f;
#pragma unroll
                    for (int w = 0; w < 8; ++w) sq += SQ[w * 64 + t];
                    const float rs = __builtin_amdgcn_rsqf(sq * (1.0f / 512.0f) + EPS);
#pragma unroll
                    for (int pt = 0; pt < 4; ++pt) mix[(size_t)(grow0 + t) * D + 64 * (4 * half + hl) + 16 * pt + fr] = f2b(yv[half][rt][pt][e] * rs); } }
    RELANE();
    { const int t0 = 8 * wave, ch = 8 * lane; v4u gcr[10], hvr[10], gbr[8]; float w[3][8];
#pragma unroll
        for (int r = 0; r < 10; ++r) { const int tt = t0 - 2 + r; const bf16* p = proj + (size_t)(grow0 + ((first && tt < 0) ? 0 : tt)) * NIN; gcr[r] = *(const GAS v4u*)(p + C_GC + ch); hvr[r] = *(const GAS v4u*)(p + C_HV + ch); }
#pragma unroll
        for (int i = 0; i < 8; ++i) gbr[i] = *(const GAS v4u*)(proj + (size_t)(grow0 + t0 + i) * NIN + C_GB + ch);
#pragma unroll
        for (int j = 0; j < 3; ++j)
#pragma unroll
            for (int e = 0; e < 8; ++e) w[j][e] = A.in[I_SC_W][(l * 3 + j) * 512 + ch + e];
#pragma unroll
        for (int r = 0; r < 10; ++r) { PIN(gcr[r]); PIN(hvr[r]); }
#pragma unroll
        for (int i = 0; i < 8; ++i) PIN(gbr[i]);
        float v2[8], v1[8];
#pragma unroll
        for (int r = 0; r < 10; ++r) { float gc[8], hv[8], v0[8]; unpack8(gcr[r], gc); unpack8(hvr[r], hv); const bool z = first && (t0 - 2 + r) < 0;
#pragma unroll
            for (int e = 0; e < 8; ++e) v0[e] = z ? 0.f : gc[e] * hv[e];
            if (r >= 2) { const int tt = t0 + r - 2; float gb[8], y[8]; unpack8(gbr[r - 2], gb); float sq = 0.f;
#pragma unroll
                for (int e = 0; e < 8; ++e) { y[e] = gb[e] * (w[0][e] * v2[e] + w[1][e] * v1[e] + w[2][e] * v0[e]); sq += y[e] * y[e]; }
                const float rs = __builtin_amdgcn_rsqf(wave_sum(sq) * (1.0f / 512.0f) + EPS);
                v4u o; o.x = cvtpk(y[0] * rs, y[1] * rs); o.y = cvtpk(y[2] * rs, y[3] * rs); o.z = cvtpk(y[4] * rs, y[5] * rs); o.w = cvtpk(y[6] * rs, y[7] * rs);
                *(GAS v4u*)(mix + (size_t)(grow0 + tt) * D + 1024 + ch) = o;
                if (lastc && tt >= 62) { float* o2 = A.out + O_PSC + ((size_t)(l * NB + b) * 2 + (tt - 62)) * 512 + ch; *(GAS f32x4*)o2 = (f32x4){v0[0], v0[1], v0[2], v0[3]}; *(GAS f32x4*)(o2 + 4) = (f32x4){v0[4], v0[5], v0[6], v0[7]}; } }
#pragma unroll
            for (int e = 0; e < 8; ++e) { v2[e] = v1[e]; v1[e] = v0[e]; } }
    }
    BLOCK_SYNC();
#pragma unroll 1
    for (int hh = 0; hh < 2; ++hh) { RELANE(); const int t0 = 8 * wave, ch = 4 * lane + 256 * hh, gI = ch >> 7;
        float u[23][4]; v2u ur[23];
#pragma unroll
        for (int r = 0; r < 23; ++r) { const int tt = t0 - 15 + r; ur[r] = *(const GAS v2u*)(proj + (size_t)(grow0 + ((first && tt < 0) ? 0 : tt)) * NIN + C_UP + ch); }
#pragma unroll
        for (int r = 0; r < 23; ++r) PIN(ur[r]);
#pragma unroll
        for (int r = 0; r < 23; ++r) { const bool z = first && (t0 - 15 + r) < 0; u[r][0] = z ? 0.f : bf_lo(ur[r].x); u[r][1] = z ? 0.f : bf_hi(ur[r].x); u[r][2] = z ? 0.f : bf_lo(ur[r].y); u[r][3] = z ? 0.f : bf_hi(ur[r].y); }
        const int win = 2 << gI;
#pragma unroll
        for (int i = 0; i < 8; ++i) { const int r = 15 + i; float pv[4]; const int pos = c * SSD_L + t0 + i; const float inv = 1.0f / (float)(pos + 1 < win ? pos + 1 : win);
#pragma unroll
            for (int e = 0; e < 4; ++e) { const float s2 = u[r][e] + u[r - 1][e], s4 = s2 + u[r - 2][e] + u[r - 3][e], s8 = s4 + (u[r - 4][e] + u[r - 5][e]) + (u[r - 6][e] + u[r - 7][e]);
                const float s16 = s8 + ((u[r - 8][e] + u[r - 9][e]) + (u[r - 10][e] + u[r - 11][e])) + ((u[r - 12][e] + u[r - 13][e]) + (u[r - 14][e] + u[r - 15][e]));
                const float cs = gI == 0 ? s2 : gI == 1 ? s4 : gI == 2 ? s8 : s16; pv[e] = cs * inv - u[r][e]; }
            v2u o; o.x = cvtpk(pv[0], pv[1]); o.y = cvtpk(pv[2], pv[3]); *(LAS v2u*)(PL + ((t0 + i) * 520 + ch) * 2) = o;
            if (lastc && t0 + i >= 49) *(GAS f32x4*)(A.out + O_PPOOL + ((size_t)(l * NB + b) * 15 + (t0 + i - 49)) * 512 + ch) = (f32x4){u[r][0], u[r][1], u[r][2], u[r][3]}; }
    }
    BLOCK_SYNC(); RELANE();
    { const int gI = wave >> 1, dh = wave & 1; const bf16* wp = (const bf16*)(ws + WS_TAB + (size_t)l * TAB_L + TB_WPT) + (size_t)gI * 128 * 128; f32x4 acc[4][4];
#pragma unroll
        for (int i = 0; i < 4; ++i)
#pragma unroll
            for (int j = 0; j < 4; ++j) acc[i][j] = (f32x4){0.f, 0.f, 0.f, 0.f};
        bf16x8 fbw[4][4]; float psc[4];
#pragma unroll
        for (int ks = 0; ks < 4; ++ks)
#pragma unroll
            for (int j = 0; j < 4; ++j) fbw[ks][j] = gfrag(wp + sfrag(64 * dh + 16 * j, 32 * ks, 128) + 8 * lane);
#pragma unroll
        for (int j = 0; j < 4; ++j) psc[j] = A.in[I_POOL_SCALE][l * 512 + 128 * gI + 64 * dh + 16 * j + fr];
#pragma unroll
        for (int ks = 0; ks < 4; ++ks)
#pragma unroll
            for (int j = 0; j < 4; ++j) PIN(fbw[ks][j]);
#pragma unroll
        for (int ks = 0; ks < 4; ++ks) { bf16x8 fa[4];
#pragma unroll
            for (int i = 0; i < 4; ++i) fa[i] = ldsfrag(PL + ((16 * i + fr) * 520 + 128 * gI + 32 * ks + 8 * fq) * 2);
#pragma unroll
            for (int i = 0; i < 4; ++i)
#pragma unroll
                for (int j = 0; j < 4; ++j) acc[i][j] = mfma16(fa[i], fbw[ks][j], acc[i][j]); }
#pragma unroll
        for (int i = 0; i < 4; ++i)
#pragma unroll
            for (int e = 0; e < 4; ++e) { float sq = 0.f;
#pragma unroll
                for (int j = 0; j < 4; ++j) { const float o = acc[i][j][e] * psc[j]; acc[i][j][e] = o; sq += o * o; }
                sq = sum16(sq); if (fr == 0) SQ2[wave * 64 + 16 * i + 4 * fq + e] = sq; }
        BLOCK_SYNC();
#pragma unroll
        for (int i = 0; i < 4; ++i)
#pragma unroll
            for (int e = 0; e < 4; ++e) { const int t = 16 * i + 4 * fq + e; float sq = 0.f;
#pragma unroll
                for (int w = 0; w < 8; ++w) sq += SQ2[w * 64 + t];
                const float rs = __builtin_amdgcn_rsqf(sq * (1.0f / 512.0f) + EPS);
#pragma unroll
                for (int j = 0; j < 4; ++j) mix[(size_t)(grow0 + t) * D + 1536 + 128 * gI + 64 * dh + 16 * j + fr] = f2b(acc[i][j][e] * rs); }
    }
    if (lastc) for (int i = tid; i < 3 * 768; i += NTHR) { const int r = i / 768, ch = i % 768; A.out[O_PCONV + ((size_t)(l * NB + b) * 3 + r) * 768 + ch] = bf2f(proj[(size_t)(grow0 + 61 + r) * NIN + C_XBC + ch]); }
    BLOCK_SYNC();
}

__device__ __forceinline__ void mc_sample_unit(const Args& A, LAS unsigned char* lds, int l, int s, int tid, int lane, int wave) {
    asm volatile("" : "+v"(tid)); lane = tid & 63; wave = __builtin_amdgcn_readfirstlane(tid >> 6);
    unsigned char* ws = A.ws; const bf16* proj = (const bf16*)(ws + WS_PROJ) + (size_t)(MP + s) * NIN; const unsigned char* tb = ws + WS_TAB + (size_t)l * TAB_L; float* out = A.out;
    LAS float* XC = (LAS float*)lds; LAS float* U5 = (LAS float*)(lds + 5120); LAS float* Y5 = (LAS float*)(lds + 7168); LAS float* PLs = (LAS float*)(lds + 9216); LAS float* OUT = (LAS float*)(lds + 11264); LAS float* ZP = (LAS float*)(lds + 19456);
    const int ls = l * MS + s;
    { const int c1 = tid < 256 ? tid + 512 : tid; const float* st0 = A.in[I_ST_CONV] + (size_t)ls * 3 * 768; const float* cw = A.in[I_CONV_W] + l * 4 * 768;
        float a[2][3], nwv[2], wv[2][4], bsv[2]; const int chs[2] = {tid, c1};
#pragma unroll
        for (int q = 0; q < 2; ++q) { const int ch = chs[q]; a[q][0] = st0[ch]; a[q][1] = st0[768 + ch]; a[q][2] = st0[1536 + ch]; nwv[q] = bf2f(proj[C_XBC + ch]); bsv[q] = A.in[I_CONV_B][l * 768 + ch];
#pragma unroll
            for (int j = 0; j < 4; ++j) wv[q][j] = cw[j * 768 + ch]; }
        float u5v = bf2f(proj[C_U5 + tid]);
#pragma unroll
        for (int q = 0; q < 2; ++q) { PIN(a[q][0]); PIN(a[q][1]); PIN(a[q][2]); PIN(nwv[q]); PIN(bsv[q]); PIN(wv[q][0]); PIN(wv[q][1]); PIN(wv[q][2]); PIN(wv[q][3]); }
        PIN(u5v);
#pragma unroll
        for (int q = 0; q < 2; ++q) if (q == 0 || tid < 256) { const int ch = chs[q]; XC[ch] = silu_f(bsv[q] + wv[q][0] * a[q][0] + wv[q][1] * a[q][1] + wv[q][2] * a[q][2] + wv[q][3] * nwv[q]);
            float* o = out + O_SCONV + (size_t)ls * 3 * 768 + ch; o[0] = a[q][1]; o[768] = a[q][2]; o[1536] = nwv[q]; }
        U5[tid] = u5v; }
    BLOCK_SYNC();
    { const int h = wave; const float dt = ((const float*)(ws + WS_DTV))[(size_t)(MP + s) * 8 + h], dec = expf(-dt * expf(A.in[I_A_LOG][l * 8 + h])), dsk = A.in[I_SSD_D][l * 8 + h];
        const int n4 = 4 * (lane & 15); const f32x4 Bv = *(const LAS f32x4*)(XC + 512 + 64 * (h >> 2) + n4), Cv = *(const LAS f32x4*)(XC + 640 + 64 * (h >> 2) + n4);
        const size_t o0 = (((size_t)ls * 8 + h) * 64 + (lane >> 4)) * 64 + n4; f32x4 h0[16]; unsigned zr[16];
#pragma unroll
        for (int it = 0; it < 16; ++it) { h0[it] = __builtin_nontemporal_load((const GAS f32x4*)(A.in[I_ST_SSD] + o0 + (size_t)it * 256)); zr[it] = (unsigned)proj[C_Z + 64 * h + it * 4 + (lane >> 4)]; }
#pragma unroll
        for (int it = 0; it < 16; ++it) { PIN(h0[it]); PIN(zr[it]); }
#pragma unroll
        for (int it = 0; it < 16; ++it) { const int p = it * 4 + (lane >> 4); const float x = XC[64 * h + p]; const f32x4 hn = h0[it] * dec + Bv * (dt * x);
            __builtin_nontemporal_store(hn, (GAS f32x4*)(out + O_SSSD + o0 + (size_t)it * 256));
            float y = (hn.x * Cv.x + hn.y * Cv.y) + (hn.z * Cv.z + hn.w * Cv.w); y = sum16(y);
            if ((lane & 15) == 0) OUT[64 * h + p] = (y + dsk * x) * silu_f(__uint_as_float(zr[it] << 16)); } }
#pragma unroll 1
    for (int gi = 0; gi < 4; ++gi) { const int g = 4 * wave + gi; const f32x2* bb = (const f32x2*)(tb + TB_BBAR) + (size_t)g * 16 * 64 + lane; f32x2 bv[16]; float cr[16], ci[16];
        const float* cre = A.in[I_C_RE] + ((size_t)l * 32 + g) * 1024 + lane; const float* cim = A.in[I_C_IM] + ((size_t)l * 32 + g) * 1024 + lane;
#pragma unroll
        for (int k = 0; k < 16; ++k) { bv[k] = bb[k * 64]; cr[k] = cre[k * 64]; ci[k] = cim[k * 64]; }
        f32x2 a = ((const f32x2*)(tb + TB_ABAR))[g * 64 + lane]; const size_t o = ((size_t)ls * 32 + g) * 64 + lane; float h0r = A.in[I_ST_S5R][o], h0i = A.in[I_ST_S5I][o]; float dv = A.in[I_S5_D][l * 512 + 16 * g + (lane & 15)];
        PIN(a); PIN(h0r); PIN(h0i); PIN(dv);
#pragma unroll
        for (int k = 0; k < 16; ++k) { PIN(bv[k]); PIN(cr[k]); PIN(ci[k]); }
        float br = 0.f, bi = 0.f;
#pragma unroll
        for (int k = 0; k < 16; ++k) { const float u = U5[16 * g + k]; br += bv[k].x * u; bi += bv[k].y * u; }
        const float hr = a.x * h0r - a.y * h0i + br, hi = a.x * h0i + a.y * h0r + bi; out[O_SS5R + o] = hr; out[O_SS5I + o] = hi;
        float mine = 0.f;
#pragma unroll
        for (int k = 0; k < 16; ++k) { const float v = wave_sum(cr[k] * hr - ci[k] * hi); mine = (lane == k) ? v : mine; }
        if (lane < 16) Y5[16 * g + lane] = gelu_tanh_f(mine + dv * U5[16 * g + lane]); }
    { const int c = tid, gI = c >> 7, win = 2 << gI; const float* st = A.in[I_ST_SC] + (size_t)ls * 2 * 512 + c; const float* w = A.in[I_SC_W] + l * 3 * 512 + c; const float* sp = A.in[I_ST_POOL] + (size_t)ls * 15 * 512 + c;
        float s0 = st[0], s1 = st[512], gc = bf2f(proj[C_GC + c]), hvv = bf2f(proj[C_HV + c]), gb = bf2f(proj[C_GB + c]), w0 = w[0], w1 = w[512], w2 = w[1024], u = bf2f(proj[C_UP + c]); float hh[15];
#pragma unroll
        for (int r = 0; r < 15; ++r) hh[r] = sp[r * 512];
        PIN(s0); PIN(s1); PIN(gc); PIN(hvv); PIN(gb); PIN(w0); PIN(w1); PIN(w2); PIN(u);
#pragma unroll
        for (int r = 0; r < 15; ++r) PIN(hh[r]);
        const float v = gc * hvv; OUT[1024 + c] = gb * (w0 * s0 + w1 * s1 + w2 * v); float* o = out + O_SSC + (size_t)ls * 2 * 512 + c; o[0] = s1; o[512] = v;
        float* op = out + O_SPOOL + (size_t)ls * 15 * 512 + c; float sum = u;
#pragma unroll
        for (int r = 0; r < 15; ++r) { if (15 - r < win) sum += hh[r]; if (r > 0) op[(r - 1) * 512] = hh[r]; }
        op[14 * 512] = u; PLs[c] = sum / (float)win - u; }
    BLOCK_SYNC();
    { const int fq = lane >> 4;
        { const int gI = wave >> 1; const bf16* wp = (const bf16*)(tb + TB_WPT) + (size_t)gI * 128 * 128 + (size_t)(4 * (wave & 1)) * 4 * 512 + 8 * lane;
            v4u pw[4][4]; float pa[4] = {0.f, 0.f, 0.f, 0.f};
#pragma unroll
            for (int ks = 0; ks < 4; ++ks)
#pragma unroll
                for (int j = 0; j < 4; ++j) pw[ks][j] = *(const GAS v4u*)(wp + ((size_t)(j * 4 + ks) << 9));
            const float psc = A.in[I_POOL_SCALE][l * 512 + 64 * wave + lane];
#pragma unroll
            for (int ks = 0; ks < 4; ++ks)
#pragma unroll
                for (int j = 0; j < 4; ++j) PIN(pw[ks][j]);
#pragma unroll
            for (int ks = 0; ks < 4; ++ks) { const LAS float* yp = PLs + 128 * gI + 32 * ks + 8 * fq; const f32x4 y0 = *(const LAS f32x4*)yp, y1 = *(const LAS f32x4*)(yp + 4);
#pragma unroll
                for (int j = 0; j < 4; ++j) { float f[8]; unpack8(pw[ks][j], f);
                    pa[j] += (f[0] * y0.x + f[1] * y0.y) + (f[2] * y0.z + f[3] * y0.w) + (f[4] * y1.x + f[5] * y1.y) + (f[6] * y1.z + f[7] * y1.w); } }
            float mine = 0.f;
#pragma unroll
            for (int j = 0; j < 4; ++j) { float t = pa[j]; t += __shfl_xor(t, 16); t += __shfl_xor(t, 32); mine = (fq == j) ? t : mine; }
            OUT[1536 + 64 * wave + lane] = mine * psc; }
        { const bf16* wg = (const bf16*)(tb + TB_WGLUT) + (size_t)(4 * wave) * 16 * 512 + 8 * lane;
            float ga[4] = {0.f, 0.f, 0.f, 0.f}; const float bgl = A.in[I_B_GLU][l * 512 + 64 * wave + lane];
#pragma unroll 1
            for (int kb = 0; kb < 16; kb += 4) { v4u wv[4][4]; const bf16* wk = wg + ((size_t)kb << 9); asm volatile("" : "+v"(wk));
#pragma unroll
                for (int q = 0; q < 4; ++q)
#pragma unroll
                    for (int j = 0; j < 4; ++j) wv[q][j] = *(const GAS v4u*)(wk + ((size_t)(j * 16 + q) << 9));
#pragma unroll
                for (int q = 0; q < 4; ++q)
#pragma unroll
                    for (int j = 0; j < 4; ++j) PIN(wv[q][j]);
#pragma unroll
                for (int q = 0; q < 4; ++q) { const LAS float* yp = Y5 + 32 * (kb + q) + 8 * fq; const f32x4 y0 = *(const LAS f32x4*)yp, y1 = *(const LAS f32x4*)(yp + 4);
#pragma unroll
                    for (int j = 0; j < 4; ++j) { float f[8]; unpack8(wv[q][j], f);
                        ga[j] += (f[0] * y0.x + f[1] * y0.y) + (f[2] * y0.z + f[3] * y0.w) + (f[4] * y1.x + f[5] * y1.y) + (f[6] * y1.z + f[7] * y1.w); } } }
            float mine = 0.f;
#pragma unroll
            for (int j = 0; j < 4; ++j) { float t = ga[j]; t += __shfl_xor(t, 16); t += __shfl_xor(t, 32); mine = (fq == j) ? t : mine; }
            { const int n = 64 * wave + lane; OUT[512 + n] = Y5[n] * sigmoid_f(bgl + mine); } } }
    BLOCK_SYNC();
    if (wave < 4) { float v[8]; float sq = 0.f;
#pragma unroll
        for (int e = 0; e < 8; ++e) { v[e] = OUT[512 * wave + 8 * lane + e]; sq += v[e] * v[e]; }
        const float rs = __builtin_amdgcn_rsqf(wave_sum(sq) * (1.0f / 512.0f) + EPS);
        v4u o; o.x = cvtpk(v[0] * rs, v[1] * rs); o.y = cvtpk(v[2] * rs, v[3] * rs); o.z = cvtpk(v[4] * rs, v[5] * rs); o.w = cvtpk(v[6] * rs, v[7] * rs);
        *(GAS v4u*)((bf16*)(ws + WS_SA + SA_MIX) + sfrag(s, 512 * wave + 8 * lane, D)) = o; }
    BLOCK_SYNC();
}

__device__ __forceinline__ void att_prompt_unit(const Args& A, LAS unsigned char* lds, int l, int b, int hd, int qb, int tid, int lane, int wave) {
    asm volatile("" : "+v"(tid)); lane = tid & 63; wave = __builtin_amdgcn_readfirstlane(tid >> 6);
    unsigned char* ws = A.ws; const int fr = lane & 15, fq = lane >> 4, grow0 = b * T + qb * 128;
    const bf16* Q = (const bf16*)(ws + WS_Q) + (size_t)grow0 * D + hd * HDX; const bf16* K = (const bf16*)(ws + WS_KB) + ((size_t)l * MROWS + b * NMEM) * D + hd * HDX;
    const bf16* V = (const bf16*)(ws + WS_VT) + (((size_t)l * NB + b) * D + hd * HDX) * NMEM; bf16* O = (bf16*)(ws + WS_O) + (size_t)grow0 * D + hd * HDX;
    LAS unsigned char* PS = lds; LAS unsigned char* KS = lds + 67584; LAS unsigned char* QS = lds + 104448; LAS unsigned char* VS = lds + 67584;
    f32x4 acc[16];
#pragma unroll
    for (int i = 0; i < 16; ++i) acc[i] = (f32x4){0.f, 0.f, 0.f, 0.f};
#pragma unroll 1
    for (int ds = 0; ds < 8; ++ds) {
        { v4u tk[4], tq[2];
#pragma unroll
            for (int i = 0; i < 4; ++i) { const int id = tid + NTHR * i, key = id >> 3, part = id & 7; tk[i] = *(const GAS v4u*)(K + (size_t)key * D + 64 * ds + 8 * part); }
#pragma unroll
            for (int i = 0; i < 2; ++i) { const int id = tid + NTHR * i, r = id >> 3, part = id & 7; tq[i] = *(const GAS v4u*)(Q + (size_t)r * D + 64 * ds + 8 * part); }
#pragma unroll
            for (int i = 0; i < 4; ++i) PIN(tk[i]);
            PIN(tq[0]); PIN(tq[1]);
#pragma unroll
            for (int i = 0; i < 4; ++i) { const int id = tid + NTHR * i, key = id >> 3, part = id & 7; *(LAS v4u*)(KS + (key * 72 + 8 * part) * 2) = tk[i]; }
#pragma unroll
            for (int i = 0; i < 2; ++i) { const int id = tid + NTHR * i, r = id >> 3, part = id & 7; *(LAS v4u*)(QS + (r * 72 + 8 * part) * 2) = tq[i]; } }
        BLOCK_SYNC();
#pragma unroll
        for (int ks = 0; ks < 2; ++ks) { const bf16x8 fa = ldsfrag(QS + ((16 * wave + fr) * 72 + 32 * ks + 8 * fq) * 2);
#pragma unroll
            for (int kt = 0; kt < 16; ++kt) acc[kt] = mfma16(fa, ldsfrag(KS + ((16 * kt + fr) * 72 + 32 * ks + 8 * fq) * 2), acc[kt]); }
        BLOCK_SYNC();
    }
    float inv[4]; const float scale = 0.044194173824159216f;
#pragma unroll
    for (int e = 0; e < 4; ++e) { float m = acc[0][e];
#pragma unroll
        for (int kt = 1; kt < 16; ++kt) m = fmaxf(m, acc[kt][e]);
        m = max16(m); float sum = 0.f;
#pragma unroll
        for (int kt = 0; kt < 16; ++kt) { const float p = __expf((acc[kt][e] - m) * scale); sum += p; *(LAS bf16*)(PS + ((16 * wave + 4 * fq + e) * 264 + 16 * kt + fr) * 2) = f2b(p); }
        inv[e] = __builtin_amdgcn_rcpf(sum16(sum)); }
#pragma unroll 1
    for (int ds = 0; ds < 8; ++ds) {
        { v4u tv[4];
#pragma unroll
            for (int i = 0; i < 4; ++i) { const int id = tid + NTHR * i, dr = id >> 5, part = id & 31; tv[i] = *(const GAS v4u*)(V + (size_t)(64 * ds + dr) * NMEM + 8 * part); }
#pragma unroll
            for (int i = 0; i < 4; ++i) PIN(tv[i]);
#pragma unroll
            for (int i = 0; i < 4; ++i) { const int id = tid + NTHR * i, dr = id >> 5, part = id & 31; *(LAS v4u*)(VS + (dr * 264 + 8 * part) * 2) = tv[i]; } }
        BLOCK_SYNC();
        f32x4 o[4] = {(f32x4){0.f, 0.f, 0.f, 0.f}, (f32x4){0.f, 0.f, 0.f, 0.f}, (f32x4){0.f, 0.f, 0.f, 0.f}, (f32x4){0.f, 0.f, 0.f, 0.f}};
#pragma unroll
        for (int ks = 0; ks < 8; ++ks) { const bf16x8 fa = ldsfrag(PS + ((16 * wave + fr) * 264 + 32 * ks + 8 * fq) * 2);
#pragma unroll
            for (int dt = 0; dt < 4; ++dt) o[dt] = mfma16(fa, ldsfrag(VS + ((16 * dt + fr) * 264 + 32 * ks + 8 * fq) * 2), o[dt]); }
#pragma unroll
        for (int dt = 0; dt < 4; ++dt)
#pragma unroll
            for (int e = 0; e < 4; ++e) O[(size_t)(16 * wave + 4 * fq + e) * D + 64 * ds + 16 * dt + fr] = f2b(o[dt][e] * inv[e]);
        BLOCK_SYNC();
    }
}
__device__ __forceinline__ void att_sample_unit(const Args& A, LAS unsigned char* lds, int l, int s, int hp, int tid, int lane, int wave) {
    asm volatile("" : "+v"(tid)); lane = tid & 63; wave = __builtin_amdgcn_readfirstlane(tid >> 6);
    unsigned char* ws = A.ws; const bf16* Q = (const bf16*)(ws + WS_Q) + (size_t)(MP + s) * D + hp * 1024;
    const float* K = A.in[I_CK] + (((size_t)l * MS + s) * NMEM) * D + hp * 1024; const float* V = A.in[I_CV] + (((size_t)l * MS + s) * NMEM) * D + hp * 1024;
    LAS float* SC = (LAS float*)lds; LAS float* RED = (LAS float*)(lds + 2048);
    f32x4 q[4];
#pragma unroll
    for (int j = 0; j < 4; ++j) { const v2u w = *(const GAS v2u*)(Q + 4 * lane + 256 * j); q[j] = (f32x4){bf_lo(w.x), bf_hi(w.x), bf_lo(w.y), bf_hi(w.y)}; }
#pragma unroll 1
    for (int kk = 0; kk < 32; kk += 8) { f32x4 kv[8][4];
        const char* kp = (const char*)(K + (size_t)(32 * wave + kk) * D) + (size_t)lane * 16; asm volatile("" : "+v"(kp));
#pragma unroll
        for (int i = 0; i < 8; ++i)
#pragma unroll
            for (int j = 0; j < 4; ++j) kv[i][j] = __builtin_nontemporal_load((const GAS f32x4*)(kp + (size_t)i * (D * 4) + j * 1024));
#pragma unroll
        for (int i = 0; i < 8; ++i)
#pragma unroll
            for (int j = 0; j < 4; ++j) PIN(kv[i][j]);
#pragma unroll
        for (int i = 0; i < 8; ++i) { const f32x4 a = kv[i][0], b2 = kv[i][1], c = kv[i][2], d = kv[i][3];
            float p0 = (a.x * q[0].x + a.y * q[0].y) + (a.z * q[0].z + a.w * q[0].w) + (b2.x * q[1].x + b2.y * q[1].y) + (b2.z * q[1].z + b2.w * q[1].w);
            float p1 = (c.x * q[2].x + c.y * q[2].y) + (c.z * q[2].z + c.w * q[2].w) + (d.x * q[3].x + d.y * q[3].y) + (d.z * q[3].z + d.w * q[3].w);
            p0 = wave_sum(p0); p1 = wave_sum(p1);
            if (lane == 0) { SC[32 * wave + kk + i] = p0; SC[256 + 32 * wave + kk + i] = p1; } } }
    BLOCK_SYNC();
    if (wave < 2) { const float scale = 0.044194173824159216f; float v[4]; float m = -3.0e38f;
#pragma unroll
        for (int e = 0; e < 4; ++e) { v[e] = SC[256 * wave + lane + 64 * e]; m = fmaxf(m, v[e]); }
        m = wave_max(m);
        float sum = 0.f;
#pragma unroll
        for (int e = 0; e < 4; ++e) { v[e] = __expf((v[e] - m) * scale); sum += v[e]; }
        const float inv = __builtin_amdgcn_rcpf(wave_sum(sum));
#pragma unroll
        for (int e = 0; e < 4; ++e) SC[256 * wave + lane + 64 * e] = v[e] * inv; }
    BLOCK_SYNC();
    f32x4 o[4] = {(f32x4){0.f, 0.f, 0.f, 0.f}, (f32x4){0.f, 0.f, 0.f, 0.f}, (f32x4){0.f, 0.f, 0.f, 0.f}, (f32x4){0.f, 0.f, 0.f, 0.f}};
#pragma unroll 1
    for (int kk = 0; kk < 32; kk += 8) { f32x4 vv[8][4];
        const char* vp = (const char*)(V + (size_t)(32 * wave + kk) * D) + (size_t)lane * 16; asm volatile("" : "+v"(vp));
#pragma unroll
        for (int i = 0; i < 8; ++i)
#pragma unroll
            for (int j = 0; j < 4; ++j) vv[i][j] = __builtin_nontemporal_load((const GAS f32x4*)(vp + (size_t)i * (D * 4) + j * 1024));
#pragma unroll
        for (int i = 0; i < 8; ++i)
#pragma unroll
            for (int j = 0; j < 4; ++j) PIN(vv[i][j]);
#pragma unroll
        for (int i = 0; i < 8; ++i) { const float p0 = SC[32 * wave + kk + i], p1 = SC[256 + 32 * wave + kk + i]; o[0] += vv[i][0] * p0; o[1] += vv[i][1] * p0; o[2] += vv[i][2] * p1; o[3] += vv[i][3] * p1; } }
#pragma unroll
    for (int j = 0; j < 4; ++j) *(LAS f32x4*)(RED + wave * 1024 + 4 * lane + 256 * j) = o[j];
    BLOCK_SYNC();
    { float a0 = 0.f, a1 = 0.f;
#pragma unroll
        for (int w = 0; w < 8; ++w) { const f32x2 v = *(const LAS f32x2*)(RED + w * 1024 + 2 * tid); a0 += v.x; a1 += v.y; }
        *(GAS unsigned*)((bf16*)(ws + WS_SA + SA_O) + sfrag(s, hp * 1024 + 2 * tid, D)) = cvtpk(a0, a1); }
    BLOCK_SYNC();
}

struct SEpiScale {
    bf16* O; int ldc; const unsigned long long* ssq; int act, frag;
    __device__ __forceinline__ void operator()(const f32x4& acc, int r, int c) const { const float rs = pg8::ssq_rstd(ssq[MP + r]); f32x4 v = acc * rs;
        if (act) {
#pragma unroll
            for (int e = 0; e < 4; ++e) { const float a = v[e] > 0.f ? v[e] : 0.f; v[e] = a * a; } }
        v2u w; w.x = cvtpk(v[0], v[1]); w.y = cvtpk(v[2], v[3]); *(GAS v2u*)(O + (frag ? sfrag(r, c, ldc) : (size_t)(MP + r) * ldc + c)) = w; }
};
struct SEpiRes {
    const float* hin; float* h; bf16* hb; bf16* hbf; unsigned long long* ssq_out;
    __device__ __forceinline__ void operator()(const f32x4& acc, int r, int c) const { float* hp = h + (size_t)(MP + r) * D + c; const f32x4 v = *(const GAS f32x4*)(hin + (size_t)r * D + c) + acc; *(GAS f32x4*)hp = v;
        v2u w; w.x = cvtpk(v[0], v[1]); w.y = cvtpk(v[2], v[3]); *(GAS v2u*)(hb + (size_t)(MP + r) * D + c) = w; *(GAS v2u*)(hbf + sfrag(r, c, D)) = w;
        float sq = (v[0] * v[0] + v[1] * v[1]) + (v[2] * v[2] + v[3] * v[3]); sq += __shfl_xor(sq, 16); sq += __shfl_xor(sq, 32);
        if ((threadIdx.x & 48) == 0) pg8::ssq_add(ssq_out + MP + r, sq); }
};
constexpr int SG_RED_OFF = 32 * 4112;
static_assert(SG_RED_OFF + 4096 <= LDSCTL_OFF, "sample_gemm LDS");
template <int ROWS, class Epi> __device__ __forceinline__ void sample_gemm(LAS unsigned char* lds, const bf16* Af, const bf16* Bt, int N, int K, const Epi& E, int nwg_main, int kq, int bx, int G, int tid) {
    asm volatile("" : "+v"(tid)); const int lane = tid & 63, wave = __builtin_amdgcn_readfirstlane(tid >> 6), fr = lane & 15, fq = lane >> 4;
    constexpr int RG = 128 / ROWS;
    const int first = nwg_main % G, ns = first ? G - first : G, nunits = (N / 32) * RG;
    int u0, st, cnt;
    if (first == 0) { u0 = bx; st = G; cnt = u0 < nunits ? (nunits - u0 + st - 1) / st : 0; }
    else if (bx >= first) { u0 = bx - first; st = ns; cnt = u0 < nunits ? (nunits - u0 + st - 1) / st : 0; cnt = cnt < kq ? cnt : kq; }
    else { u0 = ns * kq + bx; st = first; cnt = u0 < nunits ? (nunits - u0 + st - 1) / st : 0; }
    if (cnt == 0) return;
    const int rtl = ROWS == 128 ? wave : ((wave & 3) >> 1), ctw = ROWS == 128 ? 0 : (wave & 1), kh = ROWS == 128 ? 0 : (wave >> 2);
#pragma unroll 1
    for (int j = 0; j < cnt; ++j) { const int u = u0 + j * st, cg = u / RG, rg = u % RG, c0 = 32 * cg, R = rg * (ROWS / 16) + rtl;
        f32x4 acc0 = (f32x4){0.f, 0.f, 0.f, 0.f}, acc1 = (f32x4){0.f, 0.f, 0.f, 0.f};
#pragma unroll 1
        for (int kc = 0; kc < K; kc += 2048) {
            const char* apu = (const char*)(Af + ((size_t)(R * (K >> 5) + ((kc + kh * 1024) >> 5)) << 9)) + (size_t)lane * 16; asm volatile("" : "+v"(apu));
            const char* bsrc = (const char*)(Bt + (size_t)(c0 + 4 * wave) * K + kc) + (size_t)lane * 16; asm volatile("" : "+v"(bsrc));
            LAS unsigned char* bdst = lds + wave * (4 * 4112);
            BLOCK_SYNC();
#pragma unroll
            for (int r = 0; r < 4; ++r) { const char* rowp = bsrc + (size_t)r * K * 2; asm volatile("" : "+v"(rowp));
#pragma unroll
                for (int seg = 0; seg < 4; ++seg) __builtin_amdgcn_global_load_lds((const unsigned*)(rowp + seg * 1024), (LAS unsigned*)(bdst + r * 4112 + seg * 1024), 16, 0, 0); }
            bf16x8 a[32];
#pragma unroll
            for (int i = 0; i < 32; ++i) a[i] = *(const bf16x8*)(apu + (size_t)i * 1024);
#pragma unroll
            for (int i = 0; i < 32; ++i) PIN(a[i]);
            BLOCK_SYNC();
            if constexpr (ROWS == 32) {
                const LAS unsigned char* bp = lds + (16 * ctw + fr) * 4112 + kh * 2048 + 16 * fq;
#pragma unroll
                for (int i = 0; i < 32; i += 2) { acc0 = mfma16(ldsfrag(bp + 64 * i), a[i], acc0); acc1 = mfma16(ldsfrag(bp + 64 * (i + 1)), a[i + 1], acc1); }
            } else {
                const LAS unsigned char* bp = lds + fr * 4112 + 16 * fq;
#pragma unroll
                for (int i = 0; i < 32; ++i) { acc0 = mfma16(ldsfrag(bp + 64 * i), a[i], acc0); acc1 = mfma16(ldsfrag(bp + 16 * 4112 + 64 * i), a[i], acc1); }
                const char* apu2 = apu + 32 * 1024; asm volatile("" : "+v"(apu2), "+v"(acc0), "+v"(acc1));
#pragma unroll
                for (int i = 0; i < 32; ++i) a[i] = *(const bf16x8*)(apu2 + (size_t)i * 1024);
#pragma unroll
                for (int i = 0; i < 32; ++i) PIN(a[i]);
#pragma unroll
                for (int i = 0; i < 32; ++i) { acc0 = mfma16(ldsfrag(bp + 64 * (32 + i)), a[i], acc0); acc1 = mfma16(ldsfrag(bp + 16 * 4112 + 64 * (32 + i)), a[i], acc1); }
            } }
        if constexpr (ROWS == 32) {
            f32x4 acc = acc0 + acc1; LAS f32x4* red = (LAS f32x4*)(lds + SG_RED_OFF) + (wave & 3) * 64 + lane;
            if (kh == 1) *red = acc;
            BLOCK_SYNC();
            if (kh == 0) { acc += *red; E(acc, 32 * rg + 16 * rtl + fr, c0 + 16 * ctw + 4 * fq); }
        } else { E(acc0, 16 * wave + fr, c0 + 4 * fq); E(acc1, 16 * wave + fr, c0 + 16 + 4 * fq); } }
    BLOCK_SYNC();
}

__device__ __forceinline__ void final_norm(const Args& A, int vcu, int G, int wave, int lane, int mb = 0) {
    asm volatile("" : "+v"(lane));
    unsigned char* ws = A.ws; const float* H = (const float*)(ws + WS_H); const unsigned long long* ssq = (const unsigned long long*)((const unsigned*)(ws + WS_CTL) + CW_SSQ) + 6 * MPAD; const int gw = vcu * NWAVES + wave, NGW = G * NWAVES;
    f32x4 g[8];
#pragma unroll
    for (int j = 0; j < 8; ++j) g[j] = ((const GAS f32x4*)A.in[I_G_FINAL])[lane + 64 * j];
#pragma unroll 1
    for (int m0 = mb + gw; m0 < MR; m0 += 2 * NGW) { const int m1 = m0 + NGW; const bool has1 = m1 < MR; const int m1c = has1 ? m1 : m0;
        const GAS f32x4* h0 = (const GAS f32x4*)(H + (size_t)m0 * D) + lane; const GAS f32x4* h1 = (const GAS f32x4*)(H + (size_t)m1c * D) + lane; f32x4 v0[8], v1[8];
        const GAS v2u* b0 = (const GAS v2u*)((const bf16*)(ws + WS_HB) + (size_t)m0 * D) + lane; const GAS v2u* b1 = (const GAS v2u*)((const bf16*)(ws + WS_HB) + (size_t)m1c * D) + lane;
        if (m0 < MP) {
#pragma unroll
            for (int j = 0; j < 8; ++j) { const v2u w = b0[64 * j]; v0[j] = (f32x4){bf_lo(w.x), bf_hi(w.x), bf_lo(w.y), bf_hi(w.y)}; } }
        else {
#pragma unroll
            for (int j = 0; j < 8; ++j) v0[j] = __builtin_nontemporal_load(h0 + 64 * j); }
        if (m1c < MP) {
#pragma unroll
            for (int j = 0; j < 8; ++j) { const v2u w = b1[64 * j]; v1[j] = (f32x4){bf_lo(w.x), bf_hi(w.x), bf_lo(w.y), bf_hi(w.y)}; } }
        else {
#pragma unroll
            for (int j = 0; j < 8; ++j) v1[j] = __builtin_nontemporal_load(h1 + 64 * j); }
        const float rs0 = pg8::ssq_rstd(ssq[m0]), rs1 = pg8::ssq_rstd(ssq[m1c]);
#pragma unroll
        for (int j = 0; j < 8; ++j) { PIN(v0[j]); PIN(v1[j]); }
        GAS f32x4* o0 = (GAS f32x4*)(A.out + (m0 < MP ? O_YP + (size_t)m0 * D : O_YS + (size_t)(m0 - MP) * D)) + lane;
#pragma unroll
        for (int j = 0; j < 8; ++j) __builtin_nontemporal_store(v0[j] * g[j] * rs0, o0 + 64 * j);
        if (has1) { GAS f32x4* o1 = (GAS f32x4*)(A.out + (m1 < MP ? O_YP + (size_t)m1 * D : O_YS + (size_t)(m1 - MP) * D)) + lane;
#pragma unroll
            for (int j = 0; j < 8; ++j) __builtin_nontemporal_store(v1[j] * g[j] * rs1, o1 + 64 * j); } }
}

#ifndef PROBE_P0
#define PROBE_P0 1
#endif
#ifndef PROBE_MA
#define PROBE_MA 1
#endif
#ifndef PROBE_MC
#define PROBE_MC 1
#endif
#ifndef PROBE_ATT
#define PROBE_ATT 1
#endif
#ifndef PROBE_BAR
#define PROBE_BAR 1
#endif
#ifndef PROBE_KV
#define PROBE_KV 1
#endif
#ifndef PROBE_RES_O
#define PROBE_RES_O 0
#endif
#ifndef PROBE_RES_DOWN
#define PROBE_RES_DOWN 0
#endif
#ifndef PROBE_THIN
#define PROBE_THIN 0
#endif
#ifndef PROBE_SG_IN
#define PROBE_SG_IN 1
#endif
#ifndef PROBE_SG_Q
#define PROBE_SG_Q 1
#endif
#ifndef PROBE_SG_UP
#define PROBE_SG_UP 1
#endif
#ifndef PROBE_UP
#define PROBE_UP 1
#endif
#ifndef PROBE_Q
#define PROBE_Q 1
#endif
constexpr int PH_PER_LAYER = 10, PH_L0 = 3, PH_FINAL = PH_L0 + NL * PH_PER_LAYER, NPHASE = PH_FINAL + 1;
__global__ void __launch_bounds__(NTHR, 2) mk_fwd(Args args) {
    extern __shared__ __attribute__((aligned(16))) unsigned char lds_raw[];
    LAS unsigned char* lds = (LAS unsigned char*)lds_raw;
    volatile LAS unsigned* MISC = (volatile LAS unsigned*)(lds + MISC_OFF);
    int tid = threadIdx.x, lane = tid & 63, wave = __builtin_amdgcn_readfirstlane(tid >> 6);
#define RETID() do { asm volatile("" : "+v"(tid)); lane = tid & 63; wave = __builtin_amdgcn_readfirstlane(tid >> 6); asm volatile("" : "+s"(ws)); } while (0)
    const int G = gridDim.x; const int bx = blockIdx.x; const int vcu = (G % 8 == 0) ? (bx % 8) * (G / 8) + bx / 8 : bx;
    unsigned char* ws = args.ws;
    for (int u = tid; u < (LDS_BYTES - LDSCTL_OFF) / 4; u += NTHR) ((LAS unsigned*)(lds + LDSCTL_OFF))[u] = 0u;
    __syncthreads();
    XcdBarrier bar; bar.bar = (unsigned*)(ws + WS_CTL) + CW_BAR; bar.x = 0; bar.st = nullptr;
    if (!MK_PER_PHASE) bar = xcd_barrier_post((unsigned*)(ws + WS_CTL) + CW_BAR, MISC + 8);
    const int lo = args.ph_lo, hi = args.ph_hi;
#ifdef ONLY_PH
#define IN(k) (((k) < PH_L0 || (k) >= PH_FINAL) ? ((k) == ONLY_PH) : (((k) - PH_L0) % PH_PER_LAYER + PH_L0 == ONLY_PH) && lo <= (k) && (k) < hi)
#else
#define IN(k) (lo <= (k) && (k) < hi)
#endif
#define GRID_BAR() do { if (!MK_PER_PHASE) { for (int rep_ = 0; rep_ < PROBE_BAR; ++rep_) xcd_barrier(bar); } } while (0)
#define SSQ(s) ((unsigned long long*)((unsigned*)(ws + WS_CTL) + CW_SSQ) + (s) * MPAD)
    if (IN(0)) { RETID(); for (int rep = 0; rep < PROBE_P0; ++rep) { p0_prologue(args, lds, vcu, G, wave, lane); __syncthreads(); } GRID_BAR(); }
    if (IN(1)) { RETID();
        pg8::Gemm g{(const bf16*)(ws + WS_MEMB), (const bf16*)(ws + WS_WKV), MROWS, 4 * D, D}; pg8::StaticOrder S; S.init(MROWS, 4 * D, G, bx);
        pg8::EpiKV E{args.out + O_PMK, (size_t)(O_PMV - O_PMK), (bf16*)(ws + WS_KB), (bf16*)(ws + WS_VT), (bf16*)(ws + WS_VB), (const float*)(ws + WS_RSTDM)};
        for (int rep = 0; rep < PROBE_KV; ++rep) pg8::gemm_phase<pg8::EpiKV, pg8::StaticOrder, true, true>(lds + RING_OFF, g, S, E, tid);
        if (G == 256 && bx >= 128) p0_weights(args, lds, (bx - 128) * NWAVES + wave, 128 * NWAVES, P0W_DEF_LO, P0W_DEF_N, 1 << 30, 0, wave, lane);
        GRID_BAR(); }
#define SETUP_LAYER(LL, GG, CC) do { const int ll_ = (LL); pg8::Gemm g{nullptr, nullptr, 1024, 2048, 512, 2048, 2048}; \
        pg8::PreOrder S{(GG), (CC), (const bf16*)(ws + WS_KB) + (size_t)ll_ * 1024 * 2048, (const bf16*)(ws + WS_WQKD) + (size_t)ll_ * 2048 * 2048, (const bf16*)(ws + WS_W + (size_t)ll_ * W_L + WO_O), (const bf16*)(ws + WS_VB) + (size_t)ll_ * 1024 * 2048}; \
        pg8::EpiPre E{(bf16*)(ws + WS_WQK) + (size_t)ll_ * 4 * 1024 * 2048, (bf16*)(ws + WS_VWT) + (size_t)ll_ * 4 * 2048 * 1024}; \
        pg8::gemm_phase<pg8::EpiPre, pg8::PreOrder, true, true>(lds + RING_OFF, g, S, E, tid); } while (0)
    if (IN(2)) { RETID();
        SETUP_LAYER(0, G, bx);
        SETUP_LAYER(1, G, bx);
        GRID_BAR(); }
#pragma unroll 1
    for (int l = 0; l < NL; ++l) {
        const int pb = PH_L0 + l * PH_PER_LAYER; const bf16* wl = (const bf16*)(ws + WS_W + (size_t)l * W_L);
#define GEMM_MAIN(EPI, Aptr, Woff, NN, KK, ...) do { pg8::Gemm g{(const bf16*)(Aptr), (const bf16*)((const unsigned char*)wl + (Woff)), MP, (NN), (KK)}; pg8::StaticOrder S; S.init(MP, (NN), G, bx); \
            EPI E{__VA_ARGS__}; pg8::gemm_phase<EPI, pg8::StaticOrder, true, true>(lds + RING_OFF, g, S, E, tid); } while (0)
        if (IN(pb + 0)) { RETID();
#ifndef NO_DT
            dt_rows(args, lds, l, vcu, G, tid); for (int rep = 0; rep < PROBE_THIN; ++rep) dt_rows(args, lds, l, vcu, G, tid);
#endif
            GEMM_MAIN(pg8::EpiScaleBf16<0>, ws + WS_HB, WO_IN, NIN, D, (bf16*)(ws + WS_PROJ), NIN, SSQ(3 * l));
            for (int rep = 0; rep < PROBE_SG_IN; ++rep)
            sample_gemm<128>(lds, (const bf16*)(ws + WS_SA + SA_HB), (const bf16*)((const unsigned char*)wl + WO_IN), NIN, D, SEpiScale{(bf16*)(ws + WS_PROJ), NIN, SSQ(3 * l), 0, 0}, (MP / 256) * (NIN / 256), 4, bx, G, tid);
            GRID_BAR(); }
        if (IN(pb + 1)) { RETID();
            for (int rep = 0; rep < PROBE_MA; ++rep)
#pragma unroll 1
            for (int u = vcu; u < 512; u += G) { if (u < 256) ma_s5_unit(args, lds, l, u >> 6, u & 63, lane, wave); else { const int v = u - 256; ma_ssd_unit(args, lds, l, v >> 6, (v >> 1) & 31, v & 1, tid, lane, wave); } }
            GRID_BAR(); }
        if (IN(pb + 2)) { RETID(); mb_scan(args, l, vcu, G, tid); for (int rep = 0; rep < PROBE_THIN; ++rep) mb_scan(args, l, vcu, G, tid, 1); GRID_BAR(); }
        if (IN(pb + 3)) { RETID();
            for (int rep = 0; rep < PROBE_MC; ++rep)
#pragma unroll 1
            for (int u = vcu; u < 512; u += G) {
#ifndef NO_MC_S5
                if (u < 256) mc_s5_unit(args, lds, l, u >> 6, u & 63, tid, lane, wave); else
#endif
#ifndef NO_MC_REST
                if (u >= 256 && ((u - 256) & 1) == 0) { const int v = (u - 256) >> 1; mc_rest_unit(args, lds, l, v >> 5, v & 31, tid, lane, wave); } else
#endif
#ifndef NO_MC_SAMPLE
                if (u >= 256 && ((u - 256) & 1) != 0) mc_sample_unit(args, lds, l, (u - 256) >> 1, tid, lane, wave);
#endif
                { } }
            GRID_BAR(); }
        if (IN(pb + 4)) { RETID();
            GEMM_MAIN(pg8::EpiResB, ws + WS_MIX, WO_OUT, D, D, (bf16*)(ws + WS_HB), SSQ(3 * l + 1), D, (l == 0 ? args.in[I_XP] : (const float*)nullptr));
            sample_gemm<32>(lds, (const bf16*)(ws + WS_SA + SA_MIX), (const bf16*)((const unsigned char*)wl + WO_OUT), D, D, SEpiRes{(l == 0 ? args.in[I_XS] : (const float*)(ws + WS_H) + (size_t)MP * D), (float*)(ws + WS_H), (bf16*)(ws + WS_HB), (bf16*)(ws + WS_SA + SA_HB), SSQ(3 * l + 1)}, (MP / 256) * (D / 256), 1, bx, G, tid);
            if (G == 256) {
                GRID_BAR();
                sample_gemm<32>(lds, (const bf16*)(ws + WS_SA + SA_HB), (const bf16*)((const unsigned char*)wl + WO_Q), D, D, SEpiScale{(bf16*)(ws + WS_Q), D, SSQ(3 * l + 1), 0, 0}, 0, 1, bx, G, tid); }
            GRID_BAR(); }
        if (IN(pb + 5)) { RETID();
            { pg8::Gemm g{(const bf16*)(ws + WS_HB), (const bf16*)(ws + WS_WQK) + (size_t)l * 4 * 1024 * 2048, MP, 1024, D}; pg8::BatchBOrder S; S.init(MP, 1024, G, bx); S.pmb = 8; S.bbs = (size_t)1024 * 2048;
                pg8::EpiSoftmax E{(bf16*)(ws + WS_PATT), 1024, SSQ(3 * l + 1), 0.044194173824159216f};
                pg8::gemm_phase<pg8::EpiSoftmax, pg8::BatchBOrder, false, true>(lds + RING_OFF, g, S, E, tid); }
            if (G == 256) { if (bx >= 128) att_sample_unit(args, lds, l, bx - 128, 0, tid, lane, wave); }
            else
            sample_gemm<32>(lds, (const bf16*)(ws + WS_SA + SA_HB), (const bf16*)((const unsigned char*)wl + WO_Q), D, D, SEpiScale{(bf16*)(ws + WS_Q), D, SSQ(3 * l + 1), 0, 0}, 128, 2, bx, G, tid);
            GRID_BAR(); }
        if (IN(pb + 6)) { RETID();
            if (bx < 128 || G != 256) { pg8::Gemm g{(const bf16*)(ws + WS_PATT), (const bf16*)(ws + WS_VWT) + (size_t)l * 4 * 2048 * 1024, MP, D, 1024}; pg8::BatchBOrder S; S.init(MP, D, G == 256 ? 128 : G, bx); S.pmb = 8; S.bbs = (size_t)2048 * 1024;
                pg8::EpiResB E{(bf16*)(ws + WS_HB), SSQ(3 * l + 2), D, nullptr};
                pg8::gemm_phase<pg8::EpiResB, pg8::BatchBOrder, true, true>(lds + RING_OFF, g, S, E, tid); }
            if (bx >= 128 || G != 256) {
#pragma unroll 1
                for (int i = (G == 256) ? 1 : 0; i < 2; ++i) for (int c = (G == 256 ? bx - 128 : bx); c < 128; c += (G == 256 ? 128 : G)) { const int u = c * 2 + i; att_sample_unit(args, lds, l, u >> 1, u & 1, tid, lane, wave); }
                }
            GRID_BAR(); }
        if (IN(pb + 7)) { RETID();
            sample_gemm<32>(lds, (const bf16*)(ws + WS_SA + SA_O), (const bf16*)((const unsigned char*)wl + WO_O), D, D, SEpiRes{(const float*)(ws + WS_H) + (size_t)MP * D, (float*)(ws + WS_H), (bf16*)(ws + WS_HB), (bf16*)(ws + WS_SA + SA_HB), SSQ(3 * l + 2)}, 0, 1, bx, G, tid);
            GRID_BAR(); }
        if (IN(pb + 8)) { RETID();
            for (int rep = 0; rep < PROBE_UP; ++rep)
            GEMM_MAIN(pg8::EpiScaleBf16<1>, ws + WS_HB, WO_UP, FF, D, (bf16*)(ws + WS_HID), FF, SSQ(3 * l + 2));
            for (int rep = 0; rep < PROBE_SG_UP; ++rep)
            sample_gemm<128>(lds, (const bf16*)(ws + WS_SA + SA_HB), (const bf16*)((const unsigned char*)wl + WO_UP), FF, D, SEpiScale{(bf16*)(ws + WS_SA + SA_HID), FF, SSQ(3 * l + 2), 1, 1}, (MP / 256) * (FF / 256), 1, bx, G, tid);
            GRID_BAR(); }
        if (IN(pb + 9)) { RETID();
#define SFIRST() ([&]() { pg8::StaticOrder S0; S0.init(MP, D, G, bx); pg8::Unit u0; return G == 256 && S0.next(0, u0) && (u0.pm & 1) != 0; }())
            if (SFIRST()) { sample_gemm<32>(lds, (const bf16*)(ws + WS_SA + SA_HID), (const bf16*)((const unsigned char*)wl + WO_DOWN), D, FF, SEpiRes{(const float*)(ws + WS_H) + (size_t)MP * D, (float*)(ws + WS_H), (bf16*)(ws + WS_HB), (bf16*)(ws + WS_SA + SA_HB), SSQ(3 * l + 3)}, (MP / 256) * (D / 256), 1, bx, G, tid); }
            if (l == NL - 1 && G == 256) { pg8::Gemm g{(const bf16*)(ws + WS_HID), (const bf16*)((const unsigned char*)wl + WO_DOWN), MP, D, FF}; pg8::StaticOrder S; S.init(MP, D, G, bx);
                pg8::EpiResFinal E{(const bf16*)(ws + WS_HB), args.out + O_YP, args.in[I_G_FINAL], SSQ(3 * l + 3), (unsigned*)(ws + WS_CTL) + CW_FCNT, D};
                pg8::gemm_phase<pg8::EpiResFinal, pg8::StaticOrder, false, true>(lds + RING_OFF, g, S, E, tid); }
            else
            GEMM_MAIN(pg8::EpiResB, ws + WS_HID, WO_DOWN, D, FF, (bf16*)(ws + WS_HB), SSQ(3 * l + 3), D, nullptr);
            if (!SFIRST()) { sample_gemm<32>(lds, (const bf16*)(ws + WS_SA + SA_HID), (const bf16*)((const unsigned char*)wl + WO_DOWN), D, FF, SEpiRes{(const float*)(ws + WS_H) + (size_t)MP * D, (float*)(ws + WS_H), (bf16*)(ws + WS_HB), (bf16*)(ws + WS_SA + SA_HB), SSQ(3 * l + 3)}, (MP / 256) * (D / 256), 1, bx, G, tid); }
#undef SFIRST
            GRID_BAR(); }
#undef GEMM_MAIN
    }
    if (IN(PH_FINAL)) { final_norm(args, vcu, G, wave, lane, G == 256 ? MP : 0); }
#undef IN
#undef GRID_BAR
#undef SSQ
}

extern "C" void kernel_launch(void* const* d_in, const int* in_sizes, int n_in, void* d_out, int out_size, void* d_ws, size_t ws_size, hipStream_t stream) {
    static int grid = 0;
    if (grid == 0) {
        if (n_in != N_IN || in_sizes[0] != MP * D || (size_t)out_size != O_END || ws_size < WS_END) { fprintf(stderr, "kernel_launch: unexpected problem (n_in %d, in0 %d, out %d, ws %zu); nothing launched\n", n_in, n_in > 0 ? in_sizes[0] : -1, out_size, ws_size); grid = -1; return; }
        int dev = 0, cus = 0, per_cu = 0;
        if (hipGetDevice(&dev) != hipSuccess || hipDeviceGetAttribute(&cus, hipDeviceAttributeMultiprocessorCount, dev) != hipSuccess) { fprintf(stderr, "kernel_launch: device query failed\n"); grid = -1; return; }
        if (hipFuncSetAttribute((const void*)mk_fwd, hipFuncAttributeMaxDynamicSharedMemorySize, LDS_BYTES) != hipSuccess) { fprintf(stderr, "kernel_launch: hipFuncSetAttribute failed\n"); grid = -1; return; }
        if (hipOccupancyMaxActiveBlocksPerMultiprocessor(&per_cu, (const void*)mk_fwd, NTHR, LDS_BYTES) != hipSuccess || per_cu < 1) fprintf(stderr, "kernel_launch: note: occupancy query reports %d workgroups per CU\n", per_cu);
        (void)hipGetLastError();
        grid = cus;
    }
    if (grid < 0) return;
    if (hipMemsetAsync((char*)d_ws + WS_CTL, 0, CTL_ZERO_BYTES, stream) != hipSuccess) { fprintf(stderr, "kernel_launch: hipMemsetAsync failed\n"); return; }
    Args a{};
    for (int i = 0; i < N_IN; ++i) a.in[i] = (const float*)d_in[i];
    a.out = (float*)d_out; a.ws = (unsigned char*)d_ws;
#if MK_PER_PHASE
    for (int p = 0; p < NPHASE; ++p) { a.ph_lo = p; a.ph_hi = p + 1; hipLaunchKernelGGL(mk_fwd, dim3(grid), dim3(NTHR), LDS_BYTES, stream, a); }
#else
    a.ph_lo = 0; a.ph_hi = NPHASE; hipLaunchKernelGGL(mk_fwd, dim3(grid), dim3(NTHR), LDS_BYTES, stream, a);
#endif
    const hipError_t le = hipPeekAtLastError();
    if (le != hipSuccess) fprintf(stderr, "kernel_launch: launch failed: %s\n", hipGetErrorName(le));
}
```

```cpp
#include <hip/hip_runtime.h>
#include <cstdio>
#include <cstdint>
namespace pg8 {
#define PG8_LAS __attribute__((address_space(3)))
typedef unsigned short bf16_t;
typedef short bf16x8 __attribute__((ext_vector_type(8)));
typedef float f32x4 __attribute__((ext_vector_type(4)));
typedef unsigned u32x4 __attribute__((ext_vector_type(4)));
constexpr int BM = 256, BK = 64, HALF = 128, HTB = HALF * BK * 2  , STAGE_BYTES = 8 * HTB, NXCD = 8, WGM = 8;

__host__ __device__ __forceinline__ int lds_byte(int r, int c) { const int st = (r >> 4) * 2 + (c >> 5), rr = r & 15, cc = c & 31, ob = rr * 64 + cc * 2; return st * 1024 + (ob ^ (((ob >> 9) & 1) << 5)); }
__host__ __device__ __forceinline__ void stage_rc(int b, int& R, int& C) { const int st = b / 1024, sb = b % 1024, swz = sb ^ (((sb >> 9) & 1) << 5); R = (st >> 1) * 16 + swz / 64; C = (st & 1) * 32 + (swz % 64) / 2; }
__host__ __device__ __forceinline__ int perm32(int rho) { const int n = rho >> 4, i = rho & 15; return 8 * (i >> 2) + 4 * n + (i & 3); }

struct Unit { int pm, pn, z; };
struct Gemm { const bf16_t* A; const bf16_t* Bt; int M, N, K; int lda = 0, ldb = 0; };

struct StaticOrder {
    int nM, nN, nwg, G, c;
    __host__ __device__ void init(int M, int N, int G_, int c_) { nM = M / BM; nN = N / BM; nwg = nM * nN; G = G_; c = c_; }
    __host__ __device__ bool next(int i, Unit& u) const {
        const long L = (long)i * G + c; if (L >= nwg) return false;
        int wgid = (int)L; { const int q = nwg / NXCD, r = nwg % NXCD, xcd = wgid % NXCD, off = wgid / NXCD; wgid = (xcd < r ? xcd * (q + 1) : r * (q + 1) + (xcd - r) * q) + off; }
        const int nig = WGM * nN, gid = wgid / nig, fm = gid * WGM, gsz = (nM - fm) < WGM ? (nM - fm) : WGM;
        u.pm = fm + ((wgid % nig) % gsz); u.pn = (wgid % nig) / gsz; u.z = 0; return true;
    }
    __device__ __forceinline__ void a_ready(const Unit&) const {}
    __device__ __forceinline__ void done(const Unit&) const {}
    __device__ __forceinline__ const char* abase(const Gemm& g, const Unit& u) const { return (const char*)g.A + (size_t)u.pm * 256 * (size_t)(g.lda ? g.lda : g.K) * 2; }
    __device__ __forceinline__ const char* bbase(const Gemm& g, const Unit& u) const { return (const char*)g.Bt + (size_t)u.pn * 256 * (size_t)(g.ldb ? g.ldb : g.K) * 2; }
};


struct PreOrder {
    int G, c; const bf16_t* a0; const bf16_t* b0; const bf16_t* a1; const bf16_t* b1;
    __device__ __forceinline__ bool next(int i, Unit& u) const { const long L = (long)i * G + c; if (L >= 256) return false; const int mode = (int)(L >> 7), head = (int)((L & 127) >> 5), x = (int)((L & 31) >> 3), y = (int)(L & 7);
        u.z = mode * 4 + head; u.pm = mode ? y : x; u.pn = mode ? x : y; return true; }
    __device__ __forceinline__ void a_ready(const Unit&) const {}
    __device__ __forceinline__ void done(const Unit&) const {}
    __device__ __forceinline__ const char* abase(const Gemm&, const Unit& u) const { return (const char*)((u.z >> 2) ? a1 : a0) + ((size_t)u.pm * 256 * 2048 + (size_t)(u.z & 3) * 512) * 2; }
    __device__ __forceinline__ const char* bbase(const Gemm&, const Unit& u) const { return (const char*)((u.z >> 2) ? b1 : b0) + ((size_t)u.pn * 256 * 2048 + (size_t)(u.z & 3) * 512) * 2; }
};
typedef float cvt_f32x2 __attribute__((ext_vector_type(2)));
typedef __bf16 cvt_bf16x2 __attribute__((ext_vector_type(2)));
__device__ __forceinline__ unsigned cvt_pk_bf16(float lo, float hi) { const cvt_f32x2 v = {lo, hi}; return __builtin_bit_cast(unsigned, __builtin_convertvector(v, cvt_bf16x2)); }

__device__ __forceinline__ void ssq_add(unsigned long long* p, float v) { (void)__hip_atomic_fetch_add(p, (unsigned long long)__float2ull_rn(v * 16777216.0f), __ATOMIC_RELAXED, __HIP_MEMORY_SCOPE_AGENT); }
__device__ __forceinline__ float ssq_rstd(unsigned long long v) { return __builtin_amdgcn_rsqf((float)v * (1.0f / (16777216.0f * 2048.0f)) + 1e-6f); }
template <int ACT> struct EpiScaleBf16 {
    static constexpr bool PERM = true, AFTER_DRAIN = false;
    bf16_t* O; int ldc; const unsigned long long* ssq;
    __device__ __forceinline__ void operator()(const f32x4 (&acc)[2][2][4][2], const Unit& u, int wr, int wc, int fr, int fq) const {
        const int row0 = u.pm * BM + wr * 64 + fr, col0 = u.pn * BM + wc * 32 + 8 * fq;
        unsigned long long sv[2][4];
#pragma unroll
        for (int ai = 0; ai < 2; ++ai)
#pragma unroll
            for (int m = 0; m < 4; ++m) sv[ai][m] = ssq[row0 + ai * HALF + m * 16];
#pragma unroll
        for (int ai = 0; ai < 2; ++ai)
#pragma unroll
            for (int m = 0; m < 4; ++m) asm volatile("" : "+v"(sv[ai][m]));
#pragma unroll
        for (int ai = 0; ai < 2; ++ai)
#pragma unroll
            for (int m = 0; m < 4; ++m) { const int row = row0 + ai * HALF + m * 16; const float rs = ssq_rstd(sv[ai][m]);
                bf16_t* rowp = O + (size_t)row * ldc + col0;
#pragma unroll
                for (int bj = 0; bj < 2; ++bj) { f32x4 v0 = acc[ai][bj][m][0] * rs, v1 = acc[ai][bj][m][1] * rs;
                    if (ACT == 1) {
#pragma unroll
                        for (int e = 0; e < 4; ++e) { const float a0 = v0[e] > 0.f ? v0[e] : 0.f, a1 = v1[e] > 0.f ? v1[e] : 0.f; v0[e] = a0 * a0; v1[e] = a1 * a1; } }
                    u32x4 w; w.x = cvt_pk_bf16(v0[0], v0[1]); w.y = cvt_pk_bf16(v0[2], v0[3]); w.z = cvt_pk_bf16(v1[0], v1[1]); w.w = cvt_pk_bf16(v1[2], v1[3]);
                    *(u32x4*)(rowp + bj * HALF) = w; } }
    }
};
struct EpiRes {
    static constexpr bool PERM = true, AFTER_DRAIN = false;
    const float* hin; float* h; bf16_t* hb; unsigned long long* ssq_out; int ldc;
    __device__ __forceinline__ void operator()(const f32x4 (&acc)[2][2][4][2], const Unit& u, int wr, int wc, int fr, int fq) const {
        const int row0 = u.pm * BM + wr * 64 + fr, col0 = u.pn * BM + wc * 32 + 8 * fq;
#pragma unroll
        for (int ai = 0; ai < 2; ++ai) {
            f32x4 hv[4][2][2];
#pragma unroll
            for (int m = 0; m < 4; ++m) { const float* hp = hin + (size_t)(row0 + ai * HALF + m * 16) * ldc + col0;
#pragma unroll
                for (int bj = 0; bj < 2; ++bj) { hv[m][bj][0] = *(const f32x4*)(hp + bj * HALF); hv[m][bj][1] = *(const f32x4*)(hp + bj * HALF + 4); } }
#pragma unroll
            for (int m = 0; m < 4; ++m)
#pragma unroll
                for (int bj = 0; bj < 2; ++bj) { asm volatile("" : "+v"(hv[m][bj][0])); asm volatile("" : "+v"(hv[m][bj][1])); }
#pragma unroll
            for (int m = 0; m < 4; ++m) { const int row = row0 + ai * HALF + m * 16; float sq = 0.f;
                float* hp = h + (size_t)row * ldc + col0; bf16_t* bp = hb + (size_t)row * ldc + col0;
#pragma unroll
                for (int bj = 0; bj < 2; ++bj) { f32x4 v0 = hv[m][bj][0] + acc[ai][bj][m][0], v1 = hv[m][bj][1] + acc[ai][bj][m][1];
                    *(f32x4*)(hp + bj * HALF) = v0; *(f32x4*)(hp + bj * HALF + 4) = v1;
                    sq += (v0[0] * v0[0] + v0[1] * v0[1]) + (v0[2] * v0[2] + v0[3] * v0[3]) + (v1[0] * v1[0] + v1[1] * v1[1]) + (v1[2] * v1[2] + v1[3] * v1[3]);
                    u32x4 w; w.x = cvt_pk_bf16(v0[0], v0[1]); w.y = cvt_pk_bf16(v0[2], v0[3]); w.z = cvt_pk_bf16(v1[0], v1[1]); w.w = cvt_pk_bf16(v1[2], v1[3]);
                    *(u32x4*)(bp + bj * HALF) = w; }
                sq += __shfl_xor(sq, 16); sq += __shfl_xor(sq, 32);
                if (fq == 0) ssq_add(ssq_out + row, sq); } }
    }
};
struct EpiResB {
    static constexpr bool PERM = true, AFTER_DRAIN = false;
    bf16_t* hb; unsigned long long* ssq_out; int ldc; const float* xin;
    __device__ __forceinline__ void operator()(const f32x4 (&acc)[2][2][4][2], const Unit& u, int wr, int wc, int fr, int fq) const {
        const int row0 = u.pm * BM + wr * 64 + fr, col0 = u.pn * BM + wc * 32 + 8 * fq;
        if (xin) {
#pragma unroll
            for (int ai = 0; ai < 2; ++ai) {
                f32x4 xv[4][2][2];
#pragma unroll
                for (int m = 0; m < 4; ++m) { const float* hp = xin + (size_t)(row0 + ai * HALF + m * 16) * ldc + col0;
#pragma unroll
                    for (int bj = 0; bj < 2; ++bj) { xv[m][bj][0] = *(const f32x4*)(hp + bj * HALF); xv[m][bj][1] = *(const f32x4*)(hp + bj * HALF + 4); } }
#pragma unroll
                for (int m = 0; m < 4; ++m)
#pragma unroll
                    for (int bj = 0; bj < 2; ++bj) { asm volatile("" : "+v"(xv[m][bj][0])); asm volatile("" : "+v"(xv[m][bj][1])); }
#pragma unroll
                for (int m = 0; m < 4; ++m) { const int row = row0 + ai * HALF + m * 16; float sq = 0.f; bf16_t* bp = hb + (size_t)row * ldc + col0;
#pragma unroll
                    for (int bj = 0; bj < 2; ++bj) { const f32x4 v0 = xv[m][bj][0] + acc[ai][bj][m][0], v1 = xv[m][bj][1] + acc[ai][bj][m][1];
                        sq += (v0[0] * v0[0] + v0[1] * v0[1]) + (v0[2] * v0[2] + v0[3] * v0[3]) + (v1[0] * v1[0] + v1[1] * v1[1]) + (v1[2] * v1[2] + v1[3] * v1[3]);
                        u32x4 w; w.x = cvt_pk_bf16(v0[0], v0[1]); w.y = cvt_pk_bf16(v0[2], v0[3]); w.z = cvt_pk_bf16(v1[0], v1[1]); w.w = cvt_pk_bf16(v1[2], v1[3]);
                        *(u32x4*)(bp + bj * HALF) = w; }
                    sq += __shfl_xor(sq, 16); sq += __shfl_xor(sq, 32);
                    if (fq == 0) ssq_add(ssq_out + row, sq); } }
            return; }
        u32x4 hv[2][4][2];
#pragma unroll
        for (int ai = 0; ai < 2; ++ai)
#pragma unroll
            for (int m = 0; m < 4; ++m) { const bf16_t* bp = hb + (size_t)(row0 + ai * HALF + m * 16) * ldc + col0;
#pragma unroll
                for (int bj = 0; bj < 2; ++bj) hv[ai][m][bj] = *(const u32x4*)(bp + bj * HALF); }
#pragma unroll
        for (int ai = 0; ai < 2; ++ai)
#pragma unroll
            for (int m = 0; m < 4; ++m) { asm volatile("" : "+v"(hv[ai][m][0])); asm volatile("" : "+v"(hv[ai][m][1])); }
#pragma unroll
        for (int ai = 0; ai < 2; ++ai)
#pragma unroll
            for (int m = 0; m < 4; ++m) { const int row = row0 + ai * HALF + m * 16; float sq = 0.f; bf16_t* bp = hb + (size_t)row * ldc + col0;
#pragma unroll
                for (int bj = 0; bj < 2; ++bj) { const u32x4 w0 = hv[ai][m][bj];
                    const f32x4 v0 = (f32x4){__uint_as_float(w0.x << 16), __uint_as_float(w0.x & 0xffff0000u), __uint_as_float(w0.y << 16), __uint_as_float(w0.y & 0xffff0000u)} + acc[ai][bj][m][0];
                    const f32x4 v1 = (f32x4){__uint_as_float(w0.z << 16), __uint_as_float(w0.z & 0xffff0000u), __uint_as_float(w0.w << 16), __uint_as_float(w0.w & 0xffff0000u)} + acc[ai][bj][m][1];
                    sq += (v0[0] * v0[0] + v0[1] * v0[1]) + (v0[2] * v0[2] + v0[3] * v0[3]) + (v1[0] * v1[0] + v1[1] * v1[1]) + (v1[2] * v1[2] + v1[3] * v1[3]);
                    u32x4 w; w.x = cvt_pk_bf16(v0[0], v0[1]); w.y = cvt_pk_bf16(v0[2], v0[3]); w.z = cvt_pk_bf16(v1[0], v1[1]); w.w = cvt_pk_bf16(v1[2], v1[3]);
                    *(u32x4*)(bp + bj * HALF) = w; }
                sq += __shfl_xor(sq, 16); sq += __shfl_xor(sq, 32);
                if (fq == 0) ssq_add(ssq_out + row, sq); }
    }
};
struct EpiResFinal {
    static constexpr bool PERM = true, AFTER_DRAIN = true;
    const bf16_t* hin; float* y; const float* gfin; unsigned long long* ssq_out; unsigned* cnt; int ldc;
    __device__ __forceinline__ void operator()(const f32x4 (&)[2][2][4][2], const Unit&, int, int, int, int) const {}
    __device__ __forceinline__ void fused(f32x4 (&acc)[2][2][4][2], const Unit& u, int wr, int wc, int fr, int fq, PG8_LAS unsigned char*, int wid, int lane) const {
        const int row0 = u.pm * BM + wr * 64 + fr, col0 = u.pn * BM + wc * 32 + 8 * fq;
#pragma unroll
        for (int ai = 0; ai < 2; ++ai) {
            u32x4 hv[4][2];
#pragma unroll
            for (int m = 0; m < 4; ++m) { const bf16_t* hp = hin + (size_t)(row0 + ai * HALF + m * 16) * ldc + col0;
#pragma unroll
                for (int bj = 0; bj < 2; ++bj) hv[m][bj] = *(const u32x4*)(hp + bj * HALF); }
#pragma unroll
            for (int m = 0; m < 4; ++m) { asm volatile("" : "+v"(hv[m][0])); asm volatile("" : "+v"(hv[m][1])); }
#pragma unroll
            for (int m = 0; m < 4; ++m) { const int row = row0 + ai * HALF + m * 16; float sq = 0.f;
#pragma unroll
                for (int bj = 0; bj < 2; ++bj) { const u32x4 w0 = hv[m][bj];
                    const f32x4 v0 = (f32x4){__uint_as_float(w0.x << 16), __uint_as_float(w0.x & 0xffff0000u), __uint_as_float(w0.y << 16), __uint_as_float(w0.y & 0xffff0000u)} + acc[ai][bj][m][0];
                    const f32x4 v1 = (f32x4){__uint_as_float(w0.z << 16), __uint_as_float(w0.z & 0xffff0000u), __uint_as_float(w0.w << 16), __uint_as_float(w0.w & 0xffff0000u)} + acc[ai][bj][m][1];
                    acc[ai][bj][m][0] = v0; acc[ai][bj][m][1] = v1;
                    sq += (v0[0] * v0[0] + v0[1] * v0[1]) + (v0[2] * v0[2] + v0[3] * v0[3]) + (v1[0] * v1[0] + v1[1] * v1[1]) + (v1[2] * v1[2] + v1[3] * v1[3]); }
                sq += __shfl_xor(sq, 16); sq += __shfl_xor(sq, 32);
                if (fq == 0) ssq_add(ssq_out + row, sq); } }
        asm volatile("s_waitcnt vmcnt(0)" ::: "memory");
        __builtin_amdgcn_s_barrier(); asm volatile("" ::: "memory");
        if (wid == 0 && lane == 0) { unsigned* c = cnt + u.pm * 64;
            (void)__hip_atomic_fetch_add(c, 1u, __ATOMIC_RELAXED, __HIP_MEMORY_SCOPE_AGENT);
            unsigned sp = 0; while (__hip_atomic_load(c, __ATOMIC_RELAXED, __HIP_MEMORY_SCOPE_AGENT) < 8u) { __builtin_amdgcn_s_sleep(1); if (++sp > (1u << 22)) break; } }
        __builtin_amdgcn_s_barrier(); asm volatile("" ::: "memory");
        unsigned long long sv[2][4];
#pragma unroll
        for (int ai = 0; ai < 2; ++ai)
#pragma unroll
            for (int m = 0; m < 4; ++m) sv[ai][m] = __hip_atomic_load(ssq_out + row0 + ai * HALF + m * 16, __ATOMIC_RELAXED, __HIP_MEMORY_SCOPE_AGENT);
        f32x4 gv[2][2];
#pragma unroll
        for (int bj = 0; bj < 2; ++bj) { gv[bj][0] = *(const f32x4*)(gfin + col0 + bj * HALF); gv[bj][1] = *(const f32x4*)(gfin + col0 + bj * HALF + 4); }
#pragma unroll
        for (int ai = 0; ai < 2; ++ai)
#pragma unroll
            for (int m = 0; m < 4; ++m) asm volatile("" : "+v"(sv[ai][m]));
#pragma unroll
        for (int ai = 0; ai < 2; ++ai)
#pragma unroll
            for (int m = 0; m < 4; ++m) { const float rs = ssq_rstd(sv[ai][m]); float* yp = y + (size_t)(row0 + ai * HALF + m * 16) * ldc + col0;
#pragma unroll
                for (int bj = 0; bj < 2; ++bj) { *(f32x4*)(yp + bj * HALF) = acc[ai][bj][m][0] * gv[bj][0] * rs; *(f32x4*)(yp + bj * HALF + 4) = acc[ai][bj][m][1] * gv[bj][1] * rs; } }
    }
};
struct BatchBOrder : StaticOrder {
    int pmb; size_t bbs;
    __device__ __forceinline__ const char* bbase(const Gemm& g, const Unit& u) const { return (const char*)g.Bt + ((size_t)(u.pm / pmb) * bbs + (size_t)u.pn * 256 * (size_t)(g.ldb ? g.ldb : g.K)) * 2; }
};
struct EpiSoftmax {
    static constexpr bool PERM = true, AFTER_DRAIN = true;
    bf16_t* P; int ldc; const unsigned long long* ssq; float scale;
    __device__ __forceinline__ void operator()(const f32x4 (&)[2][2][4][2], const Unit&, int, int, int, int) const {}
    __device__ __forceinline__ void fused(f32x4 (&acc)[2][2][4][2], const Unit& u, int wr, int wc, int fr, int fq, PG8_LAS unsigned char* lds, int wid, int lane) const {
        PG8_LAS float* RM = (PG8_LAS float*)lds; PG8_LAS float* RS = (PG8_LAS float*)(lds + 4096);
        const int r0 = wr * 64 + fr, row0 = u.pm * BM + r0, col0 = u.pn * BM + wc * 32 + 8 * fq;
        unsigned long long sv[2][4];
#pragma unroll
        for (int ai = 0; ai < 2; ++ai)
#pragma unroll
            for (int m = 0; m < 4; ++m) sv[ai][m] = ssq[row0 + ai * HALF + m * 16];
#pragma unroll
        for (int ai = 0; ai < 2; ++ai)
#pragma unroll
            for (int m = 0; m < 4; ++m) asm volatile("" : "+v"(sv[ai][m]));
#pragma unroll
        for (int ai = 0; ai < 2; ++ai)
#pragma unroll
            for (int m = 0; m < 4; ++m) { const float sc = ssq_rstd(sv[ai][m]) * scale; float mx = -3.0e38f;
#pragma unroll
                for (int bj = 0; bj < 2; ++bj)
#pragma unroll
                    for (int n = 0; n < 2; ++n) { f32x4 v = acc[ai][bj][m][n] * sc; acc[ai][bj][m][n] = v; mx = fmaxf(fmaxf(mx, fmaxf(v[0], v[1])), fmaxf(v[2], v[3])); }
                mx = fmaxf(mx, __shfl_xor(mx, 16)); mx = fmaxf(mx, __shfl_xor(mx, 32));
                if (fq == 0) RM[(r0 + ai * HALF + m * 16) * 4 + wc] = mx; }
        asm volatile("s_waitcnt lgkmcnt(0)" ::: "memory"); __builtin_amdgcn_s_barrier(); asm volatile("" ::: "memory");
#pragma unroll
        for (int ai = 0; ai < 2; ++ai)
#pragma unroll
            for (int m = 0; m < 4; ++m) { const f32x4 q = *(const PG8_LAS f32x4*)(RM + (r0 + ai * HALF + m * 16) * 4); const float mx = fmaxf(fmaxf(q[0], q[1]), fmaxf(q[2], q[3])); float sm = 0.f;
#pragma unroll
                for (int bj = 0; bj < 2; ++bj)
#pragma unroll
                    for (int n = 0; n < 2; ++n) { f32x4 v = acc[ai][bj][m][n];
#pragma unroll
                        for (int e = 0; e < 4; ++e) { v[e] = __expf(v[e] - mx); sm += v[e]; }
                        acc[ai][bj][m][n] = v; }
                sm += __shfl_xor(sm, 16); sm += __shfl_xor(sm, 32);
                if (fq == 0) RS[(r0 + ai * HALF + m * 16) * 4 + wc] = sm; }
        asm volatile("s_waitcnt lgkmcnt(0)" ::: "memory"); __builtin_amdgcn_s_barrier(); asm volatile("" ::: "memory");
#pragma unroll
        for (int ai = 0; ai < 2; ++ai)
#pragma unroll
            for (int m = 0; m < 4; ++m) { const f32x4 q = *(const PG8_LAS f32x4*)(RS + (r0 + ai * HALF + m * 16) * 4); const float inv = __builtin_amdgcn_rcpf((q[0] + q[1]) + (q[2] + q[3]));
                bf16_t* rowp = P + (size_t)(row0 + ai * HALF + m * 16) * ldc + col0;
#pragma unroll
                for (int bj = 0; bj < 2; ++bj) { const f32x4 v0 = acc[ai][bj][m][0] * inv, v1 = acc[ai][bj][m][1] * inv;
                    u32x4 w; w.x = cvt_pk_bf16(v0[0], v0[1]); w.y = cvt_pk_bf16(v0[2], v0[3]); w.z = cvt_pk_bf16(v1[0], v1[1]); w.w = cvt_pk_bf16(v1[2], v1[3]);
                    *(u32x4*)(rowp + bj * HALF) = w; } }
    }
};
struct EpiPre {
    static constexpr bool PERM = true, AFTER_DRAIN = false;
    bf16_t* wqk; bf16_t* vwt;
    __device__ __forceinline__ void operator()(const f32x4 (&acc)[2][2][4][2], const Unit& u, int wr, int wc, int fr, int fq) const {
        const int mode = u.z >> 2, head = u.z & 3, r0 = wr * 64 + fr, c0 = wc * 32 + 8 * fq;
#pragma unroll
        for (int ai = 0; ai < 2; ++ai)
#pragma unroll
            for (int m = 0; m < 4; ++m) { const int r = r0 + ai * HALF + m * 16;
#pragma unroll
                for (int bj = 0; bj < 2; ++bj) { const int c = c0 + bj * HALF; const f32x4 v0 = acc[ai][bj][m][0], v1 = acc[ai][bj][m][1];
                    u32x4 w; w.x = cvt_pk_bf16(v0[0], v0[1]); w.y = cvt_pk_bf16(v0[2], v0[3]); w.z = cvt_pk_bf16(v1[0], v1[1]); w.w = cvt_pk_bf16(v1[2], v1[3]);
                    const size_t off = mode == 0 ? (((size_t)u.pm * 1024 + head * 256 + r) * 2048 + u.pn * 256 + c) : (((size_t)u.pn * 2048 + u.pm * 256 + r) * 1024 + head * 256 + c);
                    *(u32x4*)((mode == 0 ? wqk : vwt) + off) = w; } }
    }
};
struct EpiKV {
    static constexpr bool PERM = true, AFTER_DRAIN = false;
    float* outk; size_t voff; bf16_t* kb; bf16_t* vt; bf16_t* vb; const float* rstd;
    __device__ __forceinline__ void operator()(const f32x4 (&acc)[2][2][4][2], const Unit& u, int wr, int wc, int fr, int fq) const {
        const int row0 = u.pm * BM + wr * 64 + fr; const int colt = u.pn * BM, which = colt >> 11, l = which >> 1, isv = which & 1;
        const int col0 = (colt & 2047) + wc * 32 + 8 * fq;
        float sv[2][4];
#pragma unroll
        for (int ai = 0; ai < 2; ++ai)
#pragma unroll
            for (int m = 0; m < 4; ++m) sv[ai][m] = rstd[row0 + ai * HALF + m * 16];
#pragma unroll
        for (int ai = 0; ai < 2; ++ai)
#pragma unroll
            for (int m = 0; m < 4; ++m) asm volatile("" : "+v"(sv[ai][m]));
#pragma unroll
        for (int ai = 0; ai < 2; ++ai)
#pragma unroll
            for (int m = 0; m < 4; ++m) { const int row = row0 + ai * HALF + m * 16; const float rs = sv[ai][m];
#pragma unroll
                for (int bj = 0; bj < 2; ++bj) { const f32x4 v0 = acc[ai][bj][m][0] * rs, v1 = acc[ai][bj][m][1] * rs; const int col = col0 + bj * HALF;
                    float* op = outk + (isv ? voff : (size_t)0) + ((size_t)l * 1024 + row) * 2048 + col;
                    *(f32x4*)op = v0; *(f32x4*)(op + 4) = v1;
                    if (!isv) { u32x4 w; w.x = cvt_pk_bf16(v0[0], v0[1]); w.y = cvt_pk_bf16(v0[2], v0[3]); w.z = cvt_pk_bf16(v1[0], v1[1]); w.w = cvt_pk_bf16(v1[2], v1[3]);
                        *(u32x4*)(kb + ((size_t)l * 1024 + row) * 2048 + col) = w; }
                    else { { u32x4 w; w.x = cvt_pk_bf16(v0[0], v0[1]); w.y = cvt_pk_bf16(v0[2], v0[3]); w.z = cvt_pk_bf16(v1[0], v1[1]); w.w = cvt_pk_bf16(v1[2], v1[3]); *(u32x4*)(vb + ((size_t)l * 1024 + row) * 2048 + col) = w; }
                    } } }
    }
};
template <class Epi, class Sched, bool ALIGN_EPI = false, bool SP2 = false>
__device__ __forceinline__ void gemm_phase(PG8_LAS unsigned char* lds, const Gemm g, const Sched& S, const Epi& E, int tid) {
    asm volatile("" : "+v"(tid));
    const int wid = __builtin_amdgcn_readfirstlane(tid >> 6), lane = tid & 63, wr = wid >> 2, wc = wid & 3, fr = lane & 15, fq = lane >> 4;
    const int K = g.K, nt = K / BK, lda = g.lda ? g.lda : K, ldb = g.ldb ? g.ldb : K;
    unsigned voffA[2], voffB[2];
#pragma unroll
    for (int i = 0; i < 2; ++i) { int R, C; stage_rc(tid * 16 + i * 8192, R, C); const int Rb = Epi::PERM ? ((R & ~31) + perm32(R & 31)) : R;
        voffA[i] = (unsigned)(R * lda + C) * 2u; voffB[i] = (unsigned)(Rb * ldb + C) * 2u; }
    const size_t kstep = (size_t)(BK * 2);
    const size_t hstepA = (size_t)HALF * lda * 2, hstepB = (size_t)HALF * ldb * 2;
    const unsigned ldsw = (unsigned)wid * 1024u;
    const int aoff = lds_byte(wr * 64 + fr, fq * 8), boff = lds_byte(wc * 32 + fr, fq * 8);
#define PG8_SA(b, h) (((b) * 2 + (h)) * HTB)
#define PG8_SB(b, h) ((4 + (b) * 2 + (h)) * HTB)
#define PG8_STAGE(bufoff, gbase, voff) do { _Pragma("unroll") for (int _i = 0; _i < 2; ++_i) \
        __builtin_amdgcn_global_load_lds((const unsigned*)((const char*)(gbase) + (voff)[_i]), (PG8_LAS unsigned*)(lds + (bufoff) + ldsw + _i * 8192), 16, 0, 0); } while (0)
#define PG8_LDA(dst, b, h) do { _Pragma("unroll") for (int m = 0; m < 4; ++m) _Pragma("unroll") for (int k = 0; k < 2; ++k) dst[m][k] = *(const PG8_LAS bf16x8*)(lds + PG8_SA(b, h) + aoff + m * 2048 + k * 1024); } while (0)
#define PG8_LDB(dst, b, h) do { _Pragma("unroll") for (int n = 0; n < 2; ++n) _Pragma("unroll") for (int k = 0; k < 2; ++k) dst[n][k] = *(const PG8_LAS bf16x8*)(lds + PG8_SB(b, h) + boff + n * 2048 + k * 1024); } while (0)
#define PG8_MMA(ai, bj, At, Bt) do { __builtin_amdgcn_s_setprio(1); _Pragma("unroll") for (int m = 0; m < 4; ++m) _Pragma("unroll") for (int n = 0; n < 2; ++n) _Pragma("unroll") for (int k = 0; k < 2; ++k) \
        acc[ai][bj][m][n] = __builtin_amdgcn_mfma_f32_16x16x32_bf16(Bt[n][k], At[m][k], acc[ai][bj][m][n], 0, 0, 0); __builtin_amdgcn_s_setprio(0); } while (0)
#define PG8_WAIT_V(n) asm volatile("s_waitcnt vmcnt(" #n ")" ::: "memory")
#define PG8_WAIT_L(n) asm volatile("s_waitcnt lgkmcnt(" #n ")" ::: "memory")
#define PG8_BAR __builtin_amdgcn_s_barrier()
#define PG8_SCHED __builtin_amdgcn_sched_barrier(0)
    Unit cur, nxt; int ui = 0;
    if (!S.next(0, cur)) return;
    f32x4 acc[2][2][4][2];
#pragma unroll
    for (int a = 0; a < 2; ++a)
#pragma unroll
        for (int b = 0; b < 2; ++b)
#pragma unroll
            for (int m = 0; m < 4; ++m)
#pragma unroll
                for (int n = 0; n < 2; ++n) acc[a][b][m][n] = (f32x4){0.f, 0.f, 0.f, 0.f};
    bf16x8 At[4][2], B0[2][2], B1[2][2];
    const char* cA = S.abase(g, cur); const char* cB = S.bbase(g, cur);
    S.a_ready(cur);
    if constexpr (SP2) {
        PG8_STAGE(PG8_SB(0, 0), cB, voffB); PG8_STAGE(PG8_SB(0, 1), cB + hstepB, voffB); PG8_STAGE(PG8_SA(0, 0), cA, voffA); PG8_STAGE(PG8_SA(0, 1), cA + hstepA, voffA);
        if (wr == 1) PG8_BAR;
        PG8_WAIT_V(2); PG8_BAR;
        PG8_STAGE(PG8_SB(1, 0), cB + kstep, voffB); PG8_STAGE(PG8_SA(1, 0), cA + kstep, voffA); PG8_STAGE(PG8_SB(1, 1), cB + hstepB + kstep, voffB);
        PG8_WAIT_V(6); PG8_BAR;
    } else {
        PG8_STAGE(PG8_SB(0, 0), cB, voffB); PG8_STAGE(PG8_SA(0, 0), cA, voffA); PG8_STAGE(PG8_SB(0, 1), cB + hstepB, voffB); PG8_STAGE(PG8_SA(0, 1), cA + hstepA, voffA);
        if (wr == 1) PG8_BAR;
        PG8_WAIT_V(4); PG8_BAR;
        PG8_STAGE(PG8_SB(1, 0), cB + kstep, voffB); PG8_STAGE(PG8_SA(1, 0), cA + kstep, voffA); PG8_STAGE(PG8_SB(1, 1), cB + hstepB + kstep, voffB);
        PG8_WAIT_V(6); PG8_BAR;
    }
    for (;;) {
        const bool has_next = S.next(ui + 1, nxt);
        const char* nA = has_next ? S.abase(g, nxt) : cA; const char* nB = has_next ? S.bbase(g, nxt) : cB;
        for (int t = 0; t < nt; t += 2) {
            const bool last = (t == nt - 2);
            const char* a1 = cA + (size_t)(t + 1) * kstep;
            const char* a2 = last ? nA : cA + (size_t)(t + 2) * kstep; const char* b2 = last ? nB : cB + (size_t)(t + 2) * kstep;
            const char* a3 = a2 + kstep; const char* b3 = b2 + kstep;
            if (last && has_next) S.a_ready(nxt);
            if constexpr (SP2) {
            PG8_LDB(B0, 0, 0); PG8_LDB(B1, 0, 1); PG8_SCHED; PG8_LDA(At, 0, 0); PG8_STAGE(PG8_SA(1, 1), a1 + hstepA, voffA);
            PG8_WAIT_V(8); PG8_WAIT_L(0); PG8_BAR; PG8_MMA(0, 0, At, B0); PG8_MMA(0, 1, At, B1); PG8_BAR; PG8_SCHED;
            PG8_LDA(At, 0, 1); PG8_STAGE(PG8_SB(0, 0), b2, voffB); PG8_STAGE(PG8_SB(0, 1), b2 + hstepB, voffB); PG8_STAGE(PG8_SA(0, 0), a2, voffA);
            PG8_WAIT_V(8); PG8_WAIT_L(0); PG8_BAR; PG8_MMA(1, 0, At, B0); PG8_MMA(1, 1, At, B1); PG8_BAR; PG8_SCHED;
            PG8_LDB(B0, 1, 0); PG8_LDB(B1, 1, 1); PG8_SCHED; PG8_LDA(At, 1, 0); PG8_STAGE(PG8_SA(0, 1), a2 + hstepA, voffA);
            PG8_WAIT_V(8); PG8_WAIT_L(0); PG8_BAR; PG8_MMA(0, 0, At, B0); PG8_MMA(0, 1, At, B1); PG8_BAR; PG8_SCHED;
            PG8_LDA(At, 1, 1); PG8_STAGE(PG8_SB(1, 0), b3, voffB); PG8_STAGE(PG8_SB(1, 1), b3 + hstepB, voffB); PG8_STAGE(PG8_SA(1, 0), a3, voffA);
            PG8_WAIT_V(8); PG8_WAIT_L(0); PG8_BAR; PG8_MMA(1, 0, At, B0); PG8_MMA(1, 1, At, B1); PG8_BAR; PG8_SCHED;
            } else {
            PG8_LDB(B0, 0, 0); PG8_SCHED; PG8_LDA(At, 0, 0); PG8_STAGE(PG8_SA(1, 1), a1 + hstepA, voffA);
            PG8_WAIT_L(8); PG8_BAR; PG8_WAIT_L(0); PG8_MMA(0, 0, At, B0); PG8_BAR; PG8_SCHED;
            PG8_LDB(B1, 0, 1); PG8_STAGE(PG8_SB(0, 0), b2, voffB);
            PG8_BAR; PG8_WAIT_L(0); PG8_MMA(0, 1, At, B1); PG8_BAR;
            PG8_LDA(At, 0, 1); PG8_STAGE(PG8_SA(0, 0), a2, voffA);
            PG8_BAR; PG8_WAIT_L(0); PG8_MMA(1, 0, At, B0); PG8_BAR; PG8_SCHED;
            PG8_STAGE(PG8_SB(0, 1), b2 + hstepB, voffB);
            PG8_WAIT_V(6); PG8_BAR; PG8_MMA(1, 1, At, B1); PG8_BAR;
            PG8_LDB(B0, 1, 0); PG8_SCHED; PG8_LDA(At, 1, 0); PG8_STAGE(PG8_SA(0, 1), a2 + hstepA, voffA);
            PG8_WAIT_L(8); PG8_BAR; PG8_WAIT_L(0); PG8_MMA(0, 0, At, B0); PG8_BAR; PG8_SCHED;
            PG8_LDB(B1, 1, 1); PG8_STAGE(PG8_SB(1, 0), b3, voffB);
            PG8_BAR; PG8_WAIT_L(0); PG8_MMA(0, 1, At, B1); PG8_BAR;
            PG8_LDA(At, 1, 1); PG8_STAGE(PG8_SA(1, 0), a3, voffA);
            PG8_BAR; PG8_WAIT_L(0); PG8_MMA(1, 0, At, B0); PG8_BAR; PG8_SCHED;
            PG8_STAGE(PG8_SB(1, 1), b3 + hstepB, voffB);
            PG8_WAIT_V(6); PG8_BAR; PG8_MMA(1, 1, At, B1); PG8_BAR;
            }
        }
        if constexpr (ALIGN_EPI) { if (wr == 0) PG8_BAR; }
        if constexpr (!Epi::AFTER_DRAIN) { E(acc, cur, wr, wc, fr, fq); S.done(cur); }
        if (!has_next) break;
#pragma unroll
        for (int a = 0; a < 2; ++a)
#pragma unroll
            for (int b = 0; b < 2; ++b)
#pragma unroll
                for (int m = 0; m < 4; ++m)
#pragma unroll
                    for (int n = 0; n < 2; ++n) acc[a][b][m][n] = (f32x4){0.f, 0.f, 0.f, 0.f};
        cur = nxt; cA = nA; cB = nB; ++ui;
        if constexpr (ALIGN_EPI) { if (wr == 1) PG8_BAR; }
    }
    PG8_WAIT_V(0);
    if constexpr (!ALIGN_EPI) { if (wr == 0) PG8_BAR; }
    PG8_BAR;
    if constexpr (Epi::AFTER_DRAIN) { E.fused(acc, cur, wr, wc, fr, fq, lds, wid, lane); S.done(cur); }
#undef PG8_SA
#undef PG8_SB
#undef PG8_STAGE
#undef PG8_LDA
#undef PG8_LDB
#undef PG8_MMA
#undef PG8_WAIT_V
#undef PG8_WAIT_L
#undef PG8_BAR
#undef PG8_SCHED
}
}

constexpr int NWAVES = 8, NTHR = NWAVES * 64;
#ifndef MK_PER_PHASE
#define MK_PER_PHASE 0
#endif

constexpr int D = 2048, NB = 4, T = 2048, MP = NB * T, MS = 128, MR = MP + MS, MPAD = 8448, NL = 2;
constexpr int NIN = 3840, INW = 3848, FF = 8192, NMEM = 256, MROWS = NB * NMEM, NHX = 4, HDX = 512;
constexpr int C_Z = 0, C_XBC = 512, C_BM = 1024, C_CM = 1152, C_U5 = 1280, C_GB = 1792, C_GC = 2304, C_HV = 2816, C_UP = 3328;
constexpr float EPS = 1e-6f;
constexpr int SSD_L = 64, SSD_NC = T / SSD_L;
constexpr int S5_L = 32, S5_NC = T / S5_L;

constexpr size_t O_YP = 0, O_YS = O_YP + (size_t)MP * D, O_PCONV = O_YS + (size_t)MS * D, O_PSSD = O_PCONV + NL * NB * 3 * 768, O_PS5R = O_PSSD + NL * NB * 8 * 4096,
    O_PS5I = O_PS5R + NL * NB * 2048, O_PSC = O_PS5I + NL * NB * 2048, O_PPOOL = O_PSC + NL * NB * 2 * 512, O_PMK = O_PPOOL + NL * NB * 15 * 512, O_PMV = O_PMK + (size_t)NL * MROWS * D,
    O_SCONV = O_PMV + (size_t)NL * MROWS * D, O_SSSD = O_SCONV + NL * MS * 3 * 768, O_SS5R = O_SSSD + (size_t)NL * MS * 8 * 4096, O_SS5I = O_SS5R + NL * MS * 2048, O_SSC = O_SS5I + NL * MS * 2048,
    O_SPOOL = O_SSC + NL * MS * 2 * 512, O_END = O_SPOOL + NL * MS * 15 * 512;
static_assert(O_END == 38066176, "output size");

enum In { I_XP = 0, I_XS, I_MEM, I_ST_CONV, I_ST_SSD, I_ST_S5R, I_ST_S5I, I_ST_SC, I_ST_POOL, I_CK, I_CV, I_G_MIX, I_W_IN, I_CONV_W, I_CONV_B, I_DT_BIAS, I_A_LOG, I_SSD_D,
          I_LAM_RE, I_LAM_IM, I_LOG_DT, I_B_RE, I_B_IM, I_C_RE, I_C_IM, I_S5_D, I_W_GLU, I_B_GLU, I_SC_W, I_POOL_W, I_POOL_SCALE, I_G_MIXOUT, I_W_OUT, I_G_XA, I_G_MEM,
          I_W_Q, I_W_K, I_W_V, I_W_O, I_G_MLP, I_W_UP, I_W_DOWN, I_G_FINAL, N_IN };
static_assert(N_IN == 43, "inputs");

constexpr size_t MiB = 1u << 20;
constexpr size_t WS_CTL = 0, CTL_ZERO_BYTES = 1 * MiB;
constexpr int CW_TMO = 0, CW_BAR = 4096, CW_FCNT = 8192, CW_SSQ = 16384;
static_assert(CW_BAR + 3456 <= CW_FCNT && CW_FCNT + 32 * 64 <= CW_SSQ, "ctl words");
static_assert(CW_SSQ * 4 + 7 * MPAD * 8 <= (int)CTL_ZERO_BYTES, "ctl");
constexpr size_t WS_TAB = 1 * MiB, TAB_L = 2 * MiB;
constexpr size_t TB_ABAR = 0, TB_ABARL = 16384, TB_BBAR = 32768, TB_CMT = TB_BBAR + 262144, TB_WDT = TB_CMT + 131072, TB_WGLUT = TB_WDT + 65536, TB_WPT = TB_WGLUT + 524288, TB_BBT = TB_WPT + 131072, TB_END = TB_BBT + 131072;
static_assert(TB_END <= TAB_L, "tables");
constexpr size_t WS_W = 8 * MiB, W_L = 104 * MiB;
constexpr size_t WO_IN = 0, WO_OUT = 15 * MiB, WO_Q = 23 * MiB, WO_O = 31 * MiB, WO_UP = 39 * MiB, WO_DOWN = 71 * MiB;
static_assert(WO_DOWN + 32 * MiB <= W_L && (size_t)NIN * D * 2 == 15 * MiB, "weights");
constexpr size_t WS_WKV = WS_W + 2 * W_L;
constexpr size_t WS_H = 256 * MiB, WS_HB = 322 * MiB, WS_PROJ = 356 * MiB, WS_MIX = 418 * MiB, WS_Q = 452 * MiB, WS_O = 486 * MiB, WS_HID = 520 * MiB,
    WS_MEMB = 652 * MiB, WS_KB = 656 * MiB, WS_VT = 664 * MiB, WS_DTV = 672 * MiB, WS_RSTDM = 673 * MiB, WS_SS = 674 * MiB, WS_CD = 690 * MiB, WS_S5ER = 691 * MiB, WS_S5EI = 693 * MiB, WS_SA = 700 * MiB, WS_WQKD = 704 * MiB, WS_VB = 720 * MiB, WS_WQK = 728 * MiB, WS_VWT = 760 * MiB, WS_PATT = 792 * MiB, WS_END = 808 * MiB;
constexpr size_t SA_HB = 0, SA_MIX = 512 * 1024, SA_O = 1024 * 1024, SA_HID = 2048 * 1024;
static_assert(WS_WKV + 32 * MiB <= WS_H && WS_H + (size_t)MPAD * D * 4 <= WS_HB && WS_HB + (size_t)MPAD * D * 2 <= WS_PROJ && WS_PROJ + (size_t)MPAD * NIN * 2 <= WS_MIX, "ws map 1");
static_assert(WS_HID + (size_t)MPAD * FF * 2 <= WS_MEMB && WS_SS + (size_t)NB * SSD_NC * 8 * 4096 * 4 <= WS_CD && WS_S5ER + (size_t)NB * S5_NC * 2048 * 4 <= WS_S5EI, "ws map 2");

constexpr int RING_OFF = 0, RING_BYTES = 131072;
constexpr int LDSCTL_OFF = 136192, MISC_OFF = LDSCTL_OFF + 320;
constexpr int LDS_BYTES = 147456;
static_assert(MISC_OFF + 128 <= LDS_BYTES, "LDS map");
#define GAS __attribute__((address_space(1)))
#define LAS __attribute__((address_space(3)))
typedef unsigned short bf16;
typedef unsigned v4u __attribute__((ext_vector_type(4)));
typedef float f32x4 __attribute__((ext_vector_type(4)));
typedef short bf16x8 __attribute__((ext_vector_type(8)));
typedef GAS unsigned gu32;
typedef GAS unsigned long long gu64;
#define RLX_AGENT __ATOMIC_RELAXED, __HIP_MEMORY_SCOPE_AGENT
#define LDS_WAIT() asm volatile("s_waitcnt lgkmcnt(0)" ::: "memory")
#define VM_WAIT() asm volatile("s_waitcnt vmcnt(0)" ::: "memory")
__device__ __forceinline__ unsigned long long rt() { return __builtin_amdgcn_s_memrealtime(); }
__device__ __forceinline__ unsigned f2bf(float f) { unsigned u = __builtin_bit_cast(unsigned, f); return (u + 0x7fffu + ((u >> 16) & 1u)) >> 16; }
__device__ __forceinline__ unsigned pk2(float lo, float hi) { return f2bf(lo) | (f2bf(hi) << 16); }

#define XB_TMO      128
#define XB_XCNT(j)  (256  + 64 * (j))
#define XB_XSUB(j)  (1280 + 64 * (j))
#define XB_XGEN(j)  (2304 + 64 * (j))
#define XB_TOP      3328
#define XB_TOPGEN   3392
#define XCD_BAR_WORDS 3456
#define XB_SPIN_CAP (1u << 18)

__device__ __forceinline__ unsigned xb_ld(unsigned* p)              { return __hip_atomic_load(p, __ATOMIC_RELAXED, __HIP_MEMORY_SCOPE_AGENT); }
__device__ __forceinline__ unsigned xb_add(unsigned* p, unsigned v) { return __hip_atomic_fetch_add(p, v, __ATOMIC_RELAXED, __HIP_MEMORY_SCOPE_AGENT); }
__device__ __forceinline__ unsigned xb_xcc_id() { return (unsigned)__builtin_amdgcn_s_getreg((3 << 11) | 20) & 0xFu; }
#define XB_SPIN(cond, bar) do { unsigned _sp = 0; while (cond) { __builtin_amdgcn_s_sleep(1); \
    if ((++_sp & 255u) == 0u) { if (xb_ld(&(bar)[XB_TMO])) break; if (_sp > XB_SPIN_CAP) { atomicAdd(&(bar)[XB_TMO], 1u); break; } } } } while (0)

struct XcdBarrier {
    unsigned* bar; unsigned x;
    volatile LAS unsigned* st;
};

__device__ __forceinline__ XcdBarrier xcd_barrier_post(unsigned* bar, volatile LAS unsigned* st) {
    XcdBarrier b; b.bar = bar; b.x = xb_xcc_id(); b.st = st;
    if (threadIdx.x == 0) (void)xb_add(&bar[XB_XCNT(b.x)], 1u);
    return b;
}
__device__ __forceinline__ void xcd_barrier_complete(unsigned* bar, unsigned x, unsigned& nloc, unsigned& nx) {
    const unsigned G = gridDim.x * gridDim.y * gridDim.z;
    unsigned sum, cnt, mine, sp = 0u;
    for (;;) {
        sum = 0u; cnt = 0u; mine = 0u;
#pragma unroll
        for (unsigned j = 0; j < 16; ++j) { const unsigned c = xb_ld(&bar[XB_XCNT(j)]); sum += c; cnt += (c > 0u) ? 1u : 0u; mine = (j == x) ? c : mine; }
        if (sum == G) break;
        __builtin_amdgcn_s_sleep(1);
        if ((++sp & 255u) == 0u) { if (xb_ld(&bar[XB_TMO])) break; if (sp > XB_SPIN_CAP) { atomicAdd(&bar[XB_TMO], 1u); break; } }
    }
    nloc = mine > 0u ? mine : 1u; nx = cnt > 0u ? cnt : 1u;
}

__device__ __forceinline__ void xcd_barrier(const XcdBarrier& b) {
    asm volatile("s_waitcnt vmcnt(0)" ::: "memory");
    __syncthreads();
    if (threadIdx.x == 0) {
        unsigned* bar = b.bar;
        __builtin_amdgcn_s_waitcnt(0);
        unsigned nloc = b.st[0], nx = b.st[1];
        if (nloc == 0u) { xcd_barrier_complete(bar, b.x, nloc, nx); b.st[0] = nloc; b.st[1] = nx; }
        const unsigned old = xb_add(&bar[XB_XSUB(b.x)], 1u);
        const unsigned gen = old / nloc;
        if (old + 1u == (gen + 1u) * nloc) {
            __builtin_amdgcn_fence(__ATOMIC_RELEASE, "agent");
            asm volatile("s_waitcnt vmcnt(0)" ::: "memory");
            const unsigned og = xb_add(&bar[XB_TOP], 1u);
            const unsigned tg = og / nx;
            if (og + 1u == (tg + 1u) * nx) xb_add(&bar[XB_TOPGEN], 1u);
            else XB_SPIN(xb_ld(&bar[XB_TOPGEN]) == tg, bar);
            __builtin_amdgcn_fence(__ATOMIC_ACQUIRE, "agent");
            xb_add(&bar[XB_XGEN(b.x)], 1u);
            asm volatile("s_waitcnt vmcnt(0)" ::: "memory");
        } else {
            XB_SPIN(xb_ld(&bar[XB_XGEN(b.x)]) == gen, bar);
            __builtin_amdgcn_fence(__ATOMIC_ACQUIRE, "agent");
            asm volatile("s_waitcnt vmcnt(0)" ::: "memory");
        }
    }
    __syncthreads();
}

struct Args { const float* in[N_IN]; float* out; unsigned char* ws; int ph_lo, ph_hi; };
static_assert(sizeof(Args) == 45 * 8 + 8, "Args has no holes");
typedef float f32x2 __attribute__((ext_vector_type(2)));
typedef unsigned v2u __attribute__((ext_vector_type(2)));
#define PIN(x) asm volatile("" : "+v"(x))
#define WAVE_SYNC() asm volatile("s_waitcnt lgkmcnt(0)" ::: "memory")
#define BLOCK_SYNC() do { asm volatile("s_waitcnt vmcnt(0) lgkmcnt(0)" ::: "memory"); __builtin_amdgcn_s_barrier(); asm volatile("" ::: "memory"); } while (0)
__device__ __forceinline__ float bf_lo(unsigned u) { return __uint_as_float(u << 16); }
__device__ __forceinline__ float bf_hi(unsigned u) { return __uint_as_float(u & 0xffff0000u); }
__device__ __forceinline__ float bf2f(bf16 b) { return __uint_as_float((unsigned)b << 16); }
__device__ __forceinline__ unsigned cvtpk(float lo, float hi) { return pg8::cvt_pk_bf16(lo, hi); }
__device__ __forceinline__ bf16 f2b(float f) { return (bf16)(cvtpk(f, 0.f) & 0xffffu); }
template <int CTRL> __device__ __forceinline__ float dppf(float v) { return __builtin_bit_cast(float, __builtin_amdgcn_update_dpp(0, __builtin_bit_cast(int, v), CTRL, 0xf, 0xf, false)); }
__device__ __forceinline__ float sum16(float v) { v += dppf<0xB1>(v); v += dppf<0x4E>(v); v += dppf<0x141>(v); v += dppf<0x140>(v); return v; }
__device__ __forceinline__ float max16(float v) { v = fmaxf(v, dppf<0xB1>(v)); v = fmaxf(v, dppf<0x4E>(v)); v = fmaxf(v, dppf<0x141>(v)); v = fmaxf(v, dppf<0x140>(v)); return v; }
__device__ __forceinline__ float wave_sum(float v) { v = sum16(v);
    const float r0 = __builtin_bit_cast(float, __builtin_amdgcn_readlane(__builtin_bit_cast(int, v), 0)), r1 = __builtin_bit_cast(float, __builtin_amdgcn_readlane(__builtin_bit_cast(int, v), 16)),
                r2 = __builtin_bit_cast(float, __builtin_amdgcn_readlane(__builtin_bit_cast(int, v), 32)), r3 = __builtin_bit_cast(float, __builtin_amdgcn_readlane(__builtin_bit_cast(int, v), 48));
    return (r0 + r1) + (r2 + r3); }
__device__ __forceinline__ float wave_max(float v) { v = max16(v);
    const float r0 = __builtin_bit_cast(float, __builtin_amdgcn_readlane(__builtin_bit_cast(int, v), 0)), r1 = __builtin_bit_cast(float, __builtin_amdgcn_readlane(__builtin_bit_cast(int, v), 16)),
                r2 = __builtin_bit_cast(float, __builtin_amdgcn_readlane(__builtin_bit_cast(int, v), 32)), r3 = __builtin_bit_cast(float, __builtin_amdgcn_readlane(__builtin_bit_cast(int, v), 48));
    return fmaxf(fmaxf(r0, r1), fmaxf(r2, r3)); }
__device__ __forceinline__ float silu_f(float x) { return x * __builtin_amdgcn_rcpf(1.f + __expf(-x)); }
__device__ __forceinline__ float sigmoid_f(float x) { return __builtin_amdgcn_rcpf(1.f + __expf(-x)); }
__device__ __forceinline__ float softplus_f(float x) { return x > 20.f ? x : log1pf(expf(x)); }
__device__ __forceinline__ float gelu_tanh_f(float x) { const float u = 0.7978845608f * (x + 0.044715f * x * x * x); const float e = __expf(2.f * u); const float th = 1.f - 2.f * __builtin_amdgcn_rcpf(e + 1.f); return 0.5f * x * (1.f + th); }
__device__ __forceinline__ f32x4 mfma16(bf16x8 a, bf16x8 b, f32x4 c) { return __builtin_amdgcn_mfma_f32_16x16x32_bf16(a, b, c, 0, 0, 0); }
__device__ __forceinline__ bf16x8 ldsfrag(const LAS unsigned char* p) { return *(const LAS bf16x8*)p; }
__device__ __forceinline__ bf16x8 gfrag(const bf16* p) { return *(const bf16x8*)p; }
__device__ __forceinline__ bf16x8 pack8(f32x4 a, f32x4 b) { v4u w; w.x = cvtpk(a[0], a[1]); w.y = cvtpk(a[2], a[3]); w.z = cvtpk(b[0], b[1]); w.w = cvtpk(b[2], b[3]); return __builtin_bit_cast(bf16x8, w); }
__device__ __forceinline__ void unpack8(v4u w, float (&f)[8]) { f[0] = bf_lo(w.x); f[1] = bf_hi(w.x); f[2] = bf_lo(w.y); f[3] = bf_hi(w.y); f[4] = bf_lo(w.z); f[5] = bf_hi(w.z); f[6] = bf_lo(w.w); f[7] = bf_hi(w.w); }
__device__ __forceinline__ size_t sfrag(int r, int k, int K) { return ((size_t)((r >> 4) * (K >> 5) + (k >> 5)) << 9) + (size_t)(((((k >> 3) & 3) * 16 + (r & 15)) << 3) + (k & 7)); }
__device__ __forceinline__ void dsincos(double x, double& s, double& c) {
    const double k = rint(x * 0.63661977236758134308); double r = fma(-k, 1.57079632673412561417e+00, x); r = fma(-k, 6.07710050650619224932e-11, r);
    const double r2 = r * r;
    double sp = -7.6471637318198164759e-13; sp = fma(sp, r2, 1.6059043836821614599e-10); sp = fma(sp, r2, -2.5052108385441718775e-08); sp = fma(sp, r2, 2.7557319223985890653e-06); sp = fma(sp, r2, -1.9841269841269841270e-04);
    sp = fma(sp, r2, 8.3333333333333333333e-03); sp = fma(sp, r2, -1.6666666666666666667e-01); const double sr = fma(sp * r2, r, r);
    double cp = 4.7794773323873852974e-14; cp = fma(cp, r2, -1.1470745597729724714e-11); cp = fma(cp, r2, 2.0876756987868098979e-09); cp = fma(cp, r2, -2.7557319223985890653e-07); cp = fma(cp, r2, 2.4801587301587301587e-05);
    cp = fma(cp, r2, -1.3888888888888888889e-03); cp = fma(cp, r2, 4.1666666666666666667e-02); cp = fma(cp, r2, -0.5); const double cr = fma(cp, r2, 1.0);
    const int q = (int)k & 3;
    s = (q == 0) ? sr : (q == 1) ? cr : (q == 2) ? -sr : -cr; c = (q == 0) ? cr : (q == 1) ? -sr : (q == 2) ? -cr : sr;
}

__device__ __forceinline__ void p0_transpose_item(const float* W, int ldw, int scol0, int K, int k0, const float* gain, bf16* WT, int drow0, LAS unsigned char* scr, int lane, bool frag = false) {
    const int kq = lane >> 4, n4 = lane & 15;
    f32x4 t[8][2]; float g[8][2];
#pragma unroll
    for (int s = 0; s < 8; ++s)
#pragma unroll
        for (int h = 0; h < 2; ++h) { const int k = k0 + 8 * s + 2 * kq + h; t[s][h] = __builtin_nontemporal_load((const GAS f32x4*)(W + (size_t)k * ldw + scol0 + 4 * n4)); g[s][h] = gain ? gain[k] : 1.f; }
#pragma unroll
    for (int s = 0; s < 8; ++s) { PIN(t[s][0]); PIN(t[s][1]); }
#pragma unroll
    for (int s = 0; s < 8; ++s)
#pragma unroll
        for (int e = 0; e < 4; ++e) *(LAS unsigned*)(scr + ((4 * n4 + e) * 68 + 8 * s + 2 * kq) * 2) = cvtpk(t[s][0][e] * g[s][0], t[s][1][e] * g[s][1]);
    LDS_WAIT(); asm volatile("" ::: "memory");
    const int c = lane & 7;
#pragma unroll
    for (int j = 0; j < 8; ++j) { const int n = (lane >> 3) + 8 * j; const v2u a = *(const LAS v2u*)(scr + (n * 68 + 8 * c) * 2), b = *(const LAS v2u*)(scr + (n * 68 + 8 * c + 4) * 2);
        *(GAS v4u*)(WT + (frag ? sfrag(drow0 + n, k0 + 8 * c, K) : (size_t)(drow0 + n) * K + k0 + 8 * c)) = (v4u){a.x, a.y, b.x, b.y}; }
    LDS_WAIT(); asm volatile("" ::: "memory");
}
__device__ __forceinline__ void p0_mat(const float* W, int ldw, int K, int N, const float* gain, bf16* WT, int drow_base, int item, LAS unsigned char* scr, int lane, bool frag = false) {
    const int nblk = N / 64, kb = item / nblk, nb = item % nblk;
    p0_transpose_item(W, ldw, 64 * nb, K, 64 * kb, gain, WT, drow_base + 64 * nb, scr, lane, frag);
}
constexpr int P0W_IN = (D / 64) * (NIN / 64), P0W_SQ = (D / 64) * (D / 64), P0W_UP = (D / 64) * (FF / 64), P0W_DN = (FF / 64) * (D / 64), P0W_GLU = (512 / 64) * (512 / 64), P0W_PW = (128 / 64) * (128 / 64);
constexpr int P0W_LAYER = P0W_IN + 5 * P0W_SQ + P0W_UP + P0W_DN + P0W_GLU + 4 * P0W_PW, P0W_DEF_N = P0W_UP + P0W_DN + P0W_GLU + 4 * P0W_PW + P0W_IN + P0W_SQ, P0W_DEF_LO = NL * P0W_LAYER - P0W_DEF_N;
__device__ __forceinline__ void p0_weights(const Args& A, LAS unsigned char* lds, int gw, int NGW, int first, int count, int skip_at, int skip_n, int wave, int lane) {
    asm volatile("" : "+v"(lane));
    LAS unsigned char* scr = lds + RING_OFF + wave * 16384;
    unsigned char* ws = A.ws;
    constexpr int I_IN = P0W_IN, I_SQ = P0W_SQ, I_UP = P0W_UP, I_DN = P0W_DN, I_GLU = P0W_GLU, I_PW = P0W_PW, I_LAYER = P0W_LAYER;
#pragma unroll 1
    for (int i = gw; i < count; i += NGW) { int it = first + i; if (it >= skip_at) it += skip_n;
        const int l = it / I_LAYER; int r = it % I_LAYER + I_IN + I_SQ; if (r >= I_LAYER) r -= I_LAYER;
        bf16* wl = (bf16*)(ws + WS_W + (size_t)l * W_L); unsigned char* tb = ws + WS_TAB + (size_t)l * TAB_L;
        const float* W; const float* gain = nullptr; bf16* WT; int ldw, K, N, drow = 0; bool frag = false;
        if (r < I_IN) { const int nblk = NIN / 64, kb = r / nblk, nb = r % nblk, n0 = 64 * nb;
            p0_transpose_item(A.in[I_W_IN] + (size_t)l * D * INW, INW, n0 + (n0 >= 1280 ? 8 : 0), D, 64 * kb, A.in[I_G_MIX] + l * D, (bf16*)((unsigned char*)wl + WO_IN), n0, scr, lane); continue; } r -= I_IN;
        if (r < I_SQ) { W = A.in[I_W_OUT] + (size_t)l * D * D; gain = A.in[I_G_MIXOUT] + l * D; WT = (bf16*)((unsigned char*)wl + WO_OUT); ldw = D; K = D; N = D; }
        else if (r < 2 * I_SQ) { r -= I_SQ; W = A.in[I_W_Q] + (size_t)l * D * D; gain = A.in[I_G_XA] + l * D; WT = (bf16*)((unsigned char*)wl + WO_Q); ldw = D; K = D; N = D; }
        else if (r < 3 * I_SQ) { r -= 2 * I_SQ; W = A.in[I_W_O] + (size_t)l * D * D; WT = (bf16*)((unsigned char*)wl + WO_O); ldw = D; K = D; N = D; }
        else if (r < 4 * I_SQ) { r -= 3 * I_SQ; W = A.in[I_W_K] + (size_t)l * D * D; gain = A.in[I_G_MEM] + l * D; WT = (bf16*)(ws + WS_WKV); drow = l * 4096; ldw = D; K = D; N = D; }
        else if (r < 5 * I_SQ) { r -= 4 * I_SQ; W = A.in[I_W_V] + (size_t)l * D * D; gain = A.in[I_G_MEM] + l * D; WT = (bf16*)(ws + WS_WKV); drow = l * 4096 + 2048; ldw = D; K = D; N = D; }
        else if (r < 5 * I_SQ + I_UP) { r -= 5 * I_SQ; W = A.in[I_W_UP] + (size_t)l * D * FF; gain = A.in[I_G_MLP] + l * D; WT = (bf16*)((unsigned char*)wl + WO_UP); ldw = FF; K = D; N = FF; }
        else if (r < 5 * I_SQ + I_UP + I_DN) { r -= 5 * I_SQ + I_UP; W = A.in[I_W_DOWN] + (size_t)l * FF * D; WT = (bf16*)((unsigned char*)wl + WO_DOWN); ldw = D; K = FF; N = D; }
        else if (r < 5 * I_SQ + I_UP + I_DN + I_GLU) { r -= 5 * I_SQ + I_UP + I_DN; W = A.in[I_W_GLU] + (size_t)l * 512 * 512; WT = (bf16*)(tb + TB_WGLUT); ldw = 512; K = 512; N = 512; frag = true; }
        else { r -= 5 * I_SQ + I_UP + I_DN + I_GLU; const int gI = r / I_PW; r = r % I_PW; W = A.in[I_POOL_W] + ((size_t)l * 4 + gI) * 128 * 128; WT = (bf16*)(tb + TB_WPT) + gI * 128 * 128; ldw = 128; K = 128; N = 128; frag = true; }
        p0_mat(W, ldw, K, N, gain, WT, drow, r, scr, lane, frag);
    }
}
__device__ __forceinline__ void p0_prologue(const Args& A, LAS unsigned char* lds, int vcu, int G, int wave, int lane) {
    asm volatile("" : "+v"(lane));
    const int gw = vcu * NWAVES + wave, NGW = G * NWAVES;
    unsigned char* ws = A.ws;
    { const int nskip = G == 256 ? P0W_DEF_N : 0; p0_weights(A, lds, gw, NGW, 0, NL * P0W_LAYER - nskip, P0W_DEF_LO, nskip, wave, lane); }
    bf16* HB = (bf16*)(ws + WS_HB); unsigned long long* ssq0 = (unsigned long long*)((unsigned*)(ws + WS_CTL) + CW_SSQ);
#pragma unroll 1
    for (int m = gw; m < MR; m += NGW) {
        f32x4 v[8]; const GAS f32x4* xr = (const GAS f32x4*)(m < MP ? A.in[I_XP] + (size_t)m * D : A.in[I_XS] + (size_t)(m - MP) * D) + lane;
#pragma unroll
        for (int j = 0; j < 8; ++j) v[j] = __builtin_nontemporal_load(xr + 64 * j);
#pragma unroll
        for (int j = 0; j < 8; ++j) PIN(v[j]);
        float s = 0.f;
#pragma unroll
        for (int j = 0; j < 8; ++j) s += (v[j].x * v[j].x + v[j].y * v[j].y) + (v[j].z * v[j].z + v[j].w * v[j].w);
        s = wave_sum(s);
        GAS v2u* br = (GAS v2u*)(HB + (size_t)m * D) + lane;
#pragma unroll
        for (int j = 0; j < 8; ++j) { v2u w; w.x = cvtpk(v[j].x, v[j].y); w.y = cvtpk(v[j].z, v[j].w); br[64 * j] = w;
            if (m >= MP) *(GAS v2u*)((bf16*)(ws + WS_SA + SA_HB) + sfrag(m - MP, 4 * lane + 256 * j, D)) = w; }
        if (lane == 0) ssq0[m] = (unsigned long long)__float2ull_rn(s * 16777216.0f);
    }
    bf16* MEMB = (bf16*)(ws + WS_MEMB); float* RSTDM = (float*)(ws + WS_RSTDM);
#pragma unroll 1
    for (int m = gw; m < MROWS; m += NGW) {
        const GAS f32x4* xr = (const GAS f32x4*)(A.in[I_MEM] + (size_t)m * D) + lane; f32x4 v[8]; float s = 0.f;
#pragma unroll
        for (int j = 0; j < 8; ++j) v[j] = xr[64 * j];
#pragma unroll
        for (int j = 0; j < 8; ++j) PIN(v[j]);
#pragma unroll
        for (int j = 0; j < 8; ++j) s += (v[j].x * v[j].x + v[j].y * v[j].y) + (v[j].z * v[j].z + v[j].w * v[j].w);
        s = wave_sum(s);
        GAS v2u* br = (GAS v2u*)(MEMB + (size_t)m * D) + lane;
#pragma unroll
        for (int j = 0; j < 8; ++j) { v2u w; w.x = cvtpk(v[j].x, v[j].y); w.y = cvtpk(v[j].z, v[j].w); br[64 * j] = w; }
        if (lane == 0) RSTDM[m] = 1.0f / sqrtf(s * (1.0f / D) + EPS);
    }
    { bf16* WQKD = (bf16*)(ws + WS_WQKD);
#pragma unroll 1
        for (int m = gw; m < NL * D; m += NGW) { const int l = m >> 11, k = m & 2047; const float gk = A.in[I_G_XA][l * D + k];
            const GAS f32x4* xr = (const GAS f32x4*)(A.in[I_W_Q] + ((size_t)l * D + k) * D) + lane; f32x4 v[8];
#pragma unroll
            for (int j = 0; j < 8; ++j) v[j] = __builtin_nontemporal_load(xr + 64 * j);
#pragma unroll
            for (int j = 0; j < 8; ++j) PIN(v[j]);
            GAS v2u* br = (GAS v2u*)(WQKD + (size_t)m * D) + lane;
#pragma unroll
            for (int j = 0; j < 8; ++j) { v2u w; w.x = cvtpk(v[j].x * gk, v[j].y * gk); w.y = cvtpk(v[j].z * gk, v[j].w * gk); br[64 * j] = w; } } }
    const int gt = gw * 64 + lane, NGT = NGW * 64;
    for (int i2 = gt; i2 < NL * 2048 * 16 * 2; i2 += NGT) { if (i2 & 1) continue; const int i = i2 >> 5, k = (i2 >> 1) & 15;
        const int l = i >> 11, gn = i & 2047, g = gn >> 6, n = gn & 63; unsigned char* tb = ws + WS_TAB + (size_t)l * TAB_L;
        const double lr = (double)A.in[I_LAM_RE][l * 2048 + gn], li = (double)A.in[I_LAM_IM][l * 2048 + gn], dl = exp((double)A.in[I_LOG_DT][l * 32 + g]);
        const float bref = A.in[I_B_RE][((size_t)l * 2048 + gn) * 16 + k], bimf = A.in[I_B_IM][((size_t)l * 2048 + gn) * 16 + k];
        const float cref = A.in[I_C_RE][((size_t)l * 32 + g) * 1024 + k * 64 + n], cimf = A.in[I_C_IM][((size_t)l * 32 + g) * 1024 + k * 64 + n];
        double s1, c1, sL, cL; dsincos(li * dl, s1, c1); dsincos(li * dl * (double)S5_L, sL, cL);
        const double m1 = exp(lr * dl), mL = exp(lr * dl * (double)S5_L), ar = m1 * c1, ai = m1 * s1;
        if (k == 0) { ((f32x2*)(tb + TB_ABAR))[gn] = (f32x2){(float)ar, (float)ai}; ((f32x2*)(tb + TB_ABARL))[gn] = (f32x2){(float)(mL * cL), (float)(mL * sL)}; }
        const double den = lr * lr + li * li, cr = ((ar - 1.0) * lr + ai * li) / den, ci = (ai * lr - (ar - 1.0) * li) / den;
        f32x2* bb = (f32x2*)(tb + TB_BBAR) + (size_t)g * 16 * 64 + n; bf16* cmt = (bf16*)(tb + TB_CMT) + (size_t)g * 16 * 128;
        bf16* bbt = (bf16*)(tb + TB_BBT) + (size_t)g * 128 * 16;
        { const double br = bref, bi = bimf; bb[k * 64] = (f32x2){(float)(cr * br - ci * bi), (float)(cr * bi + ci * br)};
            bbt[n * 16 + k] = f2b((float)(cr * br - ci * bi)); bbt[(64 + n) * 16 + k] = f2b((float)(cr * bi + ci * br));
            cmt[k * 128 + n] = f2b(cref); cmt[k * 128 + 64 + n] = f2b(-cimf); }
    }
    for (int i2 = gt; i2 < NL * D * 32; i2 += NGT) { if (i2 & 31) continue; const int i = i2 >> 5;
        const int l = i >> 11, k = i & 2047; const float g = A.in[I_G_MIX][l * D + k]; const float* w = A.in[I_W_IN] + ((size_t)l * D + k) * INW + 1280;
        float* o = (float*)(ws + WS_TAB + (size_t)l * TAB_L + TB_WDT) + k * 8;
#pragma unroll
        for (int j = 0; j < 8; ++j) o[j] = g * w[j];
    }
}

__device__ __forceinline__ void dt_rows(const Args& A, LAS unsigned char* lds, int l, int vcu, int G, int tid) {
    asm volatile("" : "+v"(tid)); const int lane = tid & 63, wave = __builtin_amdgcn_readfirstlane(tid >> 6);
    unsigned char* ws = A.ws; const bf16* HB = (const bf16*)(ws + WS_HB); const float* WDT = (const float*)(ws + WS_TAB + (size_t)l * TAB_L + TB_WDT);
    const unsigned long long* ssq = (const unsigned long long*)((const unsigned*)(ws + WS_CTL) + CW_SSQ) + (3 * l) * MPAD; float* DTV = (float*)(ws + WS_DTV);
    { v4u t[8];
#pragma unroll
        for (int j = 0; j < 8; ++j) t[j] = *(const GAS v4u*)((const unsigned char*)WDT + (tid + NTHR * j) * 16);
#pragma unroll
        for (int j = 0; j < 8; ++j) PIN(t[j]);
#pragma unroll
        for (int j = 0; j < 8; ++j) { const int p = tid + NTHR * j, k = p >> 1; *(LAS v4u*)(lds + (k >> 3) * 272 + (k & 7) * 32 + (p & 1) * 16) = t[j]; } }
    BLOCK_SYNC();
    const int gw = vcu * NWAVES + wave, NGW = G * NWAVES; const float bias = A.in[I_DT_BIAS][l * 8 + (lane & 7)];
#pragma unroll 1
    for (int m0 = gw; m0 < MR; m0 += 2 * NGW) { const int m1 = m0 + NGW; const bool has1 = m1 < MR; const int m1c = has1 ? m1 : m0;
        v4u x0[4], x1[4];
#pragma unroll
        for (int i = 0; i < 4; ++i) { x0[i] = *(const GAS v4u*)(HB + (size_t)m0 * D + 8 * lane + 512 * i); x1[i] = *(const GAS v4u*)(HB + (size_t)m1c * D + 8 * lane + 512 * i); }
#pragma unroll
        for (int i = 0; i < 4; ++i) { PIN(x0[i]); PIN(x1[i]); }
        float a0[8], a1[8];
#pragma unroll
        for (int j = 0; j < 8; ++j) { a0[j] = 0.f; a1[j] = 0.f; }
#pragma unroll
        for (int i = 0; i < 4; ++i) { float f0[8], f1[8]; unpack8(x0[i], f0); unpack8(x1[i], f1);
#pragma unroll
            for (int e = 0; e < 8; ++e) { const LAS float* wp = (const LAS float*)(lds + (lane + 64 * i) * 272 + e * 32); const f32x4 w0 = *(const LAS f32x4*)wp, w1 = *(const LAS f32x4*)(wp + 4);
                a0[0] += f0[e] * w0.x; a0[1] += f0[e] * w0.y; a0[2] += f0[e] * w0.z; a0[3] += f0[e] * w0.w; a0[4] += f0[e] * w1.x; a0[5] += f0[e] * w1.y; a0[6] += f0[e] * w1.z; a0[7] += f0[e] * w1.w;
                a1[0] += f1[e] * w0.x; a1[1] += f1[e] * w0.y; a1[2] += f1[e] * w0.z; a1[3] += f1[e] * w0.w; a1[4] += f1[e] * w1.x; a1[5] += f1[e] * w1.y; a1[6] += f1[e] * w1.z; a1[7] += f1[e] * w1.w; } }
        float v0 = 0.f, v1 = 0.f;
#pragma unroll
        for (int j = 0; j < 8; ++j) { const float s0 = wave_sum(a0[j]), s1 = wave_sum(a1[j]); if ((lane & 7) == j) { v0 = s0; v1 = s1; } }
        if (lane < 8) { DTV[(size_t)m0 * 8 + lane] = softplus_f(v0 * pg8::ssq_rstd(ssq[m0]) + bias);
            if (has1) DTV[(size_t)m1 * 8 + lane] = softplus_f(v1 * pg8::ssq_rstd(ssq[m1]) + bias); }
    }
    BLOCK_SYNC();
}

__device__ __forceinline__ void lds_add(LAS float* p, float v) { (void)__hip_atomic_fetch_add(p, v, __ATOMIC_RELAXED, __HIP_MEMORY_SCOPE_WORKGROUP); }

__device__ __forceinline__ float wave_scan_incl(float v, int lane) {
#pragma unroll
    for (int o = 1; o < 64; o <<= 1) { const float t = __shfl_up(v, o); if (lane >= o) v += t; }
    return v;
}
template <int NCH> __device__ __forceinline__ void conv8(const bf16* proj, const float* cw, const float* cb, int grow0, int t0, bool seq_first, int cx0, float (&out)[8][NCH]) {
    float raw[11][NCH]; float w[4][NCH], bsv[NCH];
    unsigned rw[11][(NCH + 1) / 2];
#pragma unroll
    for (int r = 0; r < 11; ++r) { const int tt = t0 - 3 + r; const bf16* p = proj + (size_t)(grow0 + ((seq_first && tt < 0) ? 0 : tt)) * NIN + C_XBC + cx0;
        if constexpr (NCH == 4) { const v2u v = *(const GAS v2u*)p; rw[r][0] = v.x; rw[r][1] = v.y; }
        else if constexpr (NCH == 2) { rw[r][0] = *(const GAS unsigned*)p; }
        else { rw[r][0] = (unsigned)*p; } }
#pragma unroll
    for (int e = 0; e < NCH; ++e) { bsv[e] = cb[cx0 + e];
#pragma unroll
        for (int j = 0; j < 4; ++j) w[j][e] = cw[j * 768 + cx0 + e]; }
#pragma unroll
    for (int r = 0; r < 11; ++r)
#pragma unroll
        for (int q = 0; q < (NCH + 1) / 2; ++q) PIN(rw[r][q]);
#pragma unroll
    for (int r = 0; r < 11; ++r) { const bool z = seq_first && (t0 - 3 + r) < 0;
        if constexpr (NCH == 1) raw[r][0] = z ? 0.f : __uint_as_float(rw[r][0] << 16);
        else {
#pragma unroll
            for (int q = 0; q < NCH / 2; ++q) { raw[r][2 * q] = z ? 0.f : bf_lo(rw[r][q]); raw[r][2 * q + 1] = z ? 0.f : bf_hi(rw[r][q]); } } }
#pragma unroll
    for (int i = 0; i < 8; ++i)
#pragma unroll
        for (int e = 0; e < NCH; ++e) { const float v = bsv[e] + w[0][e] * raw[i][e] + w[1][e] * raw[i + 1][e] + w[2][e] * raw[i + 2][e] + w[3][e] * raw[i + 3][e]; out[i][e] = silu_f(v); }
}

__device__ __forceinline__ void ma_ssd_unit(const Args& A, LAS unsigned char* lds, int l, int b, int c, int grp, int tid, int lane, int wave) {
    asm volatile("" : "+v"(tid)); lane = tid & 63; wave = __builtin_amdgcn_readfirstlane(tid >> 6);
    unsigned char* ws = A.ws; const bf16* proj = (const bf16*)(ws + WS_PROJ); const float* DTV = (const float*)(ws + WS_DTV);
    LAS float* AC = (LAS float*)(lds); LAS float* DTs = (LAS float*)(lds + 1024); LAS unsigned char* XT = lds + 2048; LAS unsigned char* BT = lds + 2048 + 36864;
    const int grow0 = b * T + c * SSD_L;
    if (wave < 4) { const int h = 4 * grp + wave; const float an = -expf(A.in[I_A_LOG][l * 8 + h]); const float dt = DTV[(size_t)(grow0 + lane) * 8 + h];
        AC[wave * 64 + lane] = wave_scan_incl(dt * an, lane); DTs[wave * 64 + lane] = dt; }
    BLOCK_SYNC();
    { const int t0 = 8 * wave; const float* cw = A.in[I_CONV_W] + l * 4 * 768; const float* cb = A.in[I_CONV_B] + l * 768;
        float xs[8][4]; conv8<4>(proj, cw, cb, grow0, t0, c == 0, 256 * grp + 4 * lane, xs);
        const int hl = lane >> 4, p0 = 4 * (lane & 15); const float alast = AC[hl * 64 + 63];
        float sc[8];
#pragma unroll
        for (int i = 0; i < 8; ++i) sc[i] = DTs[hl * 64 + t0 + i] * __expf(alast - AC[hl * 64 + t0 + i]);
#pragma unroll
        for (int e = 0; e < 4; ++e) { v4u w; w.x = cvtpk(xs[0][e] * sc[0], xs[1][e] * sc[1]); w.y = cvtpk(xs[2][e] * sc[2], xs[3][e] * sc[3]); w.z = cvtpk(xs[4][e] * sc[4], xs[5][e] * sc[5]); w.w = cvtpk(xs[6][e] * sc[6], xs[7][e] * sc[7]);
            *(LAS v4u*)(XT + ((hl * 64 + p0 + e) * 72 + t0) * 2) = w; }
        float bm[8][1]; conv8<1>(proj, cw, cb, grow0, t0, c == 0, 512 + 64 * grp + lane, bm);
        v4u w; w.x = cvtpk(bm[0][0], bm[1][0]); w.y = cvtpk(bm[2][0], bm[3][0]); w.z = cvtpk(bm[4][0], bm[5][0]); w.w = cvtpk(bm[6][0], bm[7][0]);
        *(LAS v4u*)(BT + (lane * 72 + t0) * 2) = w; }
    BLOCK_SYNC();
    { const int hl = wave >> 1, ph = wave & 1, fr = lane & 15, fq = lane >> 4; f32x4 acc[2][4];
#pragma unroll
        for (int i = 0; i < 2; ++i)
#pragma unroll
            for (int j = 0; j < 4; ++j) acc[i][j] = (f32x4){0.f, 0.f, 0.f, 0.f};
#pragma unroll
        for (int ks = 0; ks < 2; ++ks) { bf16x8 fb[4], fx[2];
#pragma unroll
            for (int j = 0; j < 4; ++j) fb[j] = ldsfrag(BT + ((16 * j + fr) * 72 + 32 * ks + 8 * fq) * 2);
#pragma unroll
            for (int i = 0; i < 2; ++i) fx[i] = ldsfrag(XT + ((hl * 64 + 32 * ph + 16 * i + fr) * 72 + 32 * ks + 8 * fq) * 2);
#pragma unroll
            for (int i = 0; i < 2; ++i)
#pragma unroll
                for (int j = 0; j < 4; ++j) acc[i][j] = mfma16(fb[j], fx[i], acc[i][j]); }
        float* SS = (float*)(ws + WS_SS) + ((size_t)(b * SSD_NC + c) * 8 + 4 * grp + hl) * 4096;
#pragma unroll
        for (int i = 0; i < 2; ++i)
#pragma unroll
            for (int j = 0; j < 4; ++j) *(GAS f32x4*)(SS + (32 * ph + 16 * i + fr) * 64 + 16 * j + 4 * fq) = acc[i][j]; }
    if (tid < 4) ((float*)(ws + WS_CD))[(b * SSD_NC + c) * 8 + 4 * grp + tid] = expf(AC[tid * 64 + 63]);
    BLOCK_SYNC();
}

__device__ __forceinline__ void s5_bu(const Args& A, int l, int g, int grow0, int lane, LAS unsigned char* HS, float& ar, float& ai) {
    const unsigned char* tb = A.ws + WS_TAB + (size_t)l * TAB_L; const bf16* proj = (const bf16*)(A.ws + WS_PROJ); const int fr = lane & 15, fq = lane >> 4;
    const bf16* up = proj + (size_t)(grow0 + fr) * NIN + C_U5 + 16 * g + 8 * (fq & 1); const bf16* bp = (const bf16*)(tb + TB_BBT) + ((size_t)g * 128 + fr) * 16 + 8 * (fq & 1);
    v4u fu[2], fb[8];
#pragma unroll
    for (int rt = 0; rt < 2; ++rt) fu[rt] = *(const GAS v4u*)(up + (size_t)rt * 16 * NIN);
#pragma unroll
    for (int ct = 0; ct < 8; ++ct) fb[ct] = *(const GAS v4u*)(bp + ct * 256);
    f32x2 a = ((const f32x2*)(tb + TB_ABAR))[g * 64 + lane];
    PIN(fu[0]); PIN(fu[1]); PIN(a);
#pragma unroll
    for (int ct = 0; ct < 8; ++ct) PIN(fb[ct]);
    const v4u z = (v4u){0u, 0u, 0u, 0u}; const bool hi2 = fq >= 2;
#pragma unroll
    for (int rt = 0; rt < 2; ++rt) fu[rt] = hi2 ? z : fu[rt];
#pragma unroll
    for (int ct = 0; ct < 8; ++ct) fb[ct] = hi2 ? z : fb[ct];
#pragma unroll
    for (int rt = 0; rt < 2; ++rt)
#pragma unroll
        for (int ct = 0; ct < 8; ++ct) { const f32x4 d = mfma16(__builtin_bit_cast(bf16x8, fu[rt]), __builtin_bit_cast(bf16x8, fb[ct]), (f32x4){0.f, 0.f, 0.f, 0.f});
#pragma unroll
            for (int e = 0; e < 4; ++e) *(LAS bf16*)(HS + ((16 * rt + 4 * fq + e) * 136 + 16 * ct + fr) * 2) = f2b(d[e]); }
    ar = a.x; ai = a.y;
    WAVE_SYNC();
}
template <bool WRITEBACK> __device__ __forceinline__ void s5_scan(LAS unsigned char* HS, int lane, float ar, float ai, float& hr, float& hi) {
#pragma unroll 1
    for (int t0 = 0; t0 < S5_L; t0 += 8) { unsigned short br[8], bi[8];
#pragma unroll
        for (int i = 0; i < 8; ++i) { br[i] = *(const LAS bf16*)(HS + ((t0 + i) * 136 + lane) * 2); bi[i] = *(const LAS bf16*)(HS + ((t0 + i) * 136 + 64 + lane) * 2); }
#pragma unroll
        for (int i = 0; i < 8; ++i) { const float nr = ar * hr - ai * hi + bf2f(br[i]), ni = ar * hi + ai * hr + bf2f(bi[i]); hr = nr; hi = ni;
            if (WRITEBACK) { *(LAS bf16*)(HS + ((t0 + i) * 136 + lane) * 2) = f2b(hr); *(LAS bf16*)(HS + ((t0 + i) * 136 + 64 + lane) * 2) = f2b(hi); } } }
}
__device__ __forceinline__ void ma_s5_unit(const Args& A, LAS unsigned char* lds, int l, int b, int c, int lane, int wave) {
    asm volatile("" : "+v"(lane));
    LAS unsigned char* HS = lds + wave * 8704; const int grow0 = b * T + c * S5_L;
    float* ER = (float*)(A.ws + WS_S5ER); float* EI = (float*)(A.ws + WS_S5EI);
#pragma unroll 1
    for (int gi = 0; gi < 4; ++gi) { const int g = 4 * wave + gi; float ar, ai; s5_bu(A, l, g, grow0, lane, HS, ar, ai);
        float hr = 0.f, hi = 0.f; s5_scan<false>(HS, lane, ar, ai, hr, hi);
        const size_t o = ((size_t)(b * S5_NC + c) * 32 + g) * 64 + lane; ER[o] = hr; EI[o] = hi;
        WAVE_SYNC(); }
    BLOCK_SYNC();
}

__device__ __forceinline__ void mb_scan(const Args& A, int l, int vcu, int G, int tid, int dm = 0) {
    asm volatile("" : "+v"(tid));
    unsigned char* ws = A.ws; const int gt = vcu * NTHR + tid, NGT = G * NTHR;
    float* SS = (float*)(ws + (dm ? WS_END + 200 * MiB : WS_SS)); const float* CD = (const float*)(ws + WS_CD); float* outp = dm ? (float*)(ws + WS_END + 240 * MiB) : A.out;
#pragma unroll 1
    for (int i = gt; i < NB * 8 * 4096; i += NGT) { const int b = i >> 15, h = (i >> 12) & 7, pn = i & 4095; float run = 0.f; float s[SSD_NC], d[SSD_NC];
        float* p = SS + ((size_t)(b * SSD_NC) * 8 + h) * 4096 + pn; const float* dp = CD + (b * SSD_NC) * 8 + h;
#pragma unroll
        for (int c = 0; c < SSD_NC; ++c) { s[c] = p[(size_t)c * 8 * 4096]; d[c] = dp[c * 8]; }
#pragma unroll
        for (int c = 0; c < SSD_NC; ++c) { PIN(s[c]); PIN(d[c]); }
#pragma unroll
        for (int c = 0; c < SSD_NC; ++c) { p[(size_t)c * 8 * 4096] = run; run = run * d[c] + s[c]; }
        outp[O_PSSD + (size_t)l * NB * 8 * 4096 + i] = run; }
    float* ER = (float*)(ws + (dm ? WS_END + 220 * MiB : WS_S5ER)); float* EI = (float*)(ws + (dm ? WS_END + 224 * MiB : WS_S5EI)); const f32x2* AL = (const f32x2*)(ws + WS_TAB + (size_t)l * TAB_L + TB_ABARL);
#pragma unroll 1
    for (int i = gt; i < NB * 2048; i += NGT) { const int b = i >> 11, gn = i & 2047; const f32x2 a = AL[gn]; float rr = 0.f, ri = 0.f;
#pragma unroll 1
        for (int c0 = 0; c0 < S5_NC; c0 += 32) { float er[32], ei[32]; const size_t o = (size_t)(b * S5_NC + c0) * 2048 + gn;
#pragma unroll
            for (int c = 0; c < 32; ++c) { er[c] = ER[o + (size_t)c * 2048]; ei[c] = EI[o + (size_t)c * 2048]; }
#pragma unroll
            for (int c = 0; c < 32; ++c) { PIN(er[c]); PIN(ei[c]); }
#pragma unroll
            for (int c = 0; c < 32; ++c) { ER[o + (size_t)c * 2048] = rr; EI[o + (size_t)c * 2048] = ri; const float nr = a.x * rr - a.y * ri + er[c], ni = a.x * ri + a.y * rr + ei[c]; rr = nr; ri = ni; } }
        outp[O_PS5R + (size_t)l * NB * 2048 + i] = rr; outp[O_PS5I + (size_t)l * NB * 2048 + i] = ri; }
}

__device__ __forceinline__ void mc_s5_unit(const Args& A, LAS unsigned char* lds, int l, int b, int c, int tid, int lane, int wave) {
    asm volatile("" : "+v"(tid)); lane = tid & 63; wave = __builtin_amdgcn_readfirstlane(tid >> 6);
    unsigned char* ws = A.ws; const unsigned char* tb = ws + WS_TAB + (size_t)l * TAB_L;
    LAS unsigned char* HS = lds + 16384 + wave * 8704;
    LAS unsigned char* Y = lds + 16384 + 8 * 8704; LAS float* SQ = (LAS float*)(lds + 16384 + 8 * 8704 + 33280);
    const int grow0 = b * T + c * S5_L, fr = lane & 15, fq = lane >> 4;
    const float* ER = (const float*)(ws + WS_S5ER); const float* EI = (const float*)(ws + WS_S5EI);
#pragma unroll 1
    for (int gi = 0; gi < 4; ++gi) { const int g = 4 * wave + gi;
        const size_t o = ((size_t)(b * S5_NC + c) * 32 + g) * 64 + lane; float hr = ER[o], hi = EI[o];
        const bf16* cmt = (const bf16*)(tb + TB_CMT) + (size_t)g * 16 * 128; float dsk = A.in[I_S5_D][l * 512 + 16 * g + fr]; bf16x8 fc[4]; unsigned uk[2][4];
        const bf16* proj = (const bf16*)(ws + WS_PROJ);
#pragma unroll
        for (int ks = 0; ks < 4; ++ks) fc[ks] = gfrag(cmt + fr * 128 + 32 * ks + 8 * fq);
#pragma unroll
        for (int rt = 0; rt < 2; ++rt)
#pragma unroll
            for (int e = 0; e < 4; ++e) uk[rt][e] = (unsigned)proj[(size_t)(grow0 + 16 * rt + 4 * fq + e) * NIN + C_U5 + 16 * g + fr];
        float ar, ai; s5_bu(A, l, g, grow0, lane, HS, ar, ai);
        PIN(hr); PIN(hi); PIN(dsk);
#pragma unroll
        for (int ks = 0; ks < 4; ++ks) PIN(fc[ks]);
#pragma unroll
        for (int rt = 0; rt < 2; ++rt)
#pragma unroll
            for (int e = 0; e < 4; ++e) PIN(uk[rt][e]);
        s5_scan<true>(HS, lane, ar, ai, hr, hi);
        WAVE_SYNC();
        f32x4 acc[2] = {(f32x4){0.f, 0.f, 0.f, 0.f}, (f32x4){0.f, 0.f, 0.f, 0.f}};
#pragma unroll
        for (int ks = 0; ks < 4; ++ks)
#pragma unroll
            for (int rt = 0; rt < 2; ++rt) acc[rt] = mfma16(ldsfrag(HS + ((16 * rt + fr) * 136 + 32 * ks + 8 * fq) * 2), fc[ks], acc[rt]);
#pragma unroll
        for (int rt = 0; rt < 2; ++rt)
#pragma unroll
            for (int e = 0; e < 4; ++e) { const int t = 16 * rt + 4 * fq + e; const float y = acc[rt][e] + dsk * __uint_as_float(uk[rt][e] << 16); *(LAS bf16*)(Y + (t * 520 + 16 * g + fr) * 2) = f2b(gelu_tanh_f(y)); }
        WAVE_SYNC(); }
    BLOCK_SYNC();
    const bf16* wg = (const bf16*)(tb + TB_WGLUT); f32x4 acc[2][4];
#pragma unroll
    for (int i = 0; i < 2; ++i)
#pragma unroll
        for (int j = 0; j < 4; ++j) acc[i][j] = (f32x4){0.f, 0.f, 0.f, 0.f};
    float bgl[4];
#pragma unroll
    for (int j = 0; j < 4; ++j) bgl[j] = A.in[I_B_GLU][l * 512 + 64 * wave + 16 * j + fr];
#pragma unroll 1
    for (int k4 = 0; k4 < 16; k4 += 4) { bf16x8 fb[4][4];
#pragma unroll
        for (int q = 0; q < 4; ++q)
#pragma unroll
            for (int j = 0; j < 4; ++j) fb[q][j] = gfrag(wg + sfrag(64 * wave + 16 * j, 32 * (k4 + q), 512) + 8 * lane);
#pragma unroll
        for (int q = 0; q < 4; ++q)
#pragma unroll
            for (int j = 0; j < 4; ++j) PIN(fb[q][j]);
#pragma unroll
        for (int q = 0; q < 4; ++q) { bf16x8 fa[2];
#pragma unroll
            for (int i = 0; i < 2; ++i) fa[i] = ldsfrag(Y + ((16 * i + fr) * 520 + 32 * (k4 + q) + 8 * fq) * 2);
#pragma unroll
            for (int i = 0; i < 2; ++i)
#pragma unroll
                for (int j = 0; j < 4; ++j) acc[i][j] = mfma16(fa[i], fb[q][j], acc[i][j]); } }
#pragma unroll
    for (int i = 0; i < 2; ++i)
#pragma unroll
        for (int e = 0; e < 4; ++e) { const int t = 16 * i + 4 * fq + e; float sq = 0.f;
#pragma unroll
            for (int j = 0; j < 4; ++j) { const int col = 64 * wave + 16 * j + fr; const float yv = bf2f(*(const LAS bf16*)(Y + (t * 520 + col) * 2));
                const float o = yv * sigmoid_f(acc[i][j][e] + bgl[j]); acc[i][j][e] = o; sq += o * o; }
            sq = sum16(sq); if (fr == 0) SQ[wave * 32 + t] = sq; }
    BLOCK_SYNC();
    bf16* mix = (bf16*)(ws + WS_MIX);
#pragma unroll
    for (int i = 0; i < 2; ++i)
#pragma unroll
        for (int e = 0; e < 4; ++e) { const int t = 16 * i + 4 * fq + e; float sq = 0.f;
#pragma unroll
            for (int w = 0; w < 8; ++w) sq += SQ[w * 32 + t];
            const float rs = __builtin_amdgcn_rsqf(sq * (1.0f / 512.0f) + EPS);
#pragma unroll
            for (int j = 0; j < 4; ++j) mix[(size_t)(grow0 + t) * D + 512 + 64 * wave + 16 * j + fr] = f2b(acc[i][j][e] * rs); }
    BLOCK_SYNC();
}


#define RELANE() do { asm volatile("" : "+v"(tid)); lane = tid & 63; fr = lane & 15; fq = lane >> 4; } while (0)
__device__ __forceinline__ void mc_rest_unit(const Args& A, LAS unsigned char* lds, int l, int b, int c, int tid, int lane, int wave) {
    asm volatile("" : "+v"(tid)); lane = tid & 63; wave = __builtin_amdgcn_readfirstlane(tid >> 6);
    unsigned char* ws = A.ws; const bf16* proj = (const bf16*)(ws + WS_PROJ); const float* DTV = (const float*)(ws + WS_DTV); bf16* mix = (bf16*)(ws + WS_MIX);
    LAS float* AC = (LAS float*)lds; LAS float* DTs = (LAS float*)(lds + 2048); LAS float* SQ = (LAS float*)(lds + 96768); LAS float* SQ2 = (LAS float*)(lds + 98816);
    LAS unsigned char* XT = lds + 4608; LAS unsigned char* BMs = lds + 41472; LAS unsigned char* CMs = lds + 50688; LAS unsigned char* PW = lds + 59904 + wave * 4608;
    LAS unsigned char* PL = lds + 4608;
    const int grow0 = b * T + c * SSD_L; int fr = lane & 15, fq = lane >> 4; const bool first = (c == 0), lastc = (c == SSD_NC - 1);
    const float* cw = A.in[I_CONV_W] + l * 4 * 768; const float* cb = A.in[I_CONV_B] + l * 768;
    { const float an = -expf(A.in[I_A_LOG][l * 8 + wave]); const float dt = DTV[(size_t)(grow0 + lane) * 8 + wave];
        AC[wave * 64 + lane] = wave_scan_incl(dt * an, lane); DTs[wave * 64 + lane] = dt; }
    BLOCK_SYNC();
    f32x4 yv[2][2][4];
#pragma unroll
    for (int half = 0; half < 2; ++half) {
        RELANE();
        { const int t0 = 8 * wave; float xs[8][4]; conv8<4>(proj, cw, cb, grow0, t0, first, 256 * half + 4 * lane, xs);
            const int hl = lane >> 4, p0 = 4 * (lane & 15);
#pragma unroll
            for (int e = 0; e < 4; ++e) { v4u w; w.x = cvtpk(xs[0][e], xs[1][e]); w.y = cvtpk(xs[2][e], xs[3][e]); w.z = cvtpk(xs[4][e], xs[5][e]); w.w = cvtpk(xs[6][e], xs[7][e]);
                *(LAS v4u*)(XT + ((hl * 64 + p0 + e) * 72 + t0) * 2) = w; }
            float bc[8][2]; const int isc = lane >> 5, n0 = 2 * (lane & 31); conv8<2>(proj, cw, cb, grow0, t0, first, 512 + 128 * isc + 64 * half + n0, bc);
            LAS unsigned char* dst = isc ? CMs : BMs;
#pragma unroll
            for (int i = 0; i < 8; ++i) *(LAS unsigned*)(dst + ((t0 + i) * 72 + n0) * 2) = cvtpk(bc[i][0], bc[i][1]); }
        BLOCK_SYNC(); RELANE();
        { const int hl = wave >> 1, th = wave & 1, h = 4 * half + hl;
#pragma unroll
            for (int rt = 0; rt < 2; ++rt) { const bf16x8 fc0 = ldsfrag(CMs + ((32 * th + 16 * rt + fr) * 72 + 8 * fq) * 2), fc1 = ldsfrag(CMs + ((32 * th + 16 * rt + fr) * 72 + 32 + 8 * fq) * 2);
#pragma unroll
                for (int st = 0; st < 4; ++st) { f32x4 g = (f32x4){0.f, 0.f, 0.f, 0.f};
                    g = mfma16(fc0, ldsfrag(BMs + ((16 * st + fr) * 72 + 8 * fq) * 2), g); g = mfma16(fc1, ldsfrag(BMs + ((16 * st + fr) * 72 + 32 + 8 * fq) * 2), g);
                    const int s = 16 * st + fr; const float as = AC[h * 64 + s], ds = DTs[h * 64 + s];
#pragma unroll
                    for (int e = 0; e < 4; ++e) { const int tl = 16 * rt + 4 * fq + e, t = 32 * th + tl; const float pv = (s <= t) ? g[e] * __expf(AC[h * 64 + t] - as) * ds : 0.f;
                        *(LAS bf16*)(PW + (tl * 72 + s) * 2) = f2b(pv); } asm volatile("" ::: "memory"); } }
            WAVE_SYNC(); RELANE();
            const float* HP = (const float*)(ws + WS_SS) + ((size_t)(b * SSD_NC + c) * 8 + h) * 4096; float dsk = A.in[I_SSD_D][l * 8 + h]; float sqp[2][4];
            bf16x8 hpf[4][2];
            { f32x4 hq[4][4];
#pragma unroll
                for (int pt = 0; pt < 4; ++pt) { const float* hp = HP + (16 * pt + fr) * 64 + 8 * fq; hq[pt][0] = *(const GAS f32x4*)hp; hq[pt][1] = *(const GAS f32x4*)(hp + 4); hq[pt][2] = *(const GAS f32x4*)(hp + 32); hq[pt][3] = *(const GAS f32x4*)(hp + 36); }
#pragma unroll
                for (int pt = 0; pt < 4; ++pt)
#pragma unroll
                    for (int q = 0; q < 4; ++q) PIN(hq[pt][q]);
#pragma unroll
                for (int pt = 0; pt < 4; ++pt) { hpf[pt][0] = pack8(hq[pt][0], hq[pt][1]); hpf[pt][1] = pack8(hq[pt][2], hq[pt][3]); } }
            PIN(dsk);
#pragma unroll
            for (int rt = 0; rt < 2; ++rt) { const bf16x8 fp0 = ldsfrag(PW + ((16 * rt + fr) * 72 + 8 * fq) * 2), fp1 = ldsfrag(PW + ((16 * rt + fr) * 72 + 32 + 8 * fq) * 2);
                const bf16x8 fc0 = ldsfrag(CMs + ((32 * th + 16 * rt + fr) * 72 + 8 * fq) * 2), fc1 = ldsfrag(CMs + ((32 * th + 16 * rt + fr) * 72 + 32 + 8 * fq) * 2);
                unsigned zr[4][4];
#pragma unroll
                for (int pt = 0; pt < 4; ++pt)
#pragma unroll
                    for (int e = 0; e < 4; ++e) zr[pt][e] = (unsigned)proj[(size_t)(grow0 + 32 * th + 16 * rt + 4 * fq + e) * NIN + C_Z + 64 * h + 16 * pt + fr];
#pragma unroll
                for (int pt = 0; pt < 4; ++pt)
#pragma unroll
                    for (int e = 0; e < 4; ++e) PIN(zr[pt][e]);
#pragma unroll
                for (int e = 0; e < 4; ++e) sqp[rt][e] = 0.f;
#pragma unroll
                for (int pt = 0; pt < 4; ++pt) { const int p = 16 * pt + fr; f32x4 y = (f32x4){0.f, 0.f, 0.f, 0.f}, yo = (f32x4){0.f, 0.f, 0.f, 0.f};
                    y = mfma16(fp0, ldsfrag(XT + ((hl * 64 + p) * 72 + 8 * fq) * 2), y); y = mfma16(fp1, ldsfrag(XT + ((hl * 64 + p) * 72 + 32 + 8 * fq) * 2), y);
                    yo = mfma16(fc0, hpf[pt][0], yo); yo = mfma16(fc1, hpf[pt][1], yo);
                    const v2u xw = *(const LAS v2u*)(XT + ((hl * 64 + p) * 72 + 32 * th + 16 * rt + 4 * fq) * 2); const float xv[4] = {bf_lo(xw.x), bf_hi(xw.x), bf_lo(xw.y), bf_hi(xw.y)};
#pragma unroll
                    for (int e = 0; e < 4; ++e) { const int t = 32 * th + 16 * rt + 4 * fq + e; const float z = __uint_as_float(zr[pt][e] << 16);
                        const float v = (y[e] + __expf(AC[h * 64 + t]) * yo[e] + dsk * xv[e]) * silu_f(z); y[e] = v; sqp[rt][e] += v * v; }
                    yv[half][rt][pt] = y; }
#pragma unroll
                for (int e = 0; e < 4; ++e) { const float s = sum16(sqp[rt][e]); if (fr == 0) SQ[(half * 4 + hl) * 64 + 32 * th + 16 * rt + 4 * fq + e] = s; } } }
        BLOCK_SYNC();
    }
    RELANE();
    { const int hl = wave >> 1, th = wave & 1;
#pragma unroll
        for (int half = 0; half < 2; ++half)
#pragma unroll
            for (int rt = 0; rt < 2; ++rt)
#pragma unroll
                for (int e = 0; e < 4; ++e) { const int t = 32 * th + 16 * rt + 4 * fq + e; float sq = 0.f;
#pragma unroll
                    for (int w = 0; w < 8; ++w) sq += SQ[w * 64 + t];
                    const float rs = __builtin_amdgcn_rsqf(sq * (1.0f / 512.0f) + EPS);
#pragma unroll
                    for (int pt = 0; pt < 4; ++pt) mix[(size_t)(grow0 + t) * D + 64 * (4 * half + hl) + 16 * pt + fr] = f2b(yv[half][rt][pt][e] * rs); } }
    RELANE();
    { const int t0 = 8 * wave, ch = 8 * lane; v4u gcr[10], hvr[10], gbr[8]; float w[3][8];
#pragma unroll
        for (int r = 0; r < 10; ++r) { const int tt = t0 - 2 + r; const bf16* p = proj + (size_t)(grow0 + ((first && tt < 0) ? 0 : tt)) * NIN; gcr[r] = *(const GAS v4u*)(p + C_GC + ch); hvr[r] = *(const GAS v4u*)(p + C_HV + ch); }
#pragma unroll
        for (int i = 0; i < 8; ++i) gbr[i] = *(const GAS v4u*)(proj + (size_t)(grow0 + t0 + i) * NIN + C_GB + ch);
#pragma unroll
        for (int j = 0; j < 3; ++j)
#pragma unroll
            for (int e = 0; e < 8; ++e) w[j][e] = A.in[I_SC_W][(l * 3 + j) * 512 + ch + e];
#pragma unroll
        for (int r = 0; r < 10; ++r) { PIN(gcr[r]); PIN(hvr[r]); }
#pragma unroll
        for (int i = 0; i < 8; ++i) PIN(gbr[i]);
        float v2[8], v1[8];
#pragma unroll
        for (int r = 0; r < 10; ++r) { float gc[8], hv[8], v0[8]; unpack8(gcr[r], gc); unpack8(hvr[r], hv); const bool z = first && (t0 - 2 + r) < 0;
#pragma unroll
            for (int e = 0; e < 8; ++e) v0[e] = z ? 0.f : gc[e] * hv[e];
            if (r >= 2) { const int tt = t0 + r - 2; float gb[8], y[8]; unpack8(gbr[r - 2], gb); float sq = 0.f;
#pragma unroll
                for (int e = 0; e < 8; ++e) { y[e] = gb[e] * (w[0][e] * v2[e] + w[1][e] * v1[e] + w[2][e] * v0[e]); sq += y[e] * y[e]; }
                const float rs = __builtin_amdgcn_rsqf(wave_sum(sq) * (1.0f / 512.0f) + EPS);
                v4u o; o.x = cvtpk(y[0] * rs, y[1] * rs); o.y = cvtpk(y[2] * rs, y[3] * rs); o.z = cvtpk(y[4] * rs, y[5] * rs); o.w = cvtpk(y[6] * rs, y[7] * rs);
                *(GAS v4u*)(mix + (size_t)(grow0 + tt) * D + 1024 + ch) = o;
                if (lastc && tt >= 62) { float* o2 = A.out + O_PSC + ((size_t)(l * NB + b) * 2 + (tt - 62)) * 512 + ch; *(GAS f32x4*)o2 = (f32x4){v0[0], v0[1], v0[2], v0[3]}; *(GAS f32x4*)(o2 + 4) = (f32x4){v0[4], v0[5], v0[6], v0[7]}; } }
#pragma unroll
            for (int e = 0; e < 8; ++e) { v2[e] = v1[e]; v1[e] = v0[e]; } }
    }
    BLOCK_SYNC();
#pragma unroll 1
    for (int hh = 0; hh < 2; ++hh) { RELANE(); const int t0 = 8 * wave, ch = 4 * lane + 256 * hh, gI = ch >> 7;
        float u[23][4]; v2u ur[23];
#pragma unroll
        for (int r = 0; r < 23; ++r) { const int tt = t0 - 15 + r; ur[r] = *(const GAS v2u*)(proj + (size_t)(grow0 + ((first && tt < 0) ? 0 : tt)) * NIN + C_UP + ch); }
#pragma unroll
        for (int r = 0; r < 23; ++r) PIN(ur[r]);
#pragma unroll
        for (int r = 0; r < 23; ++r) { const bool z = first && (t0 - 15 + r) < 0; u[r][0] = z ? 0.f : bf_lo(ur[r].x); u[r][1] = z ? 0.f : bf_hi(ur[r].x); u[r][2] = z ? 0.f : bf_lo(ur[r].y); u[r][3] = z ? 0.f : bf_hi(ur[r].y); }
        const int win = 2 << gI;
#pragma unroll
        for (int i = 0; i < 8; ++i) { const int r = 15 + i; float pv[4]; const int pos = c * SSD_L + t0 + i; const float inv = 1.0f / (float)(pos + 1 < win ? pos + 1 : win);
#pragma unroll
            for (int e = 0; e < 4; ++e) { const float s2 = u[r][e] + u[r - 1][e], s4 = s2 + u[r - 2][e] + u[r - 3][e], s8 = s4 + (u[r - 4][e] + u[r - 5][e]) + (u[r - 6][e] + u[r - 7][e]);
                const float s16 = s8 + ((u[r - 8][e] + u[r - 9][e]) + (u[r - 10][e] + u[r - 11][e])) + ((u[r - 12][e] + u[r - 13][e]) + (u[r - 14][e] + u[r - 15][e]));
                const float cs = gI == 0 ? s2 : gI == 1 ? s4 : gI == 2 ? s8 : s16; pv[e] = cs * inv - u[r][e]; }
            v2u o; o.x = cvtpk(pv[0], pv[1]); o.y = cvtpk(pv[2], pv[3]); *(LAS v2u*)(PL + ((t0 + i) * 520 + ch) * 2) = o;
            if (lastc && t0 + i >= 49) *(GAS f32x4*)(A.out + O_PPOOL + ((size_t)(l * NB + b) * 15 + (t0 + i - 49)) * 512 + ch) = (f32x4){u[r][0], u[r][1], u[r][2], u[r][3]}; }
    }
    BLOCK_SYNC(); RELANE();
    { const int gI = wave >> 1, dh = wave & 1; const bf16* wp = (const bf16*)(ws + WS_TAB + (size_t)l * TAB_L + TB_WPT) + (size_t)gI * 128 * 128; f32x4 acc[4][4];
#pragma unroll
        for (int i = 0; i < 4; ++i)
#pragma unroll
            for (int j = 0; j < 4; ++j) acc[i][j] = (f32x4){0.f, 0.f, 0.f, 0.f};
        bf16x8 fbw[4][4]; float psc[4];
#pragma unroll
        for (int ks = 0; ks < 4; ++ks)
#pragma unroll
            for (int j = 0; j < 4; ++j) fbw[ks][j] = gfrag(wp + sfrag(64 * dh + 16 * j, 32 * ks, 128) + 8 * lane);
#pragma unroll
        for (int j = 0; j < 4; ++j) psc[j] = A.in[I_POOL_SCALE][l * 512 + 128 * gI + 64 * dh + 16 * j + fr];
#pragma unroll
        for (int ks = 0; ks < 4; ++ks)
#pragma unroll
            for (int j = 0; j < 4; ++j) PIN(fbw[ks][j]);
#pragma unroll
        for (int ks = 0; ks < 4; ++ks) { bf16x8 fa[4];
#pragma unroll
            for (int i = 0; i < 4; ++i) fa[i] = ldsfrag(PL + ((16 * i + fr) * 520 + 128 * gI + 32 * ks + 8 * fq) * 2);
#pragma unroll
            for (int i = 0; i < 4; ++i)
#pragma unroll
                for (int j = 0; j < 4; ++j) acc[i][j] = mfma16(fa[i], fbw[ks][j], acc[i][j]); }
#pragma unroll
        for (int i = 0; i < 4; ++i)
#pragma unroll
            for (int e = 0; e < 4; ++e) { float sq = 0.f;
#pragma unroll
                for (int j = 0; j < 4; ++j) { const float o = acc[i][j][e] * psc[j]; acc[i][j][e] = o; sq += o * o; }
                sq = sum16(sq); if (fr == 0) SQ2[wave * 64 + 16 * i + 4 * fq + e] = sq; }
        BLOCK_SYNC();
#pragma unroll
        for (int i = 0; i < 4; ++i)
#pragma unroll
            for (int e = 0; e < 4; ++e) { const int t = 16 * i + 4 * fq + e; float sq = 0.f;
#pragma unroll
                for (int w = 0; w < 8; ++w) sq += SQ2[w * 64 + t];
                const float rs = __builtin_amdgcn_rsqf(sq * (1.0f / 512.0f) + EPS);
#pragma unroll
                for (int j = 0; j < 4; ++j) mix[(size_t)(grow0 + t) * D + 1536 + 128 * gI + 64 * dh + 16 * j + fr] = f2b(acc[i][j][e] * rs); }
    }
    if (lastc) for (int i = tid; i < 3 * 768; i += NTHR) { const int r = i / 768, ch = i % 768; A.out[O_PCONV + ((size_t)(l * NB + b) * 3 + r) * 768 + ch] = bf2f(proj[(size_t)(grow0 + 61 + r) * NIN + C_XBC + ch]); }
    BLOCK_SYNC();
}

__device__ __forceinline__ void mc_sample_unit(const Args& A, LAS unsigned char* lds, int l, int s, int tid, int lane, int wave) {
    asm volatile("" : "+v"(tid)); lane = tid & 63; wave = __builtin_amdgcn_readfirstlane(tid >> 6);
    unsigned char* ws = A.ws; const bf16* proj = (const bf16*)(ws + WS_PROJ) + (size_t)(MP + s) * NIN; const unsigned char* tb = ws + WS_TAB + (size_t)l * TAB_L; float* out = A.out;
    LAS float* XC = (LAS float*)lds; LAS float* U5 = (LAS float*)(lds + 5120); LAS float* Y5 = (LAS float*)(lds + 7168); LAS float* PLs = (LAS float*)(lds + 9216); LAS float* OUT = (LAS float*)(lds + 11264); LAS float* ZP = (LAS float*)(lds + 19456);
    const int ls = l * MS + s;
    { const int c1 = tid < 256 ? tid + 512 : tid; const float* st0 = A.in[I_ST_CONV] + (size_t)ls * 3 * 768; const float* cw = A.in[I_CONV_W] + l * 4 * 768;
        float a[2][3], nwv[2], wv[2][4], bsv[2]; const int chs[2] = {tid, c1};
#pragma unroll
        for (int q = 0; q < 2; ++q) { const int ch = chs[q]; a[q][0] = st0[ch]; a[q][1] = st0[768 + ch]; a[q][2] = st0[1536 + ch]; nwv[q] = bf2f(proj[C_XBC + ch]); bsv[q] = A.in[I_CONV_B][l * 768 + ch];
#pragma unroll
            for (int j = 0; j < 4; ++j) wv[q][j] = cw[j * 768 + ch]; }
        float u5v = bf2f(proj[C_U5 + tid]);
#pragma unroll
        for (int q = 0; q < 2; ++q) { PIN(a[q][0]); PIN(a[q][1]); PIN(a[q][2]); PIN(nwv[q]); PIN(bsv[q]); PIN(wv[q][0]); PIN(wv[q][1]); PIN(wv[q][2]); PIN(wv[q][3]); }
        PIN(u5v);
#pragma unroll
        for (int q = 0; q < 2; ++q) if (q == 0 || tid < 256) { const int ch = chs[q]; XC[ch] = silu_f(bsv[q] + wv[q][0] * a[q][0] + wv[q][1] * a[q][1] + wv[q][2] * a[q][2] + wv[q][3] * nwv[q]);
            float* o = out + O_SCONV + (size_t)ls * 3 * 768 + ch; o[0] = a[q][1]; o[768] = a[q][2]; o[1536] = nwv[q]; }
        U5[tid] = u5v; }
    BLOCK_SYNC();
    { const int h = wave; const float dt = ((const float*)(ws + WS_DTV))[(size_t)(MP + s) * 8 + h], dec = expf(-dt * expf(A.in[I_A_LOG][l * 8 + h])), dsk = A.in[I_SSD_D][l * 8 + h];
        const int n4 = 4 * (lane & 15); const f32x4 Bv = *(const LAS f32x4*)(XC + 512 + 64 * (h >> 2) + n4), Cv = *(const LAS f32x4*)(XC + 640 + 64 * (h >> 2) + n4);
        const size_t o0 = (((size_t)ls * 8 + h) * 64 + (lane >> 4)) * 64 + n4; f32x4 h0[16]; unsigned zr[16];
#pragma unroll
        for (int it = 0; it < 16; ++it) { h0[it] = __builtin_nontemporal_load((const GAS f32x4*)(A.in[I_ST_SSD] + o0 + (size_t)it * 256)); zr[it] = (unsigned)proj[C_Z + 64 * h + it * 4 + (lane >> 4)]; }
#pragma unroll
        for (int it = 0; it < 16; ++it) { PIN(h0[it]); PIN(zr[it]); }
#pragma unroll
        for (int it = 0; it < 16; ++it) { const int p = it * 4 + (lane >> 4); const float x = XC[64 * h + p]; const f32x4 hn = h0[it] * dec + Bv * (dt * x);
            __builtin_nontemporal_store(hn, (GAS f32x4*)(out + O_SSSD + o0 + (size_t)it * 256));
            float y = (hn.x * Cv.x + hn.y * Cv.y) + (hn.z * Cv.z + hn.w * Cv.w); y = sum16(y);
            if ((lane & 15) == 0) OUT[64 * h + p] = (y + dsk * x) * silu_f(__uint_as_float(zr[it] << 16)); } }
#pragma unroll 1
    for (int gi = 0; gi < 4; ++gi) { const int g = 4 * wave + gi; const f32x2* bb = (const f32x2*)(tb + TB_BBAR) + (size_t)g * 16 * 64 + lane; f32x2 bv[16]; float cr[16], ci[16];
        const float* cre = A.in[I_C_RE] + ((size_t)l * 32 + g) * 1024 + lane; const float* cim = A.in[I_C_IM] + ((size_t)l * 32 + g) * 1024 + lane;
#pragma unroll
        for (int k = 0; k < 16; ++k) { bv[k] = bb[k * 64]; cr[k] = cre[k * 64]; ci[k] = cim[k * 64]; }
        f32x2 a = ((const f32x2*)(tb + TB_ABAR))[g * 64 + lane]; const size_t o = ((size_t)ls * 32 + g) * 64 + lane; float h0r = A.in[I_ST_S5R][o], h0i = A.in[I_ST_S5I][o]; float dv = A.in[I_S5_D][l * 512 + 16 * g + (lane & 15)];
        PIN(a); PIN(h0r); PIN(h0i); PIN(dv);
#pragma unroll
        for (int k = 0; k < 16; ++k) { PIN(bv[k]); PIN(cr[k]); PIN(ci[k]); }
        float br = 0.f, bi = 0.f;
#pragma unroll
        for (int k = 0; k < 16; ++k) { const float u = U5[16 * g + k]; br += bv[k].x * u; bi += bv[k].y * u; }
        const float hr = a.x * h0r - a.y * h0i + br, hi = a.x * h0i + a.y * h0r + bi; out[O_SS5R + o] = hr; out[O_SS5I + o] = hi;
        float mine = 0.f;
#pragma unroll
        for (int k = 0; k < 16; ++k) { const float v = wave_sum(cr[k] * hr - ci[k] * hi); mine = (lane == k) ? v : mine; }
        if (lane < 16) Y5[16 * g + lane] = gelu_tanh_f(mine + dv * U5[16 * g + lane]); }
    { const int c = tid, gI = c >> 7, win = 2 << gI; const float* st = A.in[I_ST_SC] + (size_t)ls * 2 * 512 + c; const float* w = A.in[I_SC_W] + l * 3 * 512 + c; const float* sp = A.in[I_ST_POOL] + (size_t)ls * 15 * 512 + c;
        float s0 = st[0], s1 = st[512], gc = bf2f(proj[C_GC + c]), hvv = bf2f(proj[C_HV + c]), gb = bf2f(proj[C_GB + c]), w0 = w[0], w1 = w[512], w2 = w[1024], u = bf2f(proj[C_UP + c]); float hh[15];
#pragma unroll
        for (int r = 0; r < 15; ++r) hh[r] = sp[r * 512];
        PIN(s0); PIN(s1); PIN(gc); PIN(hvv); PIN(gb); PIN(w0); PIN(w1); PIN(w2); PIN(u);
#pragma unroll
        for (int r = 0; r < 15; ++r) PIN(hh[r]);
        const float v = gc * hvv; OUT[1024 + c] = gb * (w0 * s0 + w1 * s1 + w2 * v); float* o = out + O_SSC + (size_t)ls * 2 * 512 + c; o[0] = s1; o[512] = v;
        float* op = out + O_SPOOL + (size_t)ls * 15 * 512 + c; float sum = u;
#pragma unroll
        for (int r = 0; r < 15; ++r) { if (15 - r < win) sum += hh[r]; if (r > 0) op[(r - 1) * 512] = hh[r]; }
        op[14 * 512] = u; PLs[c] = sum / (float)win - u; }
    BLOCK_SYNC();
    { const int fq = lane >> 4;
        { const int gI = wave >> 1; const bf16* wp = (const bf16*)(tb + TB_WPT) + (size_t)gI * 128 * 128 + (size_t)(4 * (wave & 1)) * 4 * 512 + 8 * lane;
            v4u pw[4][4]; float pa[4] = {0.f, 0.f, 0.f, 0.f};
#pragma unroll
            for (int ks = 0; ks < 4; ++ks)
#pragma unroll
                for (int j = 0; j < 4; ++j) pw[ks][j] = *(const GAS v4u*)(wp + ((size_t)(j * 4 + ks) << 9));
            const float psc = A.in[I_POOL_SCALE][l * 512 + 64 * wave + lane];
#pragma unroll
            for (int ks = 0; ks < 4; ++ks)
#pragma unroll
                for (int j = 0; j < 4; ++j) PIN(pw[ks][j]);
#pragma unroll
            for (int ks = 0; ks < 4; ++ks) { const LAS float* yp = PLs + 128 * gI + 32 * ks + 8 * fq; const f32x4 y0 = *(const LAS f32x4*)yp, y1 = *(const LAS f32x4*)(yp + 4);
#pragma unroll
                for (int j = 0; j < 4; ++j) { float f[8]; unpack8(pw[ks][j], f);
                    pa[j] += (f[0] * y0.x + f[1] * y0.y) + (f[2] * y0.z + f[3] * y0.w) + (f[4] * y1.x + f[5] * y1.y) + (f[6] * y1.z + f[7] * y1.w); } }
            float mine = 0.f;
#pragma unroll
            for (int j = 0; j < 4; ++j) { float t = pa[j]; t += __shfl_xor(t, 16); t += __shfl_xor(t, 32); mine = (fq == j) ? t : mine; }
            OUT[1536 + 64 * wave + lane] = mine * psc; }
        { const bf16* wg = (const bf16*)(tb + TB_WGLUT) + (size_t)(4 * wave) * 16 * 512 + 8 * lane;
            float ga[4] = {0.f, 0.f, 0.f, 0.f}; const float bgl = A.in[I_B_GLU][l * 512 + 64 * wave + lane];
#pragma unroll 1
            for (int kb = 0; kb < 16; kb += 4) { v4u wv[4][4]; const bf16* wk = wg + ((size_t)kb << 9); asm volatile("" : "+v"(wk));
#pragma unroll
                for (int q = 0; q < 4; ++q)
#pragma unroll
                    for (int j = 0; j < 4; ++j) wv[q][j] = *(const GAS v4u*)(wk + ((size_t)(j * 16 + q) << 9));
#pragma unroll
                for (int q = 0; q < 4; ++q)
#pragma unroll
                    for (int j = 0; j < 4; ++j) PIN(wv[q][j]);
#pragma unroll
                for (int q = 0; q < 4; ++q) { const LAS float* yp = Y5 + 32 * (kb + q) + 8 * fq; const f32x4 y0 = *(const LAS f32x4*)yp, y1 = *(const LAS f32x4*)(yp + 4);
#pragma unroll
                    for (int j = 0; j < 4; ++j) { float f[8]; unpack8(wv[q][j], f);
                        ga[j] += (f[0] * y0.x + f[1] * y0.y) + (f[2] * y0.z + f[3] * y0.w) + (f[4] * y1.x + f[5] * y1.y) + (f[6] * y1.z + f[7] * y1.w); } } }
            float mine = 0.f;
#pragma unroll
            for (int j = 0; j < 4; ++j) { float t = ga[j]; t += __shfl_xor(t, 16); t += __shfl_xor(t, 32); mine = (fq == j) ? t : mine; }
            { const int n = 64 * wave + lane; OUT[512 + n] = Y5[n] * sigmoid_f(bgl + mine); } } }
    BLOCK_SYNC();
    if (wave < 4) { float v[8]; float sq = 0.f;
#pragma unroll
        for (int e = 0; e < 8; ++e) { v[e] = OUT[512 * wave + 8 * lane + e]; sq += v[e] * v[e]; }
        const float rs = __builtin_amdgcn_rsqf(wave_sum(sq) * (1.0f / 512.0f) + EPS);
        v4u o; o.x = cvtpk(v[0] * rs, v[1] * rs); o.y = cvtpk(v[2] * rs, v[3] * rs); o.z = cvtpk(v[4] * rs, v[5] * rs); o.w = cvtpk(v[6] * rs, v[7] * rs);
        *(GAS v4u*)((bf16*)(ws + WS_SA + SA_MIX) + sfrag(s, 512 * wave + 8 * lane, D)) = o; }
    BLOCK_SYNC();
}

__device__ __forceinline__ void att_prompt_unit(const Args& A, LAS unsigned char* lds, int l, int b, int hd, int qb, int tid, int lane, int wave) {
    asm volatile("" : "+v"(tid)); lane = tid & 63; wave = __builtin_amdgcn_readfirstlane(tid >> 6);
    unsigned char* ws = A.ws; const int fr = lane & 15, fq = lane >> 4, grow0 = b * T + qb * 128;
    const bf16* Q = (const bf16*)(ws + WS_Q) + (size_t)grow0 * D + hd * HDX; const bf16* K = (const bf16*)(ws + WS_KB) + ((size_t)l * MROWS + b * NMEM) * D + hd * HDX;
    const bf16* V = (const bf16*)(ws + WS_VT) + (((size_t)l * NB + b) * D + hd * HDX) * NMEM; bf16* O = (bf16*)(ws + WS_O) + (size_t)grow0 * D + hd * HDX;
    LAS unsigned char* PS = lds; LAS unsigned char* KS = lds + 67584; LAS unsigned char* QS = lds + 104448; LAS unsigned char* VS = lds + 67584;
    f32x4 acc[16];
#pragma unroll
    for (int i = 0; i < 16; ++i) acc[i] = (f32x4){0.f, 0.f, 0.f, 0.f};
#pragma unroll 1
    for (int ds = 0; ds < 8; ++ds) {
        { v4u tk[4], tq[2];
#pragma unroll
            for (int i = 0; i < 4; ++i) { const int id = tid + NTHR * i, key = id >> 3, part = id & 7; tk[i] = *(const GAS v4u*)(K + (size_t)key * D + 64 * ds + 8 * part); }
#pragma unroll
            for (int i = 0; i < 2; ++i) { const int id = tid + NTHR * i, r = id >> 3, part = id & 7; tq[i] = *(const GAS v4u*)(Q + (size_t)r * D + 64 * ds + 8 * part); }
#pragma unroll
            for (int i = 0; i < 4; ++i) PIN(tk[i]);
            PIN(tq[0]); PIN(tq[1]);
#pragma unroll
            for (int i = 0; i < 4; ++i) { const int id = tid + NTHR * i, key = id >> 3, part = id & 7; *(LAS v4u*)(KS + (key * 72 + 8 * part) * 2) = tk[i]; }
#pragma unroll
            for (int i = 0; i < 2; ++i) { const int id = tid + NTHR * i, r = id >> 3, part = id & 7; *(LAS v4u*)(QS + (r * 72 + 8 * part) * 2) = tq[i]; } }
        BLOCK_SYNC();
#pragma unroll
        for (int ks = 0; ks < 2; ++ks) { const bf16x8 fa = ldsfrag(QS + ((16 * wave + fr) * 72 + 32 * ks + 8 * fq) * 2);
#pragma unroll
            for (int kt = 0; kt < 16; ++kt) acc[kt] = mfma16(fa, ldsfrag(KS + ((16 * kt + fr) * 72 + 32 * ks + 8 * fq) * 2), acc[kt]); }
        BLOCK_SYNC();
    }
    float inv[4]; const float scale = 0.044194173824159216f;
#pragma unroll
    for (int e = 0; e < 4; ++e) { float m = acc[0][e];
#pragma unroll
        for (int kt = 1; kt < 16; ++kt) m = fmaxf(m, acc[kt][e]);
        m = max16(m); float sum = 0.f;
#pragma unroll
        for (int kt = 0; kt < 16; ++kt) { const float p = __expf((acc[kt][e] - m) * scale); sum += p; *(LAS bf16*)(PS + ((16 * wave + 4 * fq + e) * 264 + 16 * kt + fr) * 2) = f2b(p); }
        inv[e] = __builtin_amdgcn_rcpf(sum16(sum)); }
#pragma unroll 1
    for (int ds = 0; ds < 8; ++ds) {
        { v4u tv[4];
#pragma unroll
            for (int i = 0; i < 4; ++i) { const int id = tid + NTHR * i, dr = id >> 5, part = id & 31; tv[i] = *(const GAS v4u*)(V + (size_t)(64 * ds + dr) * NMEM + 8 * part); }
#pragma unroll
            for (int i = 0; i < 4; ++i) PIN(tv[i]);
#pragma unroll
            for (int i = 0; i < 4; ++i) { const int id = tid + NTHR * i, dr = id >> 5, part = id & 31; *(LAS v4u*)(VS + (dr * 264 + 8 * part) * 2) = tv[i]; } }
        BLOCK_SYNC();
        f32x4 o[4] = {(f32x4){0.f, 0.f, 0.f, 0.f}, (f32x4){0.f, 0.f, 0.f, 0.f}, (f32x4){0.f, 0.f, 0.f, 0.f}, (f32x4){0.f, 0.f, 0.f, 0.f}};
#pragma unroll
        for (int ks = 0; ks < 8; ++ks) { const bf16x8 fa = ldsfrag(PS + ((16 * wave + fr) * 264 + 32 * ks + 8 * fq) * 2);
#pragma unroll
            for (int dt = 0; dt < 4; ++dt) o[dt] = mfma16(fa, ldsfrag(VS + ((16 * dt + fr) * 264 + 32 * ks + 8 * fq) * 2), o[dt]); }
#pragma unroll
        for (int dt = 0; dt < 4; ++dt)
#pragma unroll
            for (int e = 0; e < 4; ++e) O[(size_t)(16 * wave + 4 * fq + e) * D + 64 * ds + 16 * dt + fr] = f2b(o[dt][e] * inv[e]);
        BLOCK_SYNC();
    }
}
__device__ __forceinline__ void att_sample_unit(const Args& A, LAS unsigned char* lds, int l, int s, int hp, int tid, int lane, int wave) {
    asm volatile("" : "+v"(tid)); lane = tid & 63; wave = __builtin_amdgcn_readfirstlane(tid >> 6);
    unsigned char* ws = A.ws; const bf16* Q = (const bf16*)(ws + WS_Q) + (size_t)(MP + s) * D + hp * 1024;
    const float* K = A.in[I_CK] + (((size_t)l * MS + s) * NMEM) * D + hp * 1024; const float* V = A.in[I_CV] + (((size_t)l * MS + s) * NMEM) * D + hp * 1024;
    LAS float* SC = (LAS float*)lds; LAS float* RED = (LAS float*)(lds + 2048);
    f32x4 q[4];
#pragma unroll
    for (int j = 0; j < 4; ++j) { const v2u w = *(const GAS v2u*)(Q + 4 * lane + 256 * j); q[j] = (f32x4){bf_lo(w.x), bf_hi(w.x), bf_lo(w.y), bf_hi(w.y)}; }
#pragma unroll 1
    for (int kk = 0; kk < 32; kk += 8) { f32x4 kv[8][4];
        const char* kp = (const char*)(K + (size_t)(32 * wave + kk) * D) + (size_t)lane * 16; asm volatile("" : "+v"(kp));
#pragma unroll
        for (int i = 0; i < 8; ++i)
#pragma unroll
            for (int j = 0; j < 4; ++j) kv[i][j] = __builtin_nontemporal_load((const GAS f32x4*)(kp + (size_t)i * (D * 4) + j * 1024));
#pragma unroll
        for (int i = 0; i < 8; ++i)
#pragma unroll
            for (int j = 0; j < 4; ++j) PIN(kv[i][j]);
#pragma unroll
        for (int i = 0; i < 8; ++i) { const f32x4 a = kv[i][0], b2 = kv[i][1], c = kv[i][2], d = kv[i][3];
            float p0 = (a.x * q[0].x + a.y * q[0].y) + (a.z * q[0].z + a.w * q[0].w) + (b2.x * q[1].x + b2.y * q[1].y) + (b2.z * q[1].z + b2.w * q[1].w);
            float p1 = (c.x * q[2].x + c.y * q[2].y) + (c.z * q[2].z + c.w * q[2].w) + (d.x * q[3].x + d.y * q[3].y) + (d.z * q[3].z + d.w * q[3].w);
            p0 = wave_sum(p0); p1 = wave_sum(p1);
            if (lane == 0) { SC[32 * wave + kk + i] = p0; SC[256 + 32 * wave + kk + i] = p1; } } }
    BLOCK_SYNC();
    if (wave < 2) { const float scale = 0.044194173824159216f; float v[4]; float m = -3.0e38f;
#pragma unroll
        for (int e = 0; e < 4; ++e) { v[e] = SC[256 * wave + lane + 64 * e]; m = fmaxf(m, v[e]); }
        m = wave_max(m);
        float sum = 0.f;
#pragma unroll
        for (int e = 0; e < 4; ++e) { v[e] = __expf((v[e] - m) * scale); sum += v[e]; }
        const float inv = __builtin_amdgcn_rcpf(wave_sum(sum));
#pragma unroll
        for (int e = 0; e < 4; ++e) SC[256 * wave + lane + 64 * e] = v[e] * inv; }
    BLOCK_SYNC();
    f32x4 o[4] = {(f32x4){0.f, 0.f, 0.f, 0.f}, (f32x4){0.f, 0.f, 0.f, 0.f}, (f32x4){0.f, 0.f, 0.f, 0.f}, (f32x4){0.f, 0.f, 0.f, 0.f}};
#pragma unroll 1
    for (int kk = 0; kk < 32; kk += 8) { f32x4 vv[8][4];
        const char* vp = (const char*)(V + (size_t)(32 * wave + kk) * D) + (size_t)lane * 16; asm volatile("" : "+v"(vp));
#pragma unroll
        for (int i = 0; i < 8; ++i)
#pragma unroll
            for (int j = 0; j < 4; ++j) vv[i][j] = __builtin_nontemporal_load((const GAS f32x4*)(vp + (size_t)i * (D * 4) + j * 1024));
#pragma unroll
        for (int i = 0; i < 8; ++i)
#pragma unroll
            for (int j = 0; j < 4; ++j) PIN(vv[i][j]);
#pragma unroll
        for (int i = 0; i < 8; ++i) { const float p0 = SC[32 * wave + kk + i], p1 = SC[256 + 32 * wave + kk + i]; o[0] += vv[i][0] * p0; o[1] += vv[i][1] * p0; o[2] += vv[i][2] * p1; o[3] += vv[i][3] * p1; } }
#pragma unroll
    for (int j = 0; j < 4; ++j) *(LAS f32x4*)(RED + wave * 1024 + 4 * lane + 256 * j) = o[j];
    BLOCK_SYNC();
    { float a0 = 0.f, a1 = 0.f;
#pragma unroll
        for (int w = 0; w < 8; ++w) { const f32x2 v = *(const LAS f32x2*)(RED + w * 1024 + 2 * tid); a0 += v.x; a1 += v.y; }
        *(GAS unsigned*)((bf16*)(ws + WS_SA + SA_O) + sfrag(s, hp * 1024 + 2 * tid, D)) = cvtpk(a0, a1); }
    BLOCK_SYNC();
}

struct SEpiScale {
    bf16* O; int ldc; const unsigned long long* ssq; int act, frag;
    __device__ __forceinline__ void operator()(const f32x4& acc, int r, int c) const { const float rs = pg8::ssq_rstd(ssq[MP + r]); f32x4 v = acc * rs;
        if (act) {
#pragma unroll
            for (int e = 0; e < 4; ++e) { const float a = v[e] > 0.f ? v[e] : 0.f; v[e] = a * a; } }
        v2u w; w.x = cvtpk(v[0], v[1]); w.y = cvtpk(v[2], v[3]); *(GAS v2u*)(O + (frag ? sfrag(r, c, ldc) : (size_t)(MP + r) * ldc + c)) = w; }
};
struct SEpiRes {
    const float* hin; float* h; bf16* hb; bf16* hbf; unsigned long long* ssq_out;
    __device__ __forceinline__ void operator()(const f32x4& acc, int r, int c) const { float* hp = h + (size_t)(MP + r) * D + c; const f32x4 v = *(const GAS f32x4*)(hin + (size_t)r * D + c) + acc; *(GAS f32x4*)hp = v;
        v2u w; w.x = cvtpk(v[0], v[1]); w.y = cvtpk(v[2], v[3]); *(GAS v2u*)(hb + (size_t)(MP + r) * D + c) = w; *(GAS v2u*)(hbf + sfrag(r, c, D)) = w;
        float sq = (v[0] * v[0] + v[1] * v[1]) + (v[2] * v[2] + v[3] * v[3]); sq += __shfl_xor(sq, 16); sq += __shfl_xor(sq, 32);
        if ((threadIdx.x & 48) == 0) pg8::ssq_add(ssq_out + MP + r, sq); }
};
constexpr int SG_RED_OFF = 32 * 4112;
static_assert(SG_RED_OFF + 4096 <= LDSCTL_OFF, "sample_gemm LDS");
template <int ROWS, class Epi> __device__ __forceinline__ void sample_gemm(LAS unsigned char* lds, const bf16* Af, const bf16* Bt, int N, int K, const Epi& E, int nwg_main, int kq, int bx, int G, int tid) {
    asm volatile("" : "+v"(tid)); const int lane = tid & 63, wave = __builtin_amdgcn_readfirstlane(tid >> 6), fr = lane & 15, fq = lane >> 4;
    constexpr int RG = 128 / ROWS;
    const int first = nwg_main % G, ns = first ? G - first : G, nunits = (N / 32) * RG;
    int u0, st, cnt;
    if (first == 0) { u0 = bx; st = G; cnt = u0 < nunits ? (nunits - u0 + st - 1) / st : 0; }
    else if (bx >= first) { u0 = bx - first; st = ns; cnt = u0 < nunits ? (nunits - u0 + st - 1) / st : 0; cnt = cnt < kq ? cnt : kq; }
    else { u0 = ns * kq + bx; st = first; cnt = u0 < nunits ? (nunits - u0 + st - 1) / st : 0; }
    if (cnt == 0) return;
    const int rtl = ROWS == 128 ? wave : ((wave & 3) >> 1), ctw = ROWS == 128 ? 0 : (wave & 1), kh = ROWS == 128 ? 0 : (wave >> 2);
#pragma unroll 1
    for (int j = 0; j < cnt; ++j) { const int u = u0 + j * st, cg = u / RG, rg = u % RG, c0 = 32 * cg, R = rg * (ROWS / 16) + rtl;
        f32x4 acc0 = (f32x4){0.f, 0.f, 0.f, 0.f}, acc1 = (f32x4){0.f, 0.f, 0.f, 0.f};
#pragma unroll 1
        for (int kc = 0; kc < K; kc += 2048) {
            const char* apu = (const char*)(Af + ((size_t)(R * (K >> 5) + ((kc + kh * 1024) >> 5)) << 9)) + (size_t)lane * 16; asm volatile("" : "+v"(apu));
            const char* bsrc = (const char*)(Bt + (size_t)(c0 + 4 * wave) * K + kc) + (size_t)lane * 16; asm volatile("" : "+v"(bsrc));
            LAS unsigned char* bdst = lds + wave * (4 * 4112);
            BLOCK_SYNC();
#pragma unroll
            for (int r = 0; r < 4; ++r) { const char* rowp = bsrc + (size_t)r * K * 2; asm volatile("" : "+v"(rowp));
#pragma unroll
                for (int seg = 0; seg < 4; ++seg) __builtin_amdgcn_global_load_lds((const unsigned*)(rowp + seg * 1024), (LAS unsigned*)(bdst + r * 4112 + seg * 1024), 16, 0, 0); }
            bf16x8 a[32];
#pragma unroll
            for (int i = 0; i < 32; ++i) a[i] = *(const bf16x8*)(apu + (size_t)i * 1024);
#pragma unroll
            for (int i = 0; i < 32; ++i) PIN(a[i]);
            BLOCK_SYNC();
            if constexpr (ROWS == 32) {
                const LAS unsigned char* bp = lds + (16 * ctw + fr) * 4112 + kh * 2048 + 16 * fq;
#pragma unroll
                for (int i = 0; i < 32; i += 2) { acc0 = mfma16(ldsfrag(bp + 64 * i), a[i], acc0); acc1 = mfma16(ldsfrag(bp + 64 * (i + 1)), a[i + 1], acc1); }
            } else {
                const LAS unsigned char* bp = lds + fr * 4112 + 16 * fq;
#pragma unroll
                for (int i = 0; i < 32; ++i) { acc0 = mfma16(ldsfrag(bp + 64 * i), a[i], acc0); acc1 = mfma16(ldsfrag(bp + 16 * 4112 + 64 * i), a[i], acc1); }
                const char* apu2 = apu + 32 * 1024; asm volatile("" : "+v"(apu2), "+v"(acc0), "+v"(acc1));
#pragma unroll
                for (int i = 0; i < 32; ++i) a[i] = *(const bf16x8*)(apu2 + (size_t)i * 1024);
#pragma unroll
                for (int i = 0; i < 32; ++i) PIN(a[i]);
#pragma unroll
                for (int i = 0; i < 32; ++i) { acc0 = mfma16(ldsfrag(bp + 64 * (32 + i)), a[i], acc0); acc1 = mfma16(ldsfrag(bp + 16 * 4112 + 64 * (32 + i)), a[i], acc1); }
            } }
        if constexpr (ROWS == 32) {
            f32x4 acc = acc0 + acc1; LAS f32x4* red = (LAS f32x4*)(lds + SG_RED_OFF) + (wave & 3) * 64 + lane;
            if (kh == 1) *red = acc;
            BLOCK_SYNC();
            if (kh == 0) { acc += *red; E(acc, 32 * rg + 16 * rtl + fr, c0 + 16 * ctw + 4 * fq); }
        } else { E(acc0, 16 * wave + fr, c0 + 4 * fq); E(acc1, 16 * wave + fr, c0 + 16 + 4 * fq); } }
    BLOCK_SYNC();
}

__device__ __forceinline__ void final_norm(const Args& A, int vcu, int G, int wave, int lane, int mb = 0) {
    asm volatile("" : "+v"(lane));
    unsigned char* ws = A.ws; const float* H = (const float*)(ws + WS_H); const unsigned long long* ssq = (const unsigned long long*)((const unsigned*)(ws + WS_CTL) + CW_SSQ) + 6 * MPAD; const int gw = vcu * NWAVES + wave, NGW = G * NWAVES;
    f32x4 g[8];
#pragma unroll
    for (int j = 0; j < 8; ++j) g[j] = ((const GAS f32x4*)A.in[I_G_FINAL])[lane + 64 * j];
#pragma unroll 1
    for (int m0 = mb + gw; m0 < MR; m0 += 2 * NGW) { const int m1 = m0 + NGW; const bool has1 = m1 < MR; const int m1c = has1 ? m1 : m0;
        const GAS f32x4* h0 = (const GAS f32x4*)(H + (size_t)m0 * D) + lane; const GAS f32x4* h1 = (const GAS f32x4*)(H + (size_t)m1c * D) + lane; f32x4 v0[8], v1[8];
        const GAS v2u* b0 = (const GAS v2u*)((const bf16*)(ws + WS_HB) + (size_t)m0 * D) + lane; const GAS v2u* b1 = (const GAS v2u*)((const bf16*)(ws + WS_HB) + (size_t)m1c * D) + lane;
        if (m0 < MP) {
#pragma unroll
            for (int j = 0; j < 8; ++j) { const v2u w = b0[64 * j]; v0[j] = (f32x4){bf_lo(w.x), bf_hi(w.x), bf_lo(w.y), bf_hi(w.y)}; } }
        else {
#pragma unroll
            for (int j = 0; j < 8; ++j) v0[j] = __builtin_nontemporal_load(h0 + 64 * j); }
        if (m1c < MP) {
#pragma unroll
            for (int j = 0; j < 8; ++j) { const v2u w = b1[64 * j]; v1[j] = (f32x4){bf_lo(w.x), bf_hi(w.x), bf_lo(w.y), bf_hi(w.y)}; } }
        else {
#pragma unroll
            for (int j = 0; j < 8; ++j) v1[j] = __builtin_nontemporal_load(h1 + 64 * j); }
        const float rs0 = pg8::ssq_rstd(ssq[m0]), rs1 = pg8::ssq_rstd(ssq[m1c]);
#pragma unroll
        for (int j = 0; j < 8; ++j) { PIN(v0[j]); PIN(v1[j]); }
        GAS f32x4* o0 = (GAS f32x4*)(A.out + (m0 < MP ? O_YP + (size_t)m0 * D : O_YS + (size_t)(m0 - MP) * D)) + lane;
#pragma unroll
        for (int j = 0; j < 8; ++j) __builtin_nontemporal_store(v0[j] * g[j] * rs0, o0 + 64 * j);
        if (has1) { GAS f32x4* o1 = (GAS f32x4*)(A.out + (m1 < MP ? O_YP + (size_t)m1 * D : O_YS + (size_t)(m1 - MP) * D)) + lane;
#pragma unroll
            for (int j = 0; j < 8; ++j) __builtin_nontemporal_store(v1[j] * g[j] * rs1, o1 + 64 * j); } }
}

#ifndef PROBE_P0
#define PROBE_P0 1
#endif
#ifndef PROBE_MA
#define PROBE_MA 1
#endif
#ifndef PROBE_MC
#define PROBE_MC 1
#endif
#ifndef PROBE_ATT
#define PROBE_ATT 1
#endif
#ifndef PROBE_BAR
#define PROBE_BAR 1
#endif
#ifndef PROBE_KV
#define PROBE_KV 1
#endif
#ifndef PROBE_RES_O
#define PROBE_RES_O 0
#endif
#ifndef PROBE_RES_DOWN
#define PROBE_RES_DOWN 0
#endif
#ifndef PROBE_THIN
#define PROBE_THIN 0
#endif
#ifndef PROBE_SG_IN
#define PROBE_SG_IN 1
#endif
#ifndef PROBE_SG_Q
#define PROBE_SG_Q 1
#endif
#ifndef PROBE_SG_UP
#define PROBE_SG_UP 1
#endif
#ifndef PROBE_UP
#define PROBE_UP 1
#endif
#ifndef PROBE_Q
#define PROBE_Q 1
#endif
constexpr int PH_PER_LAYER = 10, PH_L0 = 3, PH_FINAL = PH_L0 + NL * PH_PER_LAYER, NPHASE = PH_FINAL + 1;
__global__ void __launch_bounds__(NTHR, 2) mk_fwd(Args args) {
    extern __shared__ __attribute__((aligned(16))) unsigned char lds_raw[];
    LAS unsigned char* lds = (LAS unsigned char*)lds_raw;
    volatile LAS unsigned* MISC = (volatile LAS unsigned*)(lds + MISC_OFF);
    int tid = threadIdx.x, lane = tid & 63, wave = __builtin_amdgcn_readfirstlane(tid >> 6);
#define RETID() do { asm volatile("" : "+v"(tid)); lane = tid & 63; wave = __builtin_amdgcn_readfirstlane(tid >> 6); asm volatile("" : "+s"(ws)); } while (0)
    const int G = gridDim.x; const int bx = blockIdx.x; const int vcu = (G % 8 == 0) ? (bx % 8) * (G / 8) + bx / 8 : bx;
    unsigned char* ws = args.ws;
    for (int u = tid; u < (LDS_BYTES - LDSCTL_OFF) / 4; u += NTHR) ((LAS unsigned*)(lds + LDSCTL_OFF))[u] = 0u;
    __syncthreads();
    XcdBarrier bar; bar.bar = (unsigned*)(ws + WS_CTL) + CW_BAR; bar.x = 0; bar.st = nullptr;
    if (!MK_PER_PHASE) bar = xcd_barrier_post((unsigned*)(ws + WS_CTL) + CW_BAR, MISC + 8);
    const int lo = args.ph_lo, hi = args.ph_hi;
#ifdef ONLY_PH
#define IN(k) (((k) < PH_L0 || (k) >= PH_FINAL) ? ((k) == ONLY_PH) : (((k) - PH_L0) % PH_PER_LAYER + PH_L0 == ONLY_PH) && lo <= (k) && (k) < hi)
#else
#define IN(k) (lo <= (k) && (k) < hi)
#endif
#define GRID_BAR() do { if (!MK_PER_PHASE) { for (int rep_ = 0; rep_ < PROBE_BAR; ++rep_) xcd_barrier(bar); } } while (0)
#define SSQ(s) ((unsigned long long*)((unsigned*)(ws + WS_CTL) + CW_SSQ) + (s) * MPAD)
    if (IN(0)) { RETID(); for (int rep = 0; rep < PROBE_P0; ++rep) { p0_prologue(args, lds, vcu, G, wave, lane); __syncthreads(); } GRID_BAR(); }
    if (IN(1)) { RETID();
        pg8::Gemm g{(const bf16*)(ws + WS_MEMB), (const bf16*)(ws + WS_WKV), MROWS, 4 * D, D}; pg8::StaticOrder S; S.init(MROWS, 4 * D, G, bx);
        pg8::EpiKV E{args.out + O_PMK, (size_t)(O_PMV - O_PMK), (bf16*)(ws + WS_KB), (bf16*)(ws + WS_VT), (bf16*)(ws + WS_VB), (const float*)(ws + WS_RSTDM)};
        for (int rep = 0; rep < PROBE_KV; ++rep) pg8::gemm_phase<pg8::EpiKV, pg8::StaticOrder, true, true>(lds + RING_OFF, g, S, E, tid);
        if (G == 256 && bx >= 128) p0_weights(args, lds, (bx - 128) * NWAVES + wave, 128 * NWAVES, P0W_DEF_LO, P0W_DEF_N, 1 << 30, 0, wave, lane);
        GRID_BAR(); }
#define SETUP_LAYER(LL, GG, CC) do { const int ll_ = (LL); pg8::Gemm g{nullptr, nullptr, 1024, 2048, 512, 2048, 2048}; \
        pg8::PreOrder S{(GG), (CC), (const bf16*)(ws + WS_KB) + (size_t)ll_ * 1024 * 2048, (const bf16*)(ws + WS_WQKD) + (size_t)ll_ * 2048 * 2048, (const bf16*)(ws + WS_W + (size_t)ll_ * W_L + WO_O), (const bf16*)(ws + WS_VB) + (size_t)ll_ * 1024 * 2048}; \
        pg8::EpiPre E{(bf16*)(ws + WS_WQK) + (size_t)ll_ * 4 * 1024 * 2048, (bf16*)(ws + WS_VWT) + (size_t)ll_ * 4 * 2048 * 1024}; \
        pg8::gemm_phase<pg8::EpiPre, pg8::PreOrder, true, true>(lds + RING_OFF, g, S, E, tid); } while (0)
    if (IN(2)) { RETID();
        SETUP_LAYER(0, G, bx);
        SETUP_LAYER(1, G, bx);
        asm volatile("s_waitcnt vmcnt(0)" ::: "memory"); __syncthreads(); }
#pragma unroll 1
    for (int l = 0; l < NL; ++l) {
        const int pb = PH_L0 + l * PH_PER_LAYER; const bf16* wl = (const bf16*)(ws + WS_W + (size_t)l * W_L);
#define GEMM_MAIN(EPI, Aptr, Woff, NN, KK, ...) do { pg8::Gemm g{(const bf16*)(Aptr), (const bf16*)((const unsigned char*)wl + (Woff)), MP, (NN), (KK)}; pg8::StaticOrder S; S.init(MP, (NN), G, bx); \
            EPI E{__VA_ARGS__}; pg8::gemm_phase<EPI, pg8::StaticOrder, true, true>(lds + RING_OFF, g, S, E, tid); } while (0)
        if (IN(pb + 0)) { RETID();
#ifndef NO_DT
            dt_rows(args, lds, l, vcu, G, tid); for (int rep = 0; rep < PROBE_THIN; ++rep) dt_rows(args, lds, l, vcu, G, tid);
#endif
            GEMM_MAIN(pg8::EpiScaleBf16<0>, ws + WS_HB, WO_IN, NIN, D, (bf16*)(ws + WS_PROJ), NIN, SSQ(3 * l));
            for (int rep = 0; rep < PROBE_SG_IN; ++rep)
            sample_gemm<128>(lds, (const bf16*)(ws + WS_SA + SA_HB), (const bf16*)((const unsigned char*)wl + WO_IN), NIN, D, SEpiScale{(bf16*)(ws + WS_PROJ), NIN, SSQ(3 * l), 0, 0}, (MP / 256) * (NIN / 256), 4, bx, G, tid);
            GRID_BAR(); }
        if (IN(pb + 1)) { RETID();
            for (int rep = 0; rep < PROBE_MA; ++rep)
#pragma unroll 1
            for (int u = vcu; u < 512; u += G) { if (u < 256) ma_s5_unit(args, lds, l, u >> 6, u & 63, lane, wave); else { const int v = u - 256; ma_ssd_unit(args, lds, l, v >> 6, (v >> 1) & 31, v & 1, tid, lane, wave); } }
            GRID_BAR(); }
        if (IN(pb + 2)) { RETID(); mb_scan(args, l, vcu, G, tid); for (int rep = 0; rep < PROBE_THIN; ++rep) mb_scan(args, l, vcu, G, tid, 1); GRID_BAR(); }
        if (IN(pb + 3)) { RETID();
            for (int rep = 0; rep < PROBE_MC; ++rep)
#pragma unroll 1
            for (int u = vcu; u < 512; u += G) {
#ifndef NO_MC_S5
                if (u < 256) mc_s5_unit(args, lds, l, u >> 6, u & 63, tid, lane, wave); else
#endif
#ifndef NO_MC_REST
                if (u >= 256 && ((u - 256) & 1) == 0) { const int v = (u - 256) >> 1; mc_rest_unit(args, lds, l, v >> 5, v & 31, tid, lane, wave); } else
#endif
#ifndef NO_MC_SAMPLE
                if (u >= 256 && ((u - 256) & 1) != 0) mc_sample_unit(args, lds, l, (u - 256) >> 1, tid, lane, wave);
#endif
                { } }
            GRID_BAR(); }
        if (IN(pb + 4)) { RETID();
            GEMM_MAIN(pg8::EpiResB, ws + WS_MIX, WO_OUT, D, D, (bf16*)(ws + WS_HB), SSQ(3 * l + 1), D, (l == 0 ? args.in[I_XP] : (const float*)nullptr));
            sample_gemm<32>(lds, (const bf16*)(ws + WS_SA + SA_MIX), (const bf16*)((const unsigned char*)wl + WO_OUT), D, D, SEpiRes{(l == 0 ? args.in[I_XS] : (const float*)(ws + WS_H) + (size_t)MP * D), (float*)(ws + WS_H), (bf16*)(ws + WS_HB), (bf16*)(ws + WS_SA + SA_HB), SSQ(3 * l + 1)}, (MP / 256) * (D / 256), 1, bx, G, tid);
            if (G == 256) {
                GRID_BAR();
                sample_gemm<32>(lds, (const bf16*)(ws + WS_SA + SA_HB), (const bf16*)((const unsigned char*)wl + WO_Q), D, D, SEpiScale{(bf16*)(ws + WS_Q), D, SSQ(3 * l + 1), 0, 0}, 0, 1, bx, G, tid); }
            GRID_BAR(); }
        if (IN(pb + 5)) { RETID();
            { pg8::Gemm g{(const bf16*)(ws + WS_HB), (const bf16*)(ws + WS_WQK) + (size_t)l * 4 * 1024 * 2048, MP, 1024, D}; pg8::BatchBOrder S; S.init(MP, 1024, G, bx); S.pmb = 8; S.bbs = (size_t)1024 * 2048;
                pg8::EpiSoftmax E{(bf16*)(ws + WS_PATT), 1024, SSQ(3 * l + 1), 0.044194173824159216f};
                pg8::gemm_phase<pg8::EpiSoftmax, pg8::BatchBOrder, false, true>(lds + RING_OFF, g, S, E, tid); }
            if (G == 256) { if (bx >= 128) att_sample_unit(args, lds, l, bx - 128, 0, tid, lane, wave); }
            else
            sample_gemm<32>(lds, (const bf16*)(ws + WS_SA + SA_HB), (const bf16*)((const unsigned char*)wl + WO_Q), D, D, SEpiScale{(bf16*)(ws + WS_Q), D, SSQ(3 * l + 1), 0, 0}, 128, 2, bx, G, tid);
            GRID_BAR(); }
        if (IN(pb + 6)) { RETID();
            if (bx < 128 || G != 256) { pg8::Gemm g{(const bf16*)(ws + WS_PATT), (const bf16*)(ws + WS_VWT) + (size_t)l * 4 * 2048 * 1024, MP, D, 1024}; pg8::BatchBOrder S; S.init(MP, D, G == 256 ? 128 : G, bx); S.pmb = 8; S.bbs = (size_t)2048 * 1024;
                pg8::EpiResB E{(bf16*)(ws + WS_HB), SSQ(3 * l + 2), D, nullptr};
                pg8::gemm_phase<pg8::EpiResB, pg8::BatchBOrder, true, true>(lds + RING_OFF, g, S, E, tid); }
            if (bx >= 128 || G != 256) {
#pragma unroll 1
                for (int i = (G == 256) ? 1 : 0; i < 2; ++i) for (int c = (G == 256 ? bx - 128 : bx); c < 128; c += (G == 256 ? 128 : G)) { const int u = c * 2 + i; att_sample_unit(args, lds, l, u >> 1, u & 1, tid, lane, wave); }
                }
            GRID_BAR(); }
        if (IN(pb + 7)) { RETID();
            sample_gemm<32>(lds, (const bf16*)(ws + WS_SA + SA_O), (const bf16*)((const unsigned char*)wl + WO_O), D, D, SEpiRes{(const float*)(ws + WS_H) + (size_t)MP * D, (float*)(ws + WS_H), (bf16*)(ws + WS_HB), (bf16*)(ws + WS_SA + SA_HB), SSQ(3 * l + 2)}, 0, 1, bx, G, tid);
            GRID_BAR(); }
        if (IN(pb + 8)) { RETID();
            for (int rep = 0; rep < PROBE_UP; ++rep)
            GEMM_MAIN(pg8::EpiScaleBf16<1>, ws + WS_HB, WO_UP, FF, D, (bf16*)(ws + WS_HID), FF, SSQ(3 * l + 2));
            for (int rep = 0; rep < PROBE_SG_UP; ++rep)
            sample_gemm<128>(lds, (const bf16*)(ws + WS_SA + SA_HB), (const bf16*)((const unsigned char*)wl + WO_UP), FF, D, SEpiScale{(bf16*)(ws + WS_SA + SA_HID), FF, SSQ(3 * l + 2), 1, 1}, (MP / 256) * (FF / 256), 1, bx, G, tid);
            GRID_BAR(); }
        if (IN(pb + 9)) { RETID();
#define SFIRST() ([&]() { pg8::StaticOrder S0; S0.init(MP, D, G, bx); pg8::Unit u0; return G == 256 && S0.next(0, u0) && (u0.pm & 1) != 0; }())
            if (SFIRST()) { sample_gemm<32>(lds, (const bf16*)(ws + WS_SA + SA_HID), (const bf16*)((const unsigned char*)wl + WO_DOWN), D, FF, SEpiRes{(const float*)(ws + WS_H) + (size_t)MP * D, (float*)(ws + WS_H), (bf16*)(ws + WS_HB), (bf16*)(ws + WS_SA + SA_HB), SSQ(3 * l + 3)}, (MP / 256) * (D / 256), 1, bx, G, tid); }
            if (l == NL - 1 && G == 256) { pg8::Gemm g{(const bf16*)(ws + WS_HID), (const bf16*)((const unsigned char*)wl + WO_DOWN), MP, D, FF}; pg8::StaticOrder S; S.init(MP, D, G, bx);
                pg8::EpiResFinal E{(const bf16*)(ws + WS_HB), args.out + O_YP, args.in[I_G_FINAL], SSQ(3 * l + 3), (unsigned*)(ws + WS_CTL) + CW_FCNT, D};
                pg8::gemm_phase<pg8::EpiResFinal, pg8::StaticOrder, false, true>(lds + RING_OFF, g, S, E, tid); }
            else
            GEMM_MAIN(pg8::EpiResB, ws + WS_HID, WO_DOWN, D, FF, (bf16*)(ws + WS_HB), SSQ(3 * l + 3), D, nullptr);
            if (!SFIRST()) { sample_gemm<32>(lds, (const bf16*)(ws + WS_SA + SA_HID), (const bf16*)((const unsigned char*)wl + WO_DOWN), D, FF, SEpiRes{(const float*)(ws + WS_H) + (size_t)MP * D, (float*)(ws + WS_H), (bf16*)(ws + WS_HB), (bf16*)(ws + WS_SA + SA_HB), SSQ(3 * l + 3)}, (MP / 256) * (D / 256), 1, bx, G, tid); }
#undef SFIRST
            GRID_BAR(); }
#undef GEMM_MAIN
    }
    if (IN(PH_FINAL)) { final_norm(args, vcu, G, wave, lane, G == 256 ? MP : 0); }
#undef IN
#undef GRID_BAR
#undef SSQ
}

extern "C" void kernel_launch(void* const* d_in, const int* in_sizes, int n_in, void* d_out, int out_size, void* d_ws, size_t ws_size, hipStream_t stream) {
    static int grid = 0;
    if (grid == 0) {
        if (n_in != N_IN || in_sizes[0] != MP * D || (size_t)out_size != O_END || ws_size < WS_END) { fprintf(stderr, "kernel_launch: unexpected problem (n_in %d, in0 %d, out %d, ws %zu); nothing launched\n", n_in, n_in > 0 ? in_sizes[0] : -1, out_size, ws_size); grid = -1; return; }
        int dev = 0, cus = 0, per_cu = 0;
        if (hipGetDevice(&dev) != hipSuccess || hipDeviceGetAttribute(&cus, hipDeviceAttributeMultiprocessorCount, dev) != hipSuccess) { fprintf(stderr, "kernel_launch: device query failed\n"); grid = -1; return; }
        if (hipFuncSetAttribute((const void*)mk_fwd, hipFuncAttributeMaxDynamicSharedMemorySize, LDS_BYTES) != hipSuccess) { fprintf(stderr, "kernel_launch: hipFuncSetAttribute failed\n"); grid = -1; return; }
        if (hipOccupancyMaxActiveBlocksPerMultiprocessor(&per_cu, (const void*)mk_fwd, NTHR, LDS_BYTES) != hipSuccess || per_cu < 1) fprintf(stderr, "kernel_launch: note: occupancy query reports %d workgroups per CU\n", per_cu);
        (void)hipGetLastError();
        grid = cus;
    }
    if (grid < 0) return;
    if (hipMemsetAsync((char*)d_ws + WS_CTL, 0, CTL_ZERO_BYTES, stream) != hipSuccess) { fprintf(stderr, "kernel_launch: hipMemsetAsync failed\n"); return; }
    Args a{};
    for (int i = 0; i < N_IN; ++i) a.in[i] = (const float*)d_in[i];
    a.out = (float*)d_out; a.ws = (unsigned char*)d_ws;
#if MK_PER_PHASE
    for (int p = 0; p < NPHASE; ++p) { a.ph_lo = p; a.ph_hi = p + 1; hipLaunchKernelGGL(mk_fwd, dim3(grid), dim3(NTHR), LDS_BYTES, stream, a); }
#else
    a.ph_lo = 0; a.ph_hi = NPHASE; hipLaunchKernelGGL(mk_fwd, dim3(grid), dim3(NTHR), LDS_BYTES, stream, a);
#endif
    const hipError_t le = hipPeekAtLastError();
    if (le != hipSuccess) fprintf(stderr, "kernel_launch: launch failed: %s\n", hipGetErrorName(le));
}
```
